# Optimizing an MI355X kernel written in HIP

```python
import jax, jax.numpy as jnp
from jax import lax
import numpy as np

D_MODEL = 1024
BATCH = 4
SEQ = 4096
DEPTH = 2

CHUNK = 64
RMS_EPS = 1e-6
MLSTM_WIDTH = D_MODEL // 2
MLSTM_HEADS = 4
MLSTM_HEAD_DIM = MLSTM_WIDTH // MLSTM_HEADS
MLSTM_STAB_INIT = -1e30
SCONV_WIDTH = D_MODEL - MLSTM_WIDTH
SCONV_KERNEL = 3
S5_WIDTH = D_MODEL // 2
S5_GROUP_CH = 16
S5_GROUPS = S5_WIDTH // S5_GROUP_CH
S5_STATE = 64
HGRN_WIDTH = D_MODEL - S5_WIDTH
HGRN_HEADS = 4
HGRN_HEAD_DIM = HGRN_WIDTH // HGRN_HEADS
MOE_GROUPS = 4
MOE_EXPERTS_PER_GROUP = 8
MOE_EXPERTS = MOE_GROUPS * MOE_EXPERTS_PER_GROUP
MOE_TOP_K = 2
MOE_FF = D_MODEL // 4
AB_SIZES = (MLSTM_WIDTH,) * 4 + (MLSTM_HEADS,) * 2 + (SCONV_WIDTH,) * 3
CD_SIZES = (S5_WIDTH,) + (HGRN_WIDTH,) * 4

kernel_name = "hybrid_mlstm_conv_s5_hgrn2_hmoe"


def _offsets(sizes):
    return [int(v) for v in np.cumsum(sizes)[:-1]]


def rmsnorm(x, w):
    xf = x.astype(jnp.float32)
    y = xf * lax.rsqrt(jnp.mean(xf * xf, axis=-1, keepdims=True) + RMS_EPS)
    return (y * w.astype(jnp.float32)).astype(x.dtype)


def head_rmsnorm(h, w):
    return h * lax.rsqrt(jnp.mean(h * h, axis=-1, keepdims=True) + RMS_EPS) * w.astype(jnp.float32)


def to_chunks(t):
    b, s, h = t.shape[:3]
    t = t.reshape((b, s // CHUNK, CHUNK, h) + t.shape[3:])
    return t.transpose((1, 0, 3, 2) + tuple(range(4, t.ndim)))


def from_chunks(t):
    nc, b, h, l = t.shape[:4]
    t = t.transpose((1, 0, 3, 2) + tuple(range(4, t.ndim)))
    return t.reshape((b, nc * l, h) + t.shape[4:])


def mlstm_chunkwise(q, k, v, i_pre, f_pre):
    b, s, h, dh = q.shape
    causal = jnp.tril(jnp.ones((CHUNK, CHUNK), dtype=bool))
    xs = (to_chunks(q), to_chunks(k), to_chunks(v), to_chunks(i_pre),
          to_chunks(jax.nn.log_sigmoid(f_pre)))

    def step(carry, chunk):
        c_mat, n_vec, m = carry
        q_, k_, v_, i_, lf = chunk
        bcum = jnp.cumsum(lf, axis=-1)
        logw = jnp.where(causal, bcum[..., :, None] - bcum[..., None, :] + i_[..., None, :], -jnp.inf)
        inter = bcum + m[..., None]
        m_row = jnp.maximum(jnp.max(logw, axis=-1), inter)
        scores = jnp.einsum('bhld,bhsd->bhls', q_, k_) * jnp.exp(logw - m_row[..., None])
        inter_scale = jnp.exp(inter - m_row)
        num = (jnp.einsum('bhls,bhsd->bhld', scores, v_)
               + inter_scale[..., None] * jnp.einsum('bhek,bhlk->bhle', c_mat, q_))
        den = jnp.sum(scores, axis=-1) + inter_scale * jnp.einsum('bhk,bhlk->bhl', n_vec, q_)
        h_out = num / jnp.maximum(jnp.abs(den), jnp.exp(-m_row))[..., None]
        b_end = bcum[..., -1]
        logg = b_end[..., None] - bcum + i_
        m_new = jnp.maximum(b_end + m, jnp.max(logg, axis=-1))
        wk = jnp.exp(logg - m_new[..., None])
        decay = jnp.exp(b_end + m - m_new)
        c_new = decay[..., None, None] * c_mat + jnp.einsum('bhl,bhle,bhlk->bhek', wk, v_, k_)
        n_new = decay[..., None] * n_vec + jnp.einsum('bhl,bhlk->bhk', wk, k_)
        return (c_new, n_new, m_new), h_out

    init = (jnp.zeros((b, h, dh, dh), jnp.float32), jnp.zeros((b, h, dh), jnp.float32),
            jnp.full((b, h), MLSTM_STAB_INIT, jnp.float32))
    _, hs = lax.scan(step, init, xs)
    return from_chunks(hs)


def causal_dwconv(z, w):
    c = z.shape[-1]
    return lax.conv_general_dilated(z, w[:, None, :].astype(z.dtype), window_strides=(1,),
                                    padding=[(SCONV_KERNEL - 1, 0)],
                                    dimension_numbers=('NWC', 'WIO', 'NWC'),
                                    feature_group_count=c)


def mixer_ab(xn, w_in, gate_bias, head_norm, conv_w, w_out):
    bsz, s, _ = xn.shape
    proj = xn @ w_in
    q, k, v, o, ig, fg, gb, gc, xin = jnp.split(proj, _offsets(AB_SIZES), axis=-1)
    heads = lambda t: t.astype(jnp.float32).reshape(bsz, s, MLSTM_HEADS, MLSTM_HEAD_DIM)
    gbias = gate_bias.astype(jnp.float32)
    i_pre = ig.astype(jnp.float32) + gbias[:MLSTM_HEADS]
    f_pre = fg.astype(jnp.float32) + gbias[MLSTM_HEADS:]
    hm = mlstm_chunkwise(heads(q), heads(k) * (MLSTM_HEAD_DIM ** -0.5), heads(v), i_pre, f_pre)
    hm = head_rmsnorm(hm, head_norm.reshape(MLSTM_HEADS, MLSTM_HEAD_DIM)) * jax.nn.sigmoid(heads(o))
    hm = hm.reshape(bsz, s, MLSTM_WIDTH).astype(xn.dtype)
    yc = gb * causal_dwconv(gc * xin, conv_w)
    return jnp.concatenate([hm, yc], axis=-1) @ w_out


def s5_mixer(u, lam_re, lam_im, b_re, b_im, c_re, c_im, d_skip, log_dt, w_glu, b_glu):
    f32 = jnp.float32
    bsz, s, _ = u.shape
    uf = u.astype(f32).reshape(bsz, s, S5_GROUPS, S5_GROUP_CH)
    lam = lax.complex(lam_re.astype(f32), lam_im.astype(f32))
    dt = jnp.exp(log_dt.astype(f32))[:, None]
    lam_bar = jnp.exp(lam * dt)
    b_bar = ((lam_bar - 1.0) / lam)[..., None] * lax.complex(b_re.astype(f32), b_im.astype(f32))
    bu = jnp.einsum('bsgc,gpc->bsgp', uf.astype(jnp.complex64), b_bar)
    a = jnp.broadcast_to(lam_bar, bu.shape)

    def combine(e1, e2):
        a1, x1 = e1
        a2, x2 = e2
        return a2 * a1, a2 * x1 + x2

    _, states = lax.associative_scan(combine, (a, bu), axis=1)
    cmat = lax.complex(c_re.astype(f32), c_im.astype(f32))
    y = jnp.real(jnp.einsum('bsgp,gcp->bsgc', states, cmat)) + d_skip.astype(f32).reshape(S5_GROUPS, S5_GROUP_CH) * uf
    z = jax.nn.gelu(y.reshape(bsz, s, S5_WIDTH))
    return z * jax.nn.sigmoid(z @ w_glu.astype(f32) + b_glu.astype(f32))


def hgrn2_chunkwise(q, log_f, k, v):
    b, s, h, dk = q.shape
    dv = v.shape[-1]
    causal = jnp.tril(jnp.ones((CHUNK, CHUNK), dtype=bool))

    def step(state, chunk):
        q_, lf, k_, v_ = chunk
        bcum = jnp.cumsum(lf, axis=-2)
        diff = bcum[..., :, None, :] - bcum[..., None, :, :]
        decay = jnp.exp(jnp.where(causal[:, :, None], diff, -jnp.inf))
        attn = jnp.einsum('bhjk,bhjsk,bhsk->bhjs', q_, decay, k_)
        o = (jnp.einsum('bhjs,bhsv->bhjv', attn, v_)
             + jnp.einsum('bhjk,bhkv->bhjv', q_ * jnp.exp(bcum), state))
        b_end = bcum[..., -1, :]
        state_new = (jnp.exp(b_end)[..., None] * state
                     + jnp.einsum('bhsk,bhsv->bhkv', k_ * jnp.exp(b_end[..., None, :] - bcum), v_))
        return state_new, o

    init = jnp.zeros((b, h, dk, dv), jnp.float32)
    _, os_ = lax.scan(step, init, (to_chunks(q), to_chunks(log_f), to_chunks(k), to_chunks(v)))
    return from_chunks(os_)


def hgrn_lower_bound(lb_param, layer):
    sm = jax.nn.softmax(lb_param.astype(jnp.float32), axis=0)
    return jnp.cumsum(sm, axis=0)[layer] - sm[0]


def mixer_cd(xn, w_in, lam_re, lam_im, b_re, b_im, c_re, c_im, d_skip, log_dt, w_glu, b_glu,
             lower_bound, out_norm, w_out):
    bsz, s, _ = xn.shape
    proj = xn @ w_in
    u, q, fg, ig, og = jnp.split(proj, _offsets(CD_SIZES), axis=-1)
    y_s5 = s5_mixer(u, lam_re, lam_im, b_re, b_im, c_re, c_im, d_skip, log_dt, w_glu, b_glu)
    heads = lambda t: t.astype(jnp.float32).reshape(bsz, s, HGRN_HEADS, HGRN_HEAD_DIM)
    lb = lower_bound.reshape(HGRN_HEADS, HGRN_HEAD_DIM)
    log_f = jnp.logaddexp(jnp.log(lb), jnp.log1p(-lb) + jax.nn.log_sigmoid(heads(fg)))
    k = -jnp.expm1(log_f)
    o = hgrn2_chunkwise(heads(q), log_f, k, heads(ig))
    o = head_rmsnorm(o, out_norm.reshape(HGRN_HEADS, HGRN_HEAD_DIM)) * jax.nn.silu(heads(og))
    o = o.reshape(bsz, s, HGRN_WIDTH)
    mixed = jnp.concatenate([y_s5.astype(xn.dtype), o.astype(xn.dtype)], axis=-1)
    return mixed @ w_out


def hier_moe(xn, w_group, b_group, w_router, b_router, w_gate, w_up, w_down):
    f32 = jnp.float32
    bsz, s, d = xn.shape
    xf = xn.reshape(-1, d)
    t = xf.shape[0]
    grp_prob = jax.nn.softmax(xf.astype(f32) @ w_group.astype(f32) + b_group.astype(f32), axis=-1)
    g_val, g_idx = lax.top_k(grp_prob, 1)
    exp_logits = (xf.astype(f32) @ w_router.astype(f32) + b_router.astype(f32)).reshape(
        t, MOE_GROUPS, MOE_EXPERTS_PER_GROUP)
    sel = jnp.take_along_axis(exp_logits, g_idx[:, :, None], axis=1)[:, 0]
    e_val, e_idx = lax.top_k(jax.nn.softmax(sel, axis=-1), MOE_TOP_K)
    weights = g_val * e_val / jnp.sum(e_val, axis=-1, keepdims=True)
    expert_id = g_idx * MOE_EXPERTS_PER_GROUP + e_idx
    combine = jnp.einsum('tk,tke->te', weights, jax.nn.one_hot(expert_id, MOE_EXPERTS, dtype=f32))
    y = jnp.zeros((t, d), f32)
    for e in range(MOE_EXPERTS):
        hid = jax.nn.silu(xf @ w_gate[e]) * (xf @ w_up[e])
        y = y + combine[:, e:e + 1] * (hid @ w_down[e]).astype(f32)
    return y.astype(xn.dtype).reshape(bsz, s, d)


def setup_inputs(seed: int = 0) -> dict:
    key = jax.random.key(seed)
    ks = jax.random.split(key, 32)
    f32 = jnp.float32
    n_even = (DEPTH + 1) // 2
    n_odd = DEPTH // 2
    nrm = lambda k, shape, scale: jax.random.normal(k, shape, f32) * scale
    gain = lambda k, shape: 1.0 + nrm(k, shape, 0.05)
    d = D_MODEL
    gate_bias = jnp.concatenate(
        [nrm(ks[5], (n_even, MLSTM_HEADS), 0.1),
         jnp.linspace(3.0, 6.0, MLSTM_HEADS, dtype=f32)[None] + nrm(ks[6], (n_even, MLSTM_HEADS), 0.1)], axis=-1)
    lam_im = jnp.pi * jnp.arange(S5_STATE, dtype=f32)
    return {
        "x": nrm(ks[0], (BATCH, SEQ, d), 1.0),
        "norm_mix": gain(ks[1], (DEPTH, d)),
        "norm_ffn": gain(ks[2], (DEPTH, d)),
        "norm_final": gain(ks[3], (d,)),
        "ab_w_in": nrm(ks[4], (n_even, d, sum(AB_SIZES)), d ** -0.5),
        "ab_gate_bias": gate_bias,
        "ab_head_norm": gain(ks[7], (n_even, MLSTM_WIDTH)),
        "ab_conv_w": nrm(ks[8], (n_even, SCONV_KERNEL, SCONV_WIDTH), SCONV_KERNEL ** -0.5),
        "ab_w_out": nrm(ks[9], (n_even, MLSTM_WIDTH + SCONV_WIDTH, d), d ** -0.5),
        "cd_w_in": nrm(ks[10], (n_odd, d, sum(CD_SIZES)), d ** -0.5),
        "s5_lambda_re": -0.5 + nrm(ks[11], (n_odd, S5_GROUPS, S5_STATE), 0.01),
        "s5_lambda_im": lam_im + nrm(ks[12], (n_odd, S5_GROUPS, S5_STATE), 0.01),
        "s5_b_re": nrm(ks[13], (n_odd, S5_GROUPS, S5_STATE, S5_GROUP_CH), (2 * S5_GROUP_CH) ** -0.5),
        "s5_b_im": nrm(ks[14], (n_odd, S5_GROUPS, S5_STATE, S5_GROUP_CH), (2 * S5_GROUP_CH) ** -0.5),
        "s5_c_re": nrm(ks[15], (n_odd, S5_GROUPS, S5_GROUP_CH, S5_STATE), 0.5),
        "s5_c_im": nrm(ks[16], (n_odd, S5_GROUPS, S5_GROUP_CH, S5_STATE), 0.5),
        "s5_d": nrm(ks[17], (n_odd, S5_WIDTH), 1.0),
        "s5_log_dt": jax.random.uniform(ks[18], (n_odd, S5_GROUPS), f32, np.log(0.001), np.log(0.1)),
        "s5_w_glu": nrm(ks[19], (n_odd, S5_WIDTH, S5_WIDTH), S5_WIDTH ** -0.5),
        "s5_b_glu": nrm(ks[20], (n_odd, S5_WIDTH), 0.01),
        "hgrn_lb": nrm(ks[21], (DEPTH, HGRN_WIDTH), 0.1),
        "hgrn_out_norm": gain(ks[22], (n_odd, HGRN_WIDTH)),
        "cd_w_out": nrm(ks[23], (n_odd, S5_WIDTH + HGRN_WIDTH, d), d ** -0.5),
        "moe_w_group": nrm(ks[24], (DEPTH, d, MOE_GROUPS), d ** -0.5),
        "moe_b_group": nrm(ks[25], (DEPTH, MOE_GROUPS), 0.01),
        "moe_w_router": nrm(ks[26], (DEPTH, d, MOE_EXPERTS), d ** -0.5),
        "moe_b_router": nrm(ks[27], (DEPTH, MOE_EXPERTS), 0.01),
        "moe_w_gate": nrm(ks[28], (DEPTH, MOE_EXPERTS, d, MOE_FF), d ** -0.5),
        "moe_w_up": nrm(ks[29], (DEPTH, MOE_EXPERTS, d, MOE_FF), d ** -0.5),
        "moe_w_down": nrm(ks[30], (DEPTH, MOE_EXPERTS, MOE_FF, d), MOE_FF ** -0.5),
    }


def reference(x, norm_mix, norm_ffn, norm_final, ab_w_in, ab_gate_bias, ab_head_norm, ab_conv_w,
              ab_w_out, cd_w_in, s5_lambda_re, s5_lambda_im, s5_b_re, s5_b_im, s5_c_re, s5_c_im,
              s5_d, s5_log_dt, s5_w_glu, s5_b_glu, hgrn_lb, hgrn_out_norm, cd_w_out,
              moe_w_group, moe_b_group, moe_w_router, moe_b_router, moe_w_gate, moe_w_up,
              moe_w_down):
    h = x
    for layer in range(DEPTH):
        j = layer // 2
        hn = rmsnorm(h, norm_mix[layer])
        if layer % 2 == 0:
            mix = mixer_ab(hn, ab_w_in[j], ab_gate_bias[j], ab_head_norm[j], ab_conv_w[j], ab_w_out[j])
        else:
            mix = mixer_cd(hn, cd_w_in[j], s5_lambda_re[j], s5_lambda_im[j], s5_b_re[j], s5_b_im[j],
                           s5_c_re[j], s5_c_im[j], s5_d[j], s5_log_dt[j], s5_w_glu[j], s5_b_glu[j],
                           hgrn_lower_bound(hgrn_lb, layer), hgrn_out_norm[j], cd_w_out[j])
        h = h + mix
        h = h + hier_moe(rmsnorm(h, norm_ffn[layer]), moe_w_group[layer], moe_b_group[layer],
                         moe_w_router[layer], moe_b_router[layer], moe_w_gate[layer],
                         moe_w_up[layer], moe_w_down[layer])
    return rmsnorm(h, norm_final)
```

```cpp
#include <hip/hip_runtime.h>
#include <hip/hip_cooperative_groups.h>
#include <cstdio>
#include <cstdint>
namespace cg = cooperative_groups;

typedef unsigned short bf16_t;
typedef short bf16x8 __attribute__((ext_vector_type(8)));
typedef float f32x4 __attribute__((ext_vector_type(4)));
typedef float f32x2 __attribute__((ext_vector_type(2)));
typedef unsigned u32x4 __attribute__((ext_vector_type(4)));
typedef unsigned u32x2 __attribute__((ext_vector_type(2)));

constexpr int T = 16384, DM = 1024, SEQ = 4096;
constexpr int NTHR = 512;
constexpr int PA = 3584;
constexpr int PC = 2560;
constexpr int ECAP = 16384;
constexpr float EPS = 1e-6f;

constexpr size_t KB = 1024, MB = 1024 * 1024;
constexpr size_t WS_CTL = 0;
constexpr size_t WS_GATES = 64 * KB;
constexpr size_t WS_S5POW = WS_GATES + 512 * KB;
constexpr size_t WS_S5BBAR = WS_S5POW + 272 * KB;
constexpr size_t WS_WCAT = WS_S5BBAR + 256 * KB;
constexpr size_t WS_NLOC = WS_WCAT + 384 * KB;
constexpr size_t WS_NPREV = WS_NLOC + 512 * KB;
constexpr size_t WS_BENDV = WS_NPREV + 512 * KB;
constexpr size_t WS_MLOC = WS_BENDV + 512 * KB;
constexpr size_t WS_BEND = WS_MLOC + 4 * KB;
constexpr size_t WS_MPREV = WS_BEND + 4 * KB;
constexpr size_t WS_KTAB = 3072 * KB;
static_assert(WS_MPREV + 4 * KB <= WS_KTAB && WS_KTAB + 512 * KB <= 4 * MB, "small region overflow");
constexpr size_t WS_S5Y = 4 * MB;
constexpr size_t WS_S5E = 10 * MB;
constexpr size_t WS_WINA = 12 * MB;
constexpr size_t WS_WOUTA = 20 * MB;
constexpr size_t WS_WINC = 22 * MB;
constexpr size_t WS_WOUTC = 27 * MB;
constexpr size_t WS_WGLU = 29 * MB;
constexpr size_t WS_A = 30 * MB;
constexpr size_t WS_B = 142 * MB;
constexpr size_t WS_C = 174 * MB;
constexpr size_t WS_D = 206 * MB;
constexpr size_t WS_H16 = 238 * MB;
constexpr size_t WS_END = 270 * MB;
constexpr size_t WS_PROJ = WS_A, WS_LIST = WS_A, WS_WLIST = WS_A + 2 * MB, WS_HID = WS_A + 4 * MB, WS_Y = WS_A + 28 * MB;
constexpr size_t WS_XN = WS_B, WS_U = WS_B, WS_Z = WS_B;
constexpr size_t WS_XEND = WS_A + 84 * MB;
constexpr size_t WS_XPREVB = WS_A + 100 * MB;
constexpr size_t WS_MIX = WS_C, WS_CPREV = WS_D, WS_WGU = WS_C, WS_WD = WS_C + 32 * MB;

__host__ __device__ constexpr size_t ws_wgu(int layer) { return layer == 0 ? WS_C : WS_A + 64 * MB; }
__host__ __device__ constexpr size_t ws_wd(int layer) { return layer == 0 ? WS_C + 32 * MB : WS_A + 96 * MB; }
__host__ __device__ constexpr size_t ws_y(int layer) { return layer == 0 ? WS_A + 28 * MB : WS_C; }
constexpr int MOE_CONV_ITEMS = 32 * (16 * 16 + 32 * 4);
constexpr int MOE_CONV_EARLY = MOE_CONV_ITEMS / 2;
constexpr int LDS_BYTES = 144 * 1024;

struct Params { const float* in[30]; float* out; unsigned char* ws; int use_cg; int pad; };

enum { I_X = 0, I_NORM_MIX, I_NORM_FFN, I_NORM_FINAL, I_AB_WIN, I_AB_GBIAS, I_AB_HNORM, I_AB_CONVW, I_AB_WOUT, I_CD_WIN, I_S5_LRE, I_S5_LIM, I_S5_BRE, I_S5_BIM,
       I_S5_CRE, I_S5_CIM, I_S5_D, I_S5_LOGDT, I_S5_WGLU, I_S5_BGLU, I_HGRN_LB, I_HGRN_ONORM, I_CD_WOUT, I_MOE_WG, I_MOE_BG, I_MOE_WR, I_MOE_BR, I_MOE_WGATE, I_MOE_WUP, I_MOE_WDOWN };

__device__ __forceinline__ int opaque_tid() { int t = threadIdx.x; asm volatile("" : "+v"(t)); return t; }
__device__ __forceinline__ float bf2f(unsigned v) { return __uint_as_float(v << 16); }
typedef __bf16 bf16x2_t __attribute__((ext_vector_type(2)));
__device__ __forceinline__ unsigned pk2(float lo, float hi) { const f32x2 v = {lo, hi}; return __builtin_bit_cast(unsigned, __builtin_convertvector(v, bf16x2_t)); }
__device__ __forceinline__ unsigned f2bf(float f) { return (unsigned)__builtin_bit_cast(unsigned short, (__bf16)f); }
__device__ __forceinline__ float wave_sum(float v) {
#pragma unroll
    for (int o = 32; o; o >>= 1) v += __shfl_xor(v, o);
    return v;
}
__device__ __forceinline__ float wave_max(float v) {
#pragma unroll
    for (int o = 32; o; o >>= 1) v = fmaxf(v, __shfl_xor(v, o));
    return v;
}
__device__ __forceinline__ float wave_incl_sum(float v, int lane) {
#pragma unroll
    for (int o = 1; o < 64; o <<= 1) { const float t = __shfl_up(v, o); if (lane >= o) v += t; }
    return v;
}
__device__ __forceinline__ float wave_incl_max(float v, int lane) {
#pragma unroll
    for (int o = 1; o < 64; o <<= 1) { const float t = __shfl_up(v, o); if (lane >= o) v = fmaxf(v, t); }
    return v;
}
__device__ __forceinline__ float sigmoid_(float x) { return 1.f / (1.f + expf(-x)); }
__device__ __forceinline__ float fexp_(float x) { return __expf(x); }
__device__ __forceinline__ float fsigmoid_(float x) { return __builtin_amdgcn_rcpf(1.f + __expf(-x)); }
__device__ __forceinline__ float fsilu_(float x) { return x * __builtin_amdgcn_rcpf(1.f + __expf(-x)); }
__device__ __forceinline__ float fgelu_tanh_(float x) { const float u = 0.7978845608028654f * (x + 0.044715f * x * x * x); return x * __builtin_amdgcn_rcpf(1.f + __expf(-2.f * u)); }
__device__ __forceinline__ float logsigmoid_(float x) { return fminf(x, 0.f) - log1pf(expf(-fabsf(x))); }
__device__ __forceinline__ float silu_(float x) { return x / (1.f + expf(-x)); }
__device__ __forceinline__ float gelu_tanh_(float x) { const float u = 0.7978845608028654f * (x + 0.044715f * x * x * x); return 0.5f * x * (1.f + tanhf(u)); }
#define LDS_WAIT() asm volatile("s_waitcnt lgkmcnt(0)" ::: "memory")
__device__ __forceinline__ int tsw(int d, int l) { return d * 72 + (l ^ (((d >> 3) & 7) << 3)); }
__device__ __forceinline__ int tswc(int d, int c) { return d * 72 + ((c ^ ((d >> 3) & 7)) << 3); }

struct BPlain {
    const bf16_t* Bt; int K;
    __device__ __forceinline__ const bf16_t* operator()(int r, int kc) const { return Bt + (size_t)r * K + kc * 8; }
};
template <class APiece, class BPiece, class Epi>
__device__ __forceinline__ void gemm128b(unsigned char* lds, const APiece& apiece, const BPiece& bpiece, int K, const Epi& epi) {
    const int tid = opaque_tid(), lane = tid & 63, wid = tid >> 6, wr = wid >> 1, wc = wid & 1, fr = lane & 15, fq = lane >> 4;
    const int nt = K >> 6;
    const int r0 = tid >> 3, c0 = tid & 7;
    const int so0 = r0 * 128 + ((c0 ^ (r0 & 7)) << 4), so1 = so0 + 64 * 128;
    u32x4 xa0 = *(const u32x4*)apiece(r0, c0), xa1 = *(const u32x4*)apiece(r0 + 64, c0), xb0 = *(const u32x4*)bpiece(r0, c0), xb1 = *(const u32x4*)bpiece(r0 + 64, c0);
    u32x4 ya0 = *(const u32x4*)apiece(r0, 8 + c0), ya1 = *(const u32x4*)apiece(r0 + 64, 8 + c0), yb0 = *(const u32x4*)bpiece(r0, 8 + c0), yb1 = *(const u32x4*)bpiece(r0 + 64, 8 + c0);
    f32x4 acc[2][4];
#pragma unroll
    for (int m = 0; m < 2; ++m)
#pragma unroll
        for (int n = 0; n < 4; ++n) acc[m][n] = (f32x4){0.f, 0.f, 0.f, 0.f};
#define G128_PUT(buf, A0, A1, B0, B1) do { unsigned char* d_ = lds + (buf) * 16384; *(u32x4*)(d_ + so0) = A0; *(u32x4*)(d_ + so1) = A1; *(u32x4*)(d_ + 32768 + so0) = B0; *(u32x4*)(d_ + 32768 + so1) = B1; } while (0)
#define G128_GET(t, A0, A1, B0, B1) do { const int kc_ = (t) * 8 + c0; A0 = *(const u32x4*)apiece(r0, kc_); A1 = *(const u32x4*)apiece(r0 + 64, kc_); B0 = *(const u32x4*)bpiece(r0, kc_); B1 = *(const u32x4*)bpiece(r0 + 64, kc_); } while (0)
#define G128_MMA(buf) do { const unsigned char* sa = lds + (buf) * 16384; const unsigned char* sb = lds + 32768 + (buf) * 16384; \
        _Pragma("unroll") for (int kk = 0; kk < 2; ++kk) { bf16x8 a[2], b[4]; \
            _Pragma("unroll") for (int m = 0; m < 2; ++m) { const int row = wr * 32 + m * 16 + fr; a[m] = *(const bf16x8*)(sa + row * 128 + (((kk * 4 + fq) ^ (row & 7)) << 4)); } \
            _Pragma("unroll") for (int n = 0; n < 4; ++n) { const int row = wc * 64 + n * 16 + fr; b[n] = *(const bf16x8*)(sb + row * 128 + (((kk * 4 + fq) ^ (row & 7)) << 4)); } \
            _Pragma("unroll") for (int m = 0; m < 2; ++m) _Pragma("unroll") for (int n = 0; n < 4; ++n) acc[m][n] = __builtin_amdgcn_mfma_f32_16x16x32_bf16(b[n], a[m], acc[m][n], 0, 0, 0); } } while (0)
    G128_PUT(0, xa0, xa1, xb0, xb1);
    __syncthreads();
#pragma unroll 1
    for (int kt = 0; kt < nt; kt += 2) {
        if (kt + 2 < nt) G128_GET(kt + 2, xa0, xa1, xb0, xb1);
        G128_MMA(0);
        G128_PUT(1, ya0, ya1, yb0, yb1);
        __syncthreads();
        if (kt + 3 < nt) G128_GET(kt + 3, ya0, ya1, yb0, yb1);
        G128_MMA(1);
        if (kt + 2 < nt) G128_PUT(0, xa0, xa1, xb0, xb1);
        __syncthreads();
    }
#undef G128_PUT
#undef G128_GET
#undef G128_MMA
    epi(acc, wr, wc, fr, fq);
}

template <class APiece, class Epi>
__device__ __forceinline__ void gemm128(unsigned char* lds, const APiece& apiece, const bf16_t* __restrict__ Bt, int K, const Epi& epi) {
    BPlain b{Bt, K};
    gemm128b(lds, apiece, b, K, epi);
}

template <class APiece, class BPiece, class Epi0, class Epi1>
__device__ __forceinline__ void gemm128x2(unsigned char* lds, const APiece& apiece, const BPiece& bp0f, const BPiece& bp1f, int K, const Epi0& epi0, const Epi1& epi1) {
    const int tid = opaque_tid(), lane = tid & 63, wid = tid >> 6, wr = wid >> 1, wc = wid & 1, fr = lane & 15, fq = lane >> 4;
    const int nt = K >> 6;
    const int r0 = tid >> 3, c0 = tid & 7;
    const int so0 = r0 * 128 + ((c0 ^ (r0 & 7)) << 4), so1 = so0 + 64 * 128;
    u32x4 ra0 = *(const u32x4*)apiece(r0, c0), ra1 = *(const u32x4*)apiece(r0 + 64, c0);
    u32x4 rb0 = *(const u32x4*)bp0f(r0, c0), rb1 = *(const u32x4*)bp0f(r0 + 64, c0);
    u32x4 rc0 = *(const u32x4*)bp1f(r0, c0), rc1 = *(const u32x4*)bp1f(r0 + 64, c0);
    f32x4 acc0[2][4], acc1[2][4];
#pragma unroll
    for (int m = 0; m < 2; ++m)
#pragma unroll
        for (int n = 0; n < 4; ++n) { acc0[m][n] = (f32x4){0.f, 0.f, 0.f, 0.f}; acc1[m][n] = (f32x4){0.f, 0.f, 0.f, 0.f}; }
    *(u32x4*)(lds + so0) = ra0; *(u32x4*)(lds + so1) = ra1;
    *(u32x4*)(lds + 32768 + so0) = rb0; *(u32x4*)(lds + 32768 + so1) = rb1;
    *(u32x4*)(lds + 65536 + so0) = rc0; *(u32x4*)(lds + 65536 + so1) = rc1;
    __syncthreads();
#pragma unroll 1
    for (int kt = 0; kt < nt; ++kt) {
        const int cur = kt & 1;
        if (kt + 1 < nt) {
            const int kc = (kt + 1) * 8 + c0;
            ra0 = *(const u32x4*)apiece(r0, kc); ra1 = *(const u32x4*)apiece(r0 + 64, kc);
            rb0 = *(const u32x4*)bp0f(r0, kc); rb1 = *(const u32x4*)bp0f(r0 + 64, kc);
            rc0 = *(const u32x4*)bp1f(r0, kc); rc1 = *(const u32x4*)bp1f(r0 + 64, kc);
        }
        const unsigned char* sa = lds + cur * 16384;
        const unsigned char* sb = lds + 32768 + cur * 16384;
        const unsigned char* sc = lds + 65536 + cur * 16384;
#pragma unroll
        for (int kk = 0; kk < 2; ++kk) {
            bf16x8 a[2], b[4], c[4];
#pragma unroll
            for (int m = 0; m < 2; ++m) { const int row = wr * 32 + m * 16 + fr; a[m] = *(const bf16x8*)(sa + row * 128 + (((kk * 4 + fq) ^ (row & 7)) << 4)); }
#pragma unroll
            for (int n = 0; n < 4; ++n) { const int row = wc * 64 + n * 16 + fr; const int o = row * 128 + (((kk * 4 + fq) ^ (row & 7)) << 4); b[n] = *(const bf16x8*)(sb + o); c[n] = *(const bf16x8*)(sc + o); }
#pragma unroll
            for (int m = 0; m < 2; ++m)
#pragma unroll
                for (int n = 0; n < 4; ++n) { acc0[m][n] = __builtin_amdgcn_mfma_f32_16x16x32_bf16(b[n], a[m], acc0[m][n], 0, 0, 0); acc1[m][n] = __builtin_amdgcn_mfma_f32_16x16x32_bf16(c[n], a[m], acc1[m][n], 0, 0, 0); }
        }
        if (kt + 1 < nt) {
            unsigned char* da = lds + (cur ^ 1) * 16384;
            *(u32x4*)(da + so0) = ra0; *(u32x4*)(da + so1) = ra1;
            *(u32x4*)(da + 32768 + so0) = rb0; *(u32x4*)(da + 32768 + so1) = rb1;
            *(u32x4*)(da + 65536 + so0) = rc0; *(u32x4*)(da + 65536 + so1) = rc1;
        }
        __syncthreads();
    }
    epi0(acc0, wr, wc, fr, fq);
    epi1(acc1, wr, wc, fr, fq);
}
struct APlain {
    const bf16_t* A; int K;
    __device__ __forceinline__ const bf16_t* operator()(int r, int kc) const { return A + (size_t)r * K + kc * 8; }
};

namespace pg8 {
#define PG8_LAS __attribute__((address_space(3)))
typedef unsigned short bf16_t;
typedef short bf16x8 __attribute__((ext_vector_type(8)));
typedef float f32x4 __attribute__((ext_vector_type(4)));
typedef unsigned u32x4 __attribute__((ext_vector_type(4)));
constexpr int BM = 256, BK = 64, HALF = 128, HTB = HALF * BK * 2  , STAGE_BYTES = 8 * HTB, NXCD = 8, WGM = 8;

__host__ __device__ __forceinline__ int lds_byte(int r, int c) { const int st = (r >> 4) * 2 + (c >> 5), rr = r & 15, cc = c & 31, ob = rr * 64 + cc * 2; return st * 1024 + (ob ^ (((ob >> 9) & 1) << 5)); }
__host__ __device__ __forceinline__ void stage_rc(int b, int& R, int& C) { const int st = b / 1024, sb = b % 1024, swz = sb ^ (((sb >> 9) & 1) << 5); R = (st >> 1) * 16 + swz / 64; C = (st & 1) * 32 + (swz % 64) / 2; }
__host__ __device__ __forceinline__ int perm32(int rho) { const int n = rho >> 4, i = rho & 15; return 8 * (i >> 2) + 4 * n + (i & 3); }

struct Unit { int pm, pn, aux, half, nh; };
struct Gemm { const bf16_t* A; const bf16_t* Bt; int M, N, K; };

struct StaticOrder {
    int nM, nN, nwg, G, c;
    __host__ __device__ void init(int M, int N, int G_, int c_) { nM = M / BM; nN = N / BM; nwg = nM * nN; G = G_; c = c_; }
    __host__ __device__ __forceinline__ bool next(int i, Unit& u) const {
        const long L = (long)i * G + c; if (L >= nwg) return false;
        int wgid = (int)L; { const int q = nwg / NXCD, r = nwg % NXCD, xcd = wgid % NXCD, off = wgid / NXCD; wgid = (xcd < r ? xcd * (q + 1) : r * (q + 1) + (xcd - r) * q) + off; }
        const int nig = WGM * nN, gid = wgid / nig, fm = gid * WGM, gsz = (nM - fm) < WGM ? (nM - fm) : WGM;
        u.pm = fm + ((wgid % nig) % gsz); u.pn = (wgid % nig) / gsz; u.aux = 0; u.half = 0; u.nh = 0; return true;
    }
    __device__ __forceinline__ void a_ready(const Unit&) const {}
    __device__ __forceinline__ void done(const Unit&) const {}
};

struct StaticOrderHalfTail : StaticOrder {
    int nNF, nNT;
    __device__ __forceinline__ bool next(int i, Unit& u) const {
        const long L = (long)i * G + c; const int nw = nM * nNT * 2;
        if (L >= (long)nwg + nw) return false;
        const bool tail = L >= nwg;
        int wgid = tail ? 0 : (int)L; { const int q = nwg / NXCD, r = nwg % NXCD, xcd = wgid % NXCD, off = wgid / NXCD; wgid = (xcd < r ? xcd * (q + 1) : r * (q + 1) + (xcd - r) * q) + off; }
        const int nig = WGM * nN, gid = wgid / nig, fm = gid * WGM, gsz = (nM - fm) < WGM ? (nM - fm) : WGM;
        const int pm_f = fm + ((wgid % nig) % gsz), pn_f = (wgid % nig) / gsz;
        int wg = tail ? (int)(L - nwg) : 0; { const int q = nw / NXCD, rr = nw % NXCD, xcd = wg % NXCD, off = wg / NXCD; wg = (xcd < rr ? xcd * (q + 1) : rr * (q + 1) + (xcd - rr) * q) + off; }
        const int t = wg % (nNT * 2);
        u.pm = tail ? wg / (nNT * 2) : pm_f; u.pn = tail ? nNF + (t >> 1) : pn_f; u.nh = tail ? 1 + (t & 1) : 0; u.aux = 0; u.half = 0;
        return true;
    }
};
__device__ __forceinline__ unsigned cvt_pk_bf16(float lo, float hi) { unsigned r; asm volatile("v_cvt_pk_bf16_f32 %0, %1, %2" : "=v"(r) : "v"(lo), "v"(hi)); return r; }
template <class Epi, class Sched, bool ALIGN_EPI = false, bool SP2 = false>
__device__ __forceinline__ void gemm_phase(PG8_LAS unsigned char* lds, const Gemm g, const Sched& S, const Epi& E) {
    const int tid = opaque_tid(), wid = __builtin_amdgcn_readfirstlane(tid >> 6), lane = tid & 63, wr = wid >> 2, wc = wid & 3, fr = lane & 15, fq = lane >> 4;
    const int K = g.K, nt = K / BK;
    unsigned voffA[2], voffB[2];
#pragma unroll
    for (int i = 0; i < 2; ++i) { int R, C; stage_rc(tid * 16 + i * 8192, R, C); const int Rb = Epi::PERM ? ((R & ~31) + perm32(R & 31)) : R;
        voffA[i] = (unsigned)(R * K + C) * 2u; voffB[i] = (unsigned)(Rb * K + C) * 2u; }
    const size_t kstep = (size_t)(BK * 2);
    const size_t hstep = (size_t)HALF * K * 2;
    const size_t tstep = 2 * hstep;
    const unsigned ldsw = (unsigned)wid * 1024u;
    const int aoff = lds_byte(wr * 64 + fr, fq * 8), boff = lds_byte(wc * 32 + fr, fq * 8);
#define PG8_SA(b, h) (((b) * 2 + (h)) * HTB)
#define PG8_SB(b, h) ((4 + (b) * 2 + (h)) * HTB)
#define PG8_STAGE(bufoff, gbase, voff) do { _Pragma("unroll") for (int _i = 0; _i < 2; ++_i) \
        __builtin_amdgcn_global_load_lds((const unsigned*)((const char*)(gbase) + (voff)[_i]), (PG8_LAS unsigned*)(lds + (bufoff) + ldsw + _i * 8192), 16, 0, 0); } while (0)
#define PG8_LDA(dst, b, h) do { _Pragma("unroll") for (int m = 0; m < 4; ++m) _Pragma("unroll") for (int k = 0; k < 2; ++k) dst[m][k] = *(const PG8_LAS bf16x8*)(lds + PG8_SA(b, h) + aoff + m * 2048 + k * 1024); } while (0)
#define PG8_LDB(dst, b, h) do { _Pragma("unroll") for (int n = 0; n < 2; ++n) _Pragma("unroll") for (int k = 0; k < 2; ++k) dst[n][k] = *(const PG8_LAS bf16x8*)(lds + PG8_SB(b, h) + boff + n * 2048 + k * 1024); } while (0)
#define PG8_MMA(ai, bj, At, Bt) do { __builtin_amdgcn_s_setprio(1); _Pragma("unroll") for (int m = 0; m < 4; ++m) _Pragma("unroll") for (int n = 0; n < 2; ++n) _Pragma("unroll") for (int k = 0; k < 2; ++k) \
        acc[ai][bj][m][n] = __builtin_amdgcn_mfma_f32_16x16x32_bf16(Bt[n][k], At[m][k], acc[ai][bj][m][n], 0, 0, 0); __builtin_amdgcn_s_setprio(0); } while (0)
#define PG8_WAIT_V(n) asm volatile("s_waitcnt vmcnt(" #n ")" ::: "memory")
#define PG8_WAIT_L(n) asm volatile("s_waitcnt lgkmcnt(" #n ")" ::: "memory")
#define PG8_BAR __builtin_amdgcn_s_barrier()
#define PG8_SCHED __builtin_amdgcn_sched_barrier(0)
    Unit cur, nxt; int ui = 0;
    if (!S.next(0, cur)) return;
    f32x4 acc[2][2][4][2];
#pragma unroll
    for (int a = 0; a < 2; ++a)
#pragma unroll
        for (int b = 0; b < 2; ++b)
#pragma unroll
            for (int m = 0; m < 4; ++m)
#pragma unroll
                for (int n = 0; n < 2; ++n) acc[a][b][m][n] = (f32x4){0.f, 0.f, 0.f, 0.f};
    bf16x8 At[4][2], B0[2][2], B1[2][2];
    const char* cA = (const char*)g.A + (size_t)cur.pm * tstep; const char* cB = (const char*)g.Bt + (size_t)cur.pn * tstep;
    S.a_ready(cur);
    if constexpr (SP2) {
        PG8_STAGE(PG8_SB(0, 0), cB, voffB); PG8_STAGE(PG8_SB(0, 1), cB + hstep, voffB); PG8_STAGE(PG8_SA(0, 0), cA, voffA); PG8_STAGE(PG8_SA(0, 1), cA + hstep, voffA);
        if (wr == 1) PG8_BAR;
        PG8_WAIT_V(2); PG8_BAR;
        PG8_STAGE(PG8_SB(1, 0), cB + kstep, voffB); PG8_STAGE(PG8_SA(1, 0), cA + kstep, voffA); PG8_STAGE(PG8_SB(1, 1), cB + hstep + kstep, voffB);
        PG8_WAIT_V(6); PG8_BAR;
    } else {
        PG8_STAGE(PG8_SB(0, 0), cB, voffB); PG8_STAGE(PG8_SA(0, 0), cA, voffA); PG8_STAGE(PG8_SB(0, 1), cB + hstep, voffB); PG8_STAGE(PG8_SA(0, 1), cA + hstep, voffA);
        if (wr == 1) PG8_BAR;
        PG8_WAIT_V(4); PG8_BAR;
        PG8_STAGE(PG8_SB(1, 0), cB + kstep, voffB); PG8_STAGE(PG8_SA(1, 0), cA + kstep, voffA); PG8_STAGE(PG8_SB(1, 1), cB + hstep + kstep, voffB);
        PG8_WAIT_V(6); PG8_BAR;
    }
    for (;;) {
        const bool has_next = S.next(ui + 1, nxt);
        const char* nA = has_next ? (const char*)g.A + (size_t)nxt.pm * tstep : cA; const char* nB = has_next ? (const char*)g.Bt + (size_t)nxt.pn * tstep : cB;
        for (int t = 0; t < nt; t += 2) {
            const bool last = (t == nt - 2);
            const char* a1 = cA + (size_t)(t + 1) * kstep;
            const char* a2 = last ? nA : cA + (size_t)(t + 2) * kstep; const char* b2 = last ? nB : cB + (size_t)(t + 2) * kstep;
            const char* a3 = a2 + kstep; const char* b3 = b2 + kstep;
            if (last && has_next) S.a_ready(nxt);
            if constexpr (SP2) {
            PG8_LDB(B0, 0, 0); PG8_LDB(B1, 0, 1); PG8_SCHED; PG8_LDA(At, 0, 0); PG8_STAGE(PG8_SA(1, 1), a1 + hstep, voffA);
            PG8_WAIT_V(8); PG8_WAIT_L(0); PG8_BAR; if (cur.nh != 2) PG8_MMA(0, 0, At, B0); if (cur.nh != 1) PG8_MMA(0, 1, At, B1); PG8_BAR; PG8_SCHED;
            PG8_LDA(At, 0, 1); PG8_STAGE(PG8_SB(0, 0), b2, voffB); PG8_STAGE(PG8_SB(0, 1), b2 + hstep, voffB); PG8_STAGE(PG8_SA(0, 0), a2, voffA);
            PG8_WAIT_V(8); PG8_WAIT_L(0); PG8_BAR; if (!cur.half) { if (cur.nh != 2) PG8_MMA(1, 0, At, B0); if (cur.nh != 1) PG8_MMA(1, 1, At, B1); } PG8_BAR; PG8_SCHED;
            PG8_LDB(B0, 1, 0); PG8_LDB(B1, 1, 1); PG8_SCHED; PG8_LDA(At, 1, 0); PG8_STAGE(PG8_SA(0, 1), a2 + hstep, voffA);
            PG8_WAIT_V(8); PG8_WAIT_L(0); PG8_BAR; if (cur.nh != 2) PG8_MMA(0, 0, At, B0); if (cur.nh != 1) PG8_MMA(0, 1, At, B1); PG8_BAR; PG8_SCHED;
            PG8_LDA(At, 1, 1); PG8_STAGE(PG8_SB(1, 0), b3, voffB); PG8_STAGE(PG8_SB(1, 1), b3 + hstep, voffB); PG8_STAGE(PG8_SA(1, 0), a3, voffA);
            PG8_WAIT_V(8); PG8_WAIT_L(0); PG8_BAR; if (!cur.half) { if (cur.nh != 2) PG8_MMA(1, 0, At, B0); if (cur.nh != 1) PG8_MMA(1, 1, At, B1); } PG8_BAR; PG8_SCHED;
            } else {
            PG8_LDB(B0, 0, 0); PG8_SCHED; PG8_LDA(At, 0, 0); PG8_STAGE(PG8_SA(1, 1), a1 + hstep, voffA);
            PG8_WAIT_L(8); PG8_BAR; PG8_WAIT_L(0); PG8_MMA(0, 0, At, B0); PG8_BAR; PG8_SCHED;
            PG8_LDB(B1, 0, 1); PG8_STAGE(PG8_SB(0, 0), b2, voffB);
            PG8_BAR; PG8_WAIT_L(0); PG8_MMA(0, 1, At, B1); PG8_BAR;
            PG8_LDA(At, 0, 1); PG8_STAGE(PG8_SA(0, 0), a2, voffA);
            PG8_BAR; PG8_WAIT_L(0); PG8_MMA(1, 0, At, B0); PG8_BAR; PG8_SCHED;
            PG8_STAGE(PG8_SB(0, 1), b2 + hstep, voffB);
            PG8_WAIT_V(6); PG8_BAR; PG8_MMA(1, 1, At, B1); PG8_BAR;
            PG8_LDB(B0, 1, 0); PG8_SCHED; PG8_LDA(At, 1, 0); PG8_STAGE(PG8_SA(0, 1), a2 + hstep, voffA);
            PG8_WAIT_L(8); PG8_BAR; PG8_WAIT_L(0); PG8_MMA(0, 0, At, B0); PG8_BAR; PG8_SCHED;
            PG8_LDB(B1, 1, 1); PG8_STAGE(PG8_SB(1, 0), b3, voffB);
            PG8_BAR; PG8_WAIT_L(0); PG8_MMA(0, 1, At, B1); PG8_BAR;
            PG8_LDA(At, 1, 1); PG8_STAGE(PG8_SA(1, 0), a3, voffA);
            PG8_BAR; PG8_WAIT_L(0); PG8_MMA(1, 0, At, B0); PG8_BAR; PG8_SCHED;
            PG8_STAGE(PG8_SB(1, 1), b3 + hstep, voffB);
            PG8_WAIT_V(6); PG8_BAR; PG8_MMA(1, 1, At, B1); PG8_BAR;
            }
        }
        if constexpr (ALIGN_EPI) { if (wr == 0) PG8_BAR; }
        if constexpr (!Epi::AFTER_DRAIN) { E(acc, cur, wr, wc, fr, fq); S.done(cur); }
        if (!has_next) break;
#pragma unroll
        for (int a = 0; a < 2; ++a)
#pragma unroll
            for (int b = 0; b < 2; ++b)
#pragma unroll
                for (int m = 0; m < 4; ++m)
#pragma unroll
                    for (int n = 0; n < 2; ++n) acc[a][b][m][n] = (f32x4){0.f, 0.f, 0.f, 0.f};
        cur = nxt; cA = nA; cB = nB; ++ui;
        if constexpr (ALIGN_EPI) { if (wr == 1) PG8_BAR; }
    }
    PG8_WAIT_V(0);
    if constexpr (!ALIGN_EPI) { if (wr == 0) PG8_BAR; }
    PG8_BAR;
    if constexpr (Epi::AFTER_DRAIN) { E.fused(acc, cur, wr, wc, fr, fq, lds, wid, lane); S.done(cur); }
#undef PG8_SA
#undef PG8_SB
#undef PG8_STAGE
#undef PG8_LDA
#undef PG8_LDB
#undef PG8_MMA
#undef PG8_WAIT_V
#undef PG8_WAIT_L
#undef PG8_BAR
#undef PG8_SCHED
}

struct EpiStore {
    static constexpr bool PERM = true, AFTER_DRAIN = false;
    bf16_t* O; int ldc;
    __device__ __forceinline__ void operator()(const f32x4 (&acc)[2][2][4][2], const Unit& u, int wr, int wc, int fr, int fq) const {
        asm volatile("s_nop 7\n\ts_nop 7" ::: "memory");
        const int row0 = u.pm * BM + wr * 64 + fr, col0 = u.pn * BM + wc * 32 + 8 * fq;
#pragma unroll
        for (int ai = 0; ai < 2; ++ai)
#pragma unroll
            for (int m = 0; m < 4; ++m) { bf16_t* rowp = O + (size_t)(row0 + ai * HALF + m * 16) * ldc + col0;
#pragma unroll
                for (int bj = 0; bj < 2; ++bj) { if (u.nh == 2 - bj) continue; const f32x4 v0 = acc[ai][bj][m][0], v1 = acc[ai][bj][m][1];
                    u32x4 w; w.x = cvt_pk_bf16(v0[0], v0[1]); w.y = cvt_pk_bf16(v0[2], v0[3]); w.z = cvt_pk_bf16(v1[0], v1[1]); w.w = cvt_pk_bf16(v1[2], v1[3]);
                    *(u32x4*)(rowp + bj * HALF) = w; } }
    }
};
struct EpiStoreGates {
    static constexpr bool PERM = true, AFTER_DRAIN = false;
    bf16_t* O; int ldc; int gate_pn; float* gates; const float* gbias;
    __device__ __forceinline__ void operator()(const f32x4 (&acc)[2][2][4][2], const Unit& u, int wr, int wc, int fr, int fq) const {
        asm volatile("s_nop 7\n\ts_nop 7" ::: "memory");
        const int row0 = u.pm * BM + wr * 64 + fr;
        if (u.pn == gate_pn) {
            if (wc == 0 && fq == 0) {
                const f32x4 b0 = *(const f32x4*)gbias, b1 = *(const f32x4*)(gbias + 4);
#pragma unroll
                for (int ai = 0; ai < 2; ++ai)
#pragma unroll
                    for (int m = 0; m < 4; ++m) { float* g = gates + (size_t)(row0 + ai * HALF + m * 16) * 8;
                        *(f32x4*)g = acc[ai][0][m][0] + b0; *(f32x4*)(g + 4) = acc[ai][0][m][1] + b1; }
            }
            return;
        }
        const int col0 = u.pn * BM + wc * 32 + 8 * fq;
#pragma unroll
        for (int ai = 0; ai < 2; ++ai)
#pragma unroll
            for (int m = 0; m < 4; ++m) { bf16_t* rowp = O + (size_t)(row0 + ai * HALF + m * 16) * ldc + col0;
#pragma unroll
                for (int bj = 0; bj < 2; ++bj) { const f32x4 v0 = acc[ai][bj][m][0], v1 = acc[ai][bj][m][1];
                    u32x4 w; w.x = cvt_pk_bf16(v0[0], v0[1]); w.y = cvt_pk_bf16(v0[2], v0[3]); w.z = cvt_pk_bf16(v1[0], v1[1]); w.w = cvt_pk_bf16(v1[2], v1[3]);
                    *(u32x4*)(rowp + bj * HALF) = w; } }
    }
};
struct EpiResid {
    static constexpr bool PERM = true, AFTER_DRAIN = false;
    const float* rf; const bf16_t* rb; bf16_t* out;
    __device__ __forceinline__ void operator()(const f32x4 (&acc)[2][2][4][2], const Unit& u, int wr, int wc, int fr, int fq) const {
        const int row0 = u.pm * BM + wr * 64 + fr, col0 = u.pn * BM + wc * 32 + 8 * fq;
#pragma unroll
        for (int ai = 0; ai < 2; ++ai)
#pragma unroll
            for (int m = 0; m < 4; ++m) { const size_t off = (size_t)(row0 + ai * HALF + m * 16) * 1024 + col0;
#pragma unroll
                for (int bj = 0; bj < 2; ++bj) {
                    f32x4 r0, r1;
                    if (rf) { r0 = *(const f32x4*)(rf + off + bj * HALF); r1 = *(const f32x4*)(rf + off + bj * HALF + 4); }
                    else { const u32x4 q = *(const u32x4*)(rb + off + bj * HALF);
                        r0 = (f32x4){__uint_as_float(q.x << 16), __uint_as_float(q.x & 0xffff0000u), __uint_as_float(q.y << 16), __uint_as_float(q.y & 0xffff0000u)};
                        r1 = (f32x4){__uint_as_float(q.z << 16), __uint_as_float(q.z & 0xffff0000u), __uint_as_float(q.w << 16), __uint_as_float(q.w & 0xffff0000u)}; }
                    const f32x4 v0 = acc[ai][bj][m][0] + r0, v1 = acc[ai][bj][m][1] + r1;
                    u32x4 w; w.x = cvt_pk_bf16(v0[0], v0[1]); w.y = cvt_pk_bf16(v0[2], v0[3]); w.z = cvt_pk_bf16(v1[0], v1[1]); w.w = cvt_pk_bf16(v1[2], v1[3]);
                    *(u32x4*)(out + off + bj * HALF) = w; } }
    }
};

template <class Epi, class Sched>
__device__ __forceinline__ void gemm_phase_g(PG8_LAS unsigned char* lds, const Gemm g, const Sched& S, const Epi& E) {
    const int tid = opaque_tid(), wid = __builtin_amdgcn_readfirstlane(tid >> 6), lane = tid & 63, wr = wid >> 2, wc = wid & 3, fr = lane & 15, fq = lane >> 4;
    const int K = g.K, nt = K / BK;
    int RA[2], CA[2]; unsigned voffB[2];
#pragma unroll
    for (int i = 0; i < 2; ++i) { int R, C; stage_rc(tid * 16 + i * 8192, R, C); RA[i] = R; CA[i] = C; const int Rb = Epi::PERM ? ((R & ~31) + perm32(R & 31)) : R; voffB[i] = (unsigned)(Rb * K + C) * 2u; }
    const size_t kstep = (size_t)(BK * 2);
    const size_t hstep = (size_t)HALF * K * 2;
    const size_t tstep = 2 * hstep;
    const unsigned ldsw = (unsigned)wid * 1024u;
    const int aoff = lds_byte(wr * 64 + fr, fq * 8), boff = lds_byte(wc * 32 + fr, fq * 8);
#define PG8_SA(b, h) (((b) * 2 + (h)) * HTB)
#define PG8_SB(b, h) ((4 + (b) * 2 + (h)) * HTB)
#define PG8_STAGE(bufoff, gbase, voff) do { _Pragma("unroll") for (int _i = 0; _i < 2; ++_i) \
        __builtin_amdgcn_global_load_lds((const unsigned*)((const char*)(gbase) + (voff)[_i]), (PG8_LAS unsigned*)(lds + (bufoff) + ldsw + _i * 8192), 16, 0, 0); } while (0)
#define PG8_LDA(dst, b, h) do { _Pragma("unroll") for (int m = 0; m < 4; ++m) _Pragma("unroll") for (int k = 0; k < 2; ++k) dst[m][k] = *(const PG8_LAS bf16x8*)(lds + PG8_SA(b, h) + aoff + m * 2048 + k * 1024); } while (0)
#define PG8_LDB(dst, b, h) do { _Pragma("unroll") for (int n = 0; n < 2; ++n) _Pragma("unroll") for (int k = 0; k < 2; ++k) dst[n][k] = *(const PG8_LAS bf16x8*)(lds + PG8_SB(b, h) + boff + n * 2048 + k * 1024); } while (0)
#define PG8_MMA(ai, bj, At, Bt) do { __builtin_amdgcn_s_setprio(1); _Pragma("unroll") for (int m = 0; m < 4; ++m) _Pragma("unroll") for (int n = 0; n < 2; ++n) _Pragma("unroll") for (int k = 0; k < 2; ++k) \
        acc[ai][bj][m][n] = __builtin_amdgcn_mfma_f32_16x16x32_bf16(Bt[n][k], At[m][k], acc[ai][bj][m][n], 0, 0, 0); __builtin_amdgcn_s_setprio(0); } while (0)
#define PG8_WAIT_V(n) asm volatile("s_waitcnt vmcnt(" #n ")" ::: "memory")
#define PG8_WAIT_L(n) asm volatile("s_waitcnt lgkmcnt(" #n ")" ::: "memory")
#define PG8_BAR __builtin_amdgcn_s_barrier()
#define PG8_SCHED __builtin_amdgcn_sched_barrier(0)
    Unit cur, nxt; int ui = 0;
    if (!S.next(0, cur)) return;
    f32x4 acc[2][2][4][2];
#pragma unroll
    for (int a = 0; a < 2; ++a)
#pragma unroll
        for (int b = 0; b < 2; ++b)
#pragma unroll
            for (int m = 0; m < 4; ++m)
#pragma unroll
                for (int n = 0; n < 2; ++n) acc[a][b][m][n] = (f32x4){0.f, 0.f, 0.f, 0.f};
    bf16x8 At[4][2], B0[2][2], B1[2][2];
    unsigned oc[2][2];
    S.aoff(0, RA, CA, oc);
    const char* Ab = (const char*)g.A;
    const char* cB = (const char*)g.Bt + (size_t)cur.pn * tstep;
    PG8_STAGE(PG8_SB(0, 0), cB, voffB); PG8_STAGE(PG8_SB(0, 1), cB + hstep, voffB); PG8_STAGE(PG8_SA(0, 0), Ab, oc[0]); PG8_STAGE(PG8_SA(0, 1), Ab, oc[1]);
    if (wr == 1) PG8_BAR;
    PG8_WAIT_V(2); PG8_BAR;
    PG8_STAGE(PG8_SB(1, 0), cB + kstep, voffB); PG8_STAGE(PG8_SA(1, 0), Ab + kstep, oc[0]); PG8_STAGE(PG8_SB(1, 1), cB + hstep + kstep, voffB);
    PG8_WAIT_V(6); PG8_BAR;
    for (;;) {
        const bool has_next = S.next(ui + 1, nxt);
        const char* nB = has_next ? (const char*)g.Bt + (size_t)nxt.pn * tstep : cB;
        for (int t = 0; t < nt; t += 2) {
            const bool last = (t == nt - 2);
            const char* a1 = Ab + (size_t)(t + 1) * kstep;
            const char* a2 = last ? Ab : Ab + (size_t)(t + 2) * kstep; const char* b2 = last ? nB : cB + (size_t)(t + 2) * kstep;
            const char* a3 = a2 + kstep; const char* b3 = b2 + kstep;
            unsigned o2[2][2];
            if (last && has_next) S.aoff(ui + 1, RA, CA, o2);
            else { o2[0][0] = oc[0][0]; o2[0][1] = oc[0][1]; o2[1][0] = oc[1][0]; o2[1][1] = oc[1][1]; }
            PG8_LDB(B0, 0, 0); PG8_LDB(B1, 0, 1); PG8_SCHED; PG8_LDA(At, 0, 0); PG8_STAGE(PG8_SA(1, 1), a1, oc[1]);
            PG8_WAIT_V(8); PG8_WAIT_L(0); PG8_BAR; if (cur.nh != 2) PG8_MMA(0, 0, At, B0); if (cur.nh != 1) PG8_MMA(0, 1, At, B1); PG8_BAR; PG8_SCHED;
            PG8_LDA(At, 0, 1); PG8_STAGE(PG8_SB(0, 0), b2, voffB); PG8_STAGE(PG8_SB(0, 1), b2 + hstep, voffB); PG8_STAGE(PG8_SA(0, 0), a2, o2[0]);
            PG8_WAIT_V(8); PG8_WAIT_L(0); PG8_BAR; if (!cur.half) { if (cur.nh != 2) PG8_MMA(1, 0, At, B0); if (cur.nh != 1) PG8_MMA(1, 1, At, B1); } PG8_BAR; PG8_SCHED;
            PG8_LDB(B0, 1, 0); PG8_LDB(B1, 1, 1); PG8_SCHED; PG8_LDA(At, 1, 0); PG8_STAGE(PG8_SA(0, 1), a2, o2[1]);
            PG8_WAIT_V(8); PG8_WAIT_L(0); PG8_BAR; if (cur.nh != 2) PG8_MMA(0, 0, At, B0); if (cur.nh != 1) PG8_MMA(0, 1, At, B1); PG8_BAR; PG8_SCHED;
            PG8_LDA(At, 1, 1); PG8_STAGE(PG8_SB(1, 0), b3, voffB); PG8_STAGE(PG8_SB(1, 1), b3 + hstep, voffB); PG8_STAGE(PG8_SA(1, 0), a3, o2[0]);
            PG8_WAIT_V(8); PG8_WAIT_L(0); PG8_BAR; if (!cur.half) { if (cur.nh != 2) PG8_MMA(1, 0, At, B0); if (cur.nh != 1) PG8_MMA(1, 1, At, B1); } PG8_BAR; PG8_SCHED;
        }
        if (wr == 0) PG8_BAR;
        E(acc, cur, wr, wc, fr, fq);
        if (!has_next) break;
#pragma unroll
        for (int a = 0; a < 2; ++a)
#pragma unroll
            for (int b = 0; b < 2; ++b)
#pragma unroll
                for (int m = 0; m < 4; ++m)
#pragma unroll
                    for (int n = 0; n < 2; ++n) acc[a][b][m][n] = (f32x4){0.f, 0.f, 0.f, 0.f};
        cur = nxt; cB = nB; ++ui;
        S.aoff(ui, RA, CA, oc);
        if (wr == 1) PG8_BAR;
    }
    PG8_WAIT_V(0);
    PG8_BAR;
#undef PG8_SA
#undef PG8_SB
#undef PG8_STAGE
#undef PG8_LDA
#undef PG8_LDB
#undef PG8_MMA
#undef PG8_WAIT_V
#undef PG8_WAIT_L
#undef PG8_BAR
#undef PG8_SCHED
}

constexpr int MOE_MAXU = 4;
struct SchedMoe {
    const int* tp; const int* cn; const unsigned* tab;
    int NT, nU, G, c;
    __device__ __forceinline__ bool next(int i, Unit& u) const {
        if (i >= MOE_MAXU) return false;
        const long L = (long)i * G + c; if (L >= nU) return false;
        int wgid = (int)L; { const int q = nU / NXCD, r = nU % NXCD, xcd = wgid % NXCD, off = wgid / NXCD; wgid = (xcd < r ? xcd * (q + 1) : r * (q + 1) + (xcd - r) * q) + off; }
        const int ti = wgid / NT, pn = wgid - ti * NT;
        int e = 0; while (tp[e + 1] <= ti) ++e;
        u.pm = ti; u.pn = e * NT + pn; u.aux = i; u.half = (cn[e] - (ti - tp[e]) * BM <= HALF) ? 1 : 0; u.nh = 0; return true;
    }
    __device__ __forceinline__ void aoff(int ui, const int (&RA)[2], const int (&CA)[2], unsigned (&o)[2][2]) const {
#pragma unroll
        for (int h = 0; h < 2; ++h)
#pragma unroll
            for (int i = 0; i < 2; ++i) o[h][i] = tab[ui * 256 + h * HALF + RA[i]] + (unsigned)CA[i] * 2u;
    }
    __device__ __forceinline__ void a_ready(const Unit&) const {}
    __device__ __forceinline__ void done(const Unit&) const {}
};
__device__ __forceinline__ float silu_f(float x) { return x * __builtin_amdgcn_rcpf(1.f + __expf(-x)); }
__device__ __forceinline__ float sig_f(float x) { return __builtin_amdgcn_rcpf(1.f + __expf(-x)); }
struct EpiGlu256 {
    static constexpr bool PERM = true, AFTER_DRAIN = false;
    const bf16_t* Z; const float* b; bf16_t* mix;
    __device__ __forceinline__ void operator()(const f32x4 (&acc)[2][2][4][2], const Unit& u, int wr, int wc, int fr, int fq) const {
        const int row0 = u.pm * BM + wr * 64 + fr, col0 = u.pn * BM + wc * 32 + 8 * fq;
#pragma unroll
        for (int ai = 0; ai < 2; ++ai)
#pragma unroll
            for (int m = 0; m < 4; ++m) { const size_t r = (size_t)(row0 + ai * HALF + m * 16);
#pragma unroll
                for (int bj = 0; bj < 2; ++bj) { const int c = col0 + bj * HALF;
                    const u32x4 q = *(const u32x4*)(Z + r * 512 + c);
                    const f32x4 b0 = *(const f32x4*)(b + c), b1 = *(const f32x4*)(b + c + 4);
                    const f32x4 v0 = acc[ai][bj][m][0] + b0, v1 = acc[ai][bj][m][1] + b1;
                    const float z0 = __uint_as_float(q.x << 16), z1 = __uint_as_float(q.x & 0xffff0000u), z2 = __uint_as_float(q.y << 16), z3 = __uint_as_float(q.y & 0xffff0000u);
                    const float z4 = __uint_as_float(q.z << 16), z5 = __uint_as_float(q.z & 0xffff0000u), z6 = __uint_as_float(q.w << 16), z7 = __uint_as_float(q.w & 0xffff0000u);
                    u32x4 w; w.x = cvt_pk_bf16(z0 * sig_f(v0[0]), z1 * sig_f(v0[1])); w.y = cvt_pk_bf16(z2 * sig_f(v0[2]), z3 * sig_f(v0[3]));
                    w.z = cvt_pk_bf16(z4 * sig_f(v1[0]), z5 * sig_f(v1[1])); w.w = cvt_pk_bf16(z6 * sig_f(v1[2]), z7 * sig_f(v1[3]));
                    *(u32x4*)(mix + r * 1024 + c) = w; } }
    }
};

struct EpiMoeUp {
    static constexpr bool PERM = true, AFTER_DRAIN = false;
    bf16_t* H;
    __device__ __forceinline__ void operator()(const f32x4 (&acc)[2][2][4][2], const Unit& u, int wr, int wc, int fr, int fq) const {
        const int row0 = u.pm * BM + wr * 64 + fr, f0 = (u.pn & 1) * 128 + wc * 32 + 8 * fq;
#pragma unroll
        for (int ai = 0; ai < 2; ++ai)
#pragma unroll
            for (int m = 0; m < 4; ++m) {
                const f32x4 g0 = acc[ai][0][m][0], g1 = acc[ai][0][m][1], u0 = acc[ai][1][m][0], u1 = acc[ai][1][m][1];
                u32x4 w; w.x = cvt_pk_bf16(silu_f(g0[0]) * u0[0], silu_f(g0[1]) * u0[1]); w.y = cvt_pk_bf16(silu_f(g0[2]) * u0[2], silu_f(g0[3]) * u0[3]);
                w.z = cvt_pk_bf16(silu_f(g1[0]) * u1[0], silu_f(g1[1]) * u1[1]); w.w = cvt_pk_bf16(silu_f(g1[2]) * u1[2], silu_f(g1[3]) * u1[3]);
                *(u32x4*)(H + (size_t)(row0 + ai * HALF + m * 16) * 256 + f0) = w;
            }
    }
};
struct EpiMoeDown {
    static constexpr bool PERM = true, AFTER_DRAIN = false;
    bf16_t* Y; const unsigned* dtab; const float* wtab;
    __device__ __forceinline__ void operator()(const f32x4 (&acc)[2][2][4][2], const Unit& u, int wr, int wc, int fr, int fq) const {
        const int pn = u.pn & 3, tb = u.aux * 256 + wr * 64 + fr, col = pn * BM + wc * 32 + 8 * fq;
#pragma unroll
        for (int ai = 0; ai < 2; ++ai)
#pragma unroll
            for (int m = 0; m < 4; ++m) {
                const unsigned d = dtab[tb + ai * HALF + m * 16]; const float w = wtab[tb + ai * HALF + m * 16];
                if (d != 0xffffffffu) {
                    bf16_t* yr = Y + (size_t)d * 1024 + col;
#pragma unroll
                    for (int bj = 0; bj < 2; ++bj) { const f32x4 v0 = acc[ai][bj][m][0] * w, v1 = acc[ai][bj][m][1] * w;
                        u32x4 o; o.x = cvt_pk_bf16(v0[0], v0[1]); o.y = cvt_pk_bf16(v0[2], v0[3]); o.z = cvt_pk_bf16(v1[0], v1[1]); o.w = cvt_pk_bf16(v1[2], v1[3]);
                        *(u32x4*)(yr + bj * HALF) = o; }
                }
            }
    }
};
}

__device__ __forceinline__ void transpose_tile(const float* __restrict__ src, int ldn, bf16_t* __restrict__ dst, int ldk, float scale, float* scr, int lane) {
    float tv[32];
#pragma unroll
    for (int i = 0; i < 32; ++i) tv[i] = __builtin_nontemporal_load(src + (size_t)(2 * i + (lane >> 5)) * ldn + (lane & 31));
#pragma unroll
    for (int i = 0; i < 32; ++i) scr[(2 * i + (lane >> 5)) * 33 + (lane & 31)] = tv[i];
    LDS_WAIT();
    const int c = lane & 7;
#pragma unroll
    for (int j = 0; j < 4; ++j) {
        const int n = (lane >> 3) + 8 * j; const float* s = scr + (8 * c) * 33 + n;
        u32x4 o; o.x = pk2(s[0] * scale, s[33] * scale); o.y = pk2(s[66] * scale, s[99] * scale); o.z = pk2(s[132] * scale, s[165] * scale); o.w = pk2(s[198] * scale, s[231] * scale);
        *(u32x4*)(dst + (size_t)n * ldk + 8 * c) = o;
    }
    LDS_WAIT();
}

__device__ __forceinline__ void rms_row(f32x4 (&v)[4], const float* __restrict__ w, bf16_t* __restrict__ xn, int lane) {
    float ss = 0.f;
#pragma unroll
    for (int j = 0; j < 4; ++j) ss += v[j].x * v[j].x + v[j].y * v[j].y + v[j].z * v[j].z + v[j].w * v[j].w;
    ss = wave_sum(ss);
    const float r = rsqrtf(ss * (1.f / 1024.f) + EPS);
#pragma unroll
    for (int j = 0; j < 4; ++j) {
        const f32x4 w4 = *(const f32x4*)(w + 4 * lane + 256 * j);
        v[j] = v[j] * r * w4;
        u32x2 o; o.x = pk2(v[j].x, v[j].y); o.y = pk2(v[j].z, v[j].w);
        *(u32x2*)(xn + 4 * lane + 256 * j) = o;
    }
}

__device__ __forceinline__ void phase_prep(const Params& p, unsigned char* lds) {
    const int tid = opaque_tid(), lane = tid & 63, wid = tid >> 6;
    const int gw = blockIdx.x * 8 + wid, NGW = gridDim.x * 8;
    const int gt = blockIdx.x * NTHR + tid, NGT = gridDim.x * NTHR;
    unsigned char* ws = p.ws;
    if (blockIdx.x == 0 && tid < 64) ((int*)(ws + WS_CTL))[tid] = 0;
    for (int idx = (tid < 8 ? blockIdx.x * 8 + tid : 2048); idx < 2048; idx += gridDim.x * 8) {
        const int g = idx >> 6;
        const double lr = p.in[I_S5_LRE][idx], li = p.in[I_S5_LIM][idx], dt = exp((double)p.in[I_S5_LOGDT][g]);
        const double zr = lr * dt, zi = li * dt, ez = exp(zr);
        const double br = ez * cos(zi), bi = ez * sin(zi);
        double pr = 1.0, pi = 0.0;
        for (int tau = 0; tau <= 16; ++tau) {
            ((f32x2*)(ws + WS_S5POW))[idx * 17 + tau] = (f32x2){(float)pr, (float)pi};
            const double nr = pr * br - pi * bi, ni = pr * bi + pi * br; pr = nr; pi = ni;
        }
        const double ar = br - 1.0, ai = bi, den = lr * lr + li * li;
        const double cr = (ar * lr + ai * li) / den, ci = (ai * lr - ar * li) / den;
        for (int c = 0; c < 16; ++c) {
            const double b_r = p.in[I_S5_BRE][idx * 16 + c], b_i = p.in[I_S5_BIM][idx * 16 + c];
            ((f32x2*)(ws + WS_S5BBAR))[idx * 16 + c] = (f32x2){(float)(cr * b_r - ci * b_i), (float)(cr * b_i + ci * b_r)};
        }
    }
    for (int idx = gt; idx < 2 * 32 * 3 * 64; idx += NGT) {
        const int l = idx / (32 * 3 * 64), rem = idx - l * (32 * 3 * 64), ks = rem / 192, r2 = rem - ks * 192, nt_ = r2 >> 6, ln = r2 & 63, col = nt_ * 16 + (ln & 15);
        float v[8];
#pragma unroll
        for (int j = 0; j < 8; ++j) {
            const int k = ks * 32 + (ln >> 4) * 8 + j;
            float w = 0.f;
            if (col < 32) w = p.in[I_MOE_WR][(size_t)(l * 1024 + k) * 32 + col];
            else if (col < 36) w = p.in[I_MOE_WG][(size_t)(l * 1024 + k) * 4 + (col - 32)];
            v[j] = w * p.in[I_NORM_FFN][l * 1024 + k];
        }
        unsigned hi[4], lo[4];
#pragma unroll
        for (int q = 0; q < 4; ++q) {
            const unsigned h0 = f2bf(v[2 * q]), h1 = f2bf(v[2 * q + 1]);
            hi[q] = h0 | (h1 << 16);
            lo[q] = pk2(v[2 * q] - bf2f(h0), v[2 * q + 1] - bf2f(h1));
        }
        bf16_t* wf = (bf16_t*)(ws + WS_WCAT);
        *(u32x4*)(wf + ((size_t)(l * 2 + 0) * 6144 + (size_t)(ks * 3 + nt_) * 64 + ln) * 8) = (u32x4){hi[0], hi[1], hi[2], hi[3]};
        *(u32x4*)(wf + ((size_t)(l * 2 + 1) * 6144 + (size_t)(ks * 3 + nt_) * 64 + ln) * 8) = (u32x4){lo[0], lo[1], lo[2], lo[3]};
    }
    float* scr = (float*)(lds + wid * 8704);
    constexpr int IT_WINA = 112 * 16, IT_WOUT = 32 * 16, IT_WINC = 80 * 16, IT_WGLU = 16 * 8;
    constexpr int IT_TOTAL = IT_WINA + IT_WOUT + IT_WINC + IT_WOUT + IT_WGLU;
    for (int it0 = gw; it0 < IT_TOTAL; it0 += NGW) {
        int it = it0; const float* src; bf16_t* dst; int ldn, ldk; float scale = 1.f;
        if (it < IT_WINA) {
            const int n0 = (it >> 4) * 32, k0 = (it & 15) * 64, srcn = n0 < 2048 ? n0 : n0 + 8;
            if (n0 >= 512 && n0 < 1024) scale = 0.08838834764831845f;
            src = p.in[I_AB_WIN] + (size_t)k0 * 3592 + srcn; ldn = 3592; dst = (bf16_t*)(ws + WS_WINA) + (size_t)n0 * 1024 + k0; ldk = 1024;
        } else if ((it -= IT_WINA) < IT_WOUT) {
            const int n0 = (it >> 4) * 32, k0 = (it & 15) * 64;
            src = p.in[I_AB_WOUT] + (size_t)k0 * 1024 + n0; ldn = 1024; dst = (bf16_t*)(ws + WS_WOUTA) + (size_t)n0 * 1024 + k0; ldk = 1024;
        } else if ((it -= IT_WOUT) < IT_WINC) {
            const int n0 = (it >> 4) * 32, k0 = (it & 15) * 64;
            src = p.in[I_CD_WIN] + (size_t)k0 * 2560 + n0; ldn = 2560; dst = (bf16_t*)(ws + WS_WINC) + (size_t)n0 * 1024 + k0; ldk = 1024;
        } else if ((it -= IT_WINC) < IT_WOUT) {
            const int n0 = (it >> 4) * 32, k0 = (it & 15) * 64;
            src = p.in[I_CD_WOUT] + (size_t)k0 * 1024 + n0; ldn = 1024; dst = (bf16_t*)(ws + WS_WOUTC) + (size_t)n0 * 1024 + k0; ldk = 1024;
        } else {
            it -= IT_WOUT;
            const int n0 = (it >> 3) * 32, k0 = (it & 7) * 64;
            src = p.in[I_S5_WGLU] + (size_t)k0 * 512 + n0; ldn = 512; dst = (bf16_t*)(ws + WS_WGLU) + (size_t)n0 * 512 + k0; ldk = 512;
        }
        transpose_tile(src, ldn, dst, ldk, scale, scr, lane);
    }
    {
        bf16_t* wg = (bf16_t*)(ws + WS_WINA) + (size_t)3584 * 1024;
        const float* win = p.in[I_AB_WIN];
        for (int idx = gt; idx < 256 * 1024; idx += NGT) {
            const int n = idx >> 10, k = idx & 1023;
            wg[idx] = (bf16_t)(n < 8 ? f2bf(win[(size_t)k * 3592 + 2048 + n]) : 0u);
        }
    }
    const float* x = p.in[I_X];
    f32x4 vn[4];
    if (gw < T) {
#pragma unroll
        for (int j = 0; j < 4; ++j) vn[j] = __builtin_nontemporal_load((const f32x4*)(x + (size_t)gw * 1024 + 4 * lane + 256 * j));
    }
    for (int row = gw; row < T; row += NGW) {
        f32x4 v[4];
#pragma unroll
        for (int j = 0; j < 4; ++j) v[j] = vn[j];
        if (row + NGW < T) {
#pragma unroll
            for (int j = 0; j < 4; ++j) vn[j] = __builtin_nontemporal_load((const f32x4*)(x + (size_t)(row + NGW) * 1024 + 4 * lane + 256 * j));
        }
        {
            bf16_t* h16 = (bf16_t*)(ws + WS_H16) + (size_t)row * 1024;
#pragma unroll
            for (int j = 0; j < 4; ++j) { u32x2 o; o.x = pk2(v[j].x, v[j].y); o.y = pk2(v[j].z, v[j].w); *(u32x2*)(h16 + 4 * lane + 256 * j) = o; }
        }
        rms_row(v, p.in[I_NORM_MIX], (bf16_t*)(ws + WS_XN) + (size_t)row * 1024, lane);
    }
}

struct EpiStoreBf16 {
    bf16_t* O; int ldc;
    __device__ __forceinline__ void operator()(const f32x4 (&acc)[2][4], int wr, int wc, int fr, int fq) const {
#pragma unroll
        for (int m = 0; m < 2; ++m)
#pragma unroll
            for (int n = 0; n < 4; ++n) {
                const f32x4 v = acc[m][n]; u32x2 o; o.x = pk2(v.x, v.y); o.y = pk2(v.z, v.w);
                *(u32x2*)(O + (size_t)(wr * 32 + m * 16 + fr) * ldc + wc * 64 + n * 16 + fq * 4) = o;
            }
    }
};
struct EpiResidF32 {
    const float* resid; float* out;
    __device__ __forceinline__ void operator()(const f32x4 (&acc)[2][4], int wr, int wc, int fr, int fq) const {
#pragma unroll
        for (int m = 0; m < 2; ++m)
#pragma unroll
            for (int n = 0; n < 4; ++n) {
                const size_t off = (size_t)(wr * 32 + m * 16 + fr) * 1024 + wc * 64 + n * 16 + fq * 4;
                const f32x4 r = *(const f32x4*)(resid + off);
                *(f32x4*)(out + off) = r + acc[m][n];
            }
    }
};
struct EpiGlu {
    const bf16_t* Z; const float* b; bf16_t* mix;
    __device__ __forceinline__ void operator()(const f32x4 (&acc)[2][4], int wr, int wc, int fr, int fq) const {
#pragma unroll
        for (int m = 0; m < 2; ++m)
#pragma unroll
            for (int n = 0; n < 4; ++n) {
                const int r = wr * 32 + m * 16 + fr, c = wc * 64 + n * 16 + fq * 4;
                const u32x2 zz = *(const u32x2*)(Z + (size_t)r * 512 + c);
                const f32x4 bb = *(const f32x4*)(b + c);
                const f32x4 v = acc[m][n] + bb;
                const float z0 = bf2f(zz.x & 0xffffu), z1 = bf2f(zz.x >> 16), z2 = bf2f(zz.y & 0xffffu), z3 = bf2f(zz.y >> 16);
                u32x2 o; o.x = pk2(z0 * fsigmoid_(v.x), z1 * fsigmoid_(v.y)); o.y = pk2(z2 * fsigmoid_(v.z), z3 * fsigmoid_(v.w));
                *(u32x2*)(mix + (size_t)r * 1024 + c) = o;
            }
    }
};

__device__ __forceinline__ void phase_gemm_store(unsigned char* lds, const bf16_t* A, const bf16_t* Bt, int N, int K, bf16_t* O, int ldc) {
    const int nN = N >> 7, nU = (T >> 7) * nN;
    for (int u = blockIdx.x; u < nU; u += gridDim.x) {
        const int pm = u / nN, pn = u - pm * nN;
        APlain ap{A + (size_t)pm * 128 * K, K};
        EpiStoreBf16 e{O + (size_t)pm * 128 * ldc + pn * 128, ldc};
        gemm128(lds, ap, Bt + (size_t)pn * 128 * K, K, e);
    }
}
__device__ __forceinline__ void phase_gemm_resid(unsigned char* lds, const bf16_t* A, const bf16_t* Bt, const float* resid, float* out) {
    const int nU = (T >> 7) * 8;
    for (int u = blockIdx.x; u < nU; u += gridDim.x) {
        const int pm = u >> 3, pn = u & 7;
        APlain ap{A + (size_t)pm * 128 * 1024, 1024};
        const size_t off = (size_t)pm * 128 * 1024 + pn * 128;
        EpiResidF32 e{resid + off, out + off};
        gemm128(lds, ap, Bt + (size_t)pn * 128 * 1024, 1024, e);
    }
}
__device__ __forceinline__ void phase_gemm_glu(unsigned char* lds, const Params& p) {
    pg8::Gemm g{(const bf16_t*)(p.ws + WS_Z), (const bf16_t*)(p.ws + WS_WGLU), T, 512, 512}; pg8::StaticOrder S; S.init(T, 512, (int)gridDim.x, (int)blockIdx.x);
    pg8::EpiGlu256 E{(const bf16_t*)(p.ws + WS_Z), p.in[I_S5_BGLU], (bf16_t*)(p.ws + WS_MIX)};
    pg8::gemm_phase<pg8::EpiGlu256, pg8::StaticOrder, true, true>((PG8_LAS unsigned char*)lds, g, S, E);
}
__device__ __forceinline__ void phase_gemm256_store(unsigned char* lds, const bf16_t* A, const bf16_t* Bt, int N, bf16_t* O) {
    pg8::Gemm g{A, Bt, T, N, 1024}; pg8::StaticOrder S; S.init(T, N, (int)gridDim.x, (int)blockIdx.x);
    pg8::EpiStore E{O, N};
    pg8::gemm_phase<pg8::EpiStore, pg8::StaticOrder, true, true>((PG8_LAS unsigned char*)lds, g, S, E);
}
__device__ __forceinline__ void phase_gemm256_inproj1(unsigned char* lds, const Params& p) {
    pg8::Gemm g{(const bf16_t*)(p.ws + WS_XN), (const bf16_t*)(p.ws + WS_WINC), T, PC, 1024}; pg8::StaticOrderHalfTail S; S.init(T, 8 * 256, (int)gridDim.x, (int)blockIdx.x); S.nNF = 8; S.nNT = 2;
    pg8::EpiStore E{(bf16_t*)(p.ws + WS_PROJ), PC};
    pg8::gemm_phase<pg8::EpiStore, pg8::StaticOrderHalfTail, true, true>((PG8_LAS unsigned char*)lds, g, S, E);
}
__device__ __forceinline__ void phase_gemm256_inproj0(unsigned char* lds, const Params& p) {
    pg8::Gemm g{(const bf16_t*)(p.ws + WS_XN), (const bf16_t*)(p.ws + WS_WINA), T, 3840, 1024}; pg8::StaticOrder S; S.init(T, 3840, (int)gridDim.x, (int)blockIdx.x);
    pg8::EpiStoreGates E{(bf16_t*)(p.ws + WS_PROJ), PA, 14, (float*)(p.ws + WS_GATES), p.in[I_AB_GBIAS]};
    pg8::gemm_phase<pg8::EpiStoreGates, pg8::StaticOrder, true, true>((PG8_LAS unsigned char*)lds, g, S, E);
}
__device__ __forceinline__ void phase_gemm256_resid(unsigned char* lds, const bf16_t* A, const bf16_t* Bt, const float* rf, const bf16_t* rb, bf16_t* out) {
    pg8::Gemm g{A, Bt, T, 1024, 1024}; pg8::StaticOrder S; S.init(T, 1024, (int)gridDim.x, (int)blockIdx.x);
    pg8::EpiResid E{rf, rb, out};
    pg8::gemm_phase<pg8::EpiResid, pg8::StaticOrder, true, true>((PG8_LAS unsigned char*)lds, g, S, E);
}

__device__ __forceinline__ void s5_gen_ktab(const Params& p) {
    const int gt = blockIdx.x * NTHR + opaque_tid(), NGT = gridDim.x * NTHR;
    const f32x2* POW = (const f32x2*)(p.ws + WS_S5POW); const f32x2* BB = (const f32x2*)(p.ws + WS_S5BBAR);
    for (int idx = gt; idx < 32 * 4096; idx += NGT) {
        const int g = idx >> 12, tau = (idx >> 8) & 15, ch = (idx >> 4) & 15, c = idx & 15;
        float sum = 0.f;
        for (int pp = 0; pp < 64; ++pp) {
            const f32x2 l = POW[(g * 64 + pp) * 17 + tau], b = BB[(g * 64 + pp) * 16 + c];
            const float wr_ = l.x * b.x - l.y * b.y, wi_ = l.x * b.y + l.y * b.x;
            sum += p.in[I_S5_CRE][(size_t)(g * 16 + ch) * 64 + pp] * wr_ - p.in[I_S5_CIM][(size_t)(g * 16 + ch) * 64 + pp] * wi_;
        }
        if (tau == 0 && ch == c) sum += p.in[I_S5_D][g * 16 + ch];
        ((float*)(p.ws + WS_KTAB))[idx] = sum;
    }
}
__device__ __forceinline__ void s5_gen_ops(const Params& p) {
    const int gt = blockIdx.x * NTHR + opaque_tid(), NGT = gridDim.x * NTHR;
    const f32x2* POW = (const f32x2*)(p.ws + WS_S5POW); const f32x2* BB = (const f32x2*)(p.ws + WS_S5BBAR);
    const float* KT = (const float*)(p.ws + WS_KTAB);
    bf16_t* BY = (bf16_t*)(p.ws + WS_S5Y); bf16_t* BE = (bf16_t*)(p.ws + WS_S5E);
    for (int idx = gt; idx < 32 * 256 * 48; idx += NGT) {
        const int kc = idx % 48, gn = idx / 48, n = gn & 255, g = gn >> 8, t = n >> 4, ch = n & 15, k0 = kc * 8;
        float v[8];
        if (k0 < 256) {
            const int s_ = k0 >> 4, c0 = k0 & 15;
            if (s_ <= t) {
                const f32x4 a = *(const f32x4*)(KT + ((g * 16 + (t - s_)) * 16 + ch) * 16 + c0), b = *(const f32x4*)(KT + ((g * 16 + (t - s_)) * 16 + ch) * 16 + c0 + 4);
                v[0] = a.x; v[1] = a.y; v[2] = a.z; v[3] = a.w; v[4] = b.x; v[5] = b.y; v[6] = b.z; v[7] = b.w;
            } else {
#pragma unroll
                for (int j = 0; j < 8; ++j) v[j] = 0.f;
            }
        } else {
            const int p0 = (k0 - 256) & 63; const bool re = k0 < 320;
#pragma unroll
            for (int j = 0; j < 8; ++j) {
                const int pp = p0 + j; const f32x2 l = POW[(g * 64 + pp) * 17 + t + 1];
                const float cr = p.in[I_S5_CRE][(size_t)(g * 16 + ch) * 64 + pp], ci = p.in[I_S5_CIM][(size_t)(g * 16 + ch) * 64 + pp];
                v[j] = re ? (cr * l.x - ci * l.y) : -(cr * l.y + ci * l.x);
            }
        }
        *(u32x4*)(BY + (size_t)gn * 384 + k0) = (u32x4){pk2(v[0], v[1]), pk2(v[2], v[3]), pk2(v[4], v[5]), pk2(v[6], v[7])};
    }
    for (int idx = gt; idx < 32 * 128 * 32; idx += NGT) {
        const int kc = idx & 31, gn = idx >> 5, n = gn & 127, g = gn >> 7, pp = n & 63, k0 = kc * 8, s_ = k0 >> 4, c0 = k0 & 15;
        const f32x2 l = POW[(g * 64 + pp) * 17 + 15 - s_];
        float v[8];
#pragma unroll
        for (int j = 0; j < 8; ++j) { const f32x2 b = BB[(g * 64 + pp) * 16 + c0 + j]; v[j] = (n < 64) ? (l.x * b.x - l.y * b.y) : (l.x * b.y + l.y * b.x); }
        *(u32x4*)(BE + (size_t)gn * 256 + k0) = (u32x4){pk2(v[0], v[1]), pk2(v[2], v[3]), pk2(v[4], v[5]), pk2(v[6], v[7])};
    }
}
struct AS5 {
    const bf16_t* proj; const bf16_t* xp; int m0, g;
    __device__ __forceinline__ const bf16_t* operator()(int r, int kc) const {
        const int m = m0 + r, k0 = kc * 8;
        return (k0 < 256) ? proj + ((size_t)(m * 16 + (k0 >> 4)) * PC + g * 16 + (k0 & 15)) : xp + ((size_t)m * 32 + g) * 128 + (k0 - 256);
    }
};
struct EpiS5E {
    float* xend; int m0, g;
    __device__ __forceinline__ void operator()(const f32x4 (&acc)[2][4], int wr, int wc, int fr, int fq) const {
#pragma unroll
        for (int m = 0; m < 2; ++m)
#pragma unroll
            for (int n = 0; n < 4; ++n) *(f32x4*)(xend + ((size_t)(m0 + wr * 32 + m * 16 + fr) * 32 + g) * 128 + wc * 64 + n * 16 + fq * 4) = acc[m][n];
    }
};
struct EpiS5Y {
    bf16_t* Z; int m0, g, n0;
    __device__ __forceinline__ void operator()(const f32x4 (&acc)[2][4], int wr, int wc, int fr, int fq) const {
#pragma unroll
        for (int m = 0; m < 2; ++m)
#pragma unroll
            for (int n = 0; n < 4; ++n) {
                const int mm = m0 + wr * 32 + m * 16 + fr, nc = n0 + wc * 64 + n * 16 + fq * 4, t = nc >> 4, ch0 = nc & 15;
                const f32x4 v = acc[m][n];
                u32x2 o; o.x = pk2(fgelu_tanh_(v.x), fgelu_tanh_(v.y)); o.y = pk2(fgelu_tanh_(v.z), fgelu_tanh_(v.w));
                *(u32x2*)(Z + (size_t)(mm * 16 + t) * 512 + g * 16 + ch0) = o;
            }
    }
};
__device__ __forceinline__ void s5_unit_E(const Params& p, unsigned char* lds, int u) {
    const int g = u >> 3, mt = u & 7;
    AS5 a{(const bf16_t*)(p.ws + WS_PROJ), nullptr, mt * 128, g};
    EpiS5E e{(float*)(p.ws + WS_XEND), mt * 128, g};
    gemm128(lds, a, (const bf16_t*)(p.ws + WS_S5E) + (size_t)g * 128 * 256, 256, e);
}
__device__ __forceinline__ void s5_unit_Y(const Params& p, unsigned char* lds, int u) {
    const int g = u >> 3, mt = u & 7;
    AS5 a{(const bf16_t*)(p.ws + WS_PROJ), (const bf16_t*)(p.ws + WS_XPREVB), mt * 128, g};
    EpiS5Y e0{(bf16_t*)(p.ws + WS_Z), mt * 128, g, 0}, e1{(bf16_t*)(p.ws + WS_Z), mt * 128, g, 128};
    BPlain b0{(const bf16_t*)(p.ws + WS_S5Y) + (size_t)g * 256 * 384, 384}, b1{(const bf16_t*)(p.ws + WS_S5Y) + ((size_t)g * 256 + 128) * 384, 384};
    gemm128x2(lds, a, b0, b1, 384, e0, e1);
}

__device__ __forceinline__ void stage_rows(const bf16_t* __restrict__ g, int pitch, bf16_t* s, int tid) {
#pragma unroll
    for (int i = 0; i < 2; ++i) { const int pc = tid + i * NTHR, l = pc >> 4, d0 = (pc & 15) * 8; *(u32x4*)(s + l * 136 + d0) = *(const u32x4*)(g + (size_t)l * pitch + d0); }
}
__device__ __forceinline__ void stage_transposed(const bf16_t* __restrict__ g, int pitch, bf16_t* s, const float* rs, int tid) {
#pragma unroll
    for (int i = 0; i < 2; ++i) {
        const int pc = tid + i * NTHR, l = pc >> 4, d0 = (pc & 15) * 8;
        const u32x4 v = *(const u32x4*)(g + (size_t)l * pitch + d0);
        const float sc = rs ? rs[l] : 1.f;
        const unsigned w[4] = {v.x, v.y, v.z, v.w};
#pragma unroll
        for (int q = 0; q < 4; ++q) {
            s[tsw(d0 + 2 * q, l)] = (bf16_t)f2bf(bf2f(w[q] & 0xffffu) * sc);
            s[tsw(d0 + 2 * q + 1, l)] = (bf16_t)f2bf(bf2f(w[q] >> 16) * sc);
        }
    }
}
__device__ __forceinline__ void state_outer(const bf16_t* Kt, const bf16_t* Vt, bf16_t* __restrict__ Uout, int wid, int fr, int fq) {
    const int v0 = wid * 16;
    bf16x8 bv[2];
#pragma unroll
    for (int ls = 0; ls < 2; ++ls) bv[ls] = *(const bf16x8*)(Vt + tswc(v0 + fr, ls * 4 + fq));
#pragma unroll
    for (int kt = 0; kt < 8; ++kt) {
        f32x4 acc = (f32x4){0.f, 0.f, 0.f, 0.f};
#pragma unroll
        for (int ls = 0; ls < 2; ++ls) {
            const bf16x8 ak = *(const bf16x8*)(Kt + tswc(kt * 16 + fr, ls * 4 + fq));
            acc = __builtin_amdgcn_mfma_f32_16x16x32_bf16(ak, bv[ls], acc, 0, 0, 0);
        }
        u32x2 o; o.x = pk2(acc.x, acc.y); o.y = pk2(acc.z, acc.w);
        *(u32x2*)(Uout + (size_t)(v0 + fr) * 128 + kt * 16 + fq * 4) = o;
    }
}
template <int GATE>
__device__ __forceinline__ void head_norm_out(const float* Hs, const float* __restrict__ w, const bf16_t* __restrict__ gsrc, int gpitch, bf16_t* __restrict__ out, int opitch, int tid) {
    const int l = tid >> 3, part = tid & 7;
    float h[16]; float ss = 0.f;
#pragma unroll
    for (int i = 0; i < 4; ++i) { const f32x4 v = *(const f32x4*)(Hs + l * 132 + part * 16 + i * 4); h[4 * i] = v.x; h[4 * i + 1] = v.y; h[4 * i + 2] = v.z; h[4 * i + 3] = v.w; ss += v.x * v.x + v.y * v.y + v.z * v.z + v.w * v.w; }
    ss += __shfl_xor(ss, 1); ss += __shfl_xor(ss, 2); ss += __shfl_xor(ss, 4);
    const float r = rsqrtf(ss * (1.f / 128.f) + EPS);
    const u32x4 g0 = *(const u32x4*)(gsrc + (size_t)l * gpitch + part * 16), g1 = *(const u32x4*)(gsrc + (size_t)l * gpitch + part * 16 + 8);
    const unsigned gw[8] = {g0.x, g0.y, g0.z, g0.w, g1.x, g1.y, g1.z, g1.w};
    unsigned ow[8];
#pragma unroll
    for (int q = 0; q < 8; ++q) {
        const float ga = bf2f(gw[q] & 0xffffu), gb = bf2f(gw[q] >> 16);
        const float a = h[2 * q] * r * w[part * 16 + 2 * q] * (GATE == 0 ? fsigmoid_(ga) : fsilu_(ga));
        const float b = h[2 * q + 1] * r * w[part * 16 + 2 * q + 1] * (GATE == 0 ? fsigmoid_(gb) : fsilu_(gb));
        ow[q] = pk2(a, b);
    }
    *(u32x4*)(out + (size_t)l * opitch + part * 16) = (u32x4){ow[0], ow[1], ow[2], ow[3]};
    *(u32x4*)(out + (size_t)l * opitch + part * 16 + 8) = (u32x4){ow[4], ow[5], ow[6], ow[7]};
}


struct Tile2 { u32x4 v[2]; };
struct Tile4 { u32x4 v[4]; };
template <bool NT = false>
__device__ __forceinline__ void tile_load(Tile2& t, const bf16_t* __restrict__ g, int pitch, int tid) {
#pragma unroll
    for (int i = 0; i < 2; ++i) { const int pc = tid + i * NTHR; const u32x4* q = (const u32x4*)(g + (size_t)(pc >> 4) * pitch + (pc & 15) * 8); t.v[i] = NT ? __builtin_nontemporal_load(q) : *q; }
}
template <bool NT = false>
__device__ __forceinline__ void tile4_load(Tile4& t, const bf16_t* __restrict__ g, int tid) {
#pragma unroll
    for (int i = 0; i < 4; ++i) { const int pc = tid + i * NTHR; const u32x4* q = (const u32x4*)(g + (size_t)pc * 8); t.v[i] = NT ? __builtin_nontemporal_load(q) : *q; }
}
__device__ __forceinline__ void tile_put_rows(const Tile2& t, bf16_t* s, int tid) {
#pragma unroll
    for (int i = 0; i < 2; ++i) { const int pc = tid + i * NTHR; *(u32x4*)(s + (pc >> 4) * 136 + (pc & 15) * 8) = t.v[i]; }
}
__device__ __forceinline__ void tile4_put(const Tile4& t, bf16_t* s, int tid) {
#pragma unroll
    for (int i = 0; i < 4; ++i) { const int pc = tid + i * NTHR; *(u32x4*)(s + (pc >> 4) * 136 + (pc & 15) * 8) = t.v[i]; }
}
__device__ __forceinline__ void tile_put_transposed(const Tile2& t, bf16_t* s, const float* rs, int tid) {
#pragma unroll
    for (int i = 0; i < 2; ++i) {
        const int pc = tid + i * NTHR, l = pc >> 4, d0 = (pc & 15) * 8;
        const unsigned w[4] = {t.v[i].x, t.v[i].y, t.v[i].z, t.v[i].w};
        if (rs) {
            const float sc = rs[l];
#pragma unroll
            for (int q = 0; q < 4; ++q) {
                const unsigned pr = pk2(bf2f(w[q] & 0xffffu) * sc, bf2f(w[q] >> 16) * sc);
                s[tsw(d0 + 2 * q, l)] = (bf16_t)(pr & 0xffffu); s[tsw(d0 + 2 * q + 1, l)] = (bf16_t)(pr >> 16);
            }
        } else {
#pragma unroll
            for (int q = 0; q < 4; ++q) { s[tsw(d0 + 2 * q, l)] = (bf16_t)(w[q] & 0xffffu); s[tsw(d0 + 2 * q + 1, l)] = (bf16_t)(w[q] >> 16); }
        }
    }
}
template <int GATE>
__device__ __forceinline__ void head_norm_out_r(const float* Hs, const float* __restrict__ w, const u32x4 (&og)[2], bf16_t* __restrict__ out, int opitch, int tid) {
    const int l = tid >> 3, part = tid & 7;
    float h[16]; float ss = 0.f;
#pragma unroll
    for (int i = 0; i < 4; ++i) { const f32x4 v = *(const f32x4*)(Hs + l * 132 + part * 16 + i * 4); h[4 * i] = v.x; h[4 * i + 1] = v.y; h[4 * i + 2] = v.z; h[4 * i + 3] = v.w; ss += v.x * v.x + v.y * v.y + v.z * v.z + v.w * v.w; }
    ss += __shfl_xor(ss, 1); ss += __shfl_xor(ss, 2); ss += __shfl_xor(ss, 4);
    const float r = rsqrtf(ss * (1.f / 128.f) + EPS);
    const unsigned gw[8] = {og[0].x, og[0].y, og[0].z, og[0].w, og[1].x, og[1].y, og[1].z, og[1].w};
    unsigned ow[8];
#pragma unroll
    for (int q = 0; q < 8; ++q) {
        const float ga = bf2f(gw[q] & 0xffffu), gb = bf2f(gw[q] >> 16);
        const float a = h[2 * q] * r * w[part * 16 + 2 * q] * (GATE == 0 ? fsigmoid_(ga) : fsilu_(ga));
        const float b = h[2 * q + 1] * r * w[part * 16 + 2 * q + 1] * (GATE == 0 ? fsigmoid_(gb) : fsilu_(gb));
        ow[q] = pk2(a, b);
    }
    *(u32x4*)(out + (size_t)l * opitch + part * 16) = (u32x4){ow[0], ow[1], ow[2], ow[3]};
    *(u32x4*)(out + (size_t)l * opitch + part * 16 + 8) = (u32x4){ow[4], ow[5], ow[6], ow[7]};
}

__device__ __forceinline__ void phase_mlstm_local(const Params& p, unsigned char* lds) {
    const int tid = opaque_tid(), lane = tid & 63, wid = tid >> 6, fr = lane & 15, fq = lane >> 4;
    unsigned char* ws = p.ws;
    const bf16_t* PROJ = (const bf16_t*)(ws + WS_PROJ);
    const float* GATES = (const float*)(ws + WS_GATES);
    bf16_t* Kt = (bf16_t*)lds;
    bf16_t* Vt = (bf16_t*)(lds + 18432);
    float* wk = (float*)(lds + 36864);
    const int NIT = 1024 + 256;
    Tile2 rk, rv; float gi = 0.f, gf = 0.f;
    auto load_item = [&](int it) {
        const int b = it >> 8, h = (it >> 6) & 3, c = it & 63, t0 = b * SEQ + c * 64;
        tile_load(rk, PROJ + (size_t)t0 * PA + 512 + h * 128, PA, tid);
        tile_load(rv, PROJ + (size_t)t0 * PA + 1024 + h * 128, PA, tid);
        gi = GATES[(size_t)(t0 + lane) * 8 + h]; gf = GATES[(size_t)(t0 + lane) * 8 + 4 + h];
    };
    if ((int)blockIdx.x < 1024) load_item(blockIdx.x);
    for (int it = blockIdx.x; it < NIT; it += gridDim.x) {
        if (it < 1024) {
            if (wid == 0) {
                const float lf = logsigmoid_(gf);
                const float bc = wave_incl_sum(lf, lane);
                const float bend = __shfl(bc, 63);
                const float logg = bend - bc + gi;
                const float ml = wave_max(logg);
                wk[lane] = expf(logg - ml);
                if (lane == 0) { ((float*)(ws + WS_MLOC))[it] = ml; ((float*)(ws + WS_BEND))[it] = bend; }
            }
            tile_put_transposed(rk, Kt, nullptr, tid);
            __syncthreads();
            tile_put_transposed(rv, Vt, wk, tid);
            __syncthreads();
            if (it + (int)gridDim.x < 1024) load_item(it + gridDim.x);
            state_outer(Kt, Vt, (bf16_t*)(ws + WS_U) + (size_t)it * 16384, wid, fr, fq);
            {
                const int k = tid >> 2, part = tid & 3;
                float sm = 0.f;
#pragma unroll
                for (int c2 = 0; c2 < 2; ++c2) {
                    const u32x4 kv = *(const u32x4*)(Kt + tswc(k, part * 2 + c2));
                    const f32x4 wa = *(const f32x4*)(wk + part * 16 + c2 * 8), wb = *(const f32x4*)(wk + part * 16 + c2 * 8 + 4);
                    sm += bf2f(kv.x & 0xffffu) * wa.x + bf2f(kv.x >> 16) * wa.y + bf2f(kv.y & 0xffffu) * wa.z + bf2f(kv.y >> 16) * wa.w
                        + bf2f(kv.z & 0xffffu) * wb.x + bf2f(kv.z >> 16) * wb.y + bf2f(kv.w & 0xffffu) * wb.z + bf2f(kv.w >> 16) * wb.w;
                }
                sm += __shfl_xor(sm, 1); sm += __shfl_xor(sm, 2);
                if (part == 0) ((float*)(ws + WS_NLOC))[(size_t)it * 128 + k] = sm;
            }
            __syncthreads();
        } else {
            const int ci = it - 1024, t0 = ci * 64, cq = tid & 63, ts = tid >> 6, c0 = cq * 8, tb = t0 + ts * 8;
            const float* cw = p.in[I_AB_CONVW];
            float w0[8], w1[8], w2[8];
#pragma unroll
            for (int j = 0; j < 8; ++j) { w0[j] = cw[c0 + j]; w1[j] = cw[512 + c0 + j]; w2[j] = cw[1024 + c0 + j]; }
            const bool halo = ((tb & (SEQ - 1)) != 0);
            float zp2[8], zp1[8];
            {
                u32x4 g2 = (u32x4){0u, 0u, 0u, 0u}, x2 = g2, g1 = g2, x1 = g2;
                if (halo) { const bf16_t* r2 = PROJ + (size_t)(tb - 2) * PA; const bf16_t* r1 = PROJ + (size_t)(tb - 1) * PA;
                    g2 = __builtin_nontemporal_load((const u32x4*)(r2 + 2560 + c0)); x2 = __builtin_nontemporal_load((const u32x4*)(r2 + 3072 + c0));
                    g1 = __builtin_nontemporal_load((const u32x4*)(r1 + 2560 + c0)); x1 = __builtin_nontemporal_load((const u32x4*)(r1 + 3072 + c0)); }
                const unsigned a0[4] = {g2.x, g2.y, g2.z, g2.w}, b0[4] = {x2.x, x2.y, x2.z, x2.w}, a1[4] = {g1.x, g1.y, g1.z, g1.w}, b1[4] = {x1.x, x1.y, x1.z, x1.w};
#pragma unroll
                for (int q = 0; q < 4; ++q) {
                    zp2[2 * q] = bf2f(a0[q] & 0xffffu) * bf2f(b0[q] & 0xffffu); zp2[2 * q + 1] = bf2f(a0[q] >> 16) * bf2f(b0[q] >> 16);
                    zp1[2 * q] = bf2f(a1[q] & 0xffffu) * bf2f(b1[q] & 0xffffu); zp1[2 * q + 1] = bf2f(a1[q] >> 16) * bf2f(b1[q] >> 16);
                }
            }
            bf16_t* mix = (bf16_t*)(ws + WS_MIX);
#pragma unroll 1
            for (int ps = 0; ps < 2; ++ps) {
                u32x4 gbv[4], gcv[4], xiv[4];
#pragma unroll
                for (int t = 0; t < 4; ++t) { const bf16_t* r = PROJ + (size_t)(tb + ps * 4 + t) * PA;
                    gbv[t] = __builtin_nontemporal_load((const u32x4*)(r + 2048 + c0)); gcv[t] = __builtin_nontemporal_load((const u32x4*)(r + 2560 + c0)); xiv[t] = __builtin_nontemporal_load((const u32x4*)(r + 3072 + c0)); }
#pragma unroll
                for (int t = 0; t < 4; ++t) {
                    const unsigned ga[4] = {gcv[t].x, gcv[t].y, gcv[t].z, gcv[t].w}, xa[4] = {xiv[t].x, xiv[t].y, xiv[t].z, xiv[t].w}, ba[4] = {gbv[t].x, gbv[t].y, gbv[t].z, gbv[t].w};
                    float y[8];
#pragma unroll
                    for (int q = 0; q < 4; ++q) {
                        const float z0 = bf2f(ga[q] & 0xffffu) * bf2f(xa[q] & 0xffffu), z1 = bf2f(ga[q] >> 16) * bf2f(xa[q] >> 16);
                        y[2 * q] = bf2f(ba[q] & 0xffffu) * (w0[2 * q] * zp2[2 * q] + w1[2 * q] * zp1[2 * q] + w2[2 * q] * z0);
                        y[2 * q + 1] = bf2f(ba[q] >> 16) * (w0[2 * q + 1] * zp2[2 * q + 1] + w1[2 * q + 1] * zp1[2 * q + 1] + w2[2 * q + 1] * z1);
                        zp2[2 * q] = zp1[2 * q]; zp1[2 * q] = z0; zp2[2 * q + 1] = zp1[2 * q + 1]; zp1[2 * q + 1] = z1;
                    }
                    *(u32x4*)(mix + (size_t)(tb + ps * 4 + t) * 1024 + 512 + c0) = (u32x4){pk2(y[0], y[1]), pk2(y[2], y[3]), pk2(y[4], y[5]), pk2(y[6], y[7])};
                }
            }
        }
    }
}

template <bool HG>
__device__ __forceinline__ void phase_scan(const Params& p, unsigned char* lds) {
    unsigned char* ws = p.ws;
    const int tid = opaque_tid();
    const int gt = blockIdx.x * NTHR + tid, NGT = gridDim.x * NTHR;
    const bf16_t* U = (const bf16_t*)(ws + WS_U);
    bf16_t* CP = (bf16_t*)(ws + WS_CPREV);
    const float* MLOC = (const float*)(ws + WS_MLOC); const float* BEND = (const float*)(ws + WS_BEND); const float* BENDV = (const float*)(ws + WS_BENDV);
    float* sd = (float*)lds;
    float* ssu = sd + 64;
    for (int base = blockIdx.x * NTHR; base < 131072; base += NGT) {
        const int idx = base + tid;
        const int bh = idx >> 13, rem = idx & 8191, e = rem >> 6, k = (rem & 63) * 2;
        if (!HG) {
            __syncthreads();
            float* sml = ssu + 64; float* sbe = sml + 64; float* smp = sbe + 64;
            if (tid < 64) { sml[tid] = MLOC[bh * 64 + tid]; sbe[tid] = BEND[bh * 64 + tid]; }
            __syncthreads();
            if (tid == 0) {
                float m = -1e30f;
                for (int c = 0; c < 64; ++c) {
                    const float ml = sml[c], be = sbe[c];
                    smp[c] = m;
                    const float mn = fmaxf(be + m, ml);
                    sd[c] = expf(be + m - mn); ssu[c] = expf(ml - mn); m = mn;
                }
            }
            __syncthreads();
            if (rem < 64 && tid < 64) ((float*)(ws + WS_MPREV))[bh * 64 + tid] = smp[tid];
            if (tid >= 504) {
                const float* NLOC = (const float*)(ws + WS_NLOC); float* NPREV = (float*)(ws + WS_NPREV);
                const int kn = ((base & 8191) >> 9) * 8 + (tid - 504);
                float n = 0.f;
#pragma unroll
                for (int hb = 0; hb < 2; ++hb) {
                    float nl[32];
#pragma unroll
                    for (int c = 0; c < 32; ++c) nl[c] = NLOC[(unsigned)((bh * 64 + hb * 32 + c) * 128 + kn)];
#pragma unroll
                    for (int c = 0; c < 32; ++c) { NPREV[(unsigned)((bh * 64 + hb * 32 + c) * 128 + kn)] = n; n = sd[hb * 32 + c] * n + ssu[hb * 32 + c] * nl[c]; }
                }
            }
        }
        float c0 = 0.f, c1 = 0.f;
#pragma unroll
        for (int half = 0; half < 2; ++half) {
            unsigned uu[32];
#pragma unroll
            for (int c = 0; c < 32; ++c) uu[c] = __builtin_nontemporal_load((const unsigned*)(U + (size_t)(bh * 64 + half * 32 + c) * 16384 + e * 128 + k));
            f32x2 bv[32];
            if (HG) {
#pragma unroll
                for (int c = 0; c < 32; ++c) bv[c] = *(const f32x2*)(BENDV + (size_t)(bh * 64 + half * 32 + c) * 128 + k);
            }
#pragma unroll
            for (int c = 0; c < 32; ++c) {
                const size_t off = (size_t)(bh * 64 + half * 32 + c) * 16384 + e * 128 + k;
                *(unsigned*)(CP + off) = pk2(c0, c1);
                const float u0 = bf2f(uu[c] & 0xffffu), u1 = bf2f(uu[c] >> 16);
                if (!HG) { const float d = sd[half * 32 + c], su = ssu[half * 32 + c]; c0 = d * c0 + su * u0; c1 = d * c1 + su * u1; }
                else { c0 = bv[c].x * c0 + u0; c1 = bv[c].y * c1 + u1; }
            }
        }
    }
    if (HG) {
        const int lane = tid & 63, wv = tid >> 6;
        if (wv < 2) {
            const f32x2* POW = (const f32x2*)(ws + WS_S5POW); const float* XEND = (const float*)(ws + WS_XEND); bf16_t* XPB = (bf16_t*)(ws + WS_XPREVB);
            for (int sb = (blockIdx.x * 2 + wv) * 16; sb < 8192; sb += gridDim.x * 32) {
                const int seq = sb + (lane & 15), seg = lane >> 4;
                const int b = seq >> 11, g = (seq >> 6) & 31, pp = seq & 63;
                const f32x2 l16 = POW[(g * 64 + pp) * 17 + 16];
                float ar = l16.x, ai = l16.y;
#pragma unroll
                for (int q = 0; q < 6; ++q) { const float nr = ar * ar - ai * ai, ni = 2.f * ar * ai; ar = nr; ai = ni; }
                const float* xe = XEND + ((size_t)(b * 256 + seg * 64) * 32 + g) * 128 + pp;
                bf16_t* xo = XPB + ((size_t)(b * 256 + seg * 64) * 32 + g) * 128 + pp;
                float xr = 0.f, xi = 0.f;
                for (int hb = 0; hb < 4; ++hb) {
                    float er[16], ei[16];
#pragma unroll
                    for (int j = 0; j < 16; ++j) { er[j] = xe[(hb * 16 + j) * 4096]; ei[j] = xe[(hb * 16 + j) * 4096 + 64]; }
#pragma unroll
                    for (int j = 0; j < 16; ++j) { const float nr = l16.x * xr - l16.y * xi + er[j], ni = l16.x * xi + l16.y * xr + ei[j]; xr = nr; xi = ni; }
                }
                float cr = 0.f, ci = 0.f;
#pragma unroll
                for (int r = 0; r < 3; ++r) {
                    const float pr = __shfl(xr, (lane & 15) + 16 * r), pi = __shfl(xi, (lane & 15) + 16 * r);
                    if (r < seg) { const float nr = ar * cr - ai * ci + pr, ni = ar * ci + ai * cr + pi; cr = nr; ci = ni; }
                }
                xr = cr; xi = ci;
                for (int hb = 0; hb < 4; ++hb) {
                    float er[16], ei[16];
#pragma unroll
                    for (int j = 0; j < 16; ++j) { er[j] = xe[(hb * 16 + j) * 4096]; ei[j] = xe[(hb * 16 + j) * 4096 + 64]; }
#pragma unroll
                    for (int j = 0; j < 16; ++j) {
                        xo[(hb * 16 + j) * 4096] = (bf16_t)f2bf(xr); xo[(hb * 16 + j) * 4096 + 64] = (bf16_t)f2bf(xi);
                        const float nr = l16.x * xr - l16.y * xi + er[j], ni = l16.x * xi + l16.y * xr + ei[j]; xr = nr; xi = ni;
                    }
                }
            }
        }
    }
}

__device__ __forceinline__ void phase_mlstm_out(const Params& p, unsigned char* lds) {
    const int tid = opaque_tid(), lane = tid & 63, wid = tid >> 6, fr = lane & 15, fq = lane >> 4;
    unsigned char* ws = p.ws;
    const bf16_t* PROJ = (const bf16_t*)(ws + WS_PROJ);
    const float* GATES = (const float*)(ws + WS_GATES);
    bf16_t* Qs = (bf16_t*)lds;
    bf16_t* Ks = (bf16_t*)(lds + 17408);
    float* Hs = (float*)lds;
    bf16_t* Vt = (bf16_t*)(lds + 34816);
    bf16_t* Cs = (bf16_t*)(lds + 53248);
    bf16_t* Ps = (bf16_t*)(lds + 88064);
    float* sa = (float*)(lds + 97280);
    float* sg = sa + 64;
    float* sisc = sg + 64;
    float* semr = sisc + 64;
    float* sdinv = semr + 64;
    float* snp = sdinv + 64;
    Tile2 rq, rk, rv; Tile4 rc; u32x4 rog[2]; float g0 = 0.f, g1 = 0.f, g2 = 0.f, g3 = 0.f, g4 = 0.f;
    auto load_item = [&](int it) {
        const int b = it >> 8, h = (it >> 6) & 3, c = it & 63, t0 = b * SEQ + c * 64;
        tile_load<true>(rq, PROJ + (size_t)t0 * PA + h * 128, PA, tid);
        tile_load<true>(rk, PROJ + (size_t)t0 * PA + 512 + h * 128, PA, tid);
        tile_load<true>(rv, PROJ + (size_t)t0 * PA + 1024 + h * 128, PA, tid);
        tile4_load<true>(rc, (const bf16_t*)(ws + WS_CPREV) + (size_t)it * 16384, tid);
        { const bf16_t* og = PROJ + (size_t)(t0 + (tid >> 3)) * PA + 1536 + h * 128 + (tid & 7) * 16; rog[0] = __builtin_nontemporal_load((const u32x4*)og); rog[1] = __builtin_nontemporal_load((const u32x4*)(og + 8)); }
        g0 = GATES[(size_t)(t0 + lane) * 8 + h]; g1 = GATES[(size_t)(t0 + lane) * 8 + 4 + h]; g2 = ((const float*)(ws + WS_MPREV))[it];
        g3 = ((const float*)(ws + WS_NPREV))[(size_t)it * 128 + lane]; g4 = ((const float*)(ws + WS_NPREV))[(size_t)it * 128 + 64 + lane];
    };
    if ((int)blockIdx.x < 1024) load_item(blockIdx.x);
    for (int it = blockIdx.x; it < 1024; it += gridDim.x) {
        const int b = it >> 8, h = (it >> 6) & 3, c = it & 63, t0 = b * SEQ + c * 64;
        if (wid == 0) {
            const float ip = g0, fp = g1, mprev = g2;
            const float bc = wave_incl_sum(logsigmoid_(fp), lane);
            const float a = ip - bc;
            const float g = fmaxf(wave_incl_max(a, lane), mprev);
            sa[lane] = a; sg[lane] = g; sisc[lane] = expf(mprev - g); semr[lane] = expf(-(bc + g));
        } else if (wid == 1) { snp[lane] = g3; snp[64 + lane] = g4; }
        tile_put_rows(rq, Qs, tid); tile_put_rows(rk, Ks, tid); tile_put_transposed(rv, Vt, nullptr, tid); tile4_put(rc, Cs, tid);
        const u32x4 ogc[2] = {rog[0], rog[1]};
        __syncthreads();
        if (it + (int)gridDim.x < 1024) load_item(it + gridDim.x);
#pragma unroll
        for (int i = 0; i < 2; ++i) {
            const int tix = wid * 2 + i, lt = tix >> 2, st = tix & 3;
            f32x4 acc = (f32x4){0.f, 0.f, 0.f, 0.f};
            if (st <= lt) {
#pragma unroll
                for (int ks = 0; ks < 4; ++ks) {
                    const bf16x8 ak = *(const bf16x8*)(Ks + (st * 16 + fr) * 136 + ks * 32 + fq * 8);
                    const bf16x8 bq = *(const bf16x8*)(Qs + (lt * 16 + fr) * 136 + ks * 32 + fq * 8);
                    acc = __builtin_amdgcn_mfma_f32_16x16x32_bf16(ak, bq, acc, 0, 0, 0);
                }
            }
            const int l = lt * 16 + fr; const float gl = sg[l];
            float pv[4];
#pragma unroll
            for (int r = 0; r < 4; ++r) { const int s = st * 16 + fq * 4 + r; pv[r] = (s <= l) ? acc[r] * fexp_(sa[s] - gl) : 0.f; }
            u32x2 o; o.x = pk2(pv[0], pv[1]); o.y = pk2(pv[2], pv[3]);
            *(u32x2*)(Ps + l * 72 + st * 16 + fq * 4) = o;
        }
        __syncthreads();
        {
            const int l = tid >> 3, part = tid & 7;
            float rs = 0.f, qn = 0.f;
            const u32x4 pw = *(const u32x4*)(Ps + l * 72 + part * 8);
            rs = (bf2f(pw.x & 0xffffu) + bf2f(pw.x >> 16)) + (bf2f(pw.y & 0xffffu) + bf2f(pw.y >> 16)) + (bf2f(pw.z & 0xffffu) + bf2f(pw.z >> 16)) + (bf2f(pw.w & 0xffffu) + bf2f(pw.w >> 16));
            const u32x4 q0 = *(const u32x4*)(Qs + l * 136 + part * 16), q1 = *(const u32x4*)(Qs + l * 136 + part * 16 + 8);
            const unsigned qw[8] = {q0.x, q0.y, q0.z, q0.w, q1.x, q1.y, q1.z, q1.w};
#pragma unroll
            for (int j = 0; j < 8; ++j) qn += bf2f(qw[j] & 0xffffu) * snp[part * 16 + 2 * j] + bf2f(qw[j] >> 16) * snp[part * 16 + 2 * j + 1];
            rs += __shfl_xor(rs, 1); rs += __shfl_xor(rs, 2); rs += __shfl_xor(rs, 4);
            qn += __shfl_xor(qn, 1); qn += __shfl_xor(qn, 2); qn += __shfl_xor(qn, 4);
            if (part == 0) { const float den = rs + sisc[l] * qn; sdinv[l] = 1.f / fmaxf(fabsf(den), semr[l]); }
        }
        f32x4 a1[4], a2[4];
#pragma unroll
        for (int lt = 0; lt < 4; ++lt) { a1[lt] = (f32x4){0.f, 0.f, 0.f, 0.f}; a2[lt] = (f32x4){0.f, 0.f, 0.f, 0.f}; }
        {
            const int e0 = wid * 16;
#pragma unroll
            for (int ss = 0; ss < 2; ++ss) {
                const bf16x8 av = *(const bf16x8*)(Vt + tswc(e0 + fr, ss * 4 + fq));
#pragma unroll
                for (int lt = 0; lt < 4; ++lt) { const bf16x8 bp = *(const bf16x8*)(Ps + (lt * 16 + fr) * 72 + ss * 32 + fq * 8); a1[lt] = __builtin_amdgcn_mfma_f32_16x16x32_bf16(av, bp, a1[lt], 0, 0, 0); }
            }
#pragma unroll
            for (int ks = 0; ks < 4; ++ks) {
                const bf16x8 ac = *(const bf16x8*)(Cs + (e0 + fr) * 136 + ks * 32 + fq * 8);
#pragma unroll
                for (int lt = 0; lt < 4; ++lt) { const bf16x8 bq = *(const bf16x8*)(Qs + (lt * 16 + fr) * 136 + ks * 32 + fq * 8); a2[lt] = __builtin_amdgcn_mfma_f32_16x16x32_bf16(ac, bq, a2[lt], 0, 0, 0); }
            }
        }
        __syncthreads();
        {
            const int e0 = wid * 16;
#pragma unroll
            for (int lt = 0; lt < 4; ++lt) {
                const int l = lt * 16 + fr; const float is = sisc[l], di = sdinv[l];
                const f32x4 hv = (a1[lt] + a2[lt] * is) * di;
                *(f32x4*)(Hs + l * 132 + e0 + fq * 4) = hv;
            }
        }
        __syncthreads();
        head_norm_out_r<0>(Hs, p.in[I_AB_HNORM] + h * 128, ogc, (bf16_t*)(ws + WS_MIX) + (size_t)t0 * 1024 + h * 128, 1024, tid);
        __syncthreads();
    }
}

__device__ __forceinline__ void load_h_row(const Params& p, int row, int lane, bool combine, f32x4 (&v)[4], int ylayer = 0) {
    const bf16_t* hrow = (const bf16_t*)(p.ws + WS_H16) + (size_t)row * 1024;
#pragma unroll
    for (int j = 0; j < 4; ++j) { const u32x2 a = *(const u32x2*)(hrow + 4 * lane + 256 * j); v[j] = (f32x4){bf2f(a.x & 0xffffu), bf2f(a.x >> 16), bf2f(a.y & 0xffffu), bf2f(a.y >> 16)}; }
    if (combine) {
        const bf16_t* y0 = (const bf16_t*)(p.ws + ws_y(ylayer)) + (size_t)row * 1024;
        const bf16_t* y1 = y0 + (size_t)T * 1024;
#pragma unroll
        for (int j = 0; j < 4; ++j) {
            const u32x2 a = __builtin_nontemporal_load((const u32x2*)(y0 + 4 * lane + 256 * j)), bq = __builtin_nontemporal_load((const u32x2*)(y1 + 4 * lane + 256 * j));
            v[j].x += bf2f(a.x & 0xffffu) + bf2f(bq.x & 0xffffu); v[j].y += bf2f(a.x >> 16) + bf2f(bq.x >> 16);
            v[j].z += bf2f(a.y & 0xffffu) + bf2f(bq.y & 0xffffu); v[j].w += bf2f(a.y >> 16) + bf2f(bq.y >> 16);
        }
    }
}

__device__ __forceinline__ void phase_combine_norm(const Params& p, bool final_) {
    const int tid = opaque_tid(), lane = tid & 63, wid = tid >> 6;
    const int gw = blockIdx.x * 8 + wid, NGW = gridDim.x * 8;
    for (int row = gw; row < T; row += NGW) {
        f32x4 v[4];
        load_h_row(p, row, lane, true, v, final_ ? 1 : 0);
        float* hrow = p.out + (size_t)row * 1024;
        if (!final_) {
            bf16_t* h16 = (bf16_t*)(p.ws + WS_H16) + (size_t)row * 1024;
#pragma unroll
            for (int j = 0; j < 4; ++j) { u32x2 o; o.x = pk2(v[j].x, v[j].y); o.y = pk2(v[j].z, v[j].w); *(u32x2*)(h16 + 4 * lane + 256 * j) = o; }
            rms_row(v, p.in[I_NORM_MIX] + 1024, (bf16_t*)(p.ws + WS_XN) + (size_t)row * 1024, lane);
        } else {
            float ss = 0.f;
#pragma unroll
            for (int j = 0; j < 4; ++j) ss += v[j].x * v[j].x + v[j].y * v[j].y + v[j].z * v[j].z + v[j].w * v[j].w;
            ss = wave_sum(ss);
            const float r = rsqrtf(ss * (1.f / 1024.f) + EPS);
#pragma unroll
            for (int j = 0; j < 4; ++j) { const f32x4 w4 = *(const f32x4*)(p.in[I_NORM_FINAL] + 4 * lane + 256 * j); __builtin_nontemporal_store(v[j] * r * w4, (f32x4*)(hrow + 4 * lane + 256 * j)); }
        }
    }
}

__device__ __forceinline__ void moe_convert(const Params& p, unsigned char* lds, int layer, int it_lo, int it_hi, int gw, int NGW, int wid, int lane) {
    unsigned char* ws = p.ws;
    float* scr = (float*)(lds + wid * 8704);
    const float* wg = p.in[I_MOE_WGATE] + (size_t)layer * 32 * 1024 * 256;
    const float* wu = p.in[I_MOE_WUP] + (size_t)layer * 32 * 1024 * 256;
    const float* wd = p.in[I_MOE_WDOWN] + (size_t)layer * 32 * 256 * 1024;
    bf16_t* WGU = (bf16_t*)(ws + ws_wgu(layer)); bf16_t* WD = (bf16_t*)(ws + ws_wd(layer));
    constexpr int IT_GU = 16 * 16, IT_D = 32 * 4, IT_E = IT_GU + IT_D;
    for (int it0 = it_lo + gw; it0 < it_hi; it0 += NGW) {
        const int e = it0 / IT_E; int it = it0 - e * IT_E;
        const float* src; bf16_t* dst; int ldn, ldk;
        if (it < IT_GU) {
            const int nb = it >> 4, kb = it & 15, n0 = nb * 32, k0 = kb * 64;
            const int pn = n0 >> 8, isup = (n0 >> 7) & 1, f0 = pn * 128 + (n0 & 127);
            src = (isup ? wu : wg) + (size_t)e * 1024 * 256 + (size_t)k0 * 256 + f0; ldn = 256;
            dst = WGU + (size_t)e * 512 * 1024 + (size_t)n0 * 1024 + k0; ldk = 1024;
        } else {
            it -= IT_GU;
            const int nb = it >> 2, kb = it & 3, n0 = nb * 32, k0 = kb * 64;
            src = wd + (size_t)e * 256 * 1024 + (size_t)k0 * 1024 + n0; ldn = 1024;
            dst = WD + (size_t)e * 1024 * 256 + (size_t)n0 * 256 + k0; ldk = 256;
        }
        transpose_tile(src, ldn, dst, ldk, 1.f, scr, lane);
    }
}
template <int RSEL>
__device__ __forceinline__ void phase_route(const Params& p, unsigned char* lds, int layer) {
    const int tid = opaque_tid(), lane = tid & 63, wid = tid >> 6, fr = lane & 15, fq = lane >> 4;
    const int gw = blockIdx.x * 8 + wid, NGW = gridDim.x * 8;
    unsigned char* ws = p.ws;
    if (RSEL != 2) moe_convert(p, lds, layer, (layer == 1 && (int)gridDim.x > 128) ? MOE_CONV_EARLY : 0, MOE_CONV_ITEMS, gw, NGW, wid, lane);
    __syncthreads();
    if (RSEL == 1) return;
    float* part = (float*)lds;
    float* ssp = (float*)(lds + 98304);
    float* lg = (float*)(lds + 98304 + 2048);
    int* rexp = (int*)(lds + 98304 + 2048 + 12288 + 256);
    float* rwt = (float*)(rexp + 128);
    const bf16_t* H16 = (const bf16_t*)(ws + WS_H16);
    const bf16_t* wf = (const bf16_t*)(ws + WS_WCAT) + (size_t)layer * 2 * 6144 * 8;
    int* cnt = (int*)(ws + WS_CTL) + layer * 32;
    int* list = (int*)(ws + WS_LIST); float* wlist = (float*)(ws + WS_WLIST);
    bf16x8 bh[4][3], bl[4][3];
#pragma unroll
    for (int s_ = 0; s_ < 4; ++s_)
#pragma unroll
        for (int n = 0; n < 3; ++n) {
            bh[s_][n] = *(const bf16x8*)(wf + ((size_t)((wid * 4 + s_) * 3 + n) * 64 + lane) * 8);
            bl[s_][n] = *(const bf16x8*)(wf + ((size_t)6144 + (size_t)((wid * 4 + s_) * 3 + n) * 64 + lane) * 8);
        }
    for (int grp = blockIdx.x; grp < T / 64; grp += gridDim.x) {
        const int row0 = grp * 64;
#pragma unroll
        for (int rt = 0; rt < 4; ++rt) {
            bf16x8 a[4];
#pragma unroll
            for (int s_ = 0; s_ < 4; ++s_) a[s_] = *(const bf16x8*)(H16 + (size_t)(row0 + rt * 16 + fr) * 1024 + wid * 128 + s_ * 32 + fq * 8);
            f32x4 acc[3] = {(f32x4){0.f, 0.f, 0.f, 0.f}, (f32x4){0.f, 0.f, 0.f, 0.f}, (f32x4){0.f, 0.f, 0.f, 0.f}};
            float ss = 0.f;
#pragma unroll
            for (int s_ = 0; s_ < 4; ++s_) {
#pragma unroll
                for (int j = 0; j < 8; ++j) { const float x = bf2f((unsigned short)a[s_][j]); ss += x * x; }
#pragma unroll
                for (int n = 0; n < 3; ++n) {
                    acc[n] = __builtin_amdgcn_mfma_f32_16x16x32_bf16(a[s_], bl[s_][n], acc[n], 0, 0, 0);
                    acc[n] = __builtin_amdgcn_mfma_f32_16x16x32_bf16(a[s_], bh[s_][n], acc[n], 0, 0, 0);
                }
            }
            ss += __shfl_xor(ss, 16); ss += __shfl_xor(ss, 32);
            if (fq == 0) ssp[wid * 64 + rt * 16 + fr] = ss;
#pragma unroll
            for (int n = 0; n < 3; ++n)
#pragma unroll
                for (int r = 0; r < 4; ++r) part[(wid * 64 + rt * 16 + fq * 4 + r) * 48 + n * 16 + fr] = acc[n][r];
        }
        __syncthreads();
        if (tid < 64) {
            float t = 0.f;
#pragma unroll
            for (int w = 0; w < 8; ++w) t += ssp[w * 64 + tid];
            lg[64 * 48 + tid] = rsqrtf(t * (1.f / 1024.f) + EPS);
        }
        for (int i = tid; i < 64 * 48; i += NTHR) {
            float t = 0.f;
#pragma unroll
            for (int w = 0; w < 8; ++w) t += part[w * 3072 + i];
            lg[i] = t;
        }
        __syncthreads();
        if (wid == 0) {
            const int row = row0 + tid;
            const float rs = lg[64 * 48 + tid];
            const float* l = lg + tid * 48;
            const float* bg = p.in[I_MOE_BG] + layer * 4; const float* br = p.in[I_MOE_BR] + layer * 32;
            float gm = l[32] * rs + bg[0]; int gi = 0; float gl[4]; gl[0] = gm;
#pragma unroll
            for (int i = 1; i < 4; ++i) { gl[i] = l[32 + i] * rs + bg[i]; if (gl[i] > gm) { gm = gl[i]; gi = i; } }
            float gs = 0.f;
#pragma unroll
            for (int i = 0; i < 4; ++i) gs += expf(gl[i] - gm);
            const float gval = 1.f / gs;
            float m1 = -3.0e38f, m2 = -3.0e38f; int i1 = 0, i2 = 0;
#pragma unroll
            for (int i = 0; i < 8; ++i) {
                const float v = l[gi * 8 + i] * rs + br[gi * 8 + i];
                if (v > m1) { m2 = m1; i2 = i1; m1 = v; i1 = i; } else if (v > m2) { m2 = v; i2 = i; }
            }
            const float e2 = expf(m2 - m1), inv = gval / (1.f + e2);
            rexp[tid * 2] = (gi * 8 + i1) | (row << 8); rexp[tid * 2 + 1] = (gi * 8 + i2) | (row << 8); rwt[tid * 2] = inv; rwt[tid * 2 + 1] = inv * e2;
            LDS_WAIT();
            if (tid < 32) {
                int c = 0;
                for (int j = 0; j < 128; ++j) c += ((rexp[j] & 255) == tid) ? 1 : 0;
                int pos = (c > 0) ? atomicAdd(&cnt[tid], c) : 0;
                for (int j = 0; j < 128; ++j) {
                    const int en = rexp[j];
                    if ((en & 255) == tid) { list[tid * ECAP + pos] = (en >> 8) * 2 + (j & 1); wlist[tid * ECAP + pos] = rwt[j]; ++pos; }
                }
            }
        } else {
            for (int r = wid - 1; r < 64; r += 7) {
                const float rs = lg[64 * 48 + r];
                const bf16_t* hrow = H16 + (size_t)(row0 + r) * 1024;
                bf16_t* xrow = (bf16_t*)(ws + WS_XN) + (size_t)(row0 + r) * 1024;
#pragma unroll
                for (int j = 0; j < 4; ++j) {
                    const u32x2 hv = *(const u32x2*)(hrow + 4 * lane + 256 * j);
                    const f32x4 w4 = *(const f32x4*)(p.in[I_NORM_FFN] + layer * 1024 + 4 * lane + 256 * j);
                    u32x2 o; o.x = pk2(bf2f(hv.x & 0xffffu) * rs * w4.x, bf2f(hv.x >> 16) * rs * w4.y); o.y = pk2(bf2f(hv.y & 0xffffu) * rs * w4.z, bf2f(hv.y >> 16) * rs * w4.w);
                    *(u32x2*)(xrow + 4 * lane + 256 * j) = o;
                }
            }
        }
        __syncthreads();
    }
}

struct AGather {
    const bf16_t* XN; const int* lst; int n;
    __device__ __forceinline__ const bf16_t* operator()(int r, int kc) const { const int tok = (r < n) ? (lst[r] >> 1) : 0; return XN + (size_t)tok * 1024 + kc * 8; }
};
struct EpiGateUp {
    bf16_t* H;
    __device__ __forceinline__ void operator()(const f32x4 (&acc)[2][4], int wr, int wc, int fr, int fq) const {
#pragma unroll
        for (int m = 0; m < 2; ++m)
#pragma unroll
            for (int n = 0; n < 2; ++n) {
                const f32x4 g = acc[m][n], u = acc[m][n + 2];
                u32x2 o; o.x = pk2(fsilu_(g.x) * u.x, fsilu_(g.y) * u.y); o.y = pk2(fsilu_(g.z) * u.z, fsilu_(g.w) * u.w);
                *(u32x2*)(H + (size_t)(wr * 32 + m * 16 + fr) * 256 + wc * 32 + n * 16 + fq * 4) = o;
            }
    }
};
struct EpiDown {
    bf16_t* Y; const int* lst; const float* wl; int n; int col0;
    __device__ __forceinline__ void operator()(const f32x4 (&acc)[2][4], int wr, int wc, int fr, int fq) const {
#pragma unroll
        for (int m = 0; m < 2; ++m) {
            const int r = wr * 32 + m * 16 + fr;
            if (r < n) {
                const int en = lst[r]; const float w = wl[r];
                bf16_t* yr = Y + ((size_t)(en & 1) * T + (en >> 1)) * 1024 + col0 + wc * 64 + fq * 4;
#pragma unroll
                for (int nn = 0; nn < 4; ++nn) { const f32x4 v = acc[m][nn] * w; u32x2 o; o.x = pk2(v.x, v.y); o.y = pk2(v.z, v.w); *(u32x2*)(yr + nn * 16) = o; }
            }
        }
    }
};
__device__ __forceinline__ void moe_prefix(const Params& p, int layer, int* tp, int* cn) {
    const int* cnt = (const int*)(p.ws + WS_CTL) + layer * 32;
    int* sp = cn + 32;
    const int tid = opaque_tid();
    __syncthreads();
    if (tid < 32) cn[tid] = cnt[tid];
    __syncthreads();
    if (tid == 0) {
        int s_ = 0, q_ = 0;
        for (int e = 0; e < 32; ++e) {
            const int c = cn[e], rem = c & 255;
            tp[e] = s_; sp[e] = q_;
            s_ += (c >> 8) + (rem > 128 ? 1 : 0); q_ += (rem > 0 && rem <= 128) ? 1 : 0;
        }
        tp[32] = s_; sp[32] = q_;
    }
    __syncthreads();
}
struct BGateUp {
    const bf16_t* W; int f0;
    __device__ __forceinline__ const bf16_t* operator()(int r, int kc) const {
        const int f = f0 + (r >> 6) * 32 + ((r >> 4) & 1) * 16 + (r & 15), isup = (r >> 5) & 1;
        return W + (size_t)((f >> 7) * 256 + isup * 128 + (f & 127)) * 1024 + kc * 8;
    }
};
constexpr int LDS_MOE_TAB = 131072, LDS_MOE_TP = 131072 + 4096;
__device__ __forceinline__ void phase_moe_up(const Params& p, unsigned char* lds, int layer) {
    unsigned* tab = (unsigned*)(lds + LDS_MOE_TAB); int* tp = (int*)(lds + LDS_MOE_TP); int* cn = tp + 64;
    moe_prefix(p, layer, tp, cn);
    pg8::SchedMoe S{tp, cn, tab, 2, tp[32] * 2, (int)gridDim.x, (int)blockIdx.x};
    const int* list = (const int*)(p.ws + WS_LIST);
    const int tid = opaque_tid();
    for (int i = 0; i < pg8::MOE_MAXU; ++i) {
        pg8::Unit u; if (!S.next(i, u)) break;
        const int e = u.pn >> 1, pos = (u.pm - tp[e]) * 256 + tid;
        if (tid < 256) tab[i * 256 + tid] = (pos < cn[e]) ? (unsigned)(list[(size_t)e * ECAP + pos] >> 1) * 2048u : 0u;
    }
    __syncthreads();
    pg8::Gemm g{(const bf16_t*)(p.ws + WS_XN), (const bf16_t*)(p.ws + ws_wgu(layer)), 0, 0, 1024};
    pg8::EpiMoeUp E{(bf16_t*)(p.ws + WS_HID)};
    pg8::gemm_phase_g<pg8::EpiMoeUp, pg8::SchedMoe>((PG8_LAS unsigned char*)lds, g, S, E);
    __syncthreads();
    const int* sp = cn + 32; const int nsm = sp[32], np8 = tp[32];
    for (int u = blockIdx.x; u < nsm * 4; u += gridDim.x) {
        const int si = u >> 2, pn4 = u & 3;
        int e = 0; while (sp[e + 1] <= si) ++e;
        const int pos0 = (tp[e + 1] - tp[e]) * 256, n = cn[e] - pos0;
        AGather ag{(const bf16_t*)(p.ws + WS_XN), list + (size_t)e * ECAP + pos0, n};
        BGateUp bg{(const bf16_t*)(p.ws + ws_wgu(layer)) + (size_t)e * 512 * 1024, pn4 * 64};
        EpiGateUp ep{(bf16_t*)(p.ws + WS_HID) + ((size_t)np8 * 256 + (size_t)si * 128) * 256 + pn4 * 64};
        gemm128b(lds, ag, bg, 1024, ep);
    }
}
__device__ __forceinline__ void phase_moe_down(const Params& p, unsigned char* lds, int layer) {
    unsigned* tab = (unsigned*)(lds + LDS_MOE_TAB); float* wtab = (float*)(lds + LDS_MOE_TAB + 4096); int* tp = (int*)(lds + LDS_MOE_TP + 4096); int* cn = tp + 64;
    moe_prefix(p, layer, tp, cn);
    pg8::SchedMoe S{tp, cn, tab, 4, tp[32] * 4, (int)gridDim.x, (int)blockIdx.x};
    const int* list = (const int*)(p.ws + WS_LIST); const float* wlist = (const float*)(p.ws + WS_WLIST);
    const int tid = opaque_tid();
    for (int i = 0; i < pg8::MOE_MAXU; ++i) {
        pg8::Unit u; if (!S.next(i, u)) break;
        const int e = u.pn >> 2, pos = (u.pm - tp[e]) * 256 + tid;
        if (tid < 256) {
            const bool ok = pos < cn[e];
            const int en = ok ? list[(size_t)e * ECAP + pos] : 0;
            tab[i * 256 + tid] = ok ? (unsigned)((en & 1) * T + (en >> 1)) : 0xffffffffu;
            wtab[i * 256 + tid] = ok ? wlist[(size_t)e * ECAP + pos] : 0.f;
        }
    }
    __syncthreads();
    pg8::Gemm g{(const bf16_t*)(p.ws + WS_HID), (const bf16_t*)(p.ws + ws_wd(layer)), 0, 0, 256};
    pg8::EpiMoeDown E{(bf16_t*)(p.ws + ws_y(layer)), tab, wtab};
    pg8::gemm_phase<pg8::EpiMoeDown, pg8::SchedMoe, true, true>((PG8_LAS unsigned char*)lds, g, S, E);
    __syncthreads();
    const int* sp = cn + 32; const int nsm = sp[32], np8 = tp[32];
    for (int u = blockIdx.x; u < nsm * 8; u += gridDim.x) {
        const int si = u >> 3, pn8 = u & 7;
        int e = 0; while (sp[e + 1] <= si) ++e;
        const int pos0 = (tp[e + 1] - tp[e]) * 256, n = cn[e] - pos0;
        APlain ap{(const bf16_t*)(p.ws + WS_HID) + ((size_t)np8 * 256 + (size_t)si * 128) * 256, 256};
        EpiDown ep{(bf16_t*)(p.ws + ws_y(layer)), list + (size_t)e * ECAP + pos0, wlist + (size_t)e * ECAP + pos0, n, pn8 * 128};
        gemm128(lds, ap, (const bf16_t*)(p.ws + ws_wd(layer)) + (size_t)e * 1024 * 256 + (size_t)pn8 * 128 * 256, 256, ep);
    }
}

constexpr int LDS_HG_SEG = 98304, LDS_HG_LBT = 106496;
struct HgBlk { float bc[4][4]; float kk[4][4]; };
__device__ __forceinline__ void hgrn_lb_table(const Params& p, float* lbt, int tid) {
    const float* lbp = p.in[I_HGRN_LB];
    lbt[tid] = sigmoid_(lbp[512 + tid] - lbp[tid]);
    __syncthreads();
}
__device__ __forceinline__ void hg_block(const bf16_t* __restrict__ fg, const float* lbt, float* seg, int tid, HgBlk& B) {
    const int k0 = (tid & 31) * 4, l0 = (tid >> 5) * 4;
    const f32x4 lb4 = *(const f32x4*)(lbt + k0);
    u32x2 w[4];
#pragma unroll
    for (int i = 0; i < 4; ++i) w[i] = *(const u32x2*)(fg + (size_t)(l0 + i) * PC + k0);
    float run[4] = {1.f, 1.f, 1.f, 1.f};
#pragma unroll
    for (int i = 0; i < 4; ++i) {
        const float x[4] = {bf2f(w[i].x & 0xffffu), bf2f(w[i].x >> 16), bf2f(w[i].y & 0xffffu), bf2f(w[i].y >> 16)};
#pragma unroll
        for (int j = 0; j < 4; ++j) {
            const float lb = lb4[j], sg = fsigmoid_(x[j]), f = lb + (1.f - lb) * sg;
            run[j] *= f; B.bc[i][j] = run[j]; B.kk[i][j] = (1.f - lb) * (1.f - sg);
        }
    }
    *(f32x4*)(seg + (tid >> 5) * 128 + k0) = (f32x4){run[0], run[1], run[2], run[3]};
}
__device__ __forceinline__ void hg_offsets(const float* seg, int tid, HgBlk& B, f32x4& bend) {
    const int k0 = (tid & 31) * 4, ls = tid >> 5;
    f32x4 off = (f32x4){1.f, 1.f, 1.f, 1.f}, tot = off;
#pragma unroll
    for (int r = 0; r < 16; ++r) { const f32x4 v = *(const f32x4*)(seg + r * 128 + k0); if (r < ls) off *= v; tot *= v; }
#pragma unroll
    for (int i = 0; i < 4; ++i)
#pragma unroll
        for (int j = 0; j < 4; ++j) B.bc[i][j] *= off[j];
    bend = tot;
}

__device__ __forceinline__ void phase_cd_local(const Params& p, unsigned char* lds) {
    const int tid = opaque_tid(), lane = tid & 63, wid = tid >> 6, fr = lane & 15, fq = lane >> 4;
    unsigned char* ws = p.ws;
    const bf16_t* PROJ = (const bf16_t*)(ws + WS_PROJ);
    bf16_t* KhT = (bf16_t*)lds;
    bf16_t* Vt = (bf16_t*)(lds + 18432);
    float* seg = (float*)(lds + LDS_HG_SEG); float* lbt = (float*)(lds + LDS_HG_LBT);
    hgrn_lb_table(p, lbt, tid);
    const int k0 = (tid & 31) * 4, l0 = (tid >> 5) * 4;
    for (int it = blockIdx.x; it < 1024 + 256; it += gridDim.x) {
        if (it < 1024) {
            const int b = it >> 8, h = (it >> 6) & 3, c = it & 63, t0 = b * SEQ + c * 64;
            HgBlk B;
            hg_block(PROJ + (size_t)t0 * PC + 1024 + h * 128, lbt + h * 128, seg, tid, B);
            Tile2 rv; tile_load(rv, PROJ + (size_t)t0 * PC + 1536 + h * 128, PC, tid);
            __syncthreads();
            f32x4 bend; hg_offsets(seg, tid, B, bend);
#pragma unroll
            for (int j = 0; j < 4; ++j) {
                u32x2 o; o.x = pk2(B.kk[0][j] * bend[j] * __builtin_amdgcn_rcpf(B.bc[0][j]), B.kk[1][j] * bend[j] * __builtin_amdgcn_rcpf(B.bc[1][j]));
                o.y = pk2(B.kk[2][j] * bend[j] * __builtin_amdgcn_rcpf(B.bc[2][j]), B.kk[3][j] * bend[j] * __builtin_amdgcn_rcpf(B.bc[3][j]));
                *(u32x2*)(KhT + tsw(k0 + j, l0)) = o;
            }
            if (tid < 32) *(f32x4*)((float*)(ws + WS_BENDV) + (size_t)it * 128 + k0) = bend;
            tile_put_transposed(rv, Vt, nullptr, tid);
            __syncthreads();
            state_outer(KhT, Vt, (bf16_t*)(ws + WS_U) + (size_t)it * 16384, wid, fr, fq);
            __syncthreads();
        } else {
            s5_unit_E(p, lds, it - 1024);
        }
    }
}

template <int SEL>
__device__ __forceinline__ void phase_cd_out(const Params& p, unsigned char* lds) {
    const int tid = opaque_tid(), lane = tid & 63, wid = tid >> 6, fr = lane & 15, fq = lane >> 4;
    unsigned char* ws = p.ws;
    const bf16_t* PROJ = (const bf16_t*)(ws + WS_PROJ);
    bf16_t* Qs = (bf16_t*)lds;
    bf16_t* Ks = (bf16_t*)(lds + 17408);
    float* Hs = (float*)lds;
    bf16_t* Vt = (bf16_t*)(lds + 34816);
    bf16_t* Ss = (bf16_t*)(lds + 53248);
    bf16_t* Ps = (bf16_t*)(lds + 88064);
    float* seg = (float*)(lds + LDS_HG_SEG); float* lbt = (float*)(lds + LDS_HG_LBT);
    hgrn_lb_table(p, lbt, tid);
    const int k0 = (tid & 31) * 4, l0 = (tid >> 5) * 4;
    for (int it = blockIdx.x + (SEL == 2 ? 1024 : 0); it < (SEL == 1 ? 1024 : 1024 + 256); it += gridDim.x) {
        if (it < 1024) {
            const int b = it >> 8, h = (it >> 6) & 3, c = it & 63, t0 = b * SEQ + c * 64;
            HgBlk B;
            hg_block(PROJ + (size_t)t0 * PC + 1024 + h * 128, lbt + h * 128, seg, tid, B);
            u32x2 qw[4];
#pragma unroll
            for (int i = 0; i < 4; ++i) qw[i] = __builtin_nontemporal_load((const u32x2*)(PROJ + (size_t)(t0 + l0 + i) * PC + 512 + h * 128 + k0));
            Tile2 rv; Tile4 rs;
            tile_load<true>(rv, PROJ + (size_t)t0 * PC + 1536 + h * 128, PC, tid);
            tile4_load<true>(rs, (const bf16_t*)(ws + WS_CPREV) + (size_t)it * 16384, tid);
            tile_put_transposed(rv, Vt, nullptr, tid); tile4_put(rs, Ss, tid);
            __syncthreads();
            f32x4 bend; hg_offsets(seg, tid, B, bend);
#pragma unroll
            for (int i = 0; i < 4; ++i) {
                const float q0 = bf2f(qw[i].x & 0xffffu), q1 = bf2f(qw[i].x >> 16), q2 = bf2f(qw[i].y & 0xffffu), q3 = bf2f(qw[i].y >> 16);
                const float e0 = B.bc[i][0], e1 = B.bc[i][1], e2 = B.bc[i][2], e3 = B.bc[i][3];
                u32x2 oq; oq.x = pk2(q0 * e0, q1 * e1); oq.y = pk2(q2 * e2, q3 * e3);
                u32x2 ok; ok.x = pk2(B.kk[i][0] * __builtin_amdgcn_rcpf(e0), B.kk[i][1] * __builtin_amdgcn_rcpf(e1)); ok.y = pk2(B.kk[i][2] * __builtin_amdgcn_rcpf(e2), B.kk[i][3] * __builtin_amdgcn_rcpf(e3));
                *(u32x2*)(Qs + (l0 + i) * 136 + k0) = oq; *(u32x2*)(Ks + (l0 + i) * 136 + k0) = ok;
            }
            __syncthreads();
#pragma unroll
            for (int i = 0; i < 2; ++i) {
                const int tix = wid * 2 + i, lt = tix >> 2, st = tix & 3;
                f32x4 acc = (f32x4){0.f, 0.f, 0.f, 0.f};
                if (st <= lt) {
#pragma unroll
                    for (int ks = 0; ks < 4; ++ks) {
                        const bf16x8 ak = *(const bf16x8*)(Ks + (st * 16 + fr) * 136 + ks * 32 + fq * 8);
                        const bf16x8 bq = *(const bf16x8*)(Qs + (lt * 16 + fr) * 136 + ks * 32 + fq * 8);
                        acc = __builtin_amdgcn_mfma_f32_16x16x32_bf16(ak, bq, acc, 0, 0, 0);
                    }
                }
                const int l = lt * 16 + fr;
                float pv[4];
#pragma unroll
                for (int r = 0; r < 4; ++r) { const int s_ = st * 16 + fq * 4 + r; pv[r] = (s_ <= l) ? acc[r] : 0.f; }
                u32x2 o; o.x = pk2(pv[0], pv[1]); o.y = pk2(pv[2], pv[3]);
                *(u32x2*)(Ps + l * 72 + st * 16 + fq * 4) = o;
            }
            __syncthreads();
            f32x4 a1[4];
#pragma unroll
            for (int lt = 0; lt < 4; ++lt) a1[lt] = (f32x4){0.f, 0.f, 0.f, 0.f};
            {
                const int e0 = wid * 16;
#pragma unroll
                for (int ss = 0; ss < 2; ++ss) {
                    const bf16x8 av = *(const bf16x8*)(Vt + tswc(e0 + fr, ss * 4 + fq));
#pragma unroll
                    for (int lt = 0; lt < 4; ++lt) { const bf16x8 bp = *(const bf16x8*)(Ps + (lt * 16 + fr) * 72 + ss * 32 + fq * 8); a1[lt] = __builtin_amdgcn_mfma_f32_16x16x32_bf16(av, bp, a1[lt], 0, 0, 0); }
                }
#pragma unroll
                for (int ks = 0; ks < 4; ++ks) {
                    const bf16x8 ac = *(const bf16x8*)(Ss + (e0 + fr) * 136 + ks * 32 + fq * 8);
#pragma unroll
                    for (int lt = 0; lt < 4; ++lt) { const bf16x8 bq = *(const bf16x8*)(Qs + (lt * 16 + fr) * 136 + ks * 32 + fq * 8); a1[lt] = __builtin_amdgcn_mfma_f32_16x16x32_bf16(ac, bq, a1[lt], 0, 0, 0); }
                }
            }
            __syncthreads();
            {
                const int e0 = wid * 16;
#pragma unroll
                for (int lt = 0; lt < 4; ++lt) *(f32x4*)(Hs + (lt * 16 + fr) * 132 + e0 + fq * 4) = a1[lt];
            }
            __syncthreads();
            head_norm_out<1>(Hs, p.in[I_HGRN_ONORM] + h * 128, PROJ + (size_t)t0 * PC + 2048 + h * 128, PC, (bf16_t*)(ws + WS_MIX) + (size_t)t0 * 1024 + 512 + h * 128, 1024, tid);
            __syncthreads();
        } else {
            s5_unit_Y(p, lds, it - 1024);
        }
    }
}

#define XB_TMO      128
#define XB_XCNT(j)  (256  + 64 * (j))
#define XB_XSUB(j)  (1280 + 64 * (j))
#define XB_XGEN(j)  (2304 + 64 * (j))
#define XB_TOP      3328
#define XB_TOPGEN   3392
#define XCD_BAR_WORDS 3456
#define XB_SPIN_CAP (1u << 22)
#define LAS __attribute__((address_space(3)))
constexpr size_t WS_BAR = 4096;
constexpr size_t CTL_ZERO_BYTES = 32768;
static_assert(WS_BAR + XCD_BAR_WORDS * 4 <= CTL_ZERO_BYTES, "barrier words outside the zeroed region");
constexpr int LDS_BAR_OFF = LDS_BYTES - 16;
__device__ __forceinline__ unsigned xb_ld(unsigned* p)              { return __hip_atomic_load(p, __ATOMIC_RELAXED, __HIP_MEMORY_SCOPE_AGENT); }
__device__ __forceinline__ unsigned xb_add(unsigned* p, unsigned v) { return __hip_atomic_fetch_add(p, v, __ATOMIC_RELAXED, __HIP_MEMORY_SCOPE_AGENT); }
__device__ __forceinline__ unsigned xb_xcc_id() { return (unsigned)__builtin_amdgcn_s_getreg((3 << 11) | 20) & 0xFu; }
#define XB_SPIN(cond, bar) do { unsigned _sp = 0; while (cond) { __builtin_amdgcn_s_sleep(1); \
    if ((++_sp & 255u) == 0u) { if (xb_ld(&(bar)[XB_TMO])) break; if (_sp > XB_SPIN_CAP) { atomicAdd(&(bar)[XB_TMO], 1u); break; } } } } while (0)
struct XcdBarrier { unsigned* bar; unsigned x; volatile LAS unsigned* st; };
__device__ __forceinline__ XcdBarrier xcd_barrier_post(unsigned* bar, volatile LAS unsigned* st) {
    XcdBarrier b; b.bar = bar; b.x = xb_xcc_id(); b.st = st;
    if (opaque_tid() == 0) (void)xb_add(&bar[XB_XCNT(b.x)], 1u);
    return b;
}
__device__ __forceinline__ void xcd_barrier_complete(unsigned* bar, unsigned x, unsigned& nloc, unsigned& nx) {
    const unsigned G = gridDim.x * gridDim.y * gridDim.z;
    unsigned sum, cnt, mine, sp = 0u;
    for (;;) {
        sum = 0u; cnt = 0u; mine = 0u;
#pragma unroll
        for (unsigned j = 0; j < 16; ++j) { const unsigned c = xb_ld(&bar[XB_XCNT(j)]); sum += c; cnt += (c > 0u) ? 1u : 0u; mine = (j == x) ? c : mine; }
        if (sum == G) break;
        __builtin_amdgcn_s_sleep(1);
        if ((++sp & 255u) == 0u) { if (xb_ld(&bar[XB_TMO])) break; if (sp > XB_SPIN_CAP) { atomicAdd(&bar[XB_TMO], 1u); break; } }
    }
    nloc = mine > 0u ? mine : 1u; nx = cnt > 0u ? cnt : 1u;
}
__device__ __forceinline__ void xcd_barrier(const XcdBarrier& b) {
    asm volatile("s_waitcnt vmcnt(0)" ::: "memory");
    __syncthreads();
    if (opaque_tid() == 0) {
        unsigned* bar = b.bar;
        __builtin_amdgcn_s_waitcnt(0);
        unsigned nloc = b.st[0], nx = b.st[1];
        if (nloc == 0u) { xcd_barrier_complete(bar, b.x, nloc, nx); b.st[0] = nloc; b.st[1] = nx; }
        const unsigned old = xb_add(&bar[XB_XSUB(b.x)], 1u);
        const unsigned gen = old / nloc;
        if (old + 1u == (gen + 1u) * nloc) {
            __builtin_amdgcn_fence(__ATOMIC_RELEASE, "agent");
            asm volatile("s_waitcnt vmcnt(0)" ::: "memory");
            const unsigned og = xb_add(&bar[XB_TOP], 1u);
            const unsigned tg = og / nx;
            if (og + 1u == (tg + 1u) * nx) xb_add(&bar[XB_TOPGEN], 1u);
            else XB_SPIN(xb_ld(&bar[XB_TOPGEN]) == tg, bar);
            __builtin_amdgcn_fence(__ATOMIC_ACQUIRE, "agent");
            xb_add(&bar[XB_XGEN(b.x)], 1u);
            asm volatile("s_waitcnt vmcnt(0)" ::: "memory");
        } else {
            XB_SPIN(xb_ld(&bar[XB_XGEN(b.x)]) == gen, bar);
            __builtin_amdgcn_fence(__ATOMIC_ACQUIRE, "agent");
            asm volatile("s_waitcnt vmcnt(0)" ::: "memory");
        }
    }
    __syncthreads();
}

constexpr int NPHASE = 20;
constexpr unsigned REP_MASK = 0u;
constexpr int PROBE_SEL = 0;
template <int PH>
__device__ __forceinline__ void run_phase(const Params& p, unsigned char* lds) {
    unsigned char* ws = p.ws;
    if constexpr (PH == 0) phase_prep(p, lds);
    else if constexpr (PH == 1) { s5_gen_ktab(p); phase_gemm256_inproj0(lds, p); }
    else if constexpr (PH == 2) { s5_gen_ops(p); phase_mlstm_local(p, lds); }
    else if constexpr (PH == 3) phase_scan<false>(p, lds);
    else if constexpr (PH == 4) phase_mlstm_out(p, lds);
    else if constexpr (PH == 5) phase_gemm256_resid(lds, (const bf16_t*)(ws + WS_MIX), (const bf16_t*)(ws + WS_WOUTA), nullptr, (const bf16_t*)(ws + WS_H16), (bf16_t*)(ws + WS_H16));
    else if constexpr (PH == 6) phase_route<0>(p, lds, 0);
    else if constexpr (PH == 7) phase_moe_up(p, lds, 0);
    else if constexpr (PH == 8) phase_moe_down(p, lds, 0);
    else if constexpr (PH == 9) phase_combine_norm(p, false);
    else if constexpr (PH == 10) phase_gemm256_inproj1(lds, p);
    else if constexpr (PH == 11) phase_cd_local(p, lds);
    else if constexpr (PH == 12) phase_scan<true>(p, lds);
    else if constexpr (PH == 13) phase_cd_out<0>(p, lds);
    else if constexpr (PH == 14) {
        phase_gemm_glu(lds, p);
        if ((int)blockIdx.x >= 128) { const int t_ = opaque_tid(); moe_convert(p, lds, 1, 0, MOE_CONV_EARLY, ((int)blockIdx.x - 128) * 8 + (t_ >> 6), ((int)gridDim.x - 128) * 8, t_ >> 6, t_ & 63); }
    }
    else if constexpr (PH == 15) phase_gemm256_resid(lds, (const bf16_t*)(ws + WS_MIX), (const bf16_t*)(ws + WS_WOUTC), nullptr, (const bf16_t*)(ws + WS_H16), (bf16_t*)(ws + WS_H16));
    else if constexpr (PH == 16) phase_route<0>(p, lds, 1);
    else if constexpr (PH == 17) phase_moe_up(p, lds, 1);
    else if constexpr (PH == 18) phase_moe_down(p, lds, 1);
    else if constexpr (PH == 19) phase_combine_norm(p, true);
}
template <int PH>
__device__ __forceinline__ void run_from(const Params& p, unsigned char* lds, const XcdBarrier& bar) {
    run_phase<PH>(p, lds);
    if constexpr ((REP_MASK >> PH) & 1u) {
        xcd_barrier(bar);
        if constexpr (PH == 6 || PH == 16) { { const int t_ = opaque_tid(); if (blockIdx.x == 0 && t_ < 32) ((int*)(p.ws + WS_CTL))[(PH == 16 ? 32 : 0) + t_] = 0; } xcd_barrier(bar); }
        if constexpr (PH == 13 && PROBE_SEL != 0) phase_cd_out<PROBE_SEL>(p, lds); else
        if constexpr (PH == 6 && PROBE_SEL != 0) phase_route<PROBE_SEL>(p, lds, 0); else
        run_phase<PH>(p, lds);
    }
    if constexpr (PH + 1 < NPHASE) {
        xcd_barrier(bar);
        run_from<PH + 1>(p, lds, bar);
    }
}
__global__ void __launch_bounds__(NTHR, 2) mega(Params p) {
    extern __shared__ __attribute__((aligned(16))) unsigned char lds[];
    if (p.use_cg) cg::this_grid().sync();
    { const int t_ = opaque_tid(); if (t_ < 4) ((unsigned*)(lds + LDS_BAR_OFF))[t_] = 0u; }
    __syncthreads();
    const XcdBarrier bar = xcd_barrier_post((unsigned*)(p.ws + WS_BAR), (volatile LAS unsigned*)(lds + LDS_BAR_OFF));
    run_from<0>(p, lds, bar);
}

extern "C" void kernel_launch(void* const* d_in, const int* in_sizes, int n_in, void* d_out, int out_size, void* d_ws, size_t ws_size, hipStream_t stream) {
    static int grid = 0;
    if (grid == 0) {
        if (n_in != 30 || out_size != T * DM || ws_size < WS_END) { fprintf(stderr, "kernel_launch: unexpected shapes (n_in %d out %d ws %zu)\n", n_in, out_size, ws_size); grid = -1; return; }
        int dev = 0, cus = 0, per_cu = 0;
        (void)hipGetDevice(&dev);
        (void)hipDeviceGetAttribute(&cus, hipDeviceAttributeMultiprocessorCount, dev);
        (void)hipFuncSetAttribute((const void*)mega, hipFuncAttributeMaxDynamicSharedMemorySize, LDS_BYTES);
        (void)hipOccupancyMaxActiveBlocksPerMultiprocessor(&per_cu, (const void*)mega, NTHR, LDS_BYTES);
        if (per_cu < 1) { fprintf(stderr, "kernel_launch: occupancy query says %d blocks per CU\n", per_cu); per_cu = 1; }
        grid = cus * 1;
        (void)hipGetLastError();
    }
    if (grid < 0) return;
    Params p{};
    for (int i = 0; i < 30; ++i) p.in[i] = (const float*)d_in[i];
    p.out = (float*)d_out; p.ws = (unsigned char*)d_ws;
    p.use_cg = 0; p.pad = 0;
    (void)hipMemsetAsync((unsigned char*)d_ws + WS_CTL, 0, CTL_ZERO_BYTES, stream);
    void* args[] = {&p};
    hipError_t e = hipLaunchCooperativeKernel((const void*)mega, dim3(grid), dim3(NTHR), args, LDS_BYTES, stream);
    if (e != hipSuccess) fprintf(stderr, "cooperative launch failed: %s (grid %d)\n", hipGetErrorString(e), grid);
}
```

```cpp
#include <hip/hip_runtime.h>
#include <hip/hip_cooperative_groups.h>
#include <cstdio>
#include <cstdint>
namespace cg = cooperative_groups;

typedef unsigned short bf16_t;
typedef short bf16x8 __attribute__((ext_vector_type(8)));
typedef float f32x4 __attribute__((ext_vector_type(4)));
typedef float f32x2 __attribute__((ext_vector_type(2)));
typedef unsigned u32x4 __attribute__((ext_vector_type(4)));
typedef unsigned u32x2 __attribute__((ext_vector_type(2)));

constexpr int T = 16384, DM = 1024, SEQ = 4096;
constexpr int NTHR = 512;
constexpr int PA = 3584;
constexpr int PC = 2560;
constexpr int ECAP = 16384;
constexpr float EPS = 1e-6f;

constexpr size_t KB = 1024, MB = 1024 * 1024;
constexpr size_t WS_CTL = 0;
constexpr size_t WS_GATES = 64 * KB;
constexpr size_t WS_S5POW = WS_GATES + 512 * KB;
constexpr size_t WS_S5BBAR = WS_S5POW + 272 * KB;
constexpr size_t WS_WCAT = WS_S5BBAR + 256 * KB;
constexpr size_t WS_NLOC = WS_WCAT + 384 * KB;
constexpr size_t WS_NPREV = WS_NLOC + 512 * KB;
constexpr size_t WS_BENDV = WS_NPREV + 512 * KB;
constexpr size_t WS_MLOC = WS_BENDV + 512 * KB;
constexpr size_t WS_BEND = WS_MLOC + 4 * KB;
constexpr size_t WS_MPREV = WS_BEND + 4 * KB;
constexpr size_t WS_KTAB = 3072 * KB;
static_assert(WS_MPREV + 4 * KB <= WS_KTAB && WS_KTAB + 512 * KB <= 4 * MB, "small region overflow");
constexpr size_t WS_S5Y = 4 * MB;
constexpr size_t WS_S5E = 10 * MB;
constexpr size_t WS_WINA = 12 * MB;
constexpr size_t WS_WOUTA = 20 * MB;
constexpr size_t WS_WINC = 22 * MB;
constexpr size_t WS_WOUTC = 27 * MB;
constexpr size_t WS_WGLU = 29 * MB;
constexpr size_t WS_A = 30 * MB;
constexpr size_t WS_B = 142 * MB;
constexpr size_t WS_C = 174 * MB;
constexpr size_t WS_D = 206 * MB;
constexpr size_t WS_H16 = 238 * MB;
constexpr size_t WS_END = 270 * MB;
constexpr size_t WS_PROJ = WS_A, WS_LIST = WS_A, WS_WLIST = WS_A + 2 * MB, WS_HID = WS_A + 4 * MB, WS_Y = WS_A + 28 * MB;
constexpr size_t WS_XN = WS_B, WS_U = WS_B, WS_Z = WS_B;
constexpr size_t WS_XEND = WS_A + 84 * MB;
constexpr size_t WS_XPREVB = WS_A + 100 * MB;
constexpr size_t WS_MIX = WS_C, WS_CPREV = WS_D, WS_WGU = WS_C, WS_WD = WS_C + 32 * MB;

__host__ __device__ constexpr size_t ws_wgu(int layer) { return layer == 0 ? WS_C : WS_A + 64 * MB; }
__host__ __device__ constexpr size_t ws_wd(int layer) { return layer == 0 ? WS_C + 32 * MB : WS_A + 96 * MB; }
__host__ __device__ constexpr size_t ws_y(int layer) { return layer == 0 ? WS_A + 28 * MB : WS_C; }
constexpr int MOE_CONV_ITEMS = 32 * (16 * 16 + 32 * 4);
constexpr int MOE_CONV_EARLY = MOE_CONV_ITEMS / 2;
constexpr int LDS_BYTES = 144 * 1024;

struct Params { const float* in[30]; float* out; unsigned char* ws; int use_cg; int pad; };

enum { I_X = 0, I_NORM_MIX, I_NORM_FFN, I_NORM_FINAL, I_AB_WIN, I_AB_GBIAS, I_AB_HNORM, I_AB_CONVW, I_AB_WOUT, I_CD_WIN, I_S5_LRE, I_S5_LIM, I_S5_BRE, I_S5_BIM,
       I_S5_CRE, I_S5_CIM, I_S5_D, I_S5_LOGDT, I_S5_WGLU, I_S5_BGLU, I_HGRN_LB, I_HGRN_ONORM, I_CD_WOUT, I_MOE_WG, I_MOE_BG, I_MOE_WR, I_MOE_BR, I_MOE_WGATE, I_MOE_WUP, I_MOE_WDOWN };

__device__ __forceinline__ int opaque_tid() { int t = threadIdx.x; asm volatile("" : "+v"(t)); return t; }
__device__ __forceinline__ float bf2f(unsigned v) { return __uint_as_float(v << 16); }
typedef __bf16 bf16x2_t __attribute__((ext_vector_type(2)));
__device__ __forceinline__ unsigned pk2(float lo, float hi) { const f32x2 v = {lo, hi}; return __builtin_bit_cast(unsigned, __builtin_convertvector(v, bf16x2_t)); }
__device__ __forceinline__ unsigned f2bf(float f) { return (unsigned)__builtin_bit_cast(unsigned short, (__bf16)f); }
__device__ __forceinline__ float wave_sum(float v) {
#pragma unroll
    for (int o = 32; o; o >>= 1) v += __shfl_xor(v, o);
    return v;
}
__device__ __forceinline__ float wave_max(float v) {
#pragma unroll
    for (int o = 32; o; o >>= 1) v = fmaxf(v, __shfl_xor(v, o));
    return v;
}
__device__ __forceinline__ float wave_incl_sum(float v, int lane) {
#pragma unroll
    for (int o = 1; o < 64; o <<= 1) { const float t = __shfl_up(v, o); if (lane >= o) v += t; }
    return v;
}
__device__ __forceinline__ float wave_incl_max(float v, int lane) {
#pragma unroll
    for (int o = 1; o < 64; o <<= 1) { const float t = __shfl_up(v, o); if (lane >= o) v = fmaxf(v, t); }
    return v;
}
__device__ __forceinline__ float sigmoid_(float x) { return 1.f / (1.f + expf(-x)); }
__device__ __forceinline__ float fexp_(float x) { return __expf(x); }
__device__ __forceinline__ float fsigmoid_(float x) { return __builtin_amdgcn_rcpf(1.f + __expf(-x)); }
__device__ __forceinline__ float fsilu_(float x) { return x * __builtin_amdgcn_rcpf(1.f + __expf(-x)); }
__device__ __forceinline__ float fgelu_tanh_(float x) { const float u = 0.7978845608028654f * (x + 0.044715f * x * x * x); return x * __builtin_amdgcn_rcpf(1.f + __expf(-2.f * u)); }
__device__ __forceinline__ float logsigmoid_(float x) { return fminf(x, 0.f) - log1pf(expf(-fabsf(x))); }
__device__ __forceinline__ float silu_(float x) { return x / (1.f + expf(-x)); }
__device__ __forceinline__ float gelu_tanh_(float x) { const float u = 0.7978845608028654f * (x + 0.044715f * x * x * x); return 0.5f * x * (1.f + tanhf(u)); }
#define LDS_WAIT() asm volatile("s_waitcnt lgkmcnt(0)" ::: "memory")
__device__ __forceinline__ int tsw(int d, int l) { return d * 72 + (l ^ (((d >> 3) & 7) << 3)); }
__device__ __forceinline__ int tswc(int d, int c) { return d * 72 + ((c ^ ((d >> 3) & 7)) << 3); }
#define LDS_AS __attribute__((address_space(3)))
typedef short s16x4 __attribute__((ext_vector_type(4)));
__device__ __forceinline__ bf16x8 frag_tr(const bf16_t* T, int pitch, int k0, int n0, int fr, int fq) {
    const bf16_t* a = T + (k0 + 8 * fq + (fr >> 2)) * pitch + n0 + 4 * (fr & 3);
    const s16x4 lo = __builtin_amdgcn_ds_read_tr16_b64_v4i16((LDS_AS s16x4*)a);
    const s16x4 hi = __builtin_amdgcn_ds_read_tr16_b64_v4i16((LDS_AS s16x4*)(a + 4 * pitch));
    return (bf16x8){lo[0], lo[1], lo[2], lo[3], hi[0], hi[1], hi[2], hi[3]};
}

struct BPlain {
    const bf16_t* Bt; int K;
    __device__ __forceinline__ const bf16_t* operator()(int r, int kc) const { return Bt + (size_t)r * K + kc * 8; }
};
template <class APiece, class BPiece, class Epi>
__device__ __forceinline__ void gemm128b(unsigned char* lds, const APiece& apiece, const BPiece& bpiece, int K, const Epi& epi) {
    const int tid = opaque_tid(), lane = tid & 63, wid = tid >> 6, wr = wid >> 1, wc = wid & 1, fr = lane & 15, fq = lane >> 4;
    const int nt = K >> 6;
    const int r0 = tid >> 3, c0 = tid & 7;
    const int so0 = r0 * 128 + ((c0 ^ (r0 & 7)) << 4), so1 = so0 + 64 * 128;
    u32x4 xa0 = *(const u32x4*)apiece(r0, c0), xa1 = *(const u32x4*)apiece(r0 + 64, c0), xb0 = *(const u32x4*)bpiece(r0, c0), xb1 = *(const u32x4*)bpiece(r0 + 64, c0);
    u32x4 ya0 = *(const u32x4*)apiece(r0, 8 + c0), ya1 = *(const u32x4*)apiece(r0 + 64, 8 + c0), yb0 = *(const u32x4*)bpiece(r0, 8 + c0), yb1 = *(const u32x4*)bpiece(r0 + 64, 8 + c0);
    f32x4 acc[2][4];
#pragma unroll
    for (int m = 0; m < 2; ++m)
#pragma unroll
        for (int n = 0; n < 4; ++n) acc[m][n] = (f32x4){0.f, 0.f, 0.f, 0.f};
#define G128_PUT(buf, A0, A1, B0, B1) do { unsigned char* d_ = lds + (buf) * 16384; *(u32x4*)(d_ + so0) = A0; *(u32x4*)(d_ + so1) = A1; *(u32x4*)(d_ + 32768 + so0) = B0; *(u32x4*)(d_ + 32768 + so1) = B1; } while (0)
#define G128_GET(t, A0, A1, B0, B1) do { const int kc_ = (t) * 8 + c0; A0 = *(const u32x4*)apiece(r0, kc_); A1 = *(const u32x4*)apiece(r0 + 64, kc_); B0 = *(const u32x4*)bpiece(r0, kc_); B1 = *(const u32x4*)bpiece(r0 + 64, kc_); } while (0)
#define G128_MMA(buf) do { const unsigned char* sa = lds + (buf) * 16384; const unsigned char* sb = lds + 32768 + (buf) * 16384; \
        _Pragma("unroll") for (int kk = 0; kk < 2; ++kk) { bf16x8 a[2], b[4]; \
            _Pragma("unroll") for (int m = 0; m < 2; ++m) { const int row = wr * 32 + m * 16 + fr; a[m] = *(const bf16x8*)(sa + row * 128 + (((kk * 4 + fq) ^ (row & 7)) << 4)); } \
            _Pragma("unroll") for (int n = 0; n < 4; ++n) { const int row = wc * 64 + n * 16 + fr; b[n] = *(const bf16x8*)(sb + row * 128 + (((kk * 4 + fq) ^ (row & 7)) << 4)); } \
            _Pragma("unroll") for (int m = 0; m < 2; ++m) _Pragma("unroll") for (int n = 0; n < 4; ++n) acc[m][n] = __builtin_amdgcn_mfma_f32_16x16x32_bf16(b[n], a[m], acc[m][n], 0, 0, 0); } } while (0)
    G128_PUT(0, xa0, xa1, xb0, xb1);
    __syncthreads();
#pragma unroll 1
    for (int kt = 0; kt < nt; kt += 2) {
        if (kt + 2 < nt) G128_GET(kt + 2, xa0, xa1, xb0, xb1);
        G128_MMA(0);
        G128_PUT(1, ya0, ya1, yb0, yb1);
        __syncthreads();
        if (kt + 3 < nt) G128_GET(kt + 3, ya0, ya1, yb0, yb1);
        G128_MMA(1);
        if (kt + 2 < nt) G128_PUT(0, xa0, xa1, xb0, xb1);
        __syncthreads();
    }
#undef G128_PUT
#undef G128_GET
#undef G128_MMA
    epi(acc, wr, wc, fr, fq);
}

template <class APiece, class Epi>
__device__ __forceinline__ void gemm128(unsigned char* lds, const APiece& apiece, const bf16_t* __restrict__ Bt, int K, const Epi& epi) {
    BPlain b{Bt, K};
    gemm128b(lds, apiece, b, K, epi);
}

template <class APiece, class BPiece, class Epi0, class Epi1>
__device__ __forceinline__ void gemm128x2(unsigned char* lds, const APiece& apiece, const BPiece& bp0f, const BPiece& bp1f, int K, const Epi0& epi0, const Epi1& epi1) {
    const int tid = opaque_tid(), lane = tid & 63, wid = tid >> 6, wr = wid >> 1, wc = wid & 1, fr = lane & 15, fq = lane >> 4;
    const int nt = K >> 6;
    const int r0 = tid >> 3, c0 = tid & 7;
    const int so0 = r0 * 128 + ((c0 ^ (r0 & 7)) << 4), so1 = so0 + 64 * 128;
    u32x4 ra0 = *(const u32x4*)apiece(r0, c0), ra1 = *(const u32x4*)apiece(r0 + 64, c0);
    u32x4 rb0 = *(const u32x4*)bp0f(r0, c0), rb1 = *(const u32x4*)bp0f(r0 + 64, c0);
    u32x4 rc0 = *(const u32x4*)bp1f(r0, c0), rc1 = *(const u32x4*)bp1f(r0 + 64, c0);
    f32x4 acc0[2][4], acc1[2][4];
#pragma unroll
    for (int m = 0; m < 2; ++m)
#pragma unroll
        for (int n = 0; n < 4; ++n) { acc0[m][n] = (f32x4){0.f, 0.f, 0.f, 0.f}; acc1[m][n] = (f32x4){0.f, 0.f, 0.f, 0.f}; }
    *(u32x4*)(lds + so0) = ra0; *(u32x4*)(lds + so1) = ra1;
    *(u32x4*)(lds + 32768 + so0) = rb0; *(u32x4*)(lds + 32768 + so1) = rb1;
    *(u32x4*)(lds + 65536 + so0) = rc0; *(u32x4*)(lds + 65536 + so1) = rc1;
    __syncthreads();
#pragma unroll 1
    for (int kt = 0; kt < nt; ++kt) {
        const int cur = kt & 1;
        if (kt + 1 < nt) {
            const int kc = (kt + 1) * 8 + c0;
            ra0 = *(const u32x4*)apiece(r0, kc); ra1 = *(const u32x4*)apiece(r0 + 64, kc);
            rb0 = *(const u32x4*)bp0f(r0, kc); rb1 = *(const u32x4*)bp0f(r0 + 64, kc);
            rc0 = *(const u32x4*)bp1f(r0, kc); rc1 = *(const u32x4*)bp1f(r0 + 64, kc);
        }
        const unsigned char* sa = lds + cur * 16384;
        const unsigned char* sb = lds + 32768 + cur * 16384;
        const unsigned char* sc = lds + 65536 + cur * 16384;
#pragma unroll
        for (int kk = 0; kk < 2; ++kk) {
            bf16x8 a[2], b[4], c[4];
#pragma unroll
            for (int m = 0; m < 2; ++m) { const int row = wr * 32 + m * 16 + fr; a[m] = *(const bf16x8*)(sa + row * 128 + (((kk * 4 + fq) ^ (row & 7)) << 4)); }
#pragma unroll
            for (int n = 0; n < 4; ++n) { const int row = wc * 64 + n * 16 + fr; const int o = row * 128 + (((kk * 4 + fq) ^ (row & 7)) << 4); b[n] = *(const bf16x8*)(sb + o); c[n] = *(const bf16x8*)(sc + o); }
#pragma unroll
            for (int m = 0; m < 2; ++m)
#pragma unroll
                for (int n = 0; n < 4; ++n) { acc0[m][n] = __builtin_amdgcn_mfma_f32_16x16x32_bf16(b[n], a[m], acc0[m][n], 0, 0, 0); acc1[m][n] = __builtin_amdgcn_mfma_f32_16x16x32_bf16(c[n], a[m], acc1[m][n], 0, 0, 0); }
        }
        if (kt + 1 < nt) {
            unsigned char* da = lds + (cur ^ 1) * 16384;
            *(u32x4*)(da + so0) = ra0; *(u32x4*)(da + so1) = ra1;
            *(u32x4*)(da + 32768 + so0) = rb0; *(u32x4*)(da + 32768 + so1) = rb1;
            *(u32x4*)(da + 65536 + so0) = rc0; *(u32x4*)(da + 65536 + so1) = rc1;
        }
        __syncthreads();
    }
    epi0(acc0, wr, wc, fr, fq);
    epi1(acc1, wr, wc, fr, fq);
}
struct APlain {
    const bf16_t* A; int K;
    __device__ __forceinline__ const bf16_t* operator()(int r, int kc) const { return A + (size_t)r * K + kc * 8; }
};

namespace pg8 {
#define PG8_LAS __attribute__((address_space(3)))
typedef unsigned short bf16_t;
typedef short bf16x8 __attribute__((ext_vector_type(8)));
typedef float f32x4 __attribute__((ext_vector_type(4)));
typedef unsigned u32x4 __attribute__((ext_vector_type(4)));
constexpr int BM = 256, BK = 64, HALF = 128, HTB = HALF * BK * 2  , STAGE_BYTES = 8 * HTB, NXCD = 8, WGM = 8;

__host__ __device__ __forceinline__ int lds_byte(int r, int c) { const int st = (r >> 4) * 2 + (c >> 5), rr = r & 15, cc = c & 31, ob = rr * 64 + cc * 2; return st * 1024 + (ob ^ (((ob >> 9) & 1) << 5)); }
__host__ __device__ __forceinline__ void stage_rc(int b, int& R, int& C) { const int st = b / 1024, sb = b % 1024, swz = sb ^ (((sb >> 9) & 1) << 5); R = (st >> 1) * 16 + swz / 64; C = (st & 1) * 32 + (swz % 64) / 2; }
__host__ __device__ __forceinline__ int perm32(int rho) { const int n = rho >> 4, i = rho & 15; return 8 * (i >> 2) + 4 * n + (i & 3); }

struct Unit { int pm, pn, aux, half, nh; };
struct Gemm { const bf16_t* A; const bf16_t* Bt; int M, N, K; };

struct StaticOrder {
    int nM, nN, nwg, G, c;
    __host__ __device__ void init(int M, int N, int G_, int c_) { nM = M / BM; nN = N / BM; nwg = nM * nN; G = G_; c = c_; }
    __host__ __device__ __forceinline__ bool next(int i, Unit& u) const {
        const long L = (long)i * G + c; if (L >= nwg) return false;
        int wgid = (int)L; { const int q = nwg / NXCD, r = nwg % NXCD, xcd = wgid % NXCD, off = wgid / NXCD; wgid = (xcd < r ? xcd * (q + 1) : r * (q + 1) + (xcd - r) * q) + off; }
        const int nig = WGM * nN, gid = wgid / nig, fm = gid * WGM, gsz = (nM - fm) < WGM ? (nM - fm) : WGM;
        u.pm = fm + ((wgid % nig) % gsz); u.pn = (wgid % nig) / gsz; u.aux = 0; u.half = 0; u.nh = 0; return true;
    }
    __device__ __forceinline__ void a_ready(const Unit&) const {}
    __device__ __forceinline__ void done(const Unit&) const {}
};

struct StaticOrderHalfTail : StaticOrder {
    int nNF, nNT;
    __device__ __forceinline__ bool next(int i, Unit& u) const {
        const long L = (long)i * G + c; const int nw = nM * nNT * 2;
        if (L >= (long)nwg + nw) return false;
        const bool tail = L >= nwg;
        int wgid = tail ? 0 : (int)L; { const int q = nwg / NXCD, r = nwg % NXCD, xcd = wgid % NXCD, off = wgid / NXCD; wgid = (xcd < r ? xcd * (q + 1) : r * (q + 1) + (xcd - r) * q) + off; }
        const int nig = WGM * nN, gid = wgid / nig, fm = gid * WGM, gsz = (nM - fm) < WGM ? (nM - fm) : WGM;
        const int pm_f = fm + ((wgid % nig) % gsz), pn_f = (wgid % nig) / gsz;
        int wg = tail ? (int)(L - nwg) : 0; { const int q = nw / NXCD, rr = nw % NXCD, xcd = wg % NXCD, off = wg / NXCD; wg = (xcd < rr ? xcd * (q + 1) : rr * (q + 1) + (xcd - rr) * q) + off; }
        const int t = wg % (nNT * 2);
        u.pm = tail ? wg / (nNT * 2) : pm_f; u.pn = tail ? nNF + (t >> 1) : pn_f; u.nh = tail ? 1 + (t & 1) : 0; u.aux = 0; u.half = 0;
        return true;
    }
};
__device__ __forceinline__ unsigned cvt_pk_bf16(float lo, float hi) { unsigned r; asm volatile("v_cvt_pk_bf16_f32 %0, %1, %2" : "=v"(r) : "v"(lo), "v"(hi)); return r; }
template <class Epi, class Sched, bool ALIGN_EPI = false, bool SP2 = false>
__device__ __forceinline__ void gemm_phase(PG8_LAS unsigned char* lds, const Gemm g, const Sched& S, const Epi& E) {
    const int tid = opaque_tid(), wid = __builtin_amdgcn_readfirstlane(tid >> 6), lane = tid & 63, wr = wid >> 2, wc = wid & 3, fr = lane & 15, fq = lane >> 4;
    const int K = g.K, nt = K / BK;
    unsigned voffA[2], voffB[2];
#pragma unroll
    for (int i = 0; i < 2; ++i) { int R, C; stage_rc(tid * 16 + i * 8192, R, C); const int Rb = Epi::PERM ? ((R & ~31) + perm32(R & 31)) : R;
        voffA[i] = (unsigned)(R * K + C) * 2u; voffB[i] = (unsigned)(Rb * K + C) * 2u; }
    const size_t kstep = (size_t)(BK * 2);
    const size_t hstep = (size_t)HALF * K * 2;
    const size_t tstep = 2 * hstep;
    const unsigned ldsw = (unsigned)wid * 1024u;
    const int aoff = lds_byte(wr * 64 + fr, fq * 8), boff = lds_byte(wc * 32 + fr, fq * 8);
#define PG8_SA(b, h) (((b) * 2 + (h)) * HTB)
#define PG8_SB(b, h) ((4 + (b) * 2 + (h)) * HTB)
#define PG8_STAGE(bufoff, gbase, voff) do { _Pragma("unroll") for (int _i = 0; _i < 2; ++_i) \
        __builtin_amdgcn_global_load_lds((const unsigned*)((const char*)(gbase) + (voff)[_i]), (PG8_LAS unsigned*)(lds + (bufoff) + ldsw + _i * 8192), 16, 0, 0); } while (0)
#define PG8_LDA(dst, b, h) do { _Pragma("unroll") for (int m = 0; m < 4; ++m) _Pragma("unroll") for (int k = 0; k < 2; ++k) dst[m][k] = *(const PG8_LAS bf16x8*)(lds + PG8_SA(b, h) + aoff + m * 2048 + k * 1024); } while (0)
#define PG8_LDB(dst, b, h) do { _Pragma("unroll") for (int n = 0; n < 2; ++n) _Pragma("unroll") for (int k = 0; k < 2; ++k) dst[n][k] = *(const PG8_LAS bf16x8*)(lds + PG8_SB(b, h) + boff + n * 2048 + k * 1024); } while (0)
#define PG8_MMA(ai, bj, At, Bt) do { __builtin_amdgcn_s_setprio(1); _Pragma("unroll") for (int m = 0; m < 4; ++m) _Pragma("unroll") for (int n = 0; n < 2; ++n) _Pragma("unroll") for (int k = 0; k < 2; ++k) \
        acc[ai][bj][m][n] = __builtin_amdgcn_mfma_f32_16x16x32_bf16(Bt[n][k], At[m][k], acc[ai][bj][m][n], 0, 0, 0); __builtin_amdgcn_s_setprio(0); } while (0)
#define PG8_WAIT_V(n) asm volatile("s_waitcnt vmcnt(" #n ")" ::: "memory")
#define PG8_WAIT_L(n) asm volatile("s_waitcnt lgkmcnt(" #n ")" ::: "memory")
#define PG8_BAR __builtin_amdgcn_s_barrier()
#define PG8_SCHED __builtin_amdgcn_sched_barrier(0)
    Unit cur, nxt; int ui = 0;
    if (!S.next(0, cur)) return;
    f32x4 acc[2][2][4][2];
#pragma unroll
    for (int a = 0; a < 2; ++a)
#pragma unroll
        for (int b = 0; b < 2; ++b)
#pragma unroll
            for (int m = 0; m < 4; ++m)
#pragma unroll
                for (int n = 0; n < 2; ++n) acc[a][b][m][n] = (f32x4){0.f, 0.f, 0.f, 0.f};
    bf16x8 At[4][2], B0[2][2], B1[2][2];
    const char* cA = (const char*)g.A + (size_t)cur.pm * tstep; const char* cB = (const char*)g.Bt + (size_t)cur.pn * tstep;
    S.a_ready(cur);
    if constexpr (SP2) {
        PG8_STAGE(PG8_SB(0, 0), cB, voffB); PG8_STAGE(PG8_SB(0, 1), cB + hstep, voffB); PG8_STAGE(PG8_SA(0, 0), cA, voffA); PG8_STAGE(PG8_SA(0, 1), cA + hstep, voffA);
        if (wr == 1) PG8_BAR;
        PG8_WAIT_V(2); PG8_BAR;
        PG8_STAGE(PG8_SB(1, 0), cB + kstep, voffB); PG8_STAGE(PG8_SA(1, 0), cA + kstep, voffA); PG8_STAGE(PG8_SB(1, 1), cB + hstep + kstep, voffB);
        PG8_WAIT_V(6); PG8_BAR;
    } else {
        PG8_STAGE(PG8_SB(0, 0), cB, voffB); PG8_STAGE(PG8_SA(0, 0), cA, voffA); PG8_STAGE(PG8_SB(0, 1), cB + hstep, voffB); PG8_STAGE(PG8_SA(0, 1), cA + hstep, voffA);
        if (wr == 1) PG8_BAR;
        PG8_WAIT_V(4); PG8_BAR;
        PG8_STAGE(PG8_SB(1, 0), cB + kstep, voffB); PG8_STAGE(PG8_SA(1, 0), cA + kstep, voffA); PG8_STAGE(PG8_SB(1, 1), cB + hstep + kstep, voffB);
        PG8_WAIT_V(6); PG8_BAR;
    }
    for (;;) {
        const bool has_next = S.next(ui + 1, nxt);
        const char* nA = has_next ? (const char*)g.A + (size_t)nxt.pm * tstep : cA; const char* nB = has_next ? (const char*)g.Bt + (size_t)nxt.pn * tstep : cB;
        for (int t = 0; t < nt; t += 2) {
            const bool last = (t == nt - 2);
            const char* a1 = cA + (size_t)(t + 1) * kstep;
            const char* a2 = last ? nA : cA + (size_t)(t + 2) * kstep; const char* b2 = last ? nB : cB + (size_t)(t + 2) * kstep;
            const char* a3 = a2 + kstep; const char* b3 = b2 + kstep;
            if (last && has_next) S.a_ready(nxt);
            if constexpr (SP2) {
            PG8_LDB(B0, 0, 0); PG8_LDB(B1, 0, 1); PG8_SCHED; PG8_LDA(At, 0, 0); PG8_STAGE(PG8_SA(1, 1), a1 + hstep, voffA);
            PG8_WAIT_V(8); PG8_WAIT_L(0); PG8_BAR; if (cur.nh != 2) PG8_MMA(0, 0, At, B0); if (cur.nh != 1) PG8_MMA(0, 1, At, B1); PG8_BAR; PG8_SCHED;
            PG8_LDA(At, 0, 1); PG8_STAGE(PG8_SB(0, 0), b2, voffB); PG8_STAGE(PG8_SB(0, 1), b2 + hstep, voffB); PG8_STAGE(PG8_SA(0, 0), a2, voffA);
            PG8_WAIT_V(8); PG8_WAIT_L(0); PG8_BAR; if (!cur.half) { if (cur.nh != 2) PG8_MMA(1, 0, At, B0); if (cur.nh != 1) PG8_MMA(1, 1, At, B1); } PG8_BAR; PG8_SCHED;
            PG8_LDB(B0, 1, 0); PG8_LDB(B1, 1, 1); PG8_SCHED; PG8_LDA(At, 1, 0); PG8_STAGE(PG8_SA(0, 1), a2 + hstep, voffA);
            PG8_WAIT_V(8); PG8_WAIT_L(0); PG8_BAR; if (cur.nh != 2) PG8_MMA(0, 0, At, B0); if (cur.nh != 1) PG8_MMA(0, 1, At, B1); PG8_BAR; PG8_SCHED;
            PG8_LDA(At, 1, 1); PG8_STAGE(PG8_SB(1, 0), b3, voffB); PG8_STAGE(PG8_SB(1, 1), b3 + hstep, voffB); PG8_STAGE(PG8_SA(1, 0), a3, voffA);
            PG8_WAIT_V(8); PG8_WAIT_L(0); PG8_BAR; if (!cur.half) { if (cur.nh != 2) PG8_MMA(1, 0, At, B0); if (cur.nh != 1) PG8_MMA(1, 1, At, B1); } PG8_BAR; PG8_SCHED;
            } else {
            PG8_LDB(B0, 0, 0); PG8_SCHED; PG8_LDA(At, 0, 0); PG8_STAGE(PG8_SA(1, 1), a1 + hstep, voffA);
            PG8_WAIT_L(8); PG8_BAR; PG8_WAIT_L(0); PG8_MMA(0, 0, At, B0); PG8_BAR; PG8_SCHED;
            PG8_LDB(B1, 0, 1); PG8_STAGE(PG8_SB(0, 0), b2, voffB);
            PG8_BAR; PG8_WAIT_L(0); PG8_MMA(0, 1, At, B1); PG8_BAR;
            PG8_LDA(At, 0, 1); PG8_STAGE(PG8_SA(0, 0), a2, voffA);
            PG8_BAR; PG8_WAIT_L(0); PG8_MMA(1, 0, At, B0); PG8_BAR; PG8_SCHED;
            PG8_STAGE(PG8_SB(0, 1), b2 + hstep, voffB);
            PG8_WAIT_V(6); PG8_BAR; PG8_MMA(1, 1, At, B1); PG8_BAR;
            PG8_LDB(B0, 1, 0); PG8_SCHED; PG8_LDA(At, 1, 0); PG8_STAGE(PG8_SA(0, 1), a2 + hstep, voffA);
            PG8_WAIT_L(8); PG8_BAR; PG8_WAIT_L(0); PG8_MMA(0, 0, At, B0); PG8_BAR; PG8_SCHED;
            PG8_LDB(B1, 1, 1); PG8_STAGE(PG8_SB(1, 0), b3, voffB);
            PG8_BAR; PG8_WAIT_L(0); PG8_MMA(0, 1, At, B1); PG8_BAR;
            PG8_LDA(At, 1, 1); PG8_STAGE(PG8_SA(1, 0), a3, voffA);
            PG8_BAR; PG8_WAIT_L(0); PG8_MMA(1, 0, At, B0); PG8_BAR; PG8_SCHED;
            PG8_STAGE(PG8_SB(1, 1), b3 + hstep, voffB);
            PG8_WAIT_V(6); PG8_BAR; PG8_MMA(1, 1, At, B1); PG8_BAR;
            }
        }
        if constexpr (ALIGN_EPI) { if (wr == 0) PG8_BAR; }
        if constexpr (!Epi::AFTER_DRAIN) { E(acc, cur, wr, wc, fr, fq); S.done(cur); }
        if (!has_next) break;
#pragma unroll
        for (int a = 0; a < 2; ++a)
#pragma unroll
            for (int b = 0; b < 2; ++b)
#pragma unroll
                for (int m = 0; m < 4; ++m)
#pragma unroll
                    for (int n = 0; n < 2; ++n) acc[a][b][m][n] = (f32x4){0.f, 0.f, 0.f, 0.f};
        cur = nxt; cA = nA; cB = nB; ++ui;
        if constexpr (ALIGN_EPI) { if (wr == 1) PG8_BAR; }
    }
    PG8_WAIT_V(0);
    if constexpr (!ALIGN_EPI) { if (wr == 0) PG8_BAR; }
    PG8_BAR;
    if constexpr (Epi::AFTER_DRAIN) { E.fused(acc, cur, wr, wc, fr, fq, lds, wid, lane); S.done(cur); }
#undef PG8_SA
#undef PG8_SB
#undef PG8_STAGE
#undef PG8_LDA
#undef PG8_LDB
#undef PG8_MMA
#undef PG8_WAIT_V
#undef PG8_WAIT_L
#undef PG8_BAR
#undef PG8_SCHED
}

struct EpiStore {
    static constexpr bool PERM = true, AFTER_DRAIN = false;
    bf16_t* O; int ldc;
    __device__ __forceinline__ void operator()(const f32x4 (&acc)[2][2][4][2], const Unit& u, int wr, int wc, int fr, int fq) const {
        asm volatile("s_nop 7\n\ts_nop 7" ::: "memory");
        const int row0 = u.pm * BM + wr * 64 + fr, col0 = u.pn * BM + wc * 32 + 8 * fq;
#pragma unroll
        for (int ai = 0; ai < 2; ++ai)
#pragma unroll
            for (int m = 0; m < 4; ++m) { bf16_t* rowp = O + (size_t)(row0 + ai * HALF + m * 16) * ldc + col0;
#pragma unroll
                for (int bj = 0; bj < 2; ++bj) { if (u.nh == 2 - bj) continue; const f32x4 v0 = acc[ai][bj][m][0], v1 = acc[ai][bj][m][1];
                    u32x4 w; w.x = cvt_pk_bf16(v0[0], v0[1]); w.y = cvt_pk_bf16(v0[2], v0[3]); w.z = cvt_pk_bf16(v1[0], v1[1]); w.w = cvt_pk_bf16(v1[2], v1[3]);
                    *(u32x4*)(rowp + bj * HALF) = w; } }
    }
};
struct EpiStoreGates {
    static constexpr bool PERM = true, AFTER_DRAIN = false;
    bf16_t* O; int ldc; int gate_pn; float* gates; const float* gbias;
    __device__ __forceinline__ void operator()(const f32x4 (&acc)[2][2][4][2], const Unit& u, int wr, int wc, int fr, int fq) const {
        asm volatile("s_nop 7\n\ts_nop 7" ::: "memory");
        const int row0 = u.pm * BM + wr * 64 + fr;
        if (u.pn == gate_pn) {
            if (wc == 0 && fq == 0) {
                const f32x4 b0 = *(const f32x4*)gbias, b1 = *(const f32x4*)(gbias + 4);
#pragma unroll
                for (int ai = 0; ai < 2; ++ai)
#pragma unroll
                    for (int m = 0; m < 4; ++m) { float* g = gates + (size_t)(row0 + ai * HALF + m * 16) * 8;
                        *(f32x4*)g = acc[ai][0][m][0] + b0; *(f32x4*)(g + 4) = acc[ai][0][m][1] + b1; }
            }
            return;
        }
        const int col0 = u.pn * BM + wc * 32 + 8 * fq;
#pragma unroll
        for (int ai = 0; ai < 2; ++ai)
#pragma unroll
            for (int m = 0; m < 4; ++m) { bf16_t* rowp = O + (size_t)(row0 + ai * HALF + m * 16) * ldc + col0;
#pragma unroll
                for (int bj = 0; bj < 2; ++bj) { const f32x4 v0 = acc[ai][bj][m][0], v1 = acc[ai][bj][m][1];
                    u32x4 w; w.x = cvt_pk_bf16(v0[0], v0[1]); w.y = cvt_pk_bf16(v0[2], v0[3]); w.z = cvt_pk_bf16(v1[0], v1[1]); w.w = cvt_pk_bf16(v1[2], v1[3]);
                    *(u32x4*)(rowp + bj * HALF) = w; } }
    }
};
struct EpiResid {
    static constexpr bool PERM = true, AFTER_DRAIN = false;
    const float* rf; const bf16_t* rb; bf16_t* out;
    __device__ __forceinline__ void operator()(const f32x4 (&acc)[2][2][4][2], const Unit& u, int wr, int wc, int fr, int fq) const {
        const int row0 = u.pm * BM + wr * 64 + fr, col0 = u.pn * BM + wc * 32 + 8 * fq;
#pragma unroll
        for (int ai = 0; ai < 2; ++ai)
#pragma unroll
            for (int m = 0; m < 4; ++m) { const size_t off = (size_t)(row0 + ai * HALF + m * 16) * 1024 + col0;
#pragma unroll
                for (int bj = 0; bj < 2; ++bj) {
                    f32x4 r0, r1;
                    if (rf) { r0 = *(const f32x4*)(rf + off + bj * HALF); r1 = *(const f32x4*)(rf + off + bj * HALF + 4); }
                    else { const u32x4 q = *(const u32x4*)(rb + off + bj * HALF);
                        r0 = (f32x4){__uint_as_float(q.x << 16), __uint_as_float(q.x & 0xffff0000u), __uint_as_float(q.y << 16), __uint_as_float(q.y & 0xffff0000u)};
                        r1 = (f32x4){__uint_as_float(q.z << 16), __uint_as_float(q.z & 0xffff0000u), __uint_as_float(q.w << 16), __uint_as_float(q.w & 0xffff0000u)}; }
                    const f32x4 v0 = acc[ai][bj][m][0] + r0, v1 = acc[ai][bj][m][1] + r1;
                    u32x4 w; w.x = cvt_pk_bf16(v0[0], v0[1]); w.y = cvt_pk_bf16(v0[2], v0[3]); w.z = cvt_pk_bf16(v1[0], v1[1]); w.w = cvt_pk_bf16(v1[2], v1[3]);
                    *(u32x4*)(out + off + bj * HALF) = w; } }
    }
};

template <class Epi, class Sched>
__device__ __forceinline__ void gemm_phase_g(PG8_LAS unsigned char* lds, const Gemm g, const Sched& S, const Epi& E) {
    const int tid = opaque_tid(), wid = __builtin_amdgcn_readfirstlane(tid >> 6), lane = tid & 63, wr = wid >> 2, wc = wid & 3, fr = lane & 15, fq = lane >> 4;
    const int K = g.K, nt = K / BK;
    int RA[2], CA[2]; unsigned voffB[2];
#pragma unroll
    for (int i = 0; i < 2; ++i) { int R, C; stage_rc(tid * 16 + i * 8192, R, C); RA[i] = R; CA[i] = C; const int Rb = Epi::PERM ? ((R & ~31) + perm32(R & 31)) : R; voffB[i] = (unsigned)(Rb * K + C) * 2u; }
    const size_t kstep = (size_t)(BK * 2);
    const size_t hstep = (size_t)HALF * K * 2;
    const size_t tstep = 2 * hstep;
    const unsigned ldsw = (unsigned)wid * 1024u;
    const int aoff = lds_byte(wr * 64 + fr, fq * 8), boff = lds_byte(wc * 32 + fr, fq * 8);
#define PG8_SA(b, h) (((b) * 2 + (h)) * HTB)
#define PG8_SB(b, h) ((4 + (b) * 2 + (h)) * HTB)
#define PG8_STAGE(bufoff, gbase, voff) do { _Pragma("unroll") for (int _i = 0; _i < 2; ++_i) \
        __builtin_amdgcn_global_load_lds((const unsigned*)((const char*)(gbase) + (voff)[_i]), (PG8_LAS unsigned*)(lds + (bufoff) + ldsw + _i * 8192), 16, 0, 0); } while (0)
#define PG8_LDA(dst, b, h) do { _Pragma("unroll") for (int m = 0; m < 4; ++m) _Pragma("unroll") for (int k = 0; k < 2; ++k) dst[m][k] = *(const PG8_LAS bf16x8*)(lds + PG8_SA(b, h) + aoff + m * 2048 + k * 1024); } while (0)
#define PG8_LDB(dst, b, h) do { _Pragma("unroll") for (int n = 0; n < 2; ++n) _Pragma("unroll") for (int k = 0; k < 2; ++k) dst[n][k] = *(const PG8_LAS bf16x8*)(lds + PG8_SB(b, h) + boff + n * 2048 + k * 1024); } while (0)
#define PG8_MMA(ai, bj, At, Bt) do { __builtin_amdgcn_s_setprio(1); _Pragma("unroll") for (int m = 0; m < 4; ++m) _Pragma("unroll") for (int n = 0; n < 2; ++n) _Pragma("unroll") for (int k = 0; k < 2; ++k) \
        acc[ai][bj][m][n] = __builtin_amdgcn_mfma_f32_16x16x32_bf16(Bt[n][k], At[m][k], acc[ai][bj][m][n], 0, 0, 0); __builtin_amdgcn_s_setprio(0); } while (0)
#define PG8_WAIT_V(n) asm volatile("s_waitcnt vmcnt(" #n ")" ::: "memory")
#define PG8_WAIT_L(n) asm volatile("s_waitcnt lgkmcnt(" #n ")" ::: "memory")
#define PG8_BAR __builtin_amdgcn_s_barrier()
#define PG8_SCHED __builtin_amdgcn_sched_barrier(0)
    Unit cur, nxt; int ui = 0;
    if (!S.next(0, cur)) return;
    f32x4 acc[2][2][4][2];
#pragma unroll
    for (int a = 0; a < 2; ++a)
#pragma unroll
        for (int b = 0; b < 2; ++b)
#pragma unroll
            for (int m = 0; m < 4; ++m)
#pragma unroll
                for (int n = 0; n < 2; ++n) acc[a][b][m][n] = (f32x4){0.f, 0.f, 0.f, 0.f};
    bf16x8 At[4][2], B0[2][2], B1[2][2];
    unsigned oc[2][2];
    S.aoff(0, RA, CA, oc);
    const char* Ab = (const char*)g.A;
    const char* cB = (const char*)g.Bt + (size_t)cur.pn * tstep;
    PG8_STAGE(PG8_SB(0, 0), cB, voffB); PG8_STAGE(PG8_SB(0, 1), cB + hstep, voffB); PG8_STAGE(PG8_SA(0, 0), Ab, oc[0]); PG8_STAGE(PG8_SA(0, 1), Ab, oc[1]);
    if (wr == 1) PG8_BAR;
    PG8_WAIT_V(2); PG8_BAR;
    PG8_STAGE(PG8_SB(1, 0), cB + kstep, voffB); PG8_STAGE(PG8_SA(1, 0), Ab + kstep, oc[0]); PG8_STAGE(PG8_SB(1, 1), cB + hstep + kstep, voffB);
    PG8_WAIT_V(6); PG8_BAR;
    for (;;) {
        const bool has_next = S.next(ui + 1, nxt);
        const char* nB = has_next ? (const char*)g.Bt + (size_t)nxt.pn * tstep : cB;
        for (int t = 0; t < nt; t += 2) {
            const bool last = (t == nt - 2);
            const char* a1 = Ab + (size_t)(t + 1) * kstep;
            const char* a2 = last ? Ab : Ab + (size_t)(t + 2) * kstep; const char* b2 = last ? nB : cB + (size_t)(t + 2) * kstep;
            const char* a3 = a2 + kstep; const char* b3 = b2 + kstep;
            unsigned o2[2][2];
            if (last && has_next) S.aoff(ui + 1, RA, CA, o2);
            else { o2[0][0] = oc[0][0]; o2[0][1] = oc[0][1]; o2[1][0] = oc[1][0]; o2[1][1] = oc[1][1]; }
            PG8_LDB(B0, 0, 0); PG8_LDB(B1, 0, 1); PG8_SCHED; PG8_LDA(At, 0, 0); PG8_STAGE(PG8_SA(1, 1), a1, oc[1]);
            PG8_WAIT_V(8); PG8_WAIT_L(0); PG8_BAR; if (cur.nh != 2) PG8_MMA(0, 0, At, B0); if (cur.nh != 1) PG8_MMA(0, 1, At, B1); PG8_BAR; PG8_SCHED;
            PG8_LDA(At, 0, 1); PG8_STAGE(PG8_SB(0, 0), b2, voffB); PG8_STAGE(PG8_SB(0, 1), b2 + hstep, voffB); PG8_STAGE(PG8_SA(0, 0), a2, o2[0]);
            PG8_WAIT_V(8); PG8_WAIT_L(0); PG8_BAR; if (!cur.half) { if (cur.nh != 2) PG8_MMA(1, 0, At, B0); if (cur.nh != 1) PG8_MMA(1, 1, At, B1); } PG8_BAR; PG8_SCHED;
            PG8_LDB(B0, 1, 0); PG8_LDB(B1, 1, 1); PG8_SCHED; PG8_LDA(At, 1, 0); PG8_STAGE(PG8_SA(0, 1), a2, o2[1]);
            PG8_WAIT_V(8); PG8_WAIT_L(0); PG8_BAR; if (cur.nh != 2) PG8_MMA(0, 0, At, B0); if (cur.nh != 1) PG8_MMA(0, 1, At, B1); PG8_BAR; PG8_SCHED;
            PG8_LDA(At, 1, 1); PG8_STAGE(PG8_SB(1, 0), b3, voffB); PG8_STAGE(PG8_SB(1, 1), b3 + hstep, voffB); PG8_STAGE(PG8_SA(1, 0), a3, o2[0]);
            PG8_WAIT_V(8); PG8_WAIT_L(0); PG8_BAR; if (!cur.half) { if (cur.nh != 2) PG8_MMA(1, 0, At, B0); if (cur.nh != 1) PG8_MMA(1, 1, At, B1); } PG8_BAR; PG8_SCHED;
        }
        if (wr == 0) PG8_BAR;
        E(acc, cur, wr, wc, fr, fq);
        if (!has_next) break;
#pragma unroll
        for (int a = 0; a < 2; ++a)
#pragma unroll
            for (int b = 0; b < 2; ++b)
#pragma unroll
                for (int m = 0; m < 4; ++m)
#pragma unroll
                    for (int n = 0; n < 2; ++n) acc[a][b][m][n] = (f32x4){0.f, 0.f, 0.f, 0.f};
        cur = nxt; cB = nB; ++ui;
        S.aoff(ui, RA, CA, oc);
        if (wr == 1) PG8_BAR;
    }
    PG8_WAIT_V(0);
    PG8_BAR;
#undef PG8_SA
#undef PG8_SB
#undef PG8_STAGE
#undef PG8_LDA
#undef PG8_LDB
#undef PG8_MMA
#undef PG8_WAIT_V
#undef PG8_WAIT_L
#undef PG8_BAR
#undef PG8_SCHED
}

constexpr int MOE_MAXU = 4;
struct SchedMoe {
    const int* tp; const int* cn; const unsigned* tab;
    int NT, nU, G, c;
    __device__ __forceinline__ bool next(int i, Unit& u) const {
        if (i >= MOE_MAXU) return false;
        const long L = (long)i * G + c; if (L >= nU) return false;
        int wgid = (int)L; { const int q = nU / NXCD, r = nU % NXCD, xcd = wgid % NXCD, off = wgid / NXCD; wgid = (xcd < r ? xcd * (q + 1) : r * (q + 1) + (xcd - r) * q) + off; }
        const int ti = wgid / NT, pn = wgid - ti * NT;
        int e = 0; while (tp[e + 1] <= ti) ++e;
        u.pm = ti; u.pn = e * NT + pn; u.aux = i; u.half = (cn[e] - (ti - tp[e]) * BM <= HALF) ? 1 : 0; u.nh = 0; return true;
    }
    __device__ __forceinline__ void aoff(int ui, const int (&RA)[2], const int (&CA)[2], unsigned (&o)[2][2]) const {
#pragma unroll
        for (int h = 0; h < 2; ++h)
#pragma unroll
            for (int i = 0; i < 2; ++i) o[h][i] = tab[ui * 256 + h * HALF + RA[i]] + (unsigned)CA[i] * 2u;
    }
    __device__ __forceinline__ void a_ready(const Unit&) const {}
    __device__ __forceinline__ void done(const Unit&) const {}
};
__device__ __forceinline__ float silu_f(float x) { return x * __builtin_amdgcn_rcpf(1.f + __expf(-x)); }
__device__ __forceinline__ float sig_f(float x) { return __builtin_amdgcn_rcpf(1.f + __expf(-x)); }
struct EpiGlu256 {
    static constexpr bool PERM = true, AFTER_DRAIN = false;
    const bf16_t* Z; const float* b; bf16_t* mix;
    __device__ __forceinline__ void operator()(const f32x4 (&acc)[2][2][4][2], const Unit& u, int wr, int wc, int fr, int fq) const {
        const int row0 = u.pm * BM + wr * 64 + fr, col0 = u.pn * BM + wc * 32 + 8 * fq;
#pragma unroll
        for (int ai = 0; ai < 2; ++ai)
#pragma unroll
            for (int m = 0; m < 4; ++m) { const size_t r = (size_t)(row0 + ai * HALF + m * 16);
#pragma unroll
                for (int bj = 0; bj < 2; ++bj) { const int c = col0 + bj * HALF;
                    const u32x4 q = *(const u32x4*)(Z + r * 512 + c);
                    const f32x4 b0 = *(const f32x4*)(b + c), b1 = *(const f32x4*)(b + c + 4);
                    const f32x4 v0 = acc[ai][bj][m][0] + b0, v1 = acc[ai][bj][m][1] + b1;
                    const float z0 = __uint_as_float(q.x << 16), z1 = __uint_as_float(q.x & 0xffff0000u), z2 = __uint_as_float(q.y << 16), z3 = __uint_as_float(q.y & 0xffff0000u);
                    const float z4 = __uint_as_float(q.z << 16), z5 = __uint_as_float(q.z & 0xffff0000u), z6 = __uint_as_float(q.w << 16), z7 = __uint_as_float(q.w & 0xffff0000u);
                    u32x4 w; w.x = cvt_pk_bf16(z0 * sig_f(v0[0]), z1 * sig_f(v0[1])); w.y = cvt_pk_bf16(z2 * sig_f(v0[2]), z3 * sig_f(v0[3]));
                    w.z = cvt_pk_bf16(z4 * sig_f(v1[0]), z5 * sig_f(v1[1])); w.w = cvt_pk_bf16(z6 * sig_f(v1[2]), z7 * sig_f(v1[3]));
                    *(u32x4*)(mix + r * 1024 + c) = w; } }
    }
};

struct EpiMoeUp {
    static constexpr bool PERM = true, AFTER_DRAIN = false;
    bf16_t* H;
    __device__ __forceinline__ void operator()(const f32x4 (&acc)[2][2][4][2], const Unit& u, int wr, int wc, int fr, int fq) const {
        const int row0 = u.pm * BM + wr * 64 + fr, f0 = (u.pn & 1) * 128 + wc * 32 + 8 * fq;
#pragma unroll
        for (int ai = 0; ai < 2; ++ai)
#pragma unroll
            for (int m = 0; m < 4; ++m) {
                const f32x4 g0 = acc[ai][0][m][0], g1 = acc[ai][0][m][1], u0 = acc[ai][1][m][0], u1 = acc[ai][1][m][1];
                u32x4 w; w.x = cvt_pk_bf16(silu_f(g0[0]) * u0[0], silu_f(g0[1]) * u0[1]); w.y = cvt_pk_bf16(silu_f(g0[2]) * u0[2], silu_f(g0[3]) * u0[3]);
                w.z = cvt_pk_bf16(silu_f(g1[0]) * u1[0], silu_f(g1[1]) * u1[1]); w.w = cvt_pk_bf16(silu_f(g1[2]) * u1[2], silu_f(g1[3]) * u1[3]);
                *(u32x4*)(H + (size_t)(row0 + ai * HALF + m * 16) * 256 + f0) = w;
            }
    }
};
struct EpiMoeDown {
    static constexpr bool PERM = true, AFTER_DRAIN = false;
    bf16_t* Y; const unsigned* dtab; const float* wtab;
    __device__ __forceinline__ void operator()(const f32x4 (&acc)[2][2][4][2], const Unit& u, int wr, int wc, int fr, int fq) const {
        const int pn = u.pn & 3, tb = u.aux * 256 + wr * 64 + fr, col = pn * BM + wc * 32 + 8 * fq;
#pragma unroll
        for (int ai = 0; ai < 2; ++ai)
#pragma unroll
            for (int m = 0; m < 4; ++m) {
                const unsigned d = dtab[tb + ai * HALF + m * 16]; const float w = wtab[tb + ai * HALF + m * 16];
                if (d != 0xffffffffu) {
                    bf16_t* yr = Y + (size_t)d * 1024 + col;
#pragma unroll
                    for (int bj = 0; bj < 2; ++bj) { const f32x4 v0 = acc[ai][bj][m][0] * w, v1 = acc[ai][bj][m][1] * w;
                        u32x4 o; o.x = cvt_pk_bf16(v0[0], v0[1]); o.y = cvt_pk_bf16(v0[2], v0[3]); o.z = cvt_pk_bf16(v1[0], v1[1]); o.w = cvt_pk_bf16(v1[2], v1[3]);
                        *(u32x4*)(yr + bj * HALF) = o; }
                }
            }
    }
};
}

__device__ __forceinline__ void transpose_tile(const float* __restrict__ src, int ldn, bf16_t* __restrict__ dst, int ldk, float scale, float* scr, int lane) {
    float tv[32];
#pragma unroll
    for (int i = 0; i < 32; ++i) tv[i] = __builtin_nontemporal_load(src + (size_t)(2 * i + (lane >> 5)) * ldn + (lane & 31));
#pragma unroll
    for (int i = 0; i < 32; ++i) scr[(2 * i + (lane >> 5)) * 33 + (lane & 31)] = tv[i];
    LDS_WAIT();
    const int c = lane & 7;
#pragma unroll
    for (int j = 0; j < 4; ++j) {
        const int n = (lane >> 3) + 8 * j; const float* s = scr + (8 * c) * 33 + n;
        u32x4 o; o.x = pk2(s[0] * scale, s[33] * scale); o.y = pk2(s[66] * scale, s[99] * scale); o.z = pk2(s[132] * scale, s[165] * scale); o.w = pk2(s[198] * scale, s[231] * scale);
        *(u32x4*)(dst + (size_t)n * ldk + 8 * c) = o;
    }
    LDS_WAIT();
}

__device__ __forceinline__ void rms_row(f32x4 (&v)[4], const float* __restrict__ w, bf16_t* __restrict__ xn, int lane) {
    float ss = 0.f;
#pragma unroll
    for (int j = 0; j < 4; ++j) ss += v[j].x * v[j].x + v[j].y * v[j].y + v[j].z * v[j].z + v[j].w * v[j].w;
    ss = wave_sum(ss);
    const float r = rsqrtf(ss * (1.f / 1024.f) + EPS);
#pragma unroll
    for (int j = 0; j < 4; ++j) {
        const f32x4 w4 = *(const f32x4*)(w + 4 * lane + 256 * j);
        v[j] = v[j] * r * w4;
        u32x2 o; o.x = pk2(v[j].x, v[j].y); o.y = pk2(v[j].z, v[j].w);
        *(u32x2*)(xn + 4 * lane + 256 * j) = o;
    }
}

__device__ __forceinline__ void phase_prep(const Params& p, unsigned char* lds) {
    const int tid = opaque_tid(), lane = tid & 63, wid = tid >> 6;
    const int gw = blockIdx.x * 8 + wid, NGW = gridDim.x * 8;
    const int gt = blockIdx.x * NTHR + tid, NGT = gridDim.x * NTHR;
    unsigned char* ws = p.ws;
    if (blockIdx.x == 0 && tid < 64) ((int*)(ws + WS_CTL))[tid] = 0;
    for (int idx = (tid < 8 ? blockIdx.x * 8 + tid : 2048); idx < 2048; idx += gridDim.x * 8) {
        const int g = idx >> 6;
        const double lr = p.in[I_S5_LRE][idx], li = p.in[I_S5_LIM][idx], dt = exp((double)p.in[I_S5_LOGDT][g]);
        const double zr = lr * dt, zi = li * dt, ez = exp(zr);
        const double br = ez * cos(zi), bi = ez * sin(zi);
        double pr = 1.0, pi = 0.0;
        for (int tau = 0; tau <= 16; ++tau) {
            ((f32x2*)(ws + WS_S5POW))[idx * 17 + tau] = (f32x2){(float)pr, (float)pi};
            const double nr = pr * br - pi * bi, ni = pr * bi + pi * br; pr = nr; pi = ni;
        }
        const double ar = br - 1.0, ai = bi, den = lr * lr + li * li;
        const double cr = (ar * lr + ai * li) / den, ci = (ai * lr - ar * li) / den;
        for (int c = 0; c < 16; ++c) {
            const double b_r = p.in[I_S5_BRE][idx * 16 + c], b_i = p.in[I_S5_BIM][idx * 16 + c];
            ((f32x2*)(ws + WS_S5BBAR))[idx * 16 + c] = (f32x2){(float)(cr * b_r - ci * b_i), (float)(cr * b_i + ci * b_r)};
        }
    }
    for (int idx = gt; idx < 2 * 32 * 3 * 64; idx += NGT) {
        const int l = idx / (32 * 3 * 64), rem = idx - l * (32 * 3 * 64), ks = rem / 192, r2 = rem - ks * 192, nt_ = r2 >> 6, ln = r2 & 63, col = nt_ * 16 + (ln & 15);
        float v[8];
#pragma unroll
        for (int j = 0; j < 8; ++j) {
            const int k = ks * 32 + (ln >> 4) * 8 + j;
            float w = 0.f;
            if (col < 32) w = p.in[I_MOE_WR][(size_t)(l * 1024 + k) * 32 + col];
            else if (col < 36) w = p.in[I_MOE_WG][(size_t)(l * 1024 + k) * 4 + (col - 32)];
            v[j] = w * p.in[I_NORM_FFN][l * 1024 + k];
        }
        unsigned hi[4], lo[4];
#pragma unroll
        for (int q = 0; q < 4; ++q) {
            const unsigned h0 = f2bf(v[2 * q]), h1 = f2bf(v[2 * q + 1]);
            hi[q] = h0 | (h1 << 16);
            lo[q] = pk2(v[2 * q] - bf2f(h0), v[2 * q + 1] - bf2f(h1));
        }
        bf16_t* wf = (bf16_t*)(ws + WS_WCAT);
        *(u32x4*)(wf + ((size_t)(l * 2 + 0) * 6144 + (size_t)(ks * 3 + nt_) * 64 + ln) * 8) = (u32x4){hi[0], hi[1], hi[2], hi[3]};
        *(u32x4*)(wf + ((size_t)(l * 2 + 1) * 6144 + (size_t)(ks * 3 + nt_) * 64 + ln) * 8) = (u32x4){lo[0], lo[1], lo[2], lo[3]};
    }
    float* scr = (float*)(lds + wid * 8704);
    constexpr int IT_WINA = 112 * 16, IT_WOUT = 32 * 16, IT_WINC = 80 * 16, IT_WGLU = 16 * 8;
    constexpr int IT_TOTAL = IT_WINA + IT_WOUT + IT_WINC + IT_WOUT + IT_WGLU;
    for (int it0 = gw; it0 < IT_TOTAL; it0 += NGW) {
        int it = it0; const float* src; bf16_t* dst; int ldn, ldk; float scale = 1.f;
        if (it < IT_WINA) {
            const int n0 = (it >> 4) * 32, k0 = (it & 15) * 64, srcn = n0 < 2048 ? n0 : n0 + 8;
            if (n0 >= 512 && n0 < 1024) scale = 0.08838834764831845f;
            src = p.in[I_AB_WIN] + (size_t)k0 * 3592 + srcn; ldn = 3592; dst = (bf16_t*)(ws + WS_WINA) + (size_t)n0 * 1024 + k0; ldk = 1024;
        } else if ((it -= IT_WINA) < IT_WOUT) {
            const int n0 = (it >> 4) * 32, k0 = (it & 15) * 64;
            src = p.in[I_AB_WOUT] + (size_t)k0 * 1024 + n0; ldn = 1024; dst = (bf16_t*)(ws + WS_WOUTA) + (size_t)n0 * 1024 + k0; ldk = 1024;
        } else if ((it -= IT_WOUT) < IT_WINC) {
            const int n0 = (it >> 4) * 32, k0 = (it & 15) * 64;
            src = p.in[I_CD_WIN] + (size_t)k0 * 2560 + n0; ldn = 2560; dst = (bf16_t*)(ws + WS_WINC) + (size_t)n0 * 1024 + k0; ldk = 1024;
        } else if ((it -= IT_WINC) < IT_WOUT) {
            const int n0 = (it >> 4) * 32, k0 = (it & 15) * 64;
            src = p.in[I_CD_WOUT] + (size_t)k0 * 1024 + n0; ldn = 1024; dst = (bf16_t*)(ws + WS_WOUTC) + (size_t)n0 * 1024 + k0; ldk = 1024;
        } else {
            it -= IT_WOUT;
            const int n0 = (it >> 3) * 32, k0 = (it & 7) * 64;
            src = p.in[I_S5_WGLU] + (size_t)k0 * 512 + n0; ldn = 512; dst = (bf16_t*)(ws + WS_WGLU) + (size_t)n0 * 512 + k0; ldk = 512;
        }
        transpose_tile(src, ldn, dst, ldk, scale, scr, lane);
    }
    {
        bf16_t* wg = (bf16_t*)(ws + WS_WINA) + (size_t)3584 * 1024;
        const float* win = p.in[I_AB_WIN];
        for (int idx = gt; idx < 256 * 1024; idx += NGT) {
            const int n = idx >> 10, k = idx & 1023;
            wg[idx] = (bf16_t)(n < 8 ? f2bf(win[(size_t)k * 3592 + 2048 + n]) : 0u);
        }
    }
    const float* x = p.in[I_X];
    f32x4 vn[4];
    if (gw < T) {
#pragma unroll
        for (int j = 0; j < 4; ++j) vn[j] = __builtin_nontemporal_load((const f32x4*)(x + (size_t)gw * 1024 + 4 * lane + 256 * j));
    }
    for (int row = gw; row < T; row += NGW) {
        f32x4 v[4];
#pragma unroll
        for (int j = 0; j < 4; ++j) v[j] = vn[j];
        if (row + NGW < T) {
#pragma unroll
            for (int j = 0; j < 4; ++j) vn[j] = __builtin_nontemporal_load((const f32x4*)(x + (size_t)(row + NGW) * 1024 + 4 * lane + 256 * j));
        }
        {
            bf16_t* h16 = (bf16_t*)(ws + WS_H16) + (size_t)row * 1024;
#pragma unroll
            for (int j = 0; j < 4; ++j) { u32x2 o; o.x = pk2(v[j].x, v[j].y); o.y = pk2(v[j].z, v[j].w); *(u32x2*)(h16 + 4 * lane + 256 * j) = o; }
        }
        rms_row(v, p.in[I_NORM_MIX], (bf16_t*)(ws + WS_XN) + (size_t)row * 1024, lane);
    }
}

struct EpiStoreBf16 {
    bf16_t* O; int ldc;
    __device__ __forceinline__ void operator()(const f32x4 (&acc)[2][4], int wr, int wc, int fr, int fq) const {
#pragma unroll
        for (int m = 0; m < 2; ++m)
#pragma unroll
            for (int n = 0; n < 4; ++n) {
                const f32x4 v = acc[m][n]; u32x2 o; o.x = pk2(v.x, v.y); o.y = pk2(v.z, v.w);
                *(u32x2*)(O + (size_t)(wr * 32 + m * 16 + fr) * ldc + wc * 64 + n * 16 + fq * 4) = o;
            }
    }
};
struct EpiResidF32 {
    const float* resid; float* out;
    __device__ __forceinline__ void operator()(const f32x4 (&acc)[2][4], int wr, int wc, int fr, int fq) const {
#pragma unroll
        for (int m = 0; m < 2; ++m)
#pragma unroll
            for (int n = 0; n < 4; ++n) {
                const size_t off = (size_t)(wr * 32 + m * 16 + fr) * 1024 + wc * 64 + n * 16 + fq * 4;
                const f32x4 r = *(const f32x4*)(resid + off);
                *(f32x4*)(out + off) = r + acc[m][n];
            }
    }
};
struct EpiGlu {
    const bf16_t* Z; const float* b; bf16_t* mix;
    __device__ __forceinline__ void operator()(const f32x4 (&acc)[2][4], int wr, int wc, int fr, int fq) const {
#pragma unroll
        for (int m = 0; m < 2; ++m)
#pragma unroll
            for (int n = 0; n < 4; ++n) {
                const int r = wr * 32 + m * 16 + fr, c = wc * 64 + n * 16 + fq * 4;
                const u32x2 zz = *(const u32x2*)(Z + (size_t)r * 512 + c);
                const f32x4 bb = *(const f32x4*)(b + c);
                const f32x4 v = acc[m][n] + bb;
                const float z0 = bf2f(zz.x & 0xffffu), z1 = bf2f(zz.x >> 16), z2 = bf2f(zz.y & 0xffffu), z3 = bf2f(zz.y >> 16);
                u32x2 o; o.x = pk2(z0 * fsigmoid_(v.x), z1 * fsigmoid_(v.y)); o.y = pk2(z2 * fsigmoid_(v.z), z3 * fsigmoid_(v.w));
                *(u32x2*)(mix + (size_t)r * 1024 + c) = o;
            }
    }
};

__device__ __forceinline__ void phase_gemm_store(unsigned char* lds, const bf16_t* A, const bf16_t* Bt, int N, int K, bf16_t* O, int ldc) {
    const int nN = N >> 7, nU = (T >> 7) * nN;
    for (int u = blockIdx.x; u < nU; u += gridDim.x) {
        const int pm = u / nN, pn = u - pm * nN;
        APlain ap{A + (size_t)pm * 128 * K, K};
        EpiStoreBf16 e{O + (size_t)pm * 128 * ldc + pn * 128, ldc};
        gemm128(lds, ap, Bt + (size_t)pn * 128 * K, K, e);
    }
}
__device__ __forceinline__ void phase_gemm_resid(unsigned char* lds, const bf16_t* A, const bf16_t* Bt, const float* resid, float* out) {
    const int nU = (T >> 7) * 8;
    for (int u = blockIdx.x; u < nU; u += gridDim.x) {
        const int pm = u >> 3, pn = u & 7;
        APlain ap{A + (size_t)pm * 128 * 1024, 1024};
        const size_t off = (size_t)pm * 128 * 1024 + pn * 128;
        EpiResidF32 e{resid + off, out + off};
        gemm128(lds, ap, Bt + (size_t)pn * 128 * 1024, 1024, e);
    }
}
__device__ __forceinline__ void phase_gemm_glu(unsigned char* lds, const Params& p) {
    pg8::Gemm g{(const bf16_t*)(p.ws + WS_Z), (const bf16_t*)(p.ws + WS_WGLU), T, 512, 512}; pg8::StaticOrder S; S.init(T, 512, (int)gridDim.x, (int)blockIdx.x);
    pg8::EpiGlu256 E{(const bf16_t*)(p.ws + WS_Z), p.in[I_S5_BGLU], (bf16_t*)(p.ws + WS_MIX)};
    pg8::gemm_phase<pg8::EpiGlu256, pg8::StaticOrder, true, true>((PG8_LAS unsigned char*)lds, g, S, E);
}
__device__ __forceinline__ void phase_gemm256_store(unsigned char* lds, const bf16_t* A, const bf16_t* Bt, int N, bf16_t* O) {
    pg8::Gemm g{A, Bt, T, N, 1024}; pg8::StaticOrder S; S.init(T, N, (int)gridDim.x, (int)blockIdx.x);
    pg8::EpiStore E{O, N};
    pg8::gemm_phase<pg8::EpiStore, pg8::StaticOrder, true, true>((PG8_LAS unsigned char*)lds, g, S, E);
}
__device__ __forceinline__ void phase_gemm256_inproj1(unsigned char* lds, const Params& p) {
    pg8::Gemm g{(const bf16_t*)(p.ws + WS_XN), (const bf16_t*)(p.ws + WS_WINC), T, PC, 1024}; pg8::StaticOrderHalfTail S; S.init(T, 8 * 256, (int)gridDim.x, (int)blockIdx.x); S.nNF = 8; S.nNT = 2;
    pg8::EpiStore E{(bf16_t*)(p.ws + WS_PROJ), PC};
    pg8::gemm_phase<pg8::EpiStore, pg8::StaticOrderHalfTail, true, true>((PG8_LAS unsigned char*)lds, g, S, E);
}
__device__ __forceinline__ void phase_gemm256_inproj0(unsigned char* lds, const Params& p) {
    pg8::Gemm g{(const bf16_t*)(p.ws + WS_XN), (const bf16_t*)(p.ws + WS_WINA), T, 3840, 1024}; pg8::StaticOrder S; S.init(T, 3840, (int)gridDim.x, (int)blockIdx.x);
    pg8::EpiStoreGates E{(bf16_t*)(p.ws + WS_PROJ), PA, 14, (float*)(p.ws + WS_GATES), p.in[I_AB_GBIAS]};
    pg8::gemm_phase<pg8::EpiStoreGates, pg8::StaticOrder, true, true>((PG8_LAS unsigned char*)lds, g, S, E);
}
__device__ __forceinline__ void phase_gemm256_resid(unsigned char* lds, const bf16_t* A, const bf16_t* Bt, const float* rf, const bf16_t* rb, bf16_t* out) {
    pg8::Gemm g{A, Bt, T, 1024, 1024}; pg8::StaticOrder S; S.init(T, 1024, (int)gridDim.x, (int)blockIdx.x);
    pg8::EpiResid E{rf, rb, out};
    pg8::gemm_phase<pg8::EpiResid, pg8::StaticOrder, true, true>((PG8_LAS unsigned char*)lds, g, S, E);
}

__device__ __forceinline__ void s5_gen_ktab(const Params& p) {
    const int gt = blockIdx.x * NTHR + opaque_tid(), NGT = gridDim.x * NTHR;
    const f32x2* POW = (const f32x2*)(p.ws + WS_S5POW); const f32x2* BB = (const f32x2*)(p.ws + WS_S5BBAR);
    for (int idx = gt; idx < 32 * 4096; idx += NGT) {
        const int g = idx >> 12, tau = (idx >> 8) & 15, ch = (idx >> 4) & 15, c = idx & 15;
        float sum = 0.f;
        for (int pp = 0; pp < 64; ++pp) {
            const f32x2 l = POW[(g * 64 + pp) * 17 + tau], b = BB[(g * 64 + pp) * 16 + c];
            const float wr_ = l.x * b.x - l.y * b.y, wi_ = l.x * b.y + l.y * b.x;
            sum += p.in[I_S5_CRE][(size_t)(g * 16 + ch) * 64 + pp] * wr_ - p.in[I_S5_CIM][(size_t)(g * 16 + ch) * 64 + pp] * wi_;
        }
        if (tau == 0 && ch == c) sum += p.in[I_S5_D][g * 16 + ch];
        ((float*)(p.ws + WS_KTAB))[idx] = sum;
    }
}
__device__ __forceinline__ void s5_gen_ops(const Params& p) {
    const int gt = blockIdx.x * NTHR + opaque_tid(), NGT = gridDim.x * NTHR;
    const f32x2* POW = (const f32x2*)(p.ws + WS_S5POW); const f32x2* BB = (const f32x2*)(p.ws + WS_S5BBAR);
    const float* KT = (const float*)(p.ws + WS_KTAB);
    bf16_t* BY = (bf16_t*)(p.ws + WS_S5Y); bf16_t* BE = (bf16_t*)(p.ws + WS_S5E);
    for (int idx = gt; idx < 32 * 256 * 48; idx += NGT) {
        const int kc = idx % 48, gn = idx / 48, n = gn & 255, g = gn >> 8, t = n >> 4, ch = n & 15, k0 = kc * 8;
        float v[8];
        if (k0 < 256) {
            const int s_ = k0 >> 4, c0 = k0 & 15;
            if (s_ <= t) {
                const f32x4 a = *(const f32x4*)(KT + ((g * 16 + (t - s_)) * 16 + ch) * 16 + c0), b = *(const f32x4*)(KT + ((g * 16 + (t - s_)) * 16 + ch) * 16 + c0 + 4);
                v[0] = a.x; v[1] = a.y; v[2] = a.z; v[3] = a.w; v[4] = b.x; v[5] = b.y; v[6] = b.z; v[7] = b.w;
            } else {
#pragma unroll
                for (int j = 0; j < 8; ++j) v[j] = 0.f;
            }
        } else {
            const int p0 = (k0 - 256) & 63; const bool re = k0 < 320;
#pragma unroll
            for (int j = 0; j < 8; ++j) {
                const int pp = p0 + j; const f32x2 l = POW[(g * 64 + pp) * 17 + t + 1];
                const float cr = p.in[I_S5_CRE][(size_t)(g * 16 + ch) * 64 + pp], ci = p.in[I_S5_CIM][(size_t)(g * 16 + ch) * 64 + pp];
                v[j] = re ? (cr * l.x - ci * l.y) : -(cr * l.y + ci * l.x);
            }
        }
        *(u32x4*)(BY + (size_t)gn * 384 + k0) = (u32x4){pk2(v[0], v[1]), pk2(v[2], v[3]), pk2(v[4], v[5]), pk2(v[6], v[7])};
    }
    for (int idx = gt; idx < 32 * 128 * 32; idx += NGT) {
        const int kc = idx & 31, gn = idx >> 5, n = gn & 127, g = gn >> 7, pp = n & 63, k0 = kc * 8, s_ = k0 >> 4, c0 = k0 & 15;
        const f32x2 l = POW[(g * 64 + pp) * 17 + 15 - s_];
        float v[8];
#pragma unroll
        for (int j = 0; j < 8; ++j) { const f32x2 b = BB[(g * 64 + pp) * 16 + c0 + j]; v[j] = (n < 64) ? (l.x * b.x - l.y * b.y) : (l.x * b.y + l.y * b.x); }
        *(u32x4*)(BE + (size_t)gn * 256 + k0) = (u32x4){pk2(v[0], v[1]), pk2(v[2], v[3]), pk2(v[4], v[5]), pk2(v[6], v[7])};
    }
}
struct AS5 {
    const bf16_t* proj; const bf16_t* xp; int m0, g;
    __device__ __forceinline__ const bf16_t* operator()(int r, int kc) const {
        const int m = m0 + r, k0 = kc * 8;
        return (k0 < 256) ? proj + ((size_t)(m * 16 + (k0 >> 4)) * PC + g * 16 + (k0 & 15)) : xp + ((size_t)m * 32 + g) * 128 + (k0 - 256);
    }
};
struct EpiS5E {
    float* xend; int m0, g;
    __device__ __forceinline__ void operator()(const f32x4 (&acc)[2][4], int wr, int wc, int fr, int fq) const {
#pragma unroll
        for (int m = 0; m < 2; ++m)
#pragma unroll
            for (int n = 0; n < 4; ++n) *(f32x4*)(xend + ((size_t)(m0 + wr * 32 + m * 16 + fr) * 32 + g) * 128 + wc * 64 + n * 16 + fq * 4) = acc[m][n];
    }
};
struct EpiS5Y {
    bf16_t* Z; int m0, g, n0;
    __device__ __forceinline__ void operator()(const f32x4 (&acc)[2][4], int wr, int wc, int fr, int fq) const {
#pragma unroll
        for (int m = 0; m < 2; ++m)
#pragma unroll
            for (int n = 0; n < 4; ++n) {
                const int mm = m0 + wr * 32 + m * 16 + fr, nc = n0 + wc * 64 + n * 16 + fq * 4, t = nc >> 4, ch0 = nc & 15;
                const f32x4 v = acc[m][n];
                u32x2 o; o.x = pk2(fgelu_tanh_(v.x), fgelu_tanh_(v.y)); o.y = pk2(fgelu_tanh_(v.z), fgelu_tanh_(v.w));
                *(u32x2*)(Z + (size_t)(mm * 16 + t) * 512 + g * 16 + ch0) = o;
            }
    }
};
__device__ __forceinline__ void s5_unit_E(const Params& p, unsigned char* lds, int u) {
    const int g = u >> 3, mt = u & 7;
    AS5 a{(const bf16_t*)(p.ws + WS_PROJ), nullptr, mt * 128, g};
    EpiS5E e{(float*)(p.ws + WS_XEND), mt * 128, g};
    gemm128(lds, a, (const bf16_t*)(p.ws + WS_S5E) + (size_t)g * 128 * 256, 256, e);
}
__device__ __forceinline__ void s5_unit_Y(const Params& p, unsigned char* lds, int u) {
    const int g = u >> 3, mt = u & 7;
    AS5 a{(const bf16_t*)(p.ws + WS_PROJ), (const bf16_t*)(p.ws + WS_XPREVB), mt * 128, g};
    EpiS5Y e0{(bf16_t*)(p.ws + WS_Z), mt * 128, g, 0}, e1{(bf16_t*)(p.ws + WS_Z), mt * 128, g, 128};
    BPlain b0{(const bf16_t*)(p.ws + WS_S5Y) + (size_t)g * 256 * 384, 384}, b1{(const bf16_t*)(p.ws + WS_S5Y) + ((size_t)g * 256 + 128) * 384, 384};
    gemm128x2(lds, a, b0, b1, 384, e0, e1);
}

__device__ __forceinline__ void stage_rows(const bf16_t* __restrict__ g, int pitch, bf16_t* s, int tid) {
#pragma unroll
    for (int i = 0; i < 2; ++i) { const int pc = tid + i * NTHR, l = pc >> 4, d0 = (pc & 15) * 8; *(u32x4*)(s + l * 136 + d0) = *(const u32x4*)(g + (size_t)l * pitch + d0); }
}
__device__ __forceinline__ void stage_transposed(const bf16_t* __restrict__ g, int pitch, bf16_t* s, const float* rs, int tid) {
#pragma unroll
    for (int i = 0; i < 2; ++i) {
        const int pc = tid + i * NTHR, l = pc >> 4, d0 = (pc & 15) * 8;
        const u32x4 v = *(const u32x4*)(g + (size_t)l * pitch + d0);
        const float sc = rs ? rs[l] : 1.f;
        const unsigned w[4] = {v.x, v.y, v.z, v.w};
#pragma unroll
        for (int q = 0; q < 4; ++q) {
            s[tsw(d0 + 2 * q, l)] = (bf16_t)f2bf(bf2f(w[q] & 0xffffu) * sc);
            s[tsw(d0 + 2 * q + 1, l)] = (bf16_t)f2bf(bf2f(w[q] >> 16) * sc);
        }
    }
}
__device__ __forceinline__ void state_outer(const bf16_t* Kt, const bf16_t* Vt, bf16_t* __restrict__ Uout, int wid, int fr, int fq) {
    const int v0 = wid * 16;
    bf16x8 bv[2];
#pragma unroll
    for (int ls = 0; ls < 2; ++ls) bv[ls] = *(const bf16x8*)(Vt + tswc(v0 + fr, ls * 4 + fq));
#pragma unroll
    for (int kt = 0; kt < 8; ++kt) {
        f32x4 acc = (f32x4){0.f, 0.f, 0.f, 0.f};
#pragma unroll
        for (int ls = 0; ls < 2; ++ls) {
            const bf16x8 ak = *(const bf16x8*)(Kt + tswc(kt * 16 + fr, ls * 4 + fq));
            acc = __builtin_amdgcn_mfma_f32_16x16x32_bf16(ak, bv[ls], acc, 0, 0, 0);
        }
        u32x2 o; o.x = pk2(acc.x, acc.y); o.y = pk2(acc.z, acc.w);
        *(u32x2*)(Uout + (size_t)(v0 + fr) * 128 + kt * 16 + fq * 4) = o;
    }
}
template <bool KRM>
__device__ __forceinline__ void state_outer_tr(const bf16_t* Kx, const bf16_t* Vs, bf16_t* __restrict__ Uout, int wid, int fr, int fq) {
    const int v0 = wid * 16;
    bf16x8 bv[2];
#pragma unroll
    for (int ls = 0; ls < 2; ++ls) bv[ls] = frag_tr(Vs, 136, ls * 32, v0, fr, fq);
#pragma unroll
    for (int kt = 0; kt < 8; ++kt) {
        f32x4 acc = (f32x4){0.f, 0.f, 0.f, 0.f};
#pragma unroll
        for (int ls = 0; ls < 2; ++ls) {
            const bf16x8 ak = KRM ? frag_tr(Kx, 136, ls * 32, kt * 16, fr, fq) : *(const bf16x8*)(Kx + tswc(kt * 16 + fr, ls * 4 + fq));
            acc = __builtin_amdgcn_mfma_f32_16x16x32_bf16(ak, bv[ls], acc, 0, 0, 0);
        }
        u32x2 o; o.x = pk2(acc.x, acc.y); o.y = pk2(acc.z, acc.w);
        *(u32x2*)(Uout + (size_t)(v0 + fr) * 128 + kt * 16 + fq * 4) = o;
    }
}
template <int GATE>
__device__ __forceinline__ void head_norm_out(const float* Hs, const float* __restrict__ w, const bf16_t* __restrict__ gsrc, int gpitch, bf16_t* __restrict__ out, int opitch, int tid) {
    const int l = tid >> 3, part = tid & 7;
    float h[16]; float ss = 0.f;
#pragma unroll
    for (int i = 0; i < 4; ++i) { const f32x4 v = *(const f32x4*)(Hs + l * 132 + part * 16 + i * 4); h[4 * i] = v.x; h[4 * i + 1] = v.y; h[4 * i + 2] = v.z; h[4 * i + 3] = v.w; ss += v.x * v.x + v.y * v.y + v.z * v.z + v.w * v.w; }
    ss += __shfl_xor(ss, 1); ss += __shfl_xor(ss, 2); ss += __shfl_xor(ss, 4);
    const float r = rsqrtf(ss * (1.f / 128.f) + EPS);
    const u32x4 g0 = *(const u32x4*)(gsrc + (size_t)l * gpitch + part * 16), g1 = *(const u32x4*)(gsrc + (size_t)l * gpitch + part * 16 + 8);
    const unsigned gw[8] = {g0.x, g0.y, g0.z, g0.w, g1.x, g1.y, g1.z, g1.w};
    unsigned ow[8];
#pragma unroll
    for (int q = 0; q < 8; ++q) {
        const float ga = bf2f(gw[q] & 0xffffu), gb = bf2f(gw[q] >> 16);
        const float a = h[2 * q] * r * w[part * 16 + 2 * q] * (GATE == 0 ? fsigmoid_(ga) : fsilu_(ga));
        const float b = h[2 * q + 1] * r * w[part * 16 + 2 * q + 1] * (GATE == 0 ? fsigmoid_(gb) : fsilu_(gb));
        ow[q] = pk2(a, b);
    }
    *(u32x4*)(out + (size_t)l * opitch + part * 16) = (u32x4){ow[0], ow[1], ow[2], ow[3]};
    *(u32x4*)(out + (size_t)l * opitch + part * 16 + 8) = (u32x4){ow[4], ow[5], ow[6], ow[7]};
}


struct Tile2 { u32x4 v[2]; };
struct Tile4 { u32x4 v[4]; };
template <bool NT = false>
__device__ __forceinline__ void tile_load(Tile2& t, const bf16_t* __restrict__ g, int pitch, int tid) {
#pragma unroll
    for (int i = 0; i < 2; ++i) { const int pc = tid + i * NTHR; const u32x4* q = (const u32x4*)(g + (size_t)(pc >> 4) * pitch + (pc & 15) * 8); t.v[i] = NT ? __builtin_nontemporal_load(q) : *q; }
}
template <bool NT = false>
__device__ __forceinline__ void tile4_load(Tile4& t, const bf16_t* __restrict__ g, int tid) {
#pragma unroll
    for (int i = 0; i < 4; ++i) { const int pc = tid + i * NTHR; const u32x4* q = (const u32x4*)(g + (size_t)pc * 8); t.v[i] = NT ? __builtin_nontemporal_load(q) : *q; }
}
__device__ __forceinline__ void tile_put_rows(const Tile2& t, bf16_t* s, int tid) {
#pragma unroll
    for (int i = 0; i < 2; ++i) { const int pc = tid + i * NTHR; *(u32x4*)(s + (pc >> 4) * 136 + (pc & 15) * 8) = t.v[i]; }
}
__device__ __forceinline__ void tile4_put(const Tile4& t, bf16_t* s, int tid) {
#pragma unroll
    for (int i = 0; i < 4; ++i) { const int pc = tid + i * NTHR; *(u32x4*)(s + (pc >> 4) * 136 + (pc & 15) * 8) = t.v[i]; }
}
__device__ __forceinline__ void tile_put_transposed(const Tile2& t, bf16_t* s, const float* rs, int tid) {
#pragma unroll
    for (int i = 0; i < 2; ++i) {
        const int pc = tid + i * NTHR, l = pc >> 4, d0 = (pc & 15) * 8;
        const unsigned w[4] = {t.v[i].x, t.v[i].y, t.v[i].z, t.v[i].w};
        if (rs) {
            const float sc = rs[l];
#pragma unroll
            for (int q = 0; q < 4; ++q) {
                const unsigned pr = pk2(bf2f(w[q] & 0xffffu) * sc, bf2f(w[q] >> 16) * sc);
                s[tsw(d0 + 2 * q, l)] = (bf16_t)(pr & 0xffffu); s[tsw(d0 + 2 * q + 1, l)] = (bf16_t)(pr >> 16);
            }
        } else {
#pragma unroll
            for (int q = 0; q < 4; ++q) { s[tsw(d0 + 2 * q, l)] = (bf16_t)(w[q] & 0xffffu); s[tsw(d0 + 2 * q + 1, l)] = (bf16_t)(w[q] >> 16); }
        }
    }
}
template <int GATE>
__device__ __forceinline__ void head_norm_out_r(const float* Hs, const float* __restrict__ w, const u32x4 (&og)[2], bf16_t* __restrict__ out, int opitch, int tid) {
    const int l = tid >> 3, part = tid & 7;
    float h[16]; float ss = 0.f;
#pragma unroll
    for (int i = 0; i < 4; ++i) { const f32x4 v = *(const f32x4*)(Hs + l * 132 + part * 16 + i * 4); h[4 * i] = v.x; h[4 * i + 1] = v.y; h[4 * i + 2] = v.z; h[4 * i + 3] = v.w; ss += v.x * v.x + v.y * v.y + v.z * v.z + v.w * v.w; }
    ss += __shfl_xor(ss, 1); ss += __shfl_xor(ss, 2); ss += __shfl_xor(ss, 4);
    const float r = rsqrtf(ss * (1.f / 128.f) + EPS);
    const unsigned gw[8] = {og[0].x, og[0].y, og[0].z, og[0].w, og[1].x, og[1].y, og[1].z, og[1].w};
    unsigned ow[8];
#pragma unroll
    for (int q = 0; q < 8; ++q) {
        const float ga = bf2f(gw[q] & 0xffffu), gb = bf2f(gw[q] >> 16);
        const float a = h[2 * q] * r * w[part * 16 + 2 * q] * (GATE == 0 ? fsigmoid_(ga) : fsilu_(ga));
        const float b = h[2 * q + 1] * r * w[part * 16 + 2 * q + 1] * (GATE == 0 ? fsigmoid_(gb) : fsilu_(gb));
        ow[q] = pk2(a, b);
    }
    *(u32x4*)(out + (size_t)l * opitch + part * 16) = (u32x4){ow[0], ow[1], ow[2], ow[3]};
    *(u32x4*)(out + (size_t)l * opitch + part * 16 + 8) = (u32x4){ow[4], ow[5], ow[6], ow[7]};
}

__device__ __forceinline__ void phase_mlstm_local(const Params& p, unsigned char* lds) {
    const int tid = opaque_tid(), lane = tid & 63, wid = tid >> 6, fr = lane & 15, fq = lane >> 4;
    unsigned char* ws = p.ws;
    const bf16_t* PROJ = (const bf16_t*)(ws + WS_PROJ);
    const float* GATES = (const float*)(ws + WS_GATES);
    bf16_t* Kt = (bf16_t*)lds;
    bf16_t* Vt = (bf16_t*)(lds + 18432);
    float* wk = (float*)(lds + 36864);
    const int NIT = 1024 + 256;
    Tile2 rk, rv; float gi = 0.f, gf = 0.f;
    auto load_item = [&](int it) {
        const int b = it >> 8, h = (it >> 6) & 3, c = it & 63, t0 = b * SEQ + c * 64;
        tile_load(rk, PROJ + (size_t)t0 * PA + 512 + h * 128, PA, tid);
        tile_load(rv, PROJ + (size_t)t0 * PA + 1024 + h * 128, PA, tid);
        gi = GATES[(size_t)(t0 + lane) * 8 + h]; gf = GATES[(size_t)(t0 + lane) * 8 + 4 + h];
    };
    if ((int)blockIdx.x < 1024) load_item(blockIdx.x);
    for (int it = blockIdx.x; it < NIT; it += gridDim.x) {
        if (it < 1024) {
            if (wid == 0) {
                const float lf = logsigmoid_(gf);
                const float bc = wave_incl_sum(lf, lane);
                const float bend = __shfl(bc, 63);
                const float logg = bend - bc + gi;
                const float ml = wave_max(logg);
                wk[lane] = expf(logg - ml);
                if (lane == 0) { ((float*)(ws + WS_MLOC))[it] = ml; ((float*)(ws + WS_BEND))[it] = bend; }
            }
            tile_put_rows(rk, Kt, tid);
            __syncthreads();
            {
#pragma unroll
                for (int i = 0; i < 2; ++i) {
                    const int pc = tid + i * NTHR, l = pc >> 4, d0 = (pc & 15) * 8; const float sc = wk[l];
                    const unsigned w[4] = {rv.v[i].x, rv.v[i].y, rv.v[i].z, rv.v[i].w};
                    u32x4 o; o.x = pk2(bf2f(w[0] & 0xffffu) * sc, bf2f(w[0] >> 16) * sc); o.y = pk2(bf2f(w[1] & 0xffffu) * sc, bf2f(w[1] >> 16) * sc);
                    o.z = pk2(bf2f(w[2] & 0xffffu) * sc, bf2f(w[2] >> 16) * sc); o.w = pk2(bf2f(w[3] & 0xffffu) * sc, bf2f(w[3] >> 16) * sc);
                    *(u32x4*)(Vt + l * 136 + d0) = o;
                }
                if (tid < 64) Vt[tid * 136 + 128] = (bf16_t)f2bf(wk[tid]);
            }
            __syncthreads();
            if (it + (int)gridDim.x < 1024) load_item(it + gridDim.x);
            state_outer_tr<true>(Kt, Vt, (bf16_t*)(ws + WS_U) + (size_t)it * 16384, wid, fr, fq);
            {
                f32x4 acc = (f32x4){0.f, 0.f, 0.f, 0.f};
#pragma unroll
                for (int ls = 0; ls < 2; ++ls) {
                    const bf16x8 bn = frag_tr(Vt, 136, ls * 32, 128, fr, fq);
                    const bf16x8 ak = frag_tr(Kt, 136, ls * 32, wid * 16, fr, fq);
                    acc = __builtin_amdgcn_mfma_f32_16x16x32_bf16(ak, bn, acc, 0, 0, 0);
                }
                if (fr == 0) *(f32x4*)((float*)(ws + WS_NLOC) + (size_t)it * 128 + wid * 16 + fq * 4) = acc;
            }
            __syncthreads();
        } else {
            const int ci = it - 1024, t0 = ci * 64, cq = tid & 63, ts = tid >> 6, c0 = cq * 8, tb = t0 + ts * 8;
            const float* cw = p.in[I_AB_CONVW];
            float w0[8], w1[8], w2[8];
#pragma unroll
            for (int j = 0; j < 8; ++j) { w0[j] = cw[c0 + j]; w1[j] = cw[512 + c0 + j]; w2[j] = cw[1024 + c0 + j]; }
            const bool halo = ((tb & (SEQ - 1)) != 0);
            float zp2[8], zp1[8];
            {
                u32x4 g2 = (u32x4){0u, 0u, 0u, 0u}, x2 = g2, g1 = g2, x1 = g2;
                if (halo) { const bf16_t* r2 = PROJ + (size_t)(tb - 2) * PA; const bf16_t* r1 = PROJ + (size_t)(tb - 1) * PA;
                    g2 = __builtin_nontemporal_load((const u32x4*)(r2 + 2560 + c0)); x2 = __builtin_nontemporal_load((const u32x4*)(r2 + 3072 + c0));
                    g1 = __builtin_nontemporal_load((const u32x4*)(r1 + 2560 + c0)); x1 = __builtin_nontemporal_load((const u32x4*)(r1 + 3072 + c0)); }
                const unsigned a0[4] = {g2.x, g2.y, g2.z, g2.w}, b0[4] = {x2.x, x2.y, x2.z, x2.w}, a1[4] = {g1.x, g1.y, g1.z, g1.w}, b1[4] = {x1.x, x1.y, x1.z, x1.w};
#pragma unroll
                for (int q = 0; q < 4; ++q) {
                    zp2[2 * q] = bf2f(a0[q] & 0xffffu) * bf2f(b0[q] & 0xffffu); zp2[2 * q + 1] = bf2f(a0[q] >> 16) * bf2f(b0[q] >> 16);
                    zp1[2 * q] = bf2f(a1[q] & 0xffffu) * bf2f(b1[q] & 0xffffu); zp1[2 * q + 1] = bf2f(a1[q] >> 16) * bf2f(b1[q] >> 16);
                }
            }
            bf16_t* mix = (bf16_t*)(ws + WS_MIX);
#pragma unroll 1
            for (int ps = 0; ps < 2; ++ps) {
                u32x4 gbv[4], gcv[4], xiv[4];
#pragma unroll
                for (int t = 0; t < 4; ++t) { const bf16_t* r = PROJ + (size_t)(tb + ps * 4 + t) * PA;
                    gbv[t] = __builtin_nontemporal_load((const u32x4*)(r + 2048 + c0)); gcv[t] = __builtin_nontemporal_load((const u32x4*)(r + 2560 + c0)); xiv[t] = __builtin_nontemporal_load((const u32x4*)(r + 3072 + c0)); }
#pragma unroll
                for (int t = 0; t < 4; ++t) {
                    const unsigned ga[4] = {gcv[t].x, gcv[t].y, gcv[t].z, gcv[t].w}, xa[4] = {xiv[t].x, xiv[t].y, xiv[t].z, xiv[t].w}, ba[4] = {gbv[t].x, gbv[t].y, gbv[t].z, gbv[t].w};
                    float y[8];
#pragma unroll
                    for (int q = 0; q < 4; ++q) {
                        const float z0 = bf2f(ga[q] & 0xffffu) * bf2f(xa[q] & 0xffffu), z1 = bf2f(ga[q] >> 16) * bf2f(xa[q] >> 16);
                        y[2 * q] = bf2f(ba[q] & 0xffffu) * (w0[2 * q] * zp2[2 * q] + w1[2 * q] * zp1[2 * q] + w2[2 * q] * z0);
                        y[2 * q + 1] = bf2f(ba[q] >> 16) * (w0[2 * q + 1] * zp2[2 * q + 1] + w1[2 * q + 1] * zp1[2 * q + 1] + w2[2 * q + 1] * z1);
                        zp2[2 * q] = zp1[2 * q]; zp1[2 * q] = z0; zp2[2 * q + 1] = zp1[2 * q + 1]; zp1[2 * q + 1] = z1;
                    }
                    *(u32x4*)(mix + (size_t)(tb + ps * 4 + t) * 1024 + 512 + c0) = (u32x4){pk2(y[0], y[1]), pk2(y[2], y[3]), pk2(y[4], y[5]), pk2(y[6], y[7])};
                }
            }
        }
    }
}

template <bool HG>
__device__ __forceinline__ void phase_scan(const Params& p, unsigned char* lds) {
    unsigned char* ws = p.ws;
    const int tid = opaque_tid();
    const int gt = blockIdx.x * NTHR + tid, NGT = gridDim.x * NTHR;
    const bf16_t* U = (const bf16_t*)(ws + WS_U);
    bf16_t* CP = (bf16_t*)(ws + WS_CPREV);
    const float* MLOC = (const float*)(ws + WS_MLOC); const float* BEND = (const float*)(ws + WS_BEND); const float* BENDV = (const float*)(ws + WS_BENDV);
    float* sd = (float*)lds;
    float* ssu = sd + 64;
    for (int base = blockIdx.x * NTHR; base < 131072; base += NGT) {
        const int idx = base + tid;
        const int bh = idx >> 13, rem = idx & 8191, e = rem >> 6, k = (rem & 63) * 2;
        if (!HG) {
            __syncthreads();
            float* sml = ssu + 64; float* sbe = sml + 64; float* smp = sbe + 64;
            if (tid < 64) { sml[tid] = MLOC[bh * 64 + tid]; sbe[tid] = BEND[bh * 64 + tid]; }
            __syncthreads();
            if (tid == 0) {
                float m = -1e30f;
                for (int c = 0; c < 64; ++c) {
                    const float ml = sml[c], be = sbe[c];
                    smp[c] = m;
                    const float mn = fmaxf(be + m, ml);
                    sd[c] = expf(be + m - mn); ssu[c] = expf(ml - mn); m = mn;
                }
            }
            __syncthreads();
            if (rem < 64 && tid < 64) ((float*)(ws + WS_MPREV))[bh * 64 + tid] = smp[tid];
            if (tid >= 504) {
                const float* NLOC = (const float*)(ws + WS_NLOC); float* NPREV = (float*)(ws + WS_NPREV);
                const int kn = ((base & 8191) >> 9) * 8 + (tid - 504);
                float n = 0.f;
#pragma unroll
                for (int hb = 0; hb < 2; ++hb) {
                    float nl[32];
#pragma unroll
                    for (int c = 0; c < 32; ++c) nl[c] = NLOC[(unsigned)((bh * 64 + hb * 32 + c) * 128 + kn)];
#pragma unroll
                    for (int c = 0; c < 32; ++c) { NPREV[(unsigned)((bh * 64 + hb * 32 + c) * 128 + kn)] = n; n = sd[hb * 32 + c] * n + ssu[hb * 32 + c] * nl[c]; }
                }
            }
        }
        float c0 = 0.f, c1 = 0.f;
#pragma unroll
        for (int half = 0; half < 2; ++half) {
            unsigned uu[32];
#pragma unroll
            for (int c = 0; c < 32; ++c) uu[c] = __builtin_nontemporal_load((const unsigned*)(U + (size_t)(bh * 64 + half * 32 + c) * 16384 + e * 128 + k));
            f32x2 bv[32];
            if (HG) {
#pragma unroll
                for (int c = 0; c < 32; ++c) bv[c] = *(const f32x2*)(BENDV + (size_t)(bh * 64 + half * 32 + c) * 128 + k);
            }
#pragma unroll
            for (int c = 0; c < 32; ++c) {
                const size_t off = (size_t)(bh * 64 + half * 32 + c) * 16384 + e * 128 + k;
                *(unsigned*)(CP + off) = pk2(c0, c1);
                const float u0 = bf2f(uu[c] & 0xffffu), u1 = bf2f(uu[c] >> 16);
                if (!HG) { const float d = sd[half * 32 + c], su = ssu[half * 32 + c]; c0 = d * c0 + su * u0; c1 = d * c1 + su * u1; }
                else { c0 = bv[c].x * c0 + u0; c1 = bv[c].y * c1 + u1; }
            }
        }
    }
    if (HG) {
        const int lane = tid & 63, wv = tid >> 6;
        if (wv < 2) {
            const f32x2* POW = (const f32x2*)(ws + WS_S5POW); const float* XEND = (const float*)(ws + WS_XEND); bf16_t* XPB = (bf16_t*)(ws + WS_XPREVB);
            for (int sb = (blockIdx.x * 2 + wv) * 16; sb < 8192; sb += gridDim.x * 32) {
                const int seq = sb + (lane & 15), seg = lane >> 4;
                const int b = seq >> 11, g = (seq >> 6) & 31, pp = seq & 63;
                const f32x2 l16 = POW[(g * 64 + pp) * 17 + 16];
                float ar = l16.x, ai = l16.y;
#pragma unroll
                for (int q = 0; q < 6; ++q) { const float nr = ar * ar - ai * ai, ni = 2.f * ar * ai; ar = nr; ai = ni; }
                const float* xe = XEND + ((size_t)(b * 256 + seg * 64) * 32 + g) * 128 + pp;
                bf16_t* xo = XPB + ((size_t)(b * 256 + seg * 64) * 32 + g) * 128 + pp;
                float xr = 0.f, xi = 0.f;
                for (int hb = 0; hb < 4; ++hb) {
                    float er[16], ei[16];
#pragma unroll
                    for (int j = 0; j < 16; ++j) { er[j] = xe[(hb * 16 + j) * 4096]; ei[j] = xe[(hb * 16 + j) * 4096 + 64]; }
#pragma unroll
                    for (int j = 0; j < 16; ++j) { const float nr = l16.x * xr - l16.y * xi + er[j], ni = l16.x * xi + l16.y * xr + ei[j]; xr = nr; xi = ni; }
                }
                float cr = 0.f, ci = 0.f;
#pragma unroll
                for (int r = 0; r < 3; ++r) {
                    const float pr = __shfl(xr, (lane & 15) + 16 * r), pi = __shfl(xi, (lane & 15) + 16 * r);
                    if (r < seg) { const float nr = ar * cr - ai * ci + pr, ni = ar * ci + ai * cr + pi; cr = nr; ci = ni; }
                }
                xr = cr; xi = ci;
                for (int hb = 0; hb < 4; ++hb) {
                    float er[16], ei[16];
#pragma unroll
                    for (int j = 0; j < 16; ++j) { er[j] = xe[(hb * 16 + j) * 4096]; ei[j] = xe[(hb * 16 + j) * 4096 + 64]; }
#pragma unroll
                    for (int j = 0; j < 16; ++j) {
                        xo[(hb * 16 + j) * 4096] = (bf16_t)f2bf(xr); xo[(hb * 16 + j) * 4096 + 64] = (bf16_t)f2bf(xi);
                        const float nr = l16.x * xr - l16.y * xi + er[j], ni = l16.x * xi + l16.y * xr + ei[j]; xr = nr; xi = ni;
                    }
                }
            }
        }
    }
}

__device__ __forceinline__ void phase_mlstm_out(const Params& p, unsigned char* lds) {
    const int tid = opaque_tid(), lane = tid & 63, wid = tid >> 6, fr = lane & 15, fq = lane >> 4;
    unsigned char* ws = p.ws;
    const bf16_t* PROJ = (const bf16_t*)(ws + WS_PROJ);
    const float* GATES = (const float*)(ws + WS_GATES);
    bf16_t* Qs = (bf16_t*)lds;
    bf16_t* Ks = (bf16_t*)(lds + 17408);
    float* Hs = (float*)lds;
    bf16_t* Vt = (bf16_t*)(lds + 34816);
    bf16_t* Cs = (bf16_t*)(lds + 53248);
    bf16_t* Ps = (bf16_t*)(lds + 88064);
    float* sa = (float*)(lds + 97280);
    float* sg = sa + 64;
    float* sisc = sg + 64;
    float* semr = sisc + 64;
    float* sdinv = semr + 64;
    float* snp = sdinv + 64;
    Tile2 rq, rk, rv; Tile4 rc; u32x4 rog[2]; float g0 = 0.f, g1 = 0.f, g2 = 0.f, g3 = 0.f, g4 = 0.f;
    auto load_item = [&](int it) {
        const int b = it >> 8, h = (it >> 6) & 3, c = it & 63, t0 = b * SEQ + c * 64;
        tile_load<true>(rq, PROJ + (size_t)t0 * PA + h * 128, PA, tid);
        tile_load<true>(rk, PROJ + (size_t)t0 * PA + 512 + h * 128, PA, tid);
        tile_load<true>(rv, PROJ + (size_t)t0 * PA + 1024 + h * 128, PA, tid);
        tile4_load<true>(rc, (const bf16_t*)(ws + WS_CPREV) + (size_t)it * 16384, tid);
        { const bf16_t* og = PROJ + (size_t)(t0 + (tid >> 3)) * PA + 1536 + h * 128 + (tid & 7) * 16; rog[0] = __builtin_nontemporal_load((const u32x4*)og); rog[1] = __builtin_nontemporal_load((const u32x4*)(og + 8)); }
        g0 = GATES[(size_t)(t0 + lane) * 8 + h]; g1 = GATES[(size_t)(t0 + lane) * 8 + 4 + h]; g2 = ((const float*)(ws + WS_MPREV))[it];
        g3 = ((const float*)(ws + WS_NPREV))[(size_t)it * 128 + lane]; g4 = ((const float*)(ws + WS_NPREV))[(size_t)it * 128 + 64 + lane];
    };
    if ((int)blockIdx.x < 1024) load_item(blockIdx.x);
    for (int it = blockIdx.x; it < 1024; it += gridDim.x) {
        const int b = it >> 8, h = (it >> 6) & 3, c = it & 63, t0 = b * SEQ + c * 64;
        if (wid == 0) {
            const float ip = g0, fp = g1, mprev = g2;
            const float bc = wave_incl_sum(logsigmoid_(fp), lane);
            const float a = ip - bc;
            const float g = fmaxf(wave_incl_max(a, lane), mprev);
            sa[lane] = a; sg[lane] = g; sisc[lane] = expf(mprev - g); semr[lane] = expf(-(bc + g));
        } else if (wid == 1) { snp[lane] = g3; snp[64 + lane] = g4; }
        tile_put_rows(rq, Qs, tid); tile_put_rows(rk, Ks, tid); tile_put_rows(rv, Vt, tid); tile4_put(rc, Cs, tid);
        const u32x4 ogc[2] = {rog[0], rog[1]};
        __syncthreads();
        if (it + (int)gridDim.x < 1024) load_item(it + gridDim.x);
#pragma unroll
        for (int i = 0; i < 2; ++i) {
            const int tix = wid * 2 + i, lt = tix >> 2, st = tix & 3;
            f32x4 acc = (f32x4){0.f, 0.f, 0.f, 0.f};
            if (st <= lt) {
#pragma unroll
                for (int ks = 0; ks < 4; ++ks) {
                    const bf16x8 ak = *(const bf16x8*)(Ks + (st * 16 + fr) * 136 + ks * 32 + fq * 8);
                    const bf16x8 bq = *(const bf16x8*)(Qs + (lt * 16 + fr) * 136 + ks * 32 + fq * 8);
                    acc = __builtin_amdgcn_mfma_f32_16x16x32_bf16(ak, bq, acc, 0, 0, 0);
                }
            }
            const int l = lt * 16 + fr; const float gl = sg[l];
            float pv[4];
#pragma unroll
            for (int r = 0; r < 4; ++r) { const int s = st * 16 + fq * 4 + r; pv[r] = (s <= l) ? acc[r] * fexp_(sa[s] - gl) : 0.f; }
            u32x2 o; o.x = pk2(pv[0], pv[1]); o.y = pk2(pv[2], pv[3]);
            *(u32x2*)(Ps + l * 72 + st * 16 + fq * 4) = o;
        }
        __syncthreads();
        {
            const int l = tid >> 3, part = tid & 7;
            float rs = 0.f, qn = 0.f;
            const u32x4 pw = *(const u32x4*)(Ps + l * 72 + part * 8);
            rs = (bf2f(pw.x & 0xffffu) + bf2f(pw.x >> 16)) + (bf2f(pw.y & 0xffffu) + bf2f(pw.y >> 16)) + (bf2f(pw.z & 0xffffu) + bf2f(pw.z >> 16)) + (bf2f(pw.w & 0xffffu) + bf2f(pw.w >> 16));
            const u32x4 q0 = *(const u32x4*)(Qs + l * 136 + part * 16), q1 = *(const u32x4*)(Qs + l * 136 + part * 16 + 8);
            const unsigned qw[8] = {q0.x, q0.y, q0.z, q0.w, q1.x, q1.y, q1.z, q1.w};
#pragma unroll
            for (int j = 0; j < 8; ++j) qn += bf2f(qw[j] & 0xffffu) * snp[part * 16 + 2 * j] + bf2f(qw[j] >> 16) * snp[part * 16 + 2 * j + 1];
            rs += __shfl_xor(rs, 1); rs += __shfl_xor(rs, 2); rs += __shfl_xor(rs, 4);
            qn += __shfl_xor(qn, 1); qn += __shfl_xor(qn, 2); qn += __shfl_xor(qn, 4);
            if (part == 0) { const float den = rs + sisc[l] * qn; sdinv[l] = 1.f / fmaxf(fabsf(den), semr[l]); }
        }
        f32x4 a1[4], a2[4];
#pragma unroll
        for (int lt = 0; lt < 4; ++lt) { a1[lt] = (f32x4){0.f, 0.f, 0.f, 0.f}; a2[lt] = (f32x4){0.f, 0.f, 0.f, 0.f}; }
        {
            const int e0 = wid * 16;
#pragma unroll
            for (int ss = 0; ss < 2; ++ss) {
                const bf16x8 av = frag_tr(Vt, 136, ss * 32, e0, fr, fq);
#pragma unroll
                for (int lt = 0; lt < 4; ++lt) { const bf16x8 bp = *(const bf16x8*)(Ps + (lt * 16 + fr) * 72 + ss * 32 + fq * 8); a1[lt] = __builtin_amdgcn_mfma_f32_16x16x32_bf16(av, bp, a1[lt], 0, 0, 0); }
            }
#pragma unroll
            for (int ks = 0; ks < 4; ++ks) {
                const bf16x8 ac = *(const bf16x8*)(Cs + (e0 + fr) * 136 + ks * 32 + fq * 8);
#pragma unroll
                for (int lt = 0; lt < 4; ++lt) { const bf16x8 bq = *(const bf16x8*)(Qs + (lt * 16 + fr) * 136 + ks * 32 + fq * 8); a2[lt] = __builtin_amdgcn_mfma_f32_16x16x32_bf16(ac, bq, a2[lt], 0, 0, 0); }
            }
        }
        __syncthreads();
        {
            const int e0 = wid * 16;
#pragma unroll
            for (int lt = 0; lt < 4; ++lt) {
                const int l = lt * 16 + fr; const float is = sisc[l], di = sdinv[l];
                const f32x4 hv = (a1[lt] + a2[lt] * is) * di;
                *(f32x4*)(Hs + l * 132 + e0 + fq * 4) = hv;
            }
        }
        __syncthreads();
        head_norm_out_r<0>(Hs, p.in[I_AB_HNORM] + h * 128, ogc, (bf16_t*)(ws + WS_MIX) + (size_t)t0 * 1024 + h * 128, 1024, tid);
        __syncthreads();
    }
}

__device__ __forceinline__ void load_h_row(const Params& p, int row, int lane, bool combine, f32x4 (&v)[4], int ylayer = 0) {
    const bf16_t* hrow = (const bf16_t*)(p.ws + WS_H16) + (size_t)row * 1024;
#pragma unroll
    for (int j = 0; j < 4; ++j) { const u32x2 a = *(const u32x2*)(hrow + 4 * lane + 256 * j); v[j] = (f32x4){bf2f(a.x & 0xffffu), bf2f(a.x >> 16), bf2f(a.y & 0xffffu), bf2f(a.y >> 16)}; }
    if (combine) {
        const bf16_t* y0 = (const bf16_t*)(p.ws + ws_y(ylayer)) + (size_t)row * 1024;
        const bf16_t* y1 = y0 + (size_t)T * 1024;
#pragma unroll
        for (int j = 0; j < 4; ++j) {
            const u32x2 a = __builtin_nontemporal_load((const u32x2*)(y0 + 4 * lane + 256 * j)), bq = __builtin_nontemporal_load((const u32x2*)(y1 + 4 * lane + 256 * j));
            v[j].x += bf2f(a.x & 0xffffu) + bf2f(bq.x & 0xffffu); v[j].y += bf2f(a.x >> 16) + bf2f(bq.x >> 16);
            v[j].z += bf2f(a.y & 0xffffu) + bf2f(bq.y & 0xffffu); v[j].w += bf2f(a.y >> 16) + bf2f(bq.y >> 16);
        }
    }
}

__device__ __forceinline__ void phase_combine_norm(const Params& p, bool final_) {
    const int tid = opaque_tid(), lane = tid & 63, wid = tid >> 6;
    const int gw = blockIdx.x * 8 + wid, NGW = gridDim.x * 8;
    for (int row = gw; row < T; row += NGW) {
        f32x4 v[4];
        load_h_row(p, row, lane, true, v, final_ ? 1 : 0);
        float* hrow = p.out + (size_t)row * 1024;
        if (!final_) {
            bf16_t* h16 = (bf16_t*)(p.ws + WS_H16) + (size_t)row * 1024;
#pragma unroll
            for (int j = 0; j < 4; ++j) { u32x2 o; o.x = pk2(v[j].x, v[j].y); o.y = pk2(v[j].z, v[j].w); *(u32x2*)(h16 + 4 * lane + 256 * j) = o; }
            rms_row(v, p.in[I_NORM_MIX] + 1024, (bf16_t*)(p.ws + WS_XN) + (size_t)row * 1024, lane);
        } else {
            float ss = 0.f;
#pragma unroll
            for (int j = 0; j < 4; ++j) ss += v[j].x * v[j].x + v[j].y * v[j].y + v[j].z * v[j].z + v[j].w * v[j].w;
            ss = wave_sum(ss);
            const float r = rsqrtf(ss * (1.f / 1024.f) + EPS);
#pragma unroll
            for (int j = 0; j < 4; ++j) { const f32x4 w4 = *(const f32x4*)(p.in[I_NORM_FINAL] + 4 * lane + 256 * j); __builtin_nontemporal_store(v[j] * r * w4, (f32x4*)(hrow + 4 * lane + 256 * j)); }
        }
    }
}

__device__ __forceinline__ void moe_convert(const Params& p, unsigned char* lds, int layer, int it_lo, int it_hi, int gw, int NGW, int wid, int lane) {
    unsigned char* ws = p.ws;
    float* scr = (float*)(lds + wid * 8704);
    const float* wg = p.in[I_MOE_WGATE] + (size_t)layer * 32 * 1024 * 256;
    const float* wu = p.in[I_MOE_WUP] + (size_t)layer * 32 * 1024 * 256;
    const float* wd = p.in[I_MOE_WDOWN] + (size_t)layer * 32 * 256 * 1024;
    bf16_t* WGU = (bf16_t*)(ws + ws_wgu(layer)); bf16_t* WD = (bf16_t*)(ws + ws_wd(layer));
    constexpr int IT_GU = 16 * 16, IT_D = 32 * 4, IT_E = IT_GU + IT_D;
    for (int it0 = it_lo + gw; it0 < it_hi; it0 += NGW) {
        const int e = it0 / IT_E; int it = it0 - e * IT_E;
        const float* src; bf16_t* dst; int ldn, ldk;
        if (it < IT_GU) {
            const int nb = it >> 4, kb = it & 15, n0 = nb * 32, k0 = kb * 64;
            const int pn = n0 >> 8, isup = (n0 >> 7) & 1, f0 = pn * 128 + (n0 & 127);
            src = (isup ? wu : wg) + (size_t)e * 1024 * 256 + (size_t)k0 * 256 + f0; ldn = 256;
            dst = WGU + (size_t)e * 512 * 1024 + (size_t)n0 * 1024 + k0; ldk = 1024;
        } else {
            it -= IT_GU;
            const int nb = it >> 2, kb = it & 3, n0 = nb * 32, k0 = kb * 64;
            src = wd + (size_t)e * 256 * 1024 + (size_t)k0 * 1024 + n0; ldn = 1024;
            dst = WD + (size_t)e * 1024 * 256 + (size_t)n0 * 256 + k0; ldk = 256;
        }
        transpose_tile(src, ldn, dst, ldk, 1.f, scr, lane);
    }
}
template <int RSEL>
__device__ __forceinline__ void phase_route(const Params& p, unsigned char* lds, int layer) {
    const int tid = opaque_tid(), lane = tid & 63, wid = tid >> 6, fr = lane & 15, fq = lane >> 4;
    const int gw = blockIdx.x * 8 + wid, NGW = gridDim.x * 8;
    unsigned char* ws = p.ws;
    if (RSEL != 2) moe_convert(p, lds, layer, (layer == 1 && (int)gridDim.x > 128) ? MOE_CONV_EARLY : 0, MOE_CONV_ITEMS, gw, NGW, wid, lane);
    __syncthreads();
    if (RSEL == 1) return;
    float* part = (float*)lds;
    float* ssp = (float*)(lds + 98304);
    float* lg = (float*)(lds + 98304 + 2048);
    int* rexp = (int*)(lds + 98304 + 2048 + 12288 + 256);
    float* rwt = (float*)(rexp + 128);
    const bf16_t* H16 = (const bf16_t*)(ws + WS_H16);
    const bf16_t* wf = (const bf16_t*)(ws + WS_WCAT) + (size_t)layer * 2 * 6144 * 8;
    int* cnt = (int*)(ws + WS_CTL) + layer * 32;
    int* list = (int*)(ws + WS_LIST); float* wlist = (float*)(ws + WS_WLIST);
    bf16x8 bh[4][3], bl[4][3];
#pragma unroll
    for (int s_ = 0; s_ < 4; ++s_)
#pragma unroll
        for (int n = 0; n < 3; ++n) {
            bh[s_][n] = *(const bf16x8*)(wf + ((size_t)((wid * 4 + s_) * 3 + n) * 64 + lane) * 8);
            bl[s_][n] = *(const bf16x8*)(wf + ((size_t)6144 + (size_t)((wid * 4 + s_) * 3 + n) * 64 + lane) * 8);
        }
    for (int grp = blockIdx.x; grp < T / 64; grp += gridDim.x) {
        const int row0 = grp * 64;
#pragma unroll
        for (int rt = 0; rt < 4; ++rt) {
            bf16x8 a[4];
#pragma unroll
            for (int s_ = 0; s_ < 4; ++s_) a[s_] = *(const bf16x8*)(H16 + (size_t)(row0 + rt * 16 + fr) * 1024 + wid * 128 + s_ * 32 + fq * 8);
            f32x4 acc[3] = {(f32x4){0.f, 0.f, 0.f, 0.f}, (f32x4){0.f, 0.f, 0.f, 0.f}, (f32x4){0.f, 0.f, 0.f, 0.f}};
            float ss = 0.f;
#pragma unroll
            for (int s_ = 0; s_ < 4; ++s_) {
#pragma unroll
                for (int j = 0; j < 8; ++j) { const float x = bf2f((unsigned short)a[s_][j]); ss += x * x; }
#pragma unroll
                for (int n = 0; n < 3; ++n) {
                    acc[n] = __builtin_amdgcn_mfma_f32_16x16x32_bf16(a[s_], bl[s_][n], acc[n], 0, 0, 0);
                    acc[n] = __builtin_amdgcn_mfma_f32_16x16x32_bf16(a[s_], bh[s_][n], acc[n], 0, 0, 0);
                }
            }
            ss += __shfl_xor(ss, 16); ss += __shfl_xor(ss, 32);
            if (fq == 0) ssp[wid * 64 + rt * 16 + fr] = ss;
#pragma unroll
            for (int n = 0; n < 3; ++n)
#pragma unroll
                for (int r = 0; r < 4; ++r) part[(wid * 64 + rt * 16 + fq * 4 + r) * 48 + n * 16 + fr] = acc[n][r];
        }
        __syncthreads();
        if (tid < 64) {
            float t = 0.f;
#pragma unroll
            for (int w = 0; w < 8; ++w) t += ssp[w * 64 + tid];
            lg[64 * 48 + tid] = rsqrtf(t * (1.f / 1024.f) + EPS);
        }
        for (int i = tid; i < 64 * 48; i += NTHR) {
            float t = 0.f;
#pragma unroll
            for (int w = 0; w < 8; ++w) t += part[w * 3072 + i];
            lg[i] = t;
        }
        __syncthreads();
        if (wid == 0) {
            const int row = row0 + tid;
            const float rs = lg[64 * 48 + tid];
            const float* l = lg + tid * 48;
            const float* bg = p.in[I_MOE_BG] + layer * 4; const float* br = p.in[I_MOE_BR] + layer * 32;
            float gm = l[32] * rs + bg[0]; int gi = 0; float gl[4]; gl[0] = gm;
#pragma unroll
            for (int i = 1; i < 4; ++i) { gl[i] = l[32 + i] * rs + bg[i]; if (gl[i] > gm) { gm = gl[i]; gi = i; } }
            float gs = 0.f;
#pragma unroll
            for (int i = 0; i < 4; ++i) gs += expf(gl[i] - gm);
            const float gval = 1.f / gs;
            float m1 = -3.0e38f, m2 = -3.0e38f; int i1 = 0, i2 = 0;
#pragma unroll
            for (int i = 0; i < 8; ++i) {
                const float v = l[gi * 8 + i] * rs + br[gi * 8 + i];
                if (v > m1) { m2 = m1; i2 = i1; m1 = v; i1 = i; } else if (v > m2) { m2 = v; i2 = i; }
            }
            const float e2 = expf(m2 - m1), inv = gval / (1.f + e2);
            rexp[tid * 2] = (gi * 8 + i1) | (row << 8); rexp[tid * 2 + 1] = (gi * 8 + i2) | (row << 8); rwt[tid * 2] = inv; rwt[tid * 2 + 1] = inv * e2;
            LDS_WAIT();
            if (tid < 32) {
                int c = 0;
                for (int j = 0; j < 128; ++j) c += ((rexp[j] & 255) == tid) ? 1 : 0;
                int pos = (c > 0) ? atomicAdd(&cnt[tid], c) : 0;
                for (int j = 0; j < 128; ++j) {
                    const int en = rexp[j];
                    if ((en & 255) == tid) { list[tid * ECAP + pos] = (en >> 8) * 2 + (j & 1); wlist[tid * ECAP + pos] = rwt[j]; ++pos; }
                }
            }
        } else {
            for (int r = wid - 1; r < 64; r += 7) {
                const float rs = lg[64 * 48 + r];
                const bf16_t* hrow = H16 + (size_t)(row0 + r) * 1024;
                bf16_t* xrow = (bf16_t*)(ws + WS_XN) + (size_t)(row0 + r) * 1024;
#pragma unroll
                for (int j = 0; j < 4; ++j) {
                    const u32x2 hv = *(const u32x2*)(hrow + 4 * lane + 256 * j);
                    const f32x4 w4 = *(const f32x4*)(p.in[I_NORM_FFN] + layer * 1024 + 4 * lane + 256 * j);
                    u32x2 o; o.x = pk2(bf2f(hv.x & 0xffffu) * rs * w4.x, bf2f(hv.x >> 16) * rs * w4.y); o.y = pk2(bf2f(hv.y & 0xffffu) * rs * w4.z, bf2f(hv.y >> 16) * rs * w4.w);
                    *(u32x2*)(xrow + 4 * lane + 256 * j) = o;
                }
            }
        }
        __syncthreads();
    }
}

struct AGather {
    const bf16_t* XN; const int* lst; int n;
    __device__ __forceinline__ const bf16_t* operator()(int r, int kc) const { const int tok = (r < n) ? (lst[r] >> 1) : 0; return XN + (size_t)tok * 1024 + kc * 8; }
};
struct EpiGateUp {
    bf16_t* H;
    __device__ __forceinline__ void operator()(const f32x4 (&acc)[2][4], int wr, int wc, int fr, int fq) const {
#pragma unroll
        for (int m = 0; m < 2; ++m)
#pragma unroll
            for (int n = 0; n < 2; ++n) {
                const f32x4 g = acc[m][n], u = acc[m][n + 2];
                u32x2 o; o.x = pk2(fsilu_(g.x) * u.x, fsilu_(g.y) * u.y); o.y = pk2(fsilu_(g.z) * u.z, fsilu_(g.w) * u.w);
                *(u32x2*)(H + (size_t)(wr * 32 + m * 16 + fr) * 256 + wc * 32 + n * 16 + fq * 4) = o;
            }
    }
};
struct EpiDown {
    bf16_t* Y; const int* lst; const float* wl; int n; int col0;
    __device__ __forceinline__ void operator()(const f32x4 (&acc)[2][4], int wr, int wc, int fr, int fq) const {
#pragma unroll
        for (int m = 0; m < 2; ++m) {
            const int r = wr * 32 + m * 16 + fr;
            if (r < n) {
                const int en = lst[r]; const float w = wl[r];
                bf16_t* yr = Y + ((size_t)(en & 1) * T + (en >> 1)) * 1024 + col0 + wc * 64 + fq * 4;
#pragma unroll
                for (int nn = 0; nn < 4; ++nn) { const f32x4 v = acc[m][nn] * w; u32x2 o; o.x = pk2(v.x, v.y); o.y = pk2(v.z, v.w); *(u32x2*)(yr + nn * 16) = o; }
            }
        }
    }
};
__device__ __forceinline__ void moe_prefix(const Params& p, int layer, int* tp, int* cn) {
    const int* cnt = (const int*)(p.ws + WS_CTL) + layer * 32;
    int* sp = cn + 32;
    const int tid = opaque_tid();
    __syncthreads();
    if (tid < 32) cn[tid] = cnt[tid];
    __syncthreads();
    if (tid == 0) {
        int s_ = 0, q_ = 0;
        for (int e = 0; e < 32; ++e) {
            const int c = cn[e], rem = c & 255;
            tp[e] = s_; sp[e] = q_;
            s_ += (c >> 8) + (rem > 128 ? 1 : 0); q_ += (rem > 0 && rem <= 128) ? 1 : 0;
        }
        tp[32] = s_; sp[32] = q_;
    }
    __syncthreads();
}
struct BGateUp {
    const bf16_t* W; int f0;
    __device__ __forceinline__ const bf16_t* operator()(int r, int kc) const {
        const int f = f0 + (r >> 6) * 32 + ((r >> 4) & 1) * 16 + (r & 15), isup = (r >> 5) & 1;
        return W + (size_t)((f >> 7) * 256 + isup * 128 + (f & 127)) * 1024 + kc * 8;
    }
};
constexpr int LDS_MOE_TAB = 131072, LDS_MOE_TP = 131072 + 4096;
__device__ __forceinline__ void phase_moe_up(const Params& p, unsigned char* lds, int layer) {
    unsigned* tab = (unsigned*)(lds + LDS_MOE_TAB); int* tp = (int*)(lds + LDS_MOE_TP); int* cn = tp + 64;
    moe_prefix(p, layer, tp, cn);
    pg8::SchedMoe S{tp, cn, tab, 2, tp[32] * 2, (int)gridDim.x, (int)blockIdx.x};
    const int* list = (const int*)(p.ws + WS_LIST);
    const int tid = opaque_tid();
    for (int i = 0; i < pg8::MOE_MAXU; ++i) {
        pg8::Unit u; if (!S.next(i, u)) break;
        const int e = u.pn >> 1, pos = (u.pm - tp[e]) * 256 + tid;
        if (tid < 256) tab[i * 256 + tid] = (pos < cn[e]) ? (unsigned)(list[(size_t)e * ECAP + pos] >> 1) * 2048u : 0u;
    }
    __syncthreads();
    pg8::Gemm g{(const bf16_t*)(p.ws + WS_XN), (const bf16_t*)(p.ws + ws_wgu(layer)), 0, 0, 1024};
    pg8::EpiMoeUp E{(bf16_t*)(p.ws + WS_HID)};
    pg8::gemm_phase_g<pg8::EpiMoeUp, pg8::SchedMoe>((PG8_LAS unsigned char*)lds, g, S, E);
    __syncthreads();
    const int* sp = cn + 32; const int nsm = sp[32], np8 = tp[32];
    for (int u = blockIdx.x; u < nsm * 4; u += gridDim.x) {
        const int si = u >> 2, pn4 = u & 3;
        int e = 0; while (sp[e + 1] <= si) ++e;
        const int pos0 = (tp[e + 1] - tp[e]) * 256, n = cn[e] - pos0;
        AGather ag{(const bf16_t*)(p.ws + WS_XN), list + (size_t)e * ECAP + pos0, n};
        BGateUp bg{(const bf16_t*)(p.ws + ws_wgu(layer)) + (size_t)e * 512 * 1024, pn4 * 64};
        EpiGateUp ep{(bf16_t*)(p.ws + WS_HID) + ((size_t)np8 * 256 + (size_t)si * 128) * 256 + pn4 * 64};
        gemm128b(lds, ag, bg, 1024, ep);
    }
}
__device__ __forceinline__ void phase_moe_down(const Params& p, unsigned char* lds, int layer) {
    unsigned* tab = (unsigned*)(lds + LDS_MOE_TAB); float* wtab = (float*)(lds + LDS_MOE_TAB + 4096); int* tp = (int*)(lds + LDS_MOE_TP + 4096); int* cn = tp + 64;
    moe_prefix(p, layer, tp, cn);
    pg8::SchedMoe S{tp, cn, tab, 4, tp[32] * 4, (int)gridDim.x, (int)blockIdx.x};
    const int* list = (const int*)(p.ws + WS_LIST); const float* wlist = (const float*)(p.ws + WS_WLIST);
    const int tid = opaque_tid();
    for (int i = 0; i < pg8::MOE_MAXU; ++i) {
        pg8::Unit u; if (!S.next(i, u)) break;
        const int e = u.pn >> 2, pos = (u.pm - tp[e]) * 256 + tid;
        if (tid < 256) {
            const bool ok = pos < cn[e];
            const int en = ok ? list[(size_t)e * ECAP + pos] : 0;
            tab[i * 256 + tid] = ok ? (unsigned)((en & 1) * T + (en >> 1)) : 0xffffffffu;
            wtab[i * 256 + tid] = ok ? wlist[(size_t)e * ECAP + pos] : 0.f;
        }
    }
    __syncthreads();
    pg8::Gemm g{(const bf16_t*)(p.ws + WS_HID), (const bf16_t*)(p.ws + ws_wd(layer)), 0, 0, 256};
    pg8::EpiMoeDown E{(bf16_t*)(p.ws + ws_y(layer)), tab, wtab};
    pg8::gemm_phase<pg8::EpiMoeDown, pg8::SchedMoe, true, true>((PG8_LAS unsigned char*)lds, g, S, E);
    __syncthreads();
    const int* sp = cn + 32; const int nsm = sp[32], np8 = tp[32];
    for (int u = blockIdx.x; u < nsm * 8; u += gridDim.x) {
        const int si = u >> 3, pn8 = u & 7;
        int e = 0; while (sp[e + 1] <= si) ++e;
        const int pos0 = (tp[e + 1] - tp[e]) * 256, n = cn[e] - pos0;
        APlain ap{(const bf16_t*)(p.ws + WS_HID) + ((size_t)np8 * 256 + (size_t)si * 128) * 256, 256};
        EpiDown ep{(bf16_t*)(p.ws + ws_y(layer)), list + (size_t)e * ECAP + pos0, wlist + (size_t)e * ECAP + pos0, n, pn8 * 128};
        gemm128(lds, ap, (const bf16_t*)(p.ws + ws_wd(layer)) + (size_t)e * 1024 * 256 + (size_t)pn8 * 128 * 256, 256, ep);
    }
}

constexpr int LDS_HG_SEG = 98304, LDS_HG_LBT = 106496;
struct HgBlk { float bc[4][4]; float kk[4][4]; };
__device__ __forceinline__ void hgrn_lb_table(const Params& p, float* lbt, int tid) {
    const float* lbp = p.in[I_HGRN_LB];
    lbt[tid] = sigmoid_(lbp[512 + tid] - lbp[tid]);
    __syncthreads();
}
__device__ __forceinline__ void hg_block(const bf16_t* __restrict__ fg, const float* lbt, float* seg, int tid, HgBlk& B) {
    const int k0 = (tid & 31) * 4, l0 = (tid >> 5) * 4;
    const f32x4 lb4 = *(const f32x4*)(lbt + k0);
    u32x2 w[4];
#pragma unroll
    for (int i = 0; i < 4; ++i) w[i] = *(const u32x2*)(fg + (size_t)(l0 + i) * PC + k0);
    float run[4] = {1.f, 1.f, 1.f, 1.f};
#pragma unroll
    for (int i = 0; i < 4; ++i) {
        const float x[4] = {bf2f(w[i].x & 0xffffu), bf2f(w[i].x >> 16), bf2f(w[i].y & 0xffffu), bf2f(w[i].y >> 16)};
#pragma unroll
        for (int j = 0; j < 4; ++j) {
            const float lb = lb4[j], sg = fsigmoid_(x[j]), f = lb + (1.f - lb) * sg;
            run[j] *= f; B.bc[i][j] = run[j]; B.kk[i][j] = (1.f - lb) * (1.f - sg);
        }
    }
    *(f32x4*)(seg + (tid >> 5) * 128 + k0) = (f32x4){run[0], run[1], run[2], run[3]};
}
__device__ __forceinline__ void hg_offsets(const float* seg, int tid, HgBlk& B, f32x4& bend) {
    const int k0 = (tid & 31) * 4, ls = tid >> 5;
    f32x4 off = (f32x4){1.f, 1.f, 1.f, 1.f}, tot = off;
#pragma unroll
    for (int r = 0; r < 16; ++r) { const f32x4 v = *(const f32x4*)(seg + r * 128 + k0); if (r < ls) off *= v; tot *= v; }
#pragma unroll
    for (int i = 0; i < 4; ++i)
#pragma unroll
        for (int j = 0; j < 4; ++j) B.bc[i][j] *= off[j];
    bend = tot;
}

__device__ __forceinline__ void phase_cd_local(const Params& p, unsigned char* lds) {
    const int tid = opaque_tid(), lane = tid & 63, wid = tid >> 6, fr = lane & 15, fq = lane >> 4;
    unsigned char* ws = p.ws;
    const bf16_t* PROJ = (const bf16_t*)(ws + WS_PROJ);
    bf16_t* KhT = (bf16_t*)lds;
    bf16_t* Vt = (bf16_t*)(lds + 18432);
    float* seg = (float*)(lds + LDS_HG_SEG); float* lbt = (float*)(lds + LDS_HG_LBT);
    hgrn_lb_table(p, lbt, tid);
    const int k0 = (tid & 31) * 4, l0 = (tid >> 5) * 4;
    for (int it = blockIdx.x; it < 1024 + 256; it += gridDim.x) {
        if (it < 1024) {
            const int b = it >> 8, h = (it >> 6) & 3, c = it & 63, t0 = b * SEQ + c * 64;
            HgBlk B;
            hg_block(PROJ + (size_t)t0 * PC + 1024 + h * 128, lbt + h * 128, seg, tid, B);
            Tile2 rv; tile_load(rv, PROJ + (size_t)t0 * PC + 1536 + h * 128, PC, tid);
            __syncthreads();
            f32x4 bend; hg_offsets(seg, tid, B, bend);
#pragma unroll
            for (int j = 0; j < 4; ++j) {
                u32x2 o; o.x = pk2(B.kk[0][j] * bend[j] * __builtin_amdgcn_rcpf(B.bc[0][j]), B.kk[1][j] * bend[j] * __builtin_amdgcn_rcpf(B.bc[1][j]));
                o.y = pk2(B.kk[2][j] * bend[j] * __builtin_amdgcn_rcpf(B.bc[2][j]), B.kk[3][j] * bend[j] * __builtin_amdgcn_rcpf(B.bc[3][j]));
                *(u32x2*)(KhT + tsw(k0 + j, l0)) = o;
            }
            if (tid < 32) *(f32x4*)((float*)(ws + WS_BENDV) + (size_t)it * 128 + k0) = bend;
            tile_put_rows(rv, Vt, tid);
            __syncthreads();
            state_outer_tr<false>(KhT, Vt, (bf16_t*)(ws + WS_U) + (size_t)it * 16384, wid, fr, fq);
            __syncthreads();
        } else {
            s5_unit_E(p, lds, it - 1024);
        }
    }
}

template <int SEL>
__device__ __forceinline__ void phase_cd_out(const Params& p, unsigned char* lds) {
    const int tid = opaque_tid(), lane = tid & 63, wid = tid >> 6, fr = lane & 15, fq = lane >> 4;
    unsigned char* ws = p.ws;
    const bf16_t* PROJ = (const bf16_t*)(ws + WS_PROJ);
    bf16_t* Qs = (bf16_t*)lds;
    bf16_t* Ks = (bf16_t*)(lds + 17408);
    float* Hs = (float*)lds;
    bf16_t* Vt = (bf16_t*)(lds + 34816);
    bf16_t* Ss = (bf16_t*)(lds + 53248);
    bf16_t* Ps = (bf16_t*)(lds + 88064);
    float* seg = (float*)(lds + LDS_HG_SEG); float* lbt = (float*)(lds + LDS_HG_LBT);
    hgrn_lb_table(p, lbt, tid);
    const int k0 = (tid & 31) * 4, l0 = (tid >> 5) * 4;
    for (int it = blockIdx.x + (SEL == 2 ? 1024 : 0); it < (SEL == 1 ? 1024 : 1024 + 256); it += gridDim.x) {
        if (it < 1024) {
            const int b = it >> 8, h = (it >> 6) & 3, c = it & 63, t0 = b * SEQ + c * 64;
            HgBlk B;
            hg_block(PROJ + (size_t)t0 * PC + 1024 + h * 128, lbt + h * 128, seg, tid, B);
            u32x2 qw[4];
#pragma unroll
            for (int i = 0; i < 4; ++i) qw[i] = __builtin_nontemporal_load((const u32x2*)(PROJ + (size_t)(t0 + l0 + i) * PC + 512 + h * 128 + k0));
            Tile2 rv; Tile4 rs;
            tile_load<true>(rv, PROJ + (size_t)t0 * PC + 1536 + h * 128, PC, tid);
            tile4_load<true>(rs, (const bf16_t*)(ws + WS_CPREV) + (size_t)it * 16384, tid);
            tile_put_rows(rv, Vt, tid); tile4_put(rs, Ss, tid);
            __syncthreads();
            f32x4 bend; hg_offsets(seg, tid, B, bend);
#pragma unroll
            for (int i = 0; i < 4; ++i) {
                const float q0 = bf2f(qw[i].x & 0xffffu), q1 = bf2f(qw[i].x >> 16), q2 = bf2f(qw[i].y & 0xffffu), q3 = bf2f(qw[i].y >> 16);
                const float e0 = B.bc[i][0], e1 = B.bc[i][1], e2 = B.bc[i][2], e3 = B.bc[i][3];
                u32x2 oq; oq.x = pk2(q0 * e0, q1 * e1); oq.y = pk2(q2 * e2, q3 * e3);
                u32x2 ok; ok.x = pk2(B.kk[i][0] * __builtin_amdgcn_rcpf(e0), B.kk[i][1] * __builtin_amdgcn_rcpf(e1)); ok.y = pk2(B.kk[i][2] * __builtin_amdgcn_rcpf(e2), B.kk[i][3] * __builtin_amdgcn_rcpf(e3));
                *(u32x2*)(Qs + (l0 + i) * 136 + k0) = oq; *(u32x2*)(Ks + (l0 + i) * 136 + k0) = ok;
            }
            __syncthreads();
#pragma unroll
            for (int i = 0; i < 2; ++i) {
                const int tix = wid * 2 + i, lt = tix >> 2, st = tix & 3;
                f32x4 acc = (f32x4){0.f, 0.f, 0.f, 0.f};
                if (st <= lt) {
#pragma unroll
                    for (int ks = 0; ks < 4; ++ks) {
                        const bf16x8 ak = *(const bf16x8*)(Ks + (st * 16 + fr) * 136 + ks * 32 + fq * 8);
                        const bf16x8 bq = *(const bf16x8*)(Qs + (lt * 16 + fr) * 136 + ks * 32 + fq * 8);
                        acc = __builtin_amdgcn_mfma_f32_16x16x32_bf16(ak, bq, acc, 0, 0, 0);
                    }
                }
                const int l = lt * 16 + fr;
                float pv[4];
#pragma unroll
                for (int r = 0; r < 4; ++r) { const int s_ = st * 16 + fq * 4 + r; pv[r] = (s_ <= l) ? acc[r] : 0.f; }
                u32x2 o; o.x = pk2(pv[0], pv[1]); o.y = pk2(pv[2], pv[3]);
                *(u32x2*)(Ps + l * 72 + st * 16 + fq * 4) = o;
            }
            __syncthreads();
            f32x4 a1[4];
#pragma unroll
            for (int lt = 0; lt < 4; ++lt) a1[lt] = (f32x4){0.f, 0.f, 0.f, 0.f};
            {
                const int e0 = wid * 16;
#pragma unroll
                for (int ss = 0; ss < 2; ++ss) {
                    const bf16x8 av = frag_tr(Vt, 136, ss * 32, e0, fr, fq);
#pragma unroll
                    for (int lt = 0; lt < 4; ++lt) { const bf16x8 bp = *(const bf16x8*)(Ps + (lt * 16 + fr) * 72 + ss * 32 + fq * 8); a1[lt] = __builtin_amdgcn_mfma_f32_16x16x32_bf16(av, bp, a1[lt], 0, 0, 0); }
                }
#pragma unroll
                for (int ks = 0; ks < 4; ++ks) {
                    const bf16x8 ac = *(const bf16x8*)(Ss + (e0 + fr) * 136 + ks * 32 + fq * 8);
#pragma unroll
                    for (int lt = 0; lt < 4; ++lt) { const bf16x8 bq = *(const bf16x8*)(Qs + (lt * 16 + fr) * 136 + ks * 32 + fq * 8); a1[lt] = __builtin_amdgcn_mfma_f32_16x16x32_bf16(ac, bq, a1[lt], 0, 0, 0); }
                }
            }
            __syncthreads();
            {
                const int e0 = wid * 16;
#pragma unroll
                for (int lt = 0; lt < 4; ++lt) *(f32x4*)(Hs + (lt * 16 + fr) * 132 + e0 + fq * 4) = a1[lt];
            }
            __syncthreads();
            head_norm_out<1>(Hs, p.in[I_HGRN_ONORM] + h * 128, PROJ + (size_t)t0 * PC + 2048 + h * 128, PC, (bf16_t*)(ws + WS_MIX) + (size_t)t0 * 1024 + 512 + h * 128, 1024, tid);
            __syncthreads();
        } else {
            s5_unit_Y(p, lds, it - 1024);
        }
    }
}

#define XB_TMO      128
#define XB_XCNT(j)  (256  + 64 * (j))
#define XB_XSUB(j)  (1280 + 64 * (j))
#define XB_XGEN(j)  (2304 + 64 * (j))
#define XB_TOP      3328
#define XB_TOPGEN   3392
#define XCD_BAR_WORDS 3456
#define XB_SPIN_CAP (1u << 22)
#define LAS __attribute__((address_space(3)))
constexpr size_t WS_BAR = 4096;
constexpr size_t CTL_ZERO_BYTES = 32768;
static_assert(WS_BAR + XCD_BAR_WORDS * 4 <= CTL_ZERO_BYTES, "barrier words outside the zeroed region");
constexpr int LDS_BAR_OFF = LDS_BYTES - 16;
__device__ __forceinline__ unsigned xb_ld(unsigned* p)              { return __hip_atomic_load(p, __ATOMIC_RELAXED, __HIP_MEMORY_SCOPE_AGENT); }
__device__ __forceinline__ unsigned xb_add(unsigned* p, unsigned v) { return __hip_atomic_fetch_add(p, v, __ATOMIC_RELAXED, __HIP_MEMORY_SCOPE_AGENT); }
__device__ __forceinline__ unsigned xb_xcc_id() { return (unsigned)__builtin_amdgcn_s_getreg((3 << 11) | 20) & 0xFu; }
#define XB_SPIN(cond, bar) do { unsigned _sp = 0; while (cond) { __builtin_amdgcn_s_sleep(1); \
    if ((++_sp & 255u) == 0u) { if (xb_ld(&(bar)[XB_TMO])) break; if (_sp > XB_SPIN_CAP) { atomicAdd(&(bar)[XB_TMO], 1u); break; } } } } while (0)
struct XcdBarrier { unsigned* bar; unsigned x; volatile LAS unsigned* st; };
__device__ __forceinline__ XcdBarrier xcd_barrier_post(unsigned* bar, volatile LAS unsigned* st) {
    XcdBarrier b; b.bar = bar; b.x = xb_xcc_id(); b.st = st;
    if (opaque_tid() == 0) (void)xb_add(&bar[XB_XCNT(b.x)], 1u);
    return b;
}
__device__ __forceinline__ void xcd_barrier_complete(unsigned* bar, unsigned x, unsigned& nloc, unsigned& nx) {
    const unsigned G = gridDim.x * gridDim.y * gridDim.z;
    unsigned sum, cnt, mine, sp = 0u;
    for (;;) {
        sum = 0u; cnt = 0u; mine = 0u;
#pragma unroll
        for (unsigned j = 0; j < 16; ++j) { const unsigned c = xb_ld(&bar[XB_XCNT(j)]); sum += c; cnt += (c > 0u) ? 1u : 0u; mine = (j == x) ? c : mine; }
        if (sum == G) break;
        __builtin_amdgcn_s_sleep(1);
        if ((++sp & 255u) == 0u) { if (xb_ld(&bar[XB_TMO])) break; if (sp > XB_SPIN_CAP) { atomicAdd(&bar[XB_TMO], 1u); break; } }
    }
    nloc = mine > 0u ? mine : 1u; nx = cnt > 0u ? cnt : 1u;
}
__device__ __forceinline__ void xcd_barrier(const XcdBarrier& b) {
    asm volatile("s_waitcnt vmcnt(0)" ::: "memory");
    __syncthreads();
    if (opaque_tid() == 0) {
        unsigned* bar = b.bar;
        __builtin_amdgcn_s_waitcnt(0);
        unsigned nloc = b.st[0], nx = b.st[1];
        if (nloc == 0u) { xcd_barrier_complete(bar, b.x, nloc, nx); b.st[0] = nloc; b.st[1] = nx; }
        const unsigned old = xb_add(&bar[XB_XSUB(b.x)], 1u);
        const unsigned gen = old / nloc;
        if (old + 1u == (gen + 1u) * nloc) {
            __builtin_amdgcn_fence(__ATOMIC_RELEASE, "agent");
            asm volatile("s_waitcnt vmcnt(0)" ::: "memory");
            const unsigned og = xb_add(&bar[XB_TOP], 1u);
            const unsigned tg = og / nx;
            if (og + 1u == (tg + 1u) * nx) xb_add(&bar[XB_TOPGEN], 1u);
            else XB_SPIN(xb_ld(&bar[XB_TOPGEN]) == tg, bar);
            __builtin_amdgcn_fence(__ATOMIC_ACQUIRE, "agent");
            xb_add(&bar[XB_XGEN(b.x)], 1u);
            asm volatile("s_waitcnt vmcnt(0)" ::: "memory");
        } else {
            XB_SPIN(xb_ld(&bar[XB_XGEN(b.x)]) == gen, bar);
            __builtin_amdgcn_fence(__ATOMIC_ACQUIRE, "agent");
            asm volatile("s_waitcnt vmcnt(0)" ::: "memory");
        }
    }
    __syncthreads();
}

constexpr int NPHASE = 20;
constexpr unsigned REP_MASK = 0u;
constexpr int PROBE_SEL = 0;
template <int PH>
__device__ __forceinline__ void run_phase(const Params& p, unsigned char* lds) {
    unsigned char* ws = p.ws;
    if constexpr (PH == 0) phase_prep(p, lds);
    else if constexpr (PH == 1) { s5_gen_ktab(p); phase_gemm256_inproj0(lds, p); }
    else if constexpr (PH == 2) { s5_gen_ops(p); phase_mlstm_local(p, lds); }
    else if constexpr (PH == 3) phase_scan<false>(p, lds);
    else if constexpr (PH == 4) phase_mlstm_out(p, lds);
    else if constexpr (PH == 5) phase_gemm256_resid(lds, (const bf16_t*)(ws + WS_MIX), (const bf16_t*)(ws + WS_WOUTA), nullptr, (const bf16_t*)(ws + WS_H16), (bf16_t*)(ws + WS_H16));
    else if constexpr (PH == 6) phase_route<0>(p, lds, 0);
    else if constexpr (PH == 7) phase_moe_up(p, lds, 0);
    else if constexpr (PH == 8) phase_moe_down(p, lds, 0);
    else if constexpr (PH == 9) phase_combine_norm(p, false);
    else if constexpr (PH == 10) phase_gemm256_inproj1(lds, p);
    else if constexpr (PH == 11) phase_cd_local(p, lds);
    else if constexpr (PH == 12) phase_scan<true>(p, lds);
    else if constexpr (PH == 13) phase_cd_out<0>(p, lds);
    else if constexpr (PH == 14) {
        phase_gemm_glu(lds, p);
        if ((int)blockIdx.x >= 128) { const int t_ = opaque_tid(); moe_convert(p, lds, 1, 0, MOE_CONV_EARLY, ((int)blockIdx.x - 128) * 8 + (t_ >> 6), ((int)gridDim.x - 128) * 8, t_ >> 6, t_ & 63); }
    }
    else if constexpr (PH == 15) phase_gemm256_resid(lds, (const bf16_t*)(ws + WS_MIX), (const bf16_t*)(ws + WS_WOUTC), nullptr, (const bf16_t*)(ws + WS_H16), (bf16_t*)(ws + WS_H16));
    else if constexpr (PH == 16) phase_route<0>(p, lds, 1);
    else if constexpr (PH == 17) phase_moe_up(p, lds, 1);
    else if constexpr (PH == 18) phase_moe_down(p, lds, 1);
    else if constexpr (PH == 19) phase_combine_norm(p, true);
}
template <int PH>
__device__ __forceinline__ void run_from(const Params& p, unsigned char* lds, const XcdBarrier& bar) {
    run_phase<PH>(p, lds);
    if constexpr ((REP_MASK >> PH) & 1u) {
        xcd_barrier(bar);
        if constexpr (PH == 6 || PH == 16) { { const int t_ = opaque_tid(); if (blockIdx.x == 0 && t_ < 32) ((int*)(p.ws + WS_CTL))[(PH == 16 ? 32 : 0) + t_] = 0; } xcd_barrier(bar); }
        if constexpr (PH == 13 && PROBE_SEL != 0) phase_cd_out<PROBE_SEL>(p, lds); else
        if constexpr (PH == 6 && PROBE_SEL != 0) phase_route<PROBE_SEL>(p, lds, 0); else
        run_phase<PH>(p, lds);
    }
    if constexpr (PH + 1 < NPHASE) {
        xcd_barrier(bar);
        run_from<PH + 1>(p, lds, bar);
    }
}
__global__ void __launch_bounds__(NTHR, 2) mega(Params p) {
    extern __shared__ __attribute__((aligned(16))) unsigned char lds[];
    if (p.use_cg) cg::this_grid().sync();
    { const int t_ = opaque_tid(); if (t_ < 4) ((unsigned*)(lds + LDS_BAR_OFF))[t_] = 0u; }
    __syncthreads();
    const XcdBarrier bar = xcd_barrier_post((unsigned*)(p.ws + WS_BAR), (volatile LAS unsigned*)(lds + LDS_BAR_OFF));
    run_from<0>(p, lds, bar);
}

extern "C" void kernel_launch(void* const* d_in, const int* in_sizes, int n_in, void* d_out, int out_size, void* d_ws, size_t ws_size, hipStream_t stream) {
    static int grid = 0;
    if (grid == 0) {
        if (n_in != 30 || out_size != T * DM || ws_size < WS_END) { fprintf(stderr, "kernel_launch: unexpected shapes (n_in %d out %d ws %zu)\n", n_in, out_size, ws_size); grid = -1; return; }
        int dev = 0, cus = 0, per_cu = 0;
        (void)hipGetDevice(&dev);
        (void)hipDeviceGetAttribute(&cus, hipDeviceAttributeMultiprocessorCount, dev);
        (void)hipFuncSetAttribute((const void*)mega, hipFuncAttributeMaxDynamicSharedMemorySize, LDS_BYTES);
        (void)hipOccupancyMaxActiveBlocksPerMultiprocessor(&per_cu, (const void*)mega, NTHR, LDS_BYTES);
        if (per_cu < 1) { fprintf(stderr, "kernel_launch: occupancy query says %d blocks per CU\n", per_cu); per_cu = 1; }
        grid = cus * 1;
        (void)hipGetLastError();
    }
    if (grid < 0) return;
    Params p{};
    for (int i = 0; i < 30; ++i) p.in[i] = (const float*)d_in[i];
    p.out = (float*)d_out; p.ws = (unsigned char*)d_ws;
    p.use_cg = 0; p.pad = 0;
    (void)hipMemsetAsync((unsigned char*)d_ws + WS_CTL, 0, CTL_ZERO_BYTES, stream);
    void* args[] = {&p};
    hipError_t e = hipLaunchCooperativeKernel((const void*)mega, dim3(grid), dim3(NTHR), args, LDS_BYTES, stream);
    if (e != hipSuccess) fprintf(stderr, "cooperative launch failed: %s (grid %d)\n", hipGetErrorString(e), grid);
}
```

```cpp
#include <hip/hip_runtime.h>
#include <hip/hip_cooperative_groups.h>
#include <cstdio>
#include <cstdint>
namespace cg = cooperative_groups;

typedef unsigned short bf16_t;
typedef short bf16x8 __attribute__((ext_vector_type(8)));
typedef float f32x4 __attribute__((ext_vector_type(4)));
typedef float f32x2 __attribute__((ext_vector_type(2)));
typedef unsigned u32x4 __attribute__((ext_vector_type(4)));
typedef unsigned u32x2 __attribute__((ext_vector_type(2)));

constexpr int T = 16384, DM = 1024, SEQ = 4096;
constexpr int NTHR = 512;
constexpr int PA = 3584;
constexpr int PC = 2560;
constexpr int ECAP = 16384;
constexpr float EPS = 1e-6f;

constexpr size_t KB = 1024, MB = 1024 * 1024;
constexpr size_t WS_CTL = 0;
constexpr size_t WS_CNT = 20480;
constexpr size_t WS_GATES = 64 * KB;
constexpr size_t WS_S5POW = WS_GATES + 512 * KB;
constexpr size_t WS_S5BBAR = WS_S5POW + 272 * KB;
constexpr size_t WS_WCAT = WS_S5BBAR + 256 * KB;
constexpr size_t WS_NLOC = WS_WCAT + 384 * KB;
constexpr size_t WS_NPREV = WS_NLOC + 512 * KB;
constexpr size_t WS_BENDV = WS_NPREV + 512 * KB;
constexpr size_t WS_MLOC = WS_BENDV + 512 * KB;
constexpr size_t WS_BEND = WS_MLOC + 4 * KB;
constexpr size_t WS_MPREV = WS_BEND + 4 * KB;
constexpr size_t WS_KTAB = 3072 * KB;
static_assert(WS_MPREV + 4 * KB <= WS_KTAB && WS_KTAB + 512 * KB <= 4 * MB, "small region overflow");
constexpr size_t WS_S5Y = 4 * MB;
constexpr size_t WS_S5E = 10 * MB;
constexpr size_t WS_WINA = 12 * MB;
constexpr size_t WS_WOUTA = 20 * MB;
constexpr size_t WS_WINC = 22 * MB;
constexpr size_t WS_WOUTC = 27 * MB;
constexpr size_t WS_WGLU = 29 * MB;
constexpr size_t WS_A = 30 * MB;
constexpr size_t WS_B = 142 * MB;
constexpr size_t WS_C = 174 * MB;
constexpr size_t WS_D = 206 * MB;
constexpr size_t WS_H16 = 238 * MB;
constexpr size_t WS_END = 270 * MB;
constexpr size_t WS_PROJ = WS_A, WS_LIST = WS_A, WS_WLIST = WS_A + 2 * MB, WS_HID = WS_A + 4 * MB, WS_Y = WS_A + 28 * MB;
constexpr size_t WS_XN = WS_B, WS_U = WS_B, WS_Z = WS_B;
constexpr size_t WS_XEND = WS_A + 84 * MB;
constexpr size_t WS_XPREVB = WS_A + 100 * MB;
constexpr size_t WS_MIX = WS_C, WS_CPREV = WS_D, WS_WGU = WS_C, WS_WD = WS_C + 32 * MB;

__host__ __device__ constexpr size_t ws_wgu(int layer) { return layer == 0 ? WS_C : WS_A + 64 * MB; }
__host__ __device__ constexpr size_t ws_wd(int layer) { return layer == 0 ? WS_C + 32 * MB : WS_A + 96 * MB; }
__host__ __device__ constexpr size_t ws_y(int layer) { return layer == 0 ? WS_A + 28 * MB : WS_C; }
constexpr int MOE_CONV_ITEMS = 32 * (16 * 16 + 32 * 4);
constexpr int MOE_CONV_EARLY = MOE_CONV_ITEMS / 2;
constexpr int LDS_BYTES = 144 * 1024;

struct Params { const float* in[30]; float* out; unsigned char* ws; int use_cg; int pad; };

enum { I_X = 0, I_NORM_MIX, I_NORM_FFN, I_NORM_FINAL, I_AB_WIN, I_AB_GBIAS, I_AB_HNORM, I_AB_CONVW, I_AB_WOUT, I_CD_WIN, I_S5_LRE, I_S5_LIM, I_S5_BRE, I_S5_BIM,
       I_S5_CRE, I_S5_CIM, I_S5_D, I_S5_LOGDT, I_S5_WGLU, I_S5_BGLU, I_HGRN_LB, I_HGRN_ONORM, I_CD_WOUT, I_MOE_WG, I_MOE_BG, I_MOE_WR, I_MOE_BR, I_MOE_WGATE, I_MOE_WUP, I_MOE_WDOWN };

__device__ __forceinline__ int opaque_tid() { int t = threadIdx.x; asm volatile("" : "+v"(t)); return t; }
__device__ __forceinline__ float bf2f(unsigned v) { return __uint_as_float(v << 16); }
typedef __bf16 bf16x2_t __attribute__((ext_vector_type(2)));
__device__ __forceinline__ unsigned pk2(float lo, float hi) { const f32x2 v = {lo, hi}; return __builtin_bit_cast(unsigned, __builtin_convertvector(v, bf16x2_t)); }
__device__ __forceinline__ unsigned f2bf(float f) { return (unsigned)__builtin_bit_cast(unsigned short, (__bf16)f); }
__device__ __forceinline__ float wave_sum(float v) {
#pragma unroll
    for (int o = 32; o; o >>= 1) v += __shfl_xor(v, o);
    return v;
}
__device__ __forceinline__ float wave_max(float v) {
#pragma unroll
    for (int o = 32; o; o >>= 1) v = fmaxf(v, __shfl_xor(v, o));
    return v;
}
__device__ __forceinline__ float wave_incl_sum(float v, int lane) {
#pragma unroll
    for (int o = 1; o < 64; o <<= 1) { const float t = __shfl_up(v, o); if (lane >= o) v += t; }
    return v;
}
__device__ __forceinline__ float wave_incl_max(float v, int lane) {
#pragma unroll
    for (int o = 1; o < 64; o <<= 1) { const float t = __shfl_up(v, o); if (lane >= o) v = fmaxf(v, t); }
    return v;
}
__device__ __forceinline__ float sigmoid_(float x) { return 1.f / (1.f + expf(-x)); }
__device__ __forceinline__ float fexp_(float x) { return __expf(x); }
__device__ __forceinline__ float fsigmoid_(float x) { return __builtin_amdgcn_rcpf(1.f + __expf(-x)); }
__device__ __forceinline__ float fsilu_(float x) { return x * __builtin_amdgcn_rcpf(1.f + __expf(-x)); }
__device__ __forceinline__ float fgelu_tanh_(float x) { const float u = 0.7978845608028654f * (x + 0.044715f * x * x * x); return x * __builtin_amdgcn_rcpf(1.f + __expf(-2.f * u)); }
__device__ __forceinline__ float logsigmoid_(float x) { return fminf(x, 0.f) - log1pf(expf(-fabsf(x))); }
__device__ __forceinline__ float silu_(float x) { return x / (1.f + expf(-x)); }
__device__ __forceinline__ float gelu_tanh_(float x) { const float u = 0.7978845608028654f * (x + 0.044715f * x * x * x); return 0.5f * x * (1.f + tanhf(u)); }
#define LDS_WAIT() asm volatile("s_waitcnt lgkmcnt(0)" ::: "memory")
__device__ __forceinline__ int tsw(int d, int l) { return d * 72 + (l ^ (((d >> 3) & 7) << 3)); }
__device__ __forceinline__ int tswc(int d, int c) { return d * 72 + ((c ^ ((d >> 3) & 7)) << 3); }
#define LDS_AS __attribute__((address_space(3)))
typedef short s16x4 __attribute__((ext_vector_type(4)));
__device__ __forceinline__ bf16x8 frag_tr(const bf16_t* T, int pitch, int k0, int n0, int fr, int fq) {
    const bf16_t* a = T + (k0 + 8 * fq + (fr >> 2)) * pitch + n0 + 4 * (fr & 3);
    const s16x4 lo = __builtin_amdgcn_ds_read_tr16_b64_v4i16((LDS_AS s16x4*)a);
    const s16x4 hi = __builtin_amdgcn_ds_read_tr16_b64_v4i16((LDS_AS s16x4*)(a + 4 * pitch));
    return (bf16x8){lo[0], lo[1], lo[2], lo[3], hi[0], hi[1], hi[2], hi[3]};
}

struct BPlain {
    const bf16_t* Bt; int K;
    __device__ __forceinline__ const bf16_t* operator()(int r, int kc) const { return Bt + (size_t)r * K + kc * 8; }
};
template <class APiece, class BPiece, class Epi>
__device__ __forceinline__ void gemm128b(unsigned char* lds, const APiece& apiece, const BPiece& bpiece, int K, const Epi& epi) {
    const int tid = opaque_tid(), lane = tid & 63, wid = tid >> 6, wr = wid >> 1, wc = wid & 1, fr = lane & 15, fq = lane >> 4;
    const int nt = K >> 6;
    const int r0 = tid >> 3, c0 = tid & 7;
    const int so0 = r0 * 128 + ((c0 ^ (r0 & 7)) << 4), so1 = so0 + 64 * 128;
    u32x4 xa0 = *(const u32x4*)apiece(r0, c0), xa1 = *(const u32x4*)apiece(r0 + 64, c0), xb0 = *(const u32x4*)bpiece(r0, c0), xb1 = *(const u32x4*)bpiece(r0 + 64, c0);
    u32x4 ya0 = *(const u32x4*)apiece(r0, 8 + c0), ya1 = *(const u32x4*)apiece(r0 + 64, 8 + c0), yb0 = *(const u32x4*)bpiece(r0, 8 + c0), yb1 = *(const u32x4*)bpiece(r0 + 64, 8 + c0);
    f32x4 acc[2][4];
#pragma unroll
    for (int m = 0; m < 2; ++m)
#pragma unroll
        for (int n = 0; n < 4; ++n) acc[m][n] = (f32x4){0.f, 0.f, 0.f, 0.f};
#define G128_PUT(buf, A0, A1, B0, B1) do { unsigned char* d_ = lds + (buf) * 16384; *(u32x4*)(d_ + so0) = A0; *(u32x4*)(d_ + so1) = A1; *(u32x4*)(d_ + 32768 + so0) = B0; *(u32x4*)(d_ + 32768 + so1) = B1; } while (0)
#define G128_GET(t, A0, A1, B0, B1) do { const int kc_ = (t) * 8 + c0; A0 = *(const u32x4*)apiece(r0, kc_); A1 = *(const u32x4*)apiece(r0 + 64, kc_); B0 = *(const u32x4*)bpiece(r0, kc_); B1 = *(const u32x4*)bpiece(r0 + 64, kc_); } while (0)
#define G128_MMA(buf) do { const unsigned char* sa = lds + (buf) * 16384; const unsigned char* sb = lds + 32768 + (buf) * 16384; \
        _Pragma("unroll") for (int kk = 0; kk < 2; ++kk) { bf16x8 a[2], b[4]; \
            _Pragma("unroll") for (int m = 0; m < 2; ++m) { const int row = wr * 32 + m * 16 + fr; a[m] = *(const bf16x8*)(sa + row * 128 + (((kk * 4 + fq) ^ (row & 7)) << 4)); } \
            _Pragma("unroll") for (int n = 0; n < 4; ++n) { const int row = wc * 64 + n * 16 + fr; b[n] = *(const bf16x8*)(sb + row * 128 + (((kk * 4 + fq) ^ (row & 7)) << 4)); } \
            _Pragma("unroll") for (int m = 0; m < 2; ++m) _Pragma("unroll") for (int n = 0; n < 4; ++n) acc[m][n] = __builtin_amdgcn_mfma_f32_16x16x32_bf16(b[n], a[m], acc[m][n], 0, 0, 0); } } while (0)
    G128_PUT(0, xa0, xa1, xb0, xb1);
    __syncthreads();
#pragma unroll 1
    for (int kt = 0; kt < nt; kt += 2) {
        if (kt + 2 < nt) G128_GET(kt + 2, xa0, xa1, xb0, xb1);
        G128_MMA(0);
        G128_PUT(1, ya0, ya1, yb0, yb1);
        __syncthreads();
        if (kt + 3 < nt) G128_GET(kt + 3, ya0, ya1, yb0, yb1);
        G128_MMA(1);
        if (kt + 2 < nt) G128_PUT(0, xa0, xa1, xb0, xb1);
        __syncthreads();
    }
#undef G128_PUT
#undef G128_GET
#undef G128_MMA
    epi(acc, wr, wc, fr, fq);
}

template <class APiece, class Epi>
__device__ __forceinline__ void gemm128(unsigned char* lds, const APiece& apiece, const bf16_t* __restrict__ Bt, int K, const Epi& epi) {
    BPlain b{Bt, K};
    gemm128b(lds, apiece, b, K, epi);
}

template <class APiece, class BPiece, class Epi0, class Epi1>
__device__ __forceinline__ void gemm128x2(unsigned char* lds, const APiece& apiece, const BPiece& bp0f, const BPiece& bp1f, int K, const Epi0& epi0, const Epi1& epi1) {
    const int tid = opaque_tid(), lane = tid & 63, wid = tid >> 6, wr = wid >> 1, wc = wid & 1, fr = lane & 15, fq = lane >> 4;
    const int nt = K >> 6;
    const int r0 = tid >> 3, c0 = tid & 7;
    const int so0 = r0 * 128 + ((c0 ^ (r0 & 7)) << 4), so1 = so0 + 64 * 128;
    u32x4 ra0 = *(const u32x4*)apiece(r0, c0), ra1 = *(const u32x4*)apiece(r0 + 64, c0);
    u32x4 rb0 = *(const u32x4*)bp0f(r0, c0), rb1 = *(const u32x4*)bp0f(r0 + 64, c0);
    u32x4 rc0 = *(const u32x4*)bp1f(r0, c0), rc1 = *(const u32x4*)bp1f(r0 + 64, c0);
    f32x4 acc0[2][4], acc1[2][4];
#pragma unroll
    for (int m = 0; m < 2; ++m)
#pragma unroll
        for (int n = 0; n < 4; ++n) { acc0[m][n] = (f32x4){0.f, 0.f, 0.f, 0.f}; acc1[m][n] = (f32x4){0.f, 0.f, 0.f, 0.f}; }
    *(u32x4*)(lds + so0) = ra0; *(u32x4*)(lds + so1) = ra1;
    *(u32x4*)(lds + 32768 + so0) = rb0; *(u32x4*)(lds + 32768 + so1) = rb1;
    *(u32x4*)(lds + 65536 + so0) = rc0; *(u32x4*)(lds + 65536 + so1) = rc1;
    __syncthreads();
#pragma unroll 1
    for (int kt = 0; kt < nt; ++kt) {
        const int cur = kt & 1;
        if (kt + 1 < nt) {
            const int kc = (kt + 1) * 8 + c0;
            ra0 = *(const u32x4*)apiece(r0, kc); ra1 = *(const u32x4*)apiece(r0 + 64, kc);
            rb0 = *(const u32x4*)bp0f(r0, kc); rb1 = *(const u32x4*)bp0f(r0 + 64, kc);
            rc0 = *(const u32x4*)bp1f(r0, kc); rc1 = *(const u32x4*)bp1f(r0 + 64, kc);
        }
        const unsigned char* sa = lds + cur * 16384;
        const unsigned char* sb = lds + 32768 + cur * 16384;
        const unsigned char* sc = lds + 65536 + cur * 16384;
#pragma unroll
        for (int kk = 0; kk < 2; ++kk) {
            bf16x8 a[2], b[4], c[4];
#pragma unroll
            for (int m = 0; m < 2; ++m) { const int row = wr * 32 + m * 16 + fr; a[m] = *(const bf16x8*)(sa + row * 128 + (((kk * 4 + fq) ^ (row & 7)) << 4)); }
#pragma unroll
            for (int n = 0; n < 4; ++n) { const int row = wc * 64 + n * 16 + fr; const int o = row * 128 + (((kk * 4 + fq) ^ (row & 7)) << 4); b[n] = *(const bf16x8*)(sb + o); c[n] = *(const bf16x8*)(sc + o); }
#pragma unroll
            for (int m = 0; m < 2; ++m)
#pragma unroll
                for (int n = 0; n < 4; ++n) { acc0[m][n] = __builtin_amdgcn_mfma_f32_16x16x32_bf16(b[n], a[m], acc0[m][n], 0, 0, 0); acc1[m][n] = __builtin_amdgcn_mfma_f32_16x16x32_bf16(c[n], a[m], acc1[m][n], 0, 0, 0); }
        }
        if (kt + 1 < nt) {
            unsigned char* da = lds + (cur ^ 1) * 16384;
            *(u32x4*)(da + so0) = ra0; *(u32x4*)(da + so1) = ra1;
            *(u32x4*)(da + 32768 + so0) = rb0; *(u32x4*)(da + 32768 + so1) = rb1;
            *(u32x4*)(da + 65536 + so0) = rc0; *(u32x4*)(da + 65536 + so1) = rc1;
        }
        __syncthreads();
    }
    epi0(acc0, wr, wc, fr, fq);
    epi1(acc1, wr, wc, fr, fq);
}
struct APlain {
    const bf16_t* A; int K;
    __device__ __forceinline__ const bf16_t* operator()(int r, int kc) const { return A + (size_t)r * K + kc * 8; }
};

namespace pg8 {
#define PG8_LAS __attribute__((address_space(3)))
typedef unsigned short bf16_t;
typedef short bf16x8 __attribute__((ext_vector_type(8)));
typedef float f32x4 __attribute__((ext_vector_type(4)));
typedef unsigned u32x4 __attribute__((ext_vector_type(4)));
constexpr int BM = 256, BK = 64, HALF = 128, HTB = HALF * BK * 2  , STAGE_BYTES = 8 * HTB, NXCD = 8, WGM = 8;

__host__ __device__ __forceinline__ int lds_byte(int r, int c) { const int st = (r >> 4) * 2 + (c >> 5), rr = r & 15, cc = c & 31, ob = rr * 64 + cc * 2; return st * 1024 + (ob ^ (((ob >> 9) & 1) << 5)); }
__host__ __device__ __forceinline__ void stage_rc(int b, int& R, int& C) { const int st = b / 1024, sb = b % 1024, swz = sb ^ (((sb >> 9) & 1) << 5); R = (st >> 1) * 16 + swz / 64; C = (st & 1) * 32 + (swz % 64) / 2; }
__host__ __device__ __forceinline__ int perm32(int rho) { const int n = rho >> 4, i = rho & 15; return 8 * (i >> 2) + 4 * n + (i & 3); }

struct Unit { int pm, pn, aux, half, nh; };
struct Gemm { const bf16_t* A; const bf16_t* Bt; int M, N, K; };

struct StaticOrder {
    int nM, nN, nwg, G, c;
    __host__ __device__ void init(int M, int N, int G_, int c_) { nM = M / BM; nN = N / BM; nwg = nM * nN; G = G_; c = c_; }
    __host__ __device__ __forceinline__ bool next(int i, Unit& u) const {
        const long L = (long)i * G + c; if (L >= nwg) return false;
        int wgid = (int)L; { const int q = nwg / NXCD, r = nwg % NXCD, xcd = wgid % NXCD, off = wgid / NXCD; wgid = (xcd < r ? xcd * (q + 1) : r * (q + 1) + (xcd - r) * q) + off; }
        const int nig = WGM * nN, gid = wgid / nig, fm = gid * WGM, gsz = (nM - fm) < WGM ? (nM - fm) : WGM;
        u.pm = fm + ((wgid % nig) % gsz); u.pn = (wgid % nig) / gsz; u.aux = 0; u.half = 0; u.nh = 0; return true;
    }
    __device__ __forceinline__ void a_ready(const Unit&) const {}
    __device__ __forceinline__ void done(const Unit&) const {}
};

struct StaticOrderHalfTail : StaticOrder {
    int nNF, nNT;
    __device__ __forceinline__ bool next(int i, Unit& u) const {
        const long L = (long)i * G + c; const int nw = nM * nNT * 2;
        if (L >= (long)nwg + nw) return false;
        const bool tail = L >= nwg;
        int wgid = tail ? 0 : (int)L; { const int q = nwg / NXCD, r = nwg % NXCD, xcd = wgid % NXCD, off = wgid / NXCD; wgid = (xcd < r ? xcd * (q + 1) : r * (q + 1) + (xcd - r) * q) + off; }
        const int nig = WGM * nN, gid = wgid / nig, fm = gid * WGM, gsz = (nM - fm) < WGM ? (nM - fm) : WGM;
        const int pm_f = fm + ((wgid % nig) % gsz), pn_f = (wgid % nig) / gsz;
        int wg = tail ? (int)(L - nwg) : 0; { const int q = nw / NXCD, rr = nw % NXCD, xcd = wg % NXCD, off = wg / NXCD; wg = (xcd < rr ? xcd * (q + 1) : rr * (q + 1) + (xcd - rr) * q) + off; }
        const int t = wg % (nNT * 2);
        u.pm = tail ? wg / (nNT * 2) : pm_f; u.pn = tail ? nNF + (t >> 1) : pn_f; u.nh = tail ? 1 + (t & 1) : 0; u.aux = 0; u.half = 0;
        return true;
    }
};
__device__ __forceinline__ unsigned cvt_pk_bf16(float lo, float hi) { unsigned r; asm volatile("v_cvt_pk_bf16_f32 %0, %1, %2" : "=v"(r) : "v"(lo), "v"(hi)); return r; }
template <class Epi, class Sched, bool ALIGN_EPI = false, bool SP2 = false>
__device__ __forceinline__ void gemm_phase(PG8_LAS unsigned char* lds, const Gemm g, const Sched& S, const Epi& E) {
    const int tid = opaque_tid(), wid = __builtin_amdgcn_readfirstlane(tid >> 6), lane = tid & 63, wr = wid >> 2, wc = wid & 3, fr = lane & 15, fq = lane >> 4;
    const int K = g.K, nt = K / BK;
    unsigned voffA[2], voffB[2];
#pragma unroll
    for (int i = 0; i < 2; ++i) { int R, C; stage_rc(tid * 16 + i * 8192, R, C); const int Rb = Epi::PERM ? ((R & ~31) + perm32(R & 31)) : R;
        voffA[i] = (unsigned)(R * K + C) * 2u; voffB[i] = (unsigned)(Rb * K + C) * 2u; }
    const size_t kstep = (size_t)(BK * 2);
    const size_t hstep = (size_t)HALF * K * 2;
    const size_t tstep = 2 * hstep;
    const unsigned ldsw = (unsigned)wid * 1024u;
    const int aoff = lds_byte(wr * 64 + fr, fq * 8), boff = lds_byte(wc * 32 + fr, fq * 8);
#define PG8_SA(b, h) (((b) * 2 + (h)) * HTB)
#define PG8_SB(b, h) ((4 + (b) * 2 + (h)) * HTB)
#define PG8_STAGE(bufoff, gbase, voff) do { _Pragma("unroll") for (int _i = 0; _i < 2; ++_i) \
        __builtin_amdgcn_global_load_lds((const unsigned*)((const char*)(gbase) + (voff)[_i]), (PG8_LAS unsigned*)(lds + (bufoff) + ldsw + _i * 8192), 16, 0, 0); } while (0)
#define PG8_LDA(dst, b, h) do { _Pragma("unroll") for (int m = 0; m < 4; ++m) _Pragma("unroll") for (int k = 0; k < 2; ++k) dst[m][k] = *(const PG8_LAS bf16x8*)(lds + PG8_SA(b, h) + aoff + m * 2048 + k * 1024); } while (0)
#define PG8_LDB(dst, b, h) do { _Pragma("unroll") for (int n = 0; n < 2; ++n) _Pragma("unroll") for (int k = 0; k < 2; ++k) dst[n][k] = *(const PG8_LAS bf16x8*)(lds + PG8_SB(b, h) + boff + n * 2048 + k * 1024); } while (0)
#define PG8_MMA(ai, bj, At, Bt) do { __builtin_amdgcn_s_setprio(1); _Pragma("unroll") for (int m = 0; m < 4; ++m) _Pragma("unroll") for (int n = 0; n < 2; ++n) _Pragma("unroll") for (int k = 0; k < 2; ++k) \
        acc[ai][bj][m][n] = __builtin_amdgcn_mfma_f32_16x16x32_bf16(Bt[n][k], At[m][k], acc[ai][bj][m][n], 0, 0, 0); __builtin_amdgcn_s_setprio(0); } while (0)
#define PG8_WAIT_V(n) asm volatile("s_waitcnt vmcnt(" #n ")" ::: "memory")
#define PG8_WAIT_L(n) asm volatile("s_waitcnt lgkmcnt(" #n ")" ::: "memory")
#define PG8_BAR __builtin_amdgcn_s_barrier()
#define PG8_SCHED __builtin_amdgcn_sched_barrier(0)
    Unit cur, nxt; int ui = 0;
    if (!S.next(0, cur)) return;
    f32x4 acc[2][2][4][2];
#pragma unroll
    for (int a = 0; a < 2; ++a)
#pragma unroll
        for (int b = 0; b < 2; ++b)
#pragma unroll
            for (int m = 0; m < 4; ++m)
#pragma unroll
                for (int n = 0; n < 2; ++n) acc[a][b][m][n] = (f32x4){0.f, 0.f, 0.f, 0.f};
    bf16x8 At[4][2], B0[2][2], B1[2][2];
    const char* cA = (const char*)g.A + (size_t)cur.pm * tstep; const char* cB = (const char*)g.Bt + (size_t)cur.pn * tstep;
    S.a_ready(cur);
    if constexpr (SP2) {
        PG8_STAGE(PG8_SB(0, 0), cB, voffB); PG8_STAGE(PG8_SB(0, 1), cB + hstep, voffB); PG8_STAGE(PG8_SA(0, 0), cA, voffA); PG8_STAGE(PG8_SA(0, 1), cA + hstep, voffA);
        if (wr == 1) PG8_BAR;
        PG8_WAIT_V(2); PG8_BAR;
        PG8_STAGE(PG8_SB(1, 0), cB + kstep, voffB); PG8_STAGE(PG8_SA(1, 0), cA + kstep, voffA); PG8_STAGE(PG8_SB(1, 1), cB + hstep + kstep, voffB);
        PG8_WAIT_V(6); PG8_BAR;
    } else {
        PG8_STAGE(PG8_SB(0, 0), cB, voffB); PG8_STAGE(PG8_SA(0, 0), cA, voffA); PG8_STAGE(PG8_SB(0, 1), cB + hstep, voffB); PG8_STAGE(PG8_SA(0, 1), cA + hstep, voffA);
        if (wr == 1) PG8_BAR;
        PG8_WAIT_V(4); PG8_BAR;
        PG8_STAGE(PG8_SB(1, 0), cB + kstep, voffB); PG8_STAGE(PG8_SA(1, 0), cA + kstep, voffA); PG8_STAGE(PG8_SB(1, 1), cB + hstep + kstep, voffB);
        PG8_WAIT_V(6); PG8_BAR;
    }
    for (;;) {
        const bool has_next = S.next(ui + 1, nxt);
        const char* nA = has_next ? (const char*)g.A + (size_t)nxt.pm * tstep : cA; const char* nB = has_next ? (const char*)g.Bt + (size_t)nxt.pn * tstep : cB;
        for (int t = 0; t < nt; t += 2) {
            const bool last = (t == nt - 2);
            const char* a1 = cA + (size_t)(t + 1) * kstep;
            const char* a2 = last ? nA : cA + (size_t)(t + 2) * kstep; const char* b2 = last ? nB : cB + (size_t)(t + 2) * kstep;
            const char* a3 = a2 + kstep; const char* b3 = b2 + kstep;
            if (last && has_next) S.a_ready(nxt);
            if constexpr (SP2) {
            PG8_LDB(B0, 0, 0); PG8_LDB(B1, 0, 1); PG8_SCHED; PG8_LDA(At, 0, 0); PG8_STAGE(PG8_SA(1, 1), a1 + hstep, voffA);
            PG8_WAIT_V(8); PG8_WAIT_L(0); PG8_BAR; if (cur.nh != 2) PG8_MMA(0, 0, At, B0); if (cur.nh != 1) PG8_MMA(0, 1, At, B1); PG8_BAR; PG8_SCHED;
            PG8_LDA(At, 0, 1); PG8_STAGE(PG8_SB(0, 0), b2, voffB); PG8_STAGE(PG8_SB(0, 1), b2 + hstep, voffB); PG8_STAGE(PG8_SA(0, 0), a2, voffA);
            PG8_WAIT_V(8); PG8_WAIT_L(0); PG8_BAR; if (!cur.half) { if (cur.nh != 2) PG8_MMA(1, 0, At, B0); if (cur.nh != 1) PG8_MMA(1, 1, At, B1); } PG8_BAR; PG8_SCHED;
            PG8_LDB(B0, 1, 0); PG8_LDB(B1, 1, 1); PG8_SCHED; PG8_LDA(At, 1, 0); PG8_STAGE(PG8_SA(0, 1), a2 + hstep, voffA);
            PG8_WAIT_V(8); PG8_WAIT_L(0); PG8_BAR; if (cur.nh != 2) PG8_MMA(0, 0, At, B0); if (cur.nh != 1) PG8_MMA(0, 1, At, B1); PG8_BAR; PG8_SCHED;
            PG8_LDA(At, 1, 1); PG8_STAGE(PG8_SB(1, 0), b3, voffB); PG8_STAGE(PG8_SB(1, 1), b3 + hstep, voffB); PG8_STAGE(PG8_SA(1, 0), a3, voffA);
            PG8_WAIT_V(8); PG8_WAIT_L(0); PG8_BAR; if (!cur.half) { if (cur.nh != 2) PG8_MMA(1, 0, At, B0); if (cur.nh != 1) PG8_MMA(1, 1, At, B1); } PG8_BAR; PG8_SCHED;
            } else {
            PG8_LDB(B0, 0, 0); PG8_SCHED; PG8_LDA(At, 0, 0); PG8_STAGE(PG8_SA(1, 1), a1 + hstep, voffA);
            PG8_WAIT_L(8); PG8_BAR; PG8_WAIT_L(0); PG8_MMA(0, 0, At, B0); PG8_BAR; PG8_SCHED;
            PG8_LDB(B1, 0, 1); PG8_STAGE(PG8_SB(0, 0), b2, voffB);
            PG8_BAR; PG8_WAIT_L(0); PG8_MMA(0, 1, At, B1); PG8_BAR;
            PG8_LDA(At, 0, 1); PG8_STAGE(PG8_SA(0, 0), a2, voffA);
            PG8_BAR; PG8_WAIT_L(0); PG8_MMA(1, 0, At, B0); PG8_BAR; PG8_SCHED;
            PG8_STAGE(PG8_SB(0, 1), b2 + hstep, voffB);
            PG8_WAIT_V(6); PG8_BAR; PG8_MMA(1, 1, At, B1); PG8_BAR;
            PG8_LDB(B0, 1, 0); PG8_SCHED; PG8_LDA(At, 1, 0); PG8_STAGE(PG8_SA(0, 1), a2 + hstep, voffA);
            PG8_WAIT_L(8); PG8_BAR; PG8_WAIT_L(0); PG8_MMA(0, 0, At, B0); PG8_BAR; PG8_SCHED;
            PG8_LDB(B1, 1, 1); PG8_STAGE(PG8_SB(1, 0), b3, voffB);
            PG8_BAR; PG8_WAIT_L(0); PG8_MMA(0, 1, At, B1); PG8_BAR;
            PG8_LDA(At, 1, 1); PG8_STAGE(PG8_SA(1, 0), a3, voffA);
            PG8_BAR; PG8_WAIT_L(0); PG8_MMA(1, 0, At, B0); PG8_BAR; PG8_SCHED;
            PG8_STAGE(PG8_SB(1, 1), b3 + hstep, voffB);
            PG8_WAIT_V(6); PG8_BAR; PG8_MMA(1, 1, At, B1); PG8_BAR;
            }
        }
        if constexpr (ALIGN_EPI) { if (wr == 0) PG8_BAR; }
        if constexpr (!Epi::AFTER_DRAIN) { E(acc, cur, wr, wc, fr, fq); S.done(cur); }
        if (!has_next) break;
#pragma unroll
        for (int a = 0; a < 2; ++a)
#pragma unroll
            for (int b = 0; b < 2; ++b)
#pragma unroll
                for (int m = 0; m < 4; ++m)
#pragma unroll
                    for (int n = 0; n < 2; ++n) acc[a][b][m][n] = (f32x4){0.f, 0.f, 0.f, 0.f};
        cur = nxt; cA = nA; cB = nB; ++ui;
        if constexpr (ALIGN_EPI) { if (wr == 1) PG8_BAR; }
    }
    PG8_WAIT_V(0);
    if constexpr (!ALIGN_EPI) { if (wr == 0) PG8_BAR; }
    PG8_BAR;
    if constexpr (Epi::AFTER_DRAIN) { E.fused(acc, cur, wr, wc, fr, fq, lds, wid, lane); S.done(cur); }
#undef PG8_SA
#undef PG8_SB
#undef PG8_STAGE
#undef PG8_LDA
#undef PG8_LDB
#undef PG8_MMA
#undef PG8_WAIT_V
#undef PG8_WAIT_L
#undef PG8_BAR
#undef PG8_SCHED
}

struct EpiStore {
    static constexpr bool PERM = true, AFTER_DRAIN = false;
    bf16_t* O; int ldc;
    __device__ __forceinline__ void operator()(const f32x4 (&acc)[2][2][4][2], const Unit& u, int wr, int wc, int fr, int fq) const {
        asm volatile("s_nop 7\n\ts_nop 7" ::: "memory");
        const int row0 = u.pm * BM + wr * 64 + fr, col0 = u.pn * BM + wc * 32 + 8 * fq;
#pragma unroll
        for (int ai = 0; ai < 2; ++ai)
#pragma unroll
            for (int m = 0; m < 4; ++m) { bf16_t* rowp = O + (size_t)(row0 + ai * HALF + m * 16) * ldc + col0;
#pragma unroll
                for (int bj = 0; bj < 2; ++bj) { if (u.nh == 2 - bj) continue; const f32x4 v0 = acc[ai][bj][m][0], v1 = acc[ai][bj][m][1];
                    u32x4 w; w.x = cvt_pk_bf16(v0[0], v0[1]); w.y = cvt_pk_bf16(v0[2], v0[3]); w.z = cvt_pk_bf16(v1[0], v1[1]); w.w = cvt_pk_bf16(v1[2], v1[3]);
                    *(u32x4*)(rowp + bj * HALF) = w; } }
    }
};
struct EpiStoreGates {
    static constexpr bool PERM = true, AFTER_DRAIN = false;
    bf16_t* O; int ldc; int gate_pn; float* gates; const float* gbias;
    __device__ __forceinline__ void operator()(const f32x4 (&acc)[2][2][4][2], const Unit& u, int wr, int wc, int fr, int fq) const {
        asm volatile("s_nop 7\n\ts_nop 7" ::: "memory");
        const int row0 = u.pm * BM + wr * 64 + fr;
        if (u.pn == gate_pn) {
            if (wc == 0 && fq == 0) {
                const f32x4 b0 = *(const f32x4*)gbias, b1 = *(const f32x4*)(gbias + 4);
#pragma unroll
                for (int ai = 0; ai < 2; ++ai)
#pragma unroll
                    for (int m = 0; m < 4; ++m) { float* g = gates + (size_t)(row0 + ai * HALF + m * 16) * 8;
                        *(f32x4*)g = acc[ai][0][m][0] + b0; *(f32x4*)(g + 4) = acc[ai][0][m][1] + b1; }
            }
            return;
        }
        const int col0 = u.pn * BM + wc * 32 + 8 * fq;
#pragma unroll
        for (int ai = 0; ai < 2; ++ai)
#pragma unroll
            for (int m = 0; m < 4; ++m) { bf16_t* rowp = O + (size_t)(row0 + ai * HALF + m * 16) * ldc + col0;
#pragma unroll
                for (int bj = 0; bj < 2; ++bj) { const f32x4 v0 = acc[ai][bj][m][0], v1 = acc[ai][bj][m][1];
                    u32x4 w; w.x = cvt_pk_bf16(v0[0], v0[1]); w.y = cvt_pk_bf16(v0[2], v0[3]); w.z = cvt_pk_bf16(v1[0], v1[1]); w.w = cvt_pk_bf16(v1[2], v1[3]);
                    *(u32x4*)(rowp + bj * HALF) = w; } }
    }
};
struct EpiResid {
    static constexpr bool PERM = true, AFTER_DRAIN = false;
    const float* rf; const bf16_t* rb; bf16_t* out;
    __device__ __forceinline__ void operator()(const f32x4 (&acc)[2][2][4][2], const Unit& u, int wr, int wc, int fr, int fq) const {
        const int row0 = u.pm * BM + wr * 64 + fr, col0 = u.pn * BM + wc * 32 + 8 * fq;
#pragma unroll
        for (int ai = 0; ai < 2; ++ai)
#pragma unroll
            for (int m = 0; m < 4; ++m) { const size_t off = (size_t)(row0 + ai * HALF + m * 16) * 1024 + col0;
#pragma unroll
                for (int bj = 0; bj < 2; ++bj) {
                    f32x4 r0, r1;
                    if (rf) { r0 = *(const f32x4*)(rf + off + bj * HALF); r1 = *(const f32x4*)(rf + off + bj * HALF + 4); }
                    else { const u32x4 q = *(const u32x4*)(rb + off + bj * HALF);
                        r0 = (f32x4){__uint_as_float(q.x << 16), __uint_as_float(q.x & 0xffff0000u), __uint_as_float(q.y << 16), __uint_as_float(q.y & 0xffff0000u)};
                        r1 = (f32x4){__uint_as_float(q.z << 16), __uint_as_float(q.z & 0xffff0000u), __uint_as_float(q.w << 16), __uint_as_float(q.w & 0xffff0000u)}; }
                    const f32x4 v0 = acc[ai][bj][m][0] + r0, v1 = acc[ai][bj][m][1] + r1;
                    u32x4 w; w.x = cvt_pk_bf16(v0[0], v0[1]); w.y = cvt_pk_bf16(v0[2], v0[3]); w.z = cvt_pk_bf16(v1[0], v1[1]); w.w = cvt_pk_bf16(v1[2], v1[3]);
                    *(u32x4*)(out + off + bj * HALF) = w; } }
    }
};

template <class Epi, class Sched>
__device__ __forceinline__ void gemm_phase_g(PG8_LAS unsigned char* lds, const Gemm g, const Sched& S, const Epi& E) {
    const int tid = opaque_tid(), wid = __builtin_amdgcn_readfirstlane(tid >> 6), lane = tid & 63, wr = wid >> 2, wc = wid & 3, fr = lane & 15, fq = lane >> 4;
    const int K = g.K, nt = K / BK;
    int RA[2], CA[2]; unsigned voffB[2];
#pragma unroll
    for (int i = 0; i < 2; ++i) { int R, C; stage_rc(tid * 16 + i * 8192, R, C); RA[i] = R; CA[i] = C; const int Rb = Epi::PERM ? ((R & ~31) + perm32(R & 31)) : R; voffB[i] = (unsigned)(Rb * K + C) * 2u; }
    const size_t kstep = (size_t)(BK * 2);
    const size_t hstep = (size_t)HALF * K * 2;
    const size_t tstep = 2 * hstep;
    const unsigned ldsw = (unsigned)wid * 1024u;
    const int aoff = lds_byte(wr * 64 + fr, fq * 8), boff = lds_byte(wc * 32 + fr, fq * 8);
#define PG8_SA(b, h) (((b) * 2 + (h)) * HTB)
#define PG8_SB(b, h) ((4 + (b) * 2 + (h)) * HTB)
#define PG8_STAGE(bufoff, gbase, voff) do { _Pragma("unroll") for (int _i = 0; _i < 2; ++_i) \
        __builtin_amdgcn_global_load_lds((const unsigned*)((const char*)(gbase) + (voff)[_i]), (PG8_LAS unsigned*)(lds + (bufoff) + ldsw + _i * 8192), 16, 0, 0); } while (0)
#define PG8_LDA(dst, b, h) do { _Pragma("unroll") for (int m = 0; m < 4; ++m) _Pragma("unroll") for (int k = 0; k < 2; ++k) dst[m][k] = *(const PG8_LAS bf16x8*)(lds + PG8_SA(b, h) + aoff + m * 2048 + k * 1024); } while (0)
#define PG8_LDB(dst, b, h) do { _Pragma("unroll") for (int n = 0; n < 2; ++n) _Pragma("unroll") for (int k = 0; k < 2; ++k) dst[n][k] = *(const PG8_LAS bf16x8*)(lds + PG8_SB(b, h) + boff + n * 2048 + k * 1024); } while (0)
#define PG8_MMA(ai, bj, At, Bt) do { __builtin_amdgcn_s_setprio(1); _Pragma("unroll") for (int m = 0; m < 4; ++m) _Pragma("unroll") for (int n = 0; n < 2; ++n) _Pragma("unroll") for (int k = 0; k < 2; ++k) \
        acc[ai][bj][m][n] = __builtin_amdgcn_mfma_f32_16x16x32_bf16(Bt[n][k], At[m][k], acc[ai][bj][m][n], 0, 0, 0); __builtin_amdgcn_s_setprio(0); } while (0)
#define PG8_WAIT_V(n) asm volatile("s_waitcnt vmcnt(" #n ")" ::: "memory")
#define PG8_WAIT_L(n) asm volatile("s_waitcnt lgkmcnt(" #n ")" ::: "memory")
#define PG8_BAR __builtin_amdgcn_s_barrier()
#define PG8_SCHED __builtin_amdgcn_sched_barrier(0)
    Unit cur, nxt; int ui = 0;
    if (!S.next(0, cur)) return;
    f32x4 acc[2][2][4][2];
#pragma unroll
    for (int a = 0; a < 2; ++a)
#pragma unroll
        for (int b = 0; b < 2; ++b)
#pragma unroll
            for (int m = 0; m < 4; ++m)
#pragma unroll
                for (int n = 0; n < 2; ++n) acc[a][b][m][n] = (f32x4){0.f, 0.f, 0.f, 0.f};
    bf16x8 At[4][2], B0[2][2], B1[2][2];
    unsigned oc[2][2];
    S.aoff(0, RA, CA, oc);
    const char* Ab = (const char*)g.A;
    const char* cB = (const char*)g.Bt + (size_t)cur.pn * tstep;
    PG8_STAGE(PG8_SB(0, 0), cB, voffB); PG8_STAGE(PG8_SB(0, 1), cB + hstep, voffB); PG8_STAGE(PG8_SA(0, 0), Ab, oc[0]); PG8_STAGE(PG8_SA(0, 1), Ab, oc[1]);
    if (wr == 1) PG8_BAR;
    PG8_WAIT_V(2); PG8_BAR;
    PG8_STAGE(PG8_SB(1, 0), cB + kstep, voffB); PG8_STAGE(PG8_SA(1, 0), Ab + kstep, oc[0]); PG8_STAGE(PG8_SB(1, 1), cB + hstep + kstep, voffB);
    PG8_WAIT_V(6); PG8_BAR;
    for (;;) {
        const bool has_next = S.next(ui + 1, nxt);
        const char* nB = has_next ? (const char*)g.Bt + (size_t)nxt.pn * tstep : cB;
        for (int t = 0; t < nt; t += 2) {
            const bool last = (t == nt - 2);
            const char* a1 = Ab + (size_t)(t + 1) * kstep;
            const char* a2 = last ? Ab : Ab + (size_t)(t + 2) * kstep; const char* b2 = last ? nB : cB + (size_t)(t + 2) * kstep;
            const char* a3 = a2 + kstep; const char* b3 = b2 + kstep;
            unsigned o2[2][2];
            if (last && has_next) S.aoff(ui + 1, RA, CA, o2);
            else { o2[0][0] = oc[0][0]; o2[0][1] = oc[0][1]; o2[1][0] = oc[1][0]; o2[1][1] = oc[1][1]; }
            PG8_LDB(B0, 0, 0); PG8_LDB(B1, 0, 1); PG8_SCHED; PG8_LDA(At, 0, 0); PG8_STAGE(PG8_SA(1, 1), a1, oc[1]);
            PG8_WAIT_V(8); PG8_WAIT_L(0); PG8_BAR; if (cur.nh != 2) PG8_MMA(0, 0, At, B0); if (cur.nh != 1) PG8_MMA(0, 1, At, B1); PG8_BAR; PG8_SCHED;
            PG8_LDA(At, 0, 1); PG8_STAGE(PG8_SB(0, 0), b2, voffB); PG8_STAGE(PG8_SB(0, 1), b2 + hstep, voffB); PG8_STAGE(PG8_SA(0, 0), a2, o2[0]);
            PG8_WAIT_V(8); PG8_WAIT_L(0); PG8_BAR; if (!cur.half) { if (cur.nh != 2) PG8_MMA(1, 0, At, B0); if (cur.nh != 1) PG8_MMA(1, 1, At, B1); } PG8_BAR; PG8_SCHED;
            PG8_LDB(B0, 1, 0); PG8_LDB(B1, 1, 1); PG8_SCHED; PG8_LDA(At, 1, 0); PG8_STAGE(PG8_SA(0, 1), a2, o2[1]);
            PG8_WAIT_V(8); PG8_WAIT_L(0); PG8_BAR; if (cur.nh != 2) PG8_MMA(0, 0, At, B0); if (cur.nh != 1) PG8_MMA(0, 1, At, B1); PG8_BAR; PG8_SCHED;
            PG8_LDA(At, 1, 1); PG8_STAGE(PG8_SB(1, 0), b3, voffB); PG8_STAGE(PG8_SB(1, 1), b3 + hstep, voffB); PG8_STAGE(PG8_SA(1, 0), a3, o2[0]);
            PG8_WAIT_V(8); PG8_WAIT_L(0); PG8_BAR; if (!cur.half) { if (cur.nh != 2) PG8_MMA(1, 0, At, B0); if (cur.nh != 1) PG8_MMA(1, 1, At, B1); } PG8_BAR; PG8_SCHED;
        }
        if (wr == 0) PG8_BAR;
        E(acc, cur, wr, wc, fr, fq);
        if (!has_next) break;
#pragma unroll
        for (int a = 0; a < 2; ++a)
#pragma unroll
            for (int b = 0; b < 2; ++b)
#pragma unroll
                for (int m = 0; m < 4; ++m)
#pragma unroll
                    for (int n = 0; n < 2; ++n) acc[a][b][m][n] = (f32x4){0.f, 0.f, 0.f, 0.f};
        cur = nxt; cB = nB; ++ui;
        S.aoff(ui, RA, CA, oc);
        if (wr == 1) PG8_BAR;
    }
    PG8_WAIT_V(0);
    PG8_BAR;
#undef PG8_SA
#undef PG8_SB
#undef PG8_STAGE
#undef PG8_LDA
#undef PG8_LDB
#undef PG8_MMA
#undef PG8_WAIT_V
#undef PG8_WAIT_L
#undef PG8_BAR
#undef PG8_SCHED
}

constexpr int MOE_MAXU = 4;
struct SchedMoe {
    const int* tp; const int* cn; const unsigned* tab;
    int NT, nU, G, c;
    __device__ __forceinline__ bool next(int i, Unit& u) const {
        if (i >= MOE_MAXU) return false;
        const long L = (long)i * G + c; if (L >= nU) return false;
        int wgid = (int)L; { const int q = nU / NXCD, r = nU % NXCD, xcd = wgid % NXCD, off = wgid / NXCD; wgid = (xcd < r ? xcd * (q + 1) : r * (q + 1) + (xcd - r) * q) + off; }
        const int ti = wgid / NT, pn = wgid - ti * NT;
        int e = 0; while (tp[e + 1] <= ti) ++e;
        u.pm = ti; u.pn = e * NT + pn; u.aux = i; u.half = (cn[e] - (ti - tp[e]) * BM <= HALF) ? 1 : 0; u.nh = 0; return true;
    }
    __device__ __forceinline__ void aoff(int ui, const int (&RA)[2], const int (&CA)[2], unsigned (&o)[2][2]) const {
#pragma unroll
        for (int h = 0; h < 2; ++h)
#pragma unroll
            for (int i = 0; i < 2; ++i) o[h][i] = tab[ui * 256 + h * HALF + RA[i]] + (unsigned)CA[i] * 2u;
    }
    __device__ __forceinline__ void a_ready(const Unit&) const {}
    __device__ __forceinline__ void done(const Unit&) const {}
};
__device__ __forceinline__ float silu_f(float x) { return x * __builtin_amdgcn_rcpf(1.f + __expf(-x)); }
__device__ __forceinline__ float sig_f(float x) { return __builtin_amdgcn_rcpf(1.f + __expf(-x)); }
struct EpiGlu256 {
    static constexpr bool PERM = true, AFTER_DRAIN = false;
    const bf16_t* Z; const float* b; bf16_t* mix;
    __device__ __forceinline__ void operator()(const f32x4 (&acc)[2][2][4][2], const Unit& u, int wr, int wc, int fr, int fq) const {
        const int row0 = u.pm * BM + wr * 64 + fr, col0 = u.pn * BM + wc * 32 + 8 * fq;
#pragma unroll
        for (int ai = 0; ai < 2; ++ai)
#pragma unroll
            for (int m = 0; m < 4; ++m) { const size_t r = (size_t)(row0 + ai * HALF + m * 16);
#pragma unroll
                for (int bj = 0; bj < 2; ++bj) { const int c = col0 + bj * HALF;
                    const u32x4 q = *(const u32x4*)(Z + r * 512 + c);
                    const f32x4 b0 = *(const f32x4*)(b + c), b1 = *(const f32x4*)(b + c + 4);
                    const f32x4 v0 = acc[ai][bj][m][0] + b0, v1 = acc[ai][bj][m][1] + b1;
                    const float z0 = __uint_as_float(q.x << 16), z1 = __uint_as_float(q.x & 0xffff0000u), z2 = __uint_as_float(q.y << 16), z3 = __uint_as_float(q.y & 0xffff0000u);
                    const float z4 = __uint_as_float(q.z << 16), z5 = __uint_as_float(q.z & 0xffff0000u), z6 = __uint_as_float(q.w << 16), z7 = __uint_as_float(q.w & 0xffff0000u);
                    u32x4 w; w.x = cvt_pk_bf16(z0 * sig_f(v0[0]), z1 * sig_f(v0[1])); w.y = cvt_pk_bf16(z2 * sig_f(v0[2]), z3 * sig_f(v0[3]));
                    w.z = cvt_pk_bf16(z4 * sig_f(v1[0]), z5 * sig_f(v1[1])); w.w = cvt_pk_bf16(z6 * sig_f(v1[2]), z7 * sig_f(v1[3]));
                    *(u32x4*)(mix + r * 1024 + c) = w; } }
    }
};

struct EpiMoeUp {
    static constexpr bool PERM = true, AFTER_DRAIN = false;
    bf16_t* H;
    __device__ __forceinline__ void operator()(const f32x4 (&acc)[2][2][4][2], const Unit& u, int wr, int wc, int fr, int fq) const {
        const int row0 = u.pm * BM + wr * 64 + fr, f0 = (u.pn & 1) * 128 + wc * 32 + 8 * fq;
#pragma unroll
        for (int ai = 0; ai < 2; ++ai)
#pragma unroll
            for (int m = 0; m < 4; ++m) {
                const f32x4 g0 = acc[ai][0][m][0], g1 = acc[ai][0][m][1], u0 = acc[ai][1][m][0], u1 = acc[ai][1][m][1];
                u32x4 w; w.x = cvt_pk_bf16(silu_f(g0[0]) * u0[0], silu_f(g0[1]) * u0[1]); w.y = cvt_pk_bf16(silu_f(g0[2]) * u0[2], silu_f(g0[3]) * u0[3]);
                w.z = cvt_pk_bf16(silu_f(g1[0]) * u1[0], silu_f(g1[1]) * u1[1]); w.w = cvt_pk_bf16(silu_f(g1[2]) * u1[2], silu_f(g1[3]) * u1[3]);
                *(u32x4*)(H + (size_t)(row0 + ai * HALF + m * 16) * 256 + f0) = w;
            }
    }
};
struct EpiMoeDown {
    static constexpr bool PERM = true, AFTER_DRAIN = false;
    bf16_t* Y; const unsigned* dtab; const float* wtab;
    __device__ __forceinline__ void operator()(const f32x4 (&acc)[2][2][4][2], const Unit& u, int wr, int wc, int fr, int fq) const {
        const int pn = u.pn & 3, tb = u.aux * 256 + wr * 64 + fr, col = pn * BM + wc * 32 + 8 * fq;
#pragma unroll
        for (int ai = 0; ai < 2; ++ai)
#pragma unroll
            for (int m = 0; m < 4; ++m) {
                const unsigned d = dtab[tb + ai * HALF + m * 16]; const float w = wtab[tb + ai * HALF + m * 16];
                if (d != 0xffffffffu) {
                    bf16_t* yr = Y + (size_t)d * 1024 + col;
#pragma unroll
                    for (int bj = 0; bj < 2; ++bj) { const f32x4 v0 = acc[ai][bj][m][0] * w, v1 = acc[ai][bj][m][1] * w;
                        u32x4 o; o.x = cvt_pk_bf16(v0[0], v0[1]); o.y = cvt_pk_bf16(v0[2], v0[3]); o.z = cvt_pk_bf16(v1[0], v1[1]); o.w = cvt_pk_bf16(v1[2], v1[3]);
                        *(u32x4*)(yr + bj * HALF) = o; }
                }
            }
    }
};
}

__device__ __forceinline__ void transpose_tile(const float* __restrict__ src, int ldn, bf16_t* __restrict__ dst, int ldk, float scale, float* scr, int lane) {
    float tv[32];
#pragma unroll
    for (int i = 0; i < 32; ++i) tv[i] = __builtin_nontemporal_load(src + (size_t)(2 * i + (lane >> 5)) * ldn + (lane & 31));
#pragma unroll
    for (int i = 0; i < 32; ++i) scr[(2 * i + (lane >> 5)) * 33 + (lane & 31)] = tv[i];
    LDS_WAIT();
    const int c = lane & 7;
#pragma unroll
    for (int j = 0; j < 4; ++j) {
        const int n = (lane >> 3) + 8 * j; const float* s = scr + (8 * c) * 33 + n;
        u32x4 o; o.x = pk2(s[0] * scale, s[33] * scale); o.y = pk2(s[66] * scale, s[99] * scale); o.z = pk2(s[132] * scale, s[165] * scale); o.w = pk2(s[198] * scale, s[231] * scale);
        *(u32x4*)(dst + (size_t)n * ldk + 8 * c) = o;
    }
    LDS_WAIT();
}

__device__ __forceinline__ void rms_row(f32x4 (&v)[4], const float* __restrict__ w, bf16_t* __restrict__ xn, int lane) {
    float ss = 0.f;
#pragma unroll
    for (int j = 0; j < 4; ++j) ss += v[j].x * v[j].x + v[j].y * v[j].y + v[j].z * v[j].z + v[j].w * v[j].w;
    ss = wave_sum(ss);
    const float r = rsqrtf(ss * (1.f / 1024.f) + EPS);
#pragma unroll
    for (int j = 0; j < 4; ++j) {
        const f32x4 w4 = *(const f32x4*)(w + 4 * lane + 256 * j);
        v[j] = v[j] * r * w4;
        u32x2 o; o.x = pk2(v[j].x, v[j].y); o.y = pk2(v[j].z, v[j].w);
        *(u32x2*)(xn + 4 * lane + 256 * j) = o;
    }
}

__device__ __forceinline__ void phase_prep(const Params& p, unsigned char* lds) {
    const int tid = opaque_tid(), lane = tid & 63, wid = tid >> 6;
    const int gw = blockIdx.x * 8 + wid, NGW = gridDim.x * 8;
    const int gt = blockIdx.x * NTHR + tid, NGT = gridDim.x * NTHR;
    unsigned char* ws = p.ws;
    if (blockIdx.x == 0 && tid < 64) ((int*)(ws + WS_CNT))[(tid >> 5) * 1024 + (tid & 31) * 32] = 0;
    for (int idx = (tid < 8 ? blockIdx.x * 8 + tid : 2048); idx < 2048; idx += gridDim.x * 8) {
        const int g = idx >> 6;
        const double lr = p.in[I_S5_LRE][idx], li = p.in[I_S5_LIM][idx], dt = exp((double)p.in[I_S5_LOGDT][g]);
        const double zr = lr * dt, zi = li * dt, ez = exp(zr);
        const double br = ez * cos(zi), bi = ez * sin(zi);
        double pr = 1.0, pi = 0.0;
        for (int tau = 0; tau <= 16; ++tau) {
            ((f32x2*)(ws + WS_S5POW))[idx * 17 + tau] = (f32x2){(float)pr, (float)pi};
            const double nr = pr * br - pi * bi, ni = pr * bi + pi * br; pr = nr; pi = ni;
        }
        const double ar = br - 1.0, ai = bi, den = lr * lr + li * li;
        const double cr = (ar * lr + ai * li) / den, ci = (ai * lr - ar * li) / den;
        for (int c = 0; c < 16; ++c) {
            const double b_r = p.in[I_S5_BRE][idx * 16 + c], b_i = p.in[I_S5_BIM][idx * 16 + c];
            ((f32x2*)(ws + WS_S5BBAR))[idx * 16 + c] = (f32x2){(float)(cr * b_r - ci * b_i), (float)(cr * b_i + ci * b_r)};
        }
    }
    for (int idx = gt; idx < 2 * 32 * 3 * 64; idx += NGT) {
        const int l = idx / (32 * 3 * 64), rem = idx - l * (32 * 3 * 64), ks = rem / 192, r2 = rem - ks * 192, nt_ = r2 >> 6, ln = r2 & 63, col = nt_ * 16 + (ln & 15);
        float v[8];
#pragma unroll
        for (int j = 0; j < 8; ++j) {
            const int k = ks * 32 + (ln >> 4) * 8 + j;
            float w = 0.f;
            if (col < 32) w = p.in[I_MOE_WR][(size_t)(l * 1024 + k) * 32 + col];
            else if (col < 36) w = p.in[I_MOE_WG][(size_t)(l * 1024 + k) * 4 + (col - 32)];
            v[j] = w * p.in[I_NORM_FFN][l * 1024 + k];
        }
        unsigned hi[4], lo[4];
#pragma unroll
        for (int q = 0; q < 4; ++q) {
            const unsigned h0 = f2bf(v[2 * q]), h1 = f2bf(v[2 * q + 1]);
            hi[q] = h0 | (h1 << 16);
            lo[q] = pk2(v[2 * q] - bf2f(h0), v[2 * q + 1] - bf2f(h1));
        }
        bf16_t* wf = (bf16_t*)(ws + WS_WCAT);
        *(u32x4*)(wf + ((size_t)(l * 2 + 0) * 6144 + (size_t)(ks * 3 + nt_) * 64 + ln) * 8) = (u32x4){hi[0], hi[1], hi[2], hi[3]};
        *(u32x4*)(wf + ((size_t)(l * 2 + 1) * 6144 + (size_t)(ks * 3 + nt_) * 64 + ln) * 8) = (u32x4){lo[0], lo[1], lo[2], lo[3]};
    }
    float* scr = (float*)(lds + wid * 8704);
    constexpr int IT_WINA = 112 * 16, IT_WOUT = 32 * 16, IT_WINC = 80 * 16, IT_WGLU = 16 * 8;
    constexpr int IT_TOTAL = IT_WINA + IT_WOUT + IT_WINC + IT_WOUT + IT_WGLU;
    for (int it0 = gw; it0 < IT_TOTAL; it0 += NGW) {
        int it = it0; const float* src; bf16_t* dst; int ldn, ldk; float scale = 1.f;
        if (it < IT_WINA) {
            const int n0 = (it >> 4) * 32, k0 = (it & 15) * 64, srcn = n0 < 2048 ? n0 : n0 + 8;
            if (n0 >= 512 && n0 < 1024) scale = 0.08838834764831845f;
            src = p.in[I_AB_WIN] + (size_t)k0 * 3592 + srcn; ldn = 3592; dst = (bf16_t*)(ws + WS_WINA) + (size_t)n0 * 1024 + k0; ldk = 1024;
        } else if ((it -= IT_WINA) < IT_WOUT) {
            const int n0 = (it >> 4) * 32, k0 = (it & 15) * 64;
            src = p.in[I_AB_WOUT] + (size_t)k0 * 1024 + n0; ldn = 1024; dst = (bf16_t*)(ws + WS_WOUTA) + (size_t)n0 * 1024 + k0; ldk = 1024;
        } else if ((it -= IT_WOUT) < IT_WINC) {
            const int n0 = (it >> 4) * 32, k0 = (it & 15) * 64;
            src = p.in[I_CD_WIN] + (size_t)k0 * 2560 + n0; ldn = 2560; dst = (bf16_t*)(ws + WS_WINC) + (size_t)n0 * 1024 + k0; ldk = 1024;
        } else if ((it -= IT_WINC) < IT_WOUT) {
            const int n0 = (it >> 4) * 32, k0 = (it & 15) * 64;
            src = p.in[I_CD_WOUT] + (size_t)k0 * 1024 + n0; ldn = 1024; dst = (bf16_t*)(ws + WS_WOUTC) + (size_t)n0 * 1024 + k0; ldk = 1024;
        } else {
            it -= IT_WOUT;
            const int n0 = (it >> 3) * 32, k0 = (it & 7) * 64;
            src = p.in[I_S5_WGLU] + (size_t)k0 * 512 + n0; ldn = 512; dst = (bf16_t*)(ws + WS_WGLU) + (size_t)n0 * 512 + k0; ldk = 512;
        }
        transpose_tile(src, ldn, dst, ldk, scale, scr, lane);
    }
    {
        bf16_t* wg = (bf16_t*)(ws + WS_WINA) + (size_t)3584 * 1024;
        const float* win = p.in[I_AB_WIN];
        for (int idx = gt; idx < 256 * 1024; idx += NGT) {
            const int n = idx >> 10, k = idx & 1023;
            wg[idx] = (bf16_t)(n < 8 ? f2bf(win[(size_t)k * 3592 + 2048 + n]) : 0u);
        }
    }
    const float* x = p.in[I_X];
    f32x4 vn[4];
    if (gw < T) {
#pragma unroll
        for (int j = 0; j < 4; ++j) vn[j] = __builtin_nontemporal_load((const f32x4*)(x + (size_t)gw * 1024 + 4 * lane + 256 * j));
    }
    for (int row = gw; row < T; row += NGW) {
        f32x4 v[4];
#pragma unroll
        for (int j = 0; j < 4; ++j) v[j] = vn[j];
        if (row + NGW < T) {
#pragma unroll
            for (int j = 0; j < 4; ++j) vn[j] = __builtin_nontemporal_load((const f32x4*)(x + (size_t)(row + NGW) * 1024 + 4 * lane + 256 * j));
        }
        {
            bf16_t* h16 = (bf16_t*)(ws + WS_H16) + (size_t)row * 1024;
#pragma unroll
            for (int j = 0; j < 4; ++j) { u32x2 o; o.x = pk2(v[j].x, v[j].y); o.y = pk2(v[j].z, v[j].w); *(u32x2*)(h16 + 4 * lane + 256 * j) = o; }
        }
        rms_row(v, p.in[I_NORM_MIX], (bf16_t*)(ws + WS_XN) + (size_t)row * 1024, lane);
    }
}

struct EpiStoreBf16 {
    bf16_t* O; int ldc;
    __device__ __forceinline__ void operator()(const f32x4 (&acc)[2][4], int wr, int wc, int fr, int fq) const {
#pragma unroll
        for (int m = 0; m < 2; ++m)
#pragma unroll
            for (int n = 0; n < 4; ++n) {
                const f32x4 v = acc[m][n]; u32x2 o; o.x = pk2(v.x, v.y); o.y = pk2(v.z, v.w);
                *(u32x2*)(O + (size_t)(wr * 32 + m * 16 + fr) * ldc + wc * 64 + n * 16 + fq * 4) = o;
            }
    }
};
struct EpiResidF32 {
    const float* resid; float* out;
    __device__ __forceinline__ void operator()(const f32x4 (&acc)[2][4], int wr, int wc, int fr, int fq) const {
#pragma unroll
        for (int m = 0; m < 2; ++m)
#pragma unroll
            for (int n = 0; n < 4; ++n) {
                const size_t off = (size_t)(wr * 32 + m * 16 + fr) * 1024 + wc * 64 + n * 16 + fq * 4;
                const f32x4 r = *(const f32x4*)(resid + off);
                *(f32x4*)(out + off) = r + acc[m][n];
            }
    }
};
struct EpiGlu {
    const bf16_t* Z; const float* b; bf16_t* mix;
    __device__ __forceinline__ void operator()(const f32x4 (&acc)[2][4], int wr, int wc, int fr, int fq) const {
#pragma unroll
        for (int m = 0; m < 2; ++m)
#pragma unroll
            for (int n = 0; n < 4; ++n) {
                const int r = wr * 32 + m * 16 + fr, c = wc * 64 + n * 16 + fq * 4;
                const u32x2 zz = *(const u32x2*)(Z + (size_t)r * 512 + c);
                const f32x4 bb = *(const f32x4*)(b + c);
                const f32x4 v = acc[m][n] + bb;
                const float z0 = bf2f(zz.x & 0xffffu), z1 = bf2f(zz.x >> 16), z2 = bf2f(zz.y & 0xffffu), z3 = bf2f(zz.y >> 16);
                u32x2 o; o.x = pk2(z0 * fsigmoid_(v.x), z1 * fsigmoid_(v.y)); o.y = pk2(z2 * fsigmoid_(v.z), z3 * fsigmoid_(v.w));
                *(u32x2*)(mix + (size_t)r * 1024 + c) = o;
            }
    }
};

__device__ __forceinline__ void phase_gemm_store(unsigned char* lds, const bf16_t* A, const bf16_t* Bt, int N, int K, bf16_t* O, int ldc) {
    const int nN = N >> 7, nU = (T >> 7) * nN;
    for (int u = blockIdx.x; u < nU; u += gridDim.x) {
        const int pm = u / nN, pn = u - pm * nN;
        APlain ap{A + (size_t)pm * 128 * K, K};
        EpiStoreBf16 e{O + (size_t)pm * 128 * ldc + pn * 128, ldc};
        gemm128(lds, ap, Bt + (size_t)pn * 128 * K, K, e);
    }
}
__device__ __forceinline__ void phase_gemm_resid(unsigned char* lds, const bf16_t* A, const bf16_t* Bt, const float* resid, float* out) {
    const int nU = (T >> 7) * 8;
    for (int u = blockIdx.x; u < nU; u += gridDim.x) {
        const int pm = u >> 3, pn = u & 7;
        APlain ap{A + (size_t)pm * 128 * 1024, 1024};
        const size_t off = (size_t)pm * 128 * 1024 + pn * 128;
        EpiResidF32 e{resid + off, out + off};
        gemm128(lds, ap, Bt + (size_t)pn * 128 * 1024, 1024, e);
    }
}
__device__ __forceinline__ void phase_gemm_glu(unsigned char* lds, const Params& p) {
    pg8::Gemm g{(const bf16_t*)(p.ws + WS_Z), (const bf16_t*)(p.ws + WS_WGLU), T, 512, 512}; pg8::StaticOrder S; S.init(T, 512, (int)gridDim.x, (int)blockIdx.x);
    pg8::EpiGlu256 E{(const bf16_t*)(p.ws + WS_Z), p.in[I_S5_BGLU], (bf16_t*)(p.ws + WS_MIX)};
    pg8::gemm_phase<pg8::EpiGlu256, pg8::StaticOrder, true, true>((PG8_LAS unsigned char*)lds, g, S, E);
}
__device__ __forceinline__ void phase_gemm256_store(unsigned char* lds, const bf16_t* A, const bf16_t* Bt, int N, bf16_t* O) {
    pg8::Gemm g{A, Bt, T, N, 1024}; pg8::StaticOrder S; S.init(T, N, (int)gridDim.x, (int)blockIdx.x);
    pg8::EpiStore E{O, N};
    pg8::gemm_phase<pg8::EpiStore, pg8::StaticOrder, true, true>((PG8_LAS unsigned char*)lds, g, S, E);
}
__device__ __forceinline__ void phase_gemm256_inproj1(unsigned char* lds, const Params& p) {
    pg8::Gemm g{(const bf16_t*)(p.ws + WS_XN), (const bf16_t*)(p.ws + WS_WINC), T, PC, 1024}; pg8::StaticOrderHalfTail S; S.init(T, 8 * 256, (int)gridDim.x, (int)blockIdx.x); S.nNF = 8; S.nNT = 2;
    pg8::EpiStore E{(bf16_t*)(p.ws + WS_PROJ), PC};
    pg8::gemm_phase<pg8::EpiStore, pg8::StaticOrderHalfTail, true, true>((PG8_LAS unsigned char*)lds, g, S, E);
}
__device__ __forceinline__ void phase_gemm256_inproj0(unsigned char* lds, const Params& p) {
    pg8::Gemm g{(const bf16_t*)(p.ws + WS_XN), (const bf16_t*)(p.ws + WS_WINA), T, 3840, 1024}; pg8::StaticOrder S; S.init(T, 3840, (int)gridDim.x, (int)blockIdx.x);
    pg8::EpiStoreGates E{(bf16_t*)(p.ws + WS_PROJ), PA, 14, (float*)(p.ws + WS_GATES), p.in[I_AB_GBIAS]};
    pg8::gemm_phase<pg8::EpiStoreGates, pg8::StaticOrder, true, true>((PG8_LAS unsigned char*)lds, g, S, E);
}
__device__ __forceinline__ void phase_gemm256_resid(unsigned char* lds, const bf16_t* A, const bf16_t* Bt, const float* rf, const bf16_t* rb, bf16_t* out) {
    pg8::Gemm g{A, Bt, T, 1024, 1024}; pg8::StaticOrder S; S.init(T, 1024, (int)gridDim.x, (int)blockIdx.x);
    pg8::EpiResid E{rf, rb, out};
    pg8::gemm_phase<pg8::EpiResid, pg8::StaticOrder, true, true>((PG8_LAS unsigned char*)lds, g, S, E);
}

__device__ __forceinline__ void s5_gen_ktab(const Params& p) {
    const int gt = blockIdx.x * NTHR + opaque_tid(), NGT = gridDim.x * NTHR;
    const f32x2* POW = (const f32x2*)(p.ws + WS_S5POW); const f32x2* BB = (const f32x2*)(p.ws + WS_S5BBAR);
    for (int idx = gt; idx < 32 * 4096; idx += NGT) {
        const int g = idx >> 12, tau = (idx >> 8) & 15, ch = (idx >> 4) & 15, c = idx & 15;
        float sum = 0.f;
        for (int pp = 0; pp < 64; ++pp) {
            const f32x2 l = POW[(g * 64 + pp) * 17 + tau], b = BB[(g * 64 + pp) * 16 + c];
            const float wr_ = l.x * b.x - l.y * b.y, wi_ = l.x * b.y + l.y * b.x;
            sum += p.in[I_S5_CRE][(size_t)(g * 16 + ch) * 64 + pp] * wr_ - p.in[I_S5_CIM][(size_t)(g * 16 + ch) * 64 + pp] * wi_;
        }
        if (tau == 0 && ch == c) sum += p.in[I_S5_D][g * 16 + ch];
        ((float*)(p.ws + WS_KTAB))[idx] = sum;
    }
}
__device__ __forceinline__ void s5_gen_ops(const Params& p) {
    const int gt = blockIdx.x * NTHR + opaque_tid(), NGT = gridDim.x * NTHR;
    const f32x2* POW = (const f32x2*)(p.ws + WS_S5POW); const f32x2* BB = (const f32x2*)(p.ws + WS_S5BBAR);
    const float* KT = (const float*)(p.ws + WS_KTAB);
    bf16_t* BY = (bf16_t*)(p.ws + WS_S5Y); bf16_t* BE = (bf16_t*)(p.ws + WS_S5E);
    for (int idx = gt; idx < 32 * 256 * 48; idx += NGT) {
        const int kc = idx % 48, gn = idx / 48, n = gn & 255, g = gn >> 8, t = n >> 4, ch = n & 15, k0 = kc * 8;
        float v[8];
        if (k0 < 256) {
            const int s_ = k0 >> 4, c0 = k0 & 15;
            if (s_ <= t) {
                const f32x4 a = *(const f32x4*)(KT + ((g * 16 + (t - s_)) * 16 + ch) * 16 + c0), b = *(const f32x4*)(KT + ((g * 16 + (t - s_)) * 16 + ch) * 16 + c0 + 4);
                v[0] = a.x; v[1] = a.y; v[2] = a.z; v[3] = a.w; v[4] = b.x; v[5] = b.y; v[6] = b.z; v[7] = b.w;
            } else {
#pragma unroll
                for (int j = 0; j < 8; ++j) v[j] = 0.f;
            }
        } else {
            const int p0 = (k0 - 256) & 63; const bool re = k0 < 320;
#pragma unroll
            for (int j = 0; j < 8; ++j) {
                const int pp = p0 + j; const f32x2 l = POW[(g * 64 + pp) * 17 + t + 1];
                const float cr = p.in[I_S5_CRE][(size_t)(g * 16 + ch) * 64 + pp], ci = p.in[I_S5_CIM][(size_t)(g * 16 + ch) * 64 + pp];
                v[j] = re ? (cr * l.x - ci * l.y) : -(cr * l.y + ci * l.x);
            }
        }
        *(u32x4*)(BY + (size_t)gn * 384 + k0) = (u32x4){pk2(v[0], v[1]), pk2(v[2], v[3]), pk2(v[4], v[5]), pk2(v[6], v[7])};
    }
    for (int idx = gt; idx < 32 * 128 * 32; idx += NGT) {
        const int kc = idx & 31, gn = idx >> 5, n = gn & 127, g = gn >> 7, pp = n & 63, k0 = kc * 8, s_ = k0 >> 4, c0 = k0 & 15;
        const f32x2 l = POW[(g * 64 + pp) * 17 + 15 - s_];
        float v[8];
#pragma unroll
        for (int j = 0; j < 8; ++j) { const f32x2 b = BB[(g * 64 + pp) * 16 + c0 + j]; v[j] = (n < 64) ? (l.x * b.x - l.y * b.y) : (l.x * b.y + l.y * b.x); }
        *(u32x4*)(BE + (size_t)gn * 256 + k0) = (u32x4){pk2(v[0], v[1]), pk2(v[2], v[3]), pk2(v[4], v[5]), pk2(v[6], v[7])};
    }
}
struct AS5 {
    const bf16_t* proj; const bf16_t* xp; int m0, g;
    __device__ __forceinline__ const bf16_t* operator()(int r, int kc) const {
        const int m = m0 + r, k0 = kc * 8;
        return (k0 < 256) ? proj + ((size_t)(m * 16 + (k0 >> 4)) * PC + g * 16 + (k0 & 15)) : xp + ((size_t)m * 32 + g) * 128 + (k0 - 256);
    }
};
struct EpiS5E {
    float* xend; int m0, g;
    __device__ __forceinline__ void operator()(const f32x4 (&acc)[2][4], int wr, int wc, int fr, int fq) const {
#pragma unroll
        for (int m = 0; m < 2; ++m)
#pragma unroll
            for (int n = 0; n < 4; ++n) *(f32x4*)(xend + ((size_t)(m0 + wr * 32 + m * 16 + fr) * 32 + g) * 128 + wc * 64 + n * 16 + fq * 4) = acc[m][n];
    }
};
struct EpiS5Y {
    bf16_t* Z; int m0, g, n0;
    __device__ __forceinline__ void operator()(const f32x4 (&acc)[2][4], int wr, int wc, int fr, int fq) const {
#pragma unroll
        for (int m = 0; m < 2; ++m)
#pragma unroll
            for (int n = 0; n < 4; ++n) {
                const int mm = m0 + wr * 32 + m * 16 + fr, nc = n0 + wc * 64 + n * 16 + fq * 4, t = nc >> 4, ch0 = nc & 15;
                const f32x4 v = acc[m][n];
                u32x2 o; o.x = pk2(fgelu_tanh_(v.x), fgelu_tanh_(v.y)); o.y = pk2(fgelu_tanh_(v.z), fgelu_tanh_(v.w));
                *(u32x2*)(Z + (size_t)(mm * 16 + t) * 512 + g * 16 + ch0) = o;
            }
    }
};
__device__ __forceinline__ void s5_unit_E(const Params& p, unsigned char* lds, int u) {
    const int g = u >> 3, mt = u & 7;
    AS5 a{(const bf16_t*)(p.ws + WS_PROJ), nullptr, mt * 128, g};
    EpiS5E e{(float*)(p.ws + WS_XEND), mt * 128, g};
    gemm128(lds, a, (const bf16_t*)(p.ws + WS_S5E) + (size_t)g * 128 * 256, 256, e);
}
__device__ __forceinline__ void s5_unit_Y(const Params& p, unsigned char* lds, int u) {
    const int g = u >> 3, mt = u & 7;
    AS5 a{(const bf16_t*)(p.ws + WS_PROJ), (const bf16_t*)(p.ws + WS_XPREVB), mt * 128, g};
    EpiS5Y e0{(bf16_t*)(p.ws + WS_Z), mt * 128, g, 0}, e1{(bf16_t*)(p.ws + WS_Z), mt * 128, g, 128};
    BPlain b0{(const bf16_t*)(p.ws + WS_S5Y) + (size_t)g * 256 * 384, 384}, b1{(const bf16_t*)(p.ws + WS_S5Y) + ((size_t)g * 256 + 128) * 384, 384};
    gemm128x2(lds, a, b0, b1, 384, e0, e1);
}

__device__ __forceinline__ void stage_rows(const bf16_t* __restrict__ g, int pitch, bf16_t* s, int tid) {
#pragma unroll
    for (int i = 0; i < 2; ++i) { const int pc = tid + i * NTHR, l = pc >> 4, d0 = (pc & 15) * 8; *(u32x4*)(s + l * 136 + d0) = *(const u32x4*)(g + (size_t)l * pitch + d0); }
}
__device__ __forceinline__ void stage_transposed(const bf16_t* __restrict__ g, int pitch, bf16_t* s, const float* rs, int tid) {
#pragma unroll
    for (int i = 0; i < 2; ++i) {
        const int pc = tid + i * NTHR, l = pc >> 4, d0 = (pc & 15) * 8;
        const u32x4 v = *(const u32x4*)(g + (size_t)l * pitch + d0);
        const float sc = rs ? rs[l] : 1.f;
        const unsigned w[4] = {v.x, v.y, v.z, v.w};
#pragma unroll
        for (int q = 0; q < 4; ++q) {
            s[tsw(d0 + 2 * q, l)] = (bf16_t)f2bf(bf2f(w[q] & 0xffffu) * sc);
            s[tsw(d0 + 2 * q + 1, l)] = (bf16_t)f2bf(bf2f(w[q] >> 16) * sc);
        }
    }
}
__device__ __forceinline__ void state_outer(const bf16_t* Kt, const bf16_t* Vt, bf16_t* __restrict__ Uout, int wid, int fr, int fq) {
    const int v0 = wid * 16;
    bf16x8 bv[2];
#pragma unroll
    for (int ls = 0; ls < 2; ++ls) bv[ls] = *(const bf16x8*)(Vt + tswc(v0 + fr, ls * 4 + fq));
#pragma unroll
    for (int kt = 0; kt < 8; ++kt) {
        f32x4 acc = (f32x4){0.f, 0.f, 0.f, 0.f};
#pragma unroll
        for (int ls = 0; ls < 2; ++ls) {
            const bf16x8 ak = *(const bf16x8*)(Kt + tswc(kt * 16 + fr, ls * 4 + fq));
            acc = __builtin_amdgcn_mfma_f32_16x16x32_bf16(ak, bv[ls], acc, 0, 0, 0);
        }
        u32x2 o; o.x = pk2(acc.x, acc.y); o.y = pk2(acc.z, acc.w);
        *(u32x2*)(Uout + (size_t)(v0 + fr) * 128 + kt * 16 + fq * 4) = o;
    }
}
template <bool KRM>
__device__ __forceinline__ void state_outer_tr(const bf16_t* Kx, const bf16_t* Vs, bf16_t* __restrict__ Uout, int wid, int fr, int fq) {
    const int v0 = wid * 16;
    bf16x8 bv[2];
#pragma unroll
    for (int ls = 0; ls < 2; ++ls) bv[ls] = frag_tr(Vs, 136, ls * 32, v0, fr, fq);
#pragma unroll
    for (int kt = 0; kt < 8; ++kt) {
        f32x4 acc = (f32x4){0.f, 0.f, 0.f, 0.f};
#pragma unroll
        for (int ls = 0; ls < 2; ++ls) {
            const bf16x8 ak = KRM ? frag_tr(Kx, 136, ls * 32, kt * 16, fr, fq) : *(const bf16x8*)(Kx + tswc(kt * 16 + fr, ls * 4 + fq));
            acc = __builtin_amdgcn_mfma_f32_16x16x32_bf16(ak, bv[ls], acc, 0, 0, 0);
        }
        u32x2 o; o.x = pk2(acc.x, acc.y); o.y = pk2(acc.z, acc.w);
        *(u32x2*)(Uout + (size_t)(v0 + fr) * 128 + kt * 16 + fq * 4) = o;
    }
}
template <int GATE>
__device__ __forceinline__ void head_norm_out(const float* Hs, const float* __restrict__ w, const bf16_t* __restrict__ gsrc, int gpitch, bf16_t* __restrict__ out, int opitch, int tid) {
    const int l = tid >> 3, part = tid & 7;
    float h[16]; float ss = 0.f;
#pragma unroll
    for (int i = 0; i < 4; ++i) { const f32x4 v = *(const f32x4*)(Hs + l * 132 + part * 16 + i * 4); h[4 * i] = v.x; h[4 * i + 1] = v.y; h[4 * i + 2] = v.z; h[4 * i + 3] = v.w; ss += v.x * v.x + v.y * v.y + v.z * v.z + v.w * v.w; }
    ss += __shfl_xor(ss, 1); ss += __shfl_xor(ss, 2); ss += __shfl_xor(ss, 4);
    const float r = rsqrtf(ss * (1.f / 128.f) + EPS);
    const u32x4 g0 = *(const u32x4*)(gsrc + (size_t)l * gpitch + part * 16), g1 = *(const u32x4*)(gsrc + (size_t)l * gpitch + part * 16 + 8);
    const unsigned gw[8] = {g0.x, g0.y, g0.z, g0.w, g1.x, g1.y, g1.z, g1.w};
    unsigned ow[8];
#pragma unroll
    for (int q = 0; q < 8; ++q) {
        const float ga = bf2f(gw[q] & 0xffffu), gb = bf2f(gw[q] >> 16);
        const float a = h[2 * q] * r * w[part * 16 + 2 * q] * (GATE == 0 ? fsigmoid_(ga) : fsilu_(ga));
        const float b = h[2 * q + 1] * r * w[part * 16 + 2 * q + 1] * (GATE == 0 ? fsigmoid_(gb) : fsilu_(gb));
        ow[q] = pk2(a, b);
    }
    *(u32x4*)(out + (size_t)l * opitch + part * 16) = (u32x4){ow[0], ow[1], ow[2], ow[3]};
    *(u32x4*)(out + (size_t)l * opitch + part * 16 + 8) = (u32x4){ow[4], ow[5], ow[6], ow[7]};
}


struct Tile2 { u32x4 v[2]; };
struct Tile4 { u32x4 v[4]; };
template <bool NT = false>
__device__ __forceinline__ void tile_load(Tile2& t, const bf16_t* __restrict__ g, int pitch, int tid) {
#pragma unroll
    for (int i = 0; i < 2; ++i) { const int pc = tid + i * NTHR; const u32x4* q = (const u32x4*)(g + (size_t)(pc >> 4) * pitch + (pc & 15) * 8); t.v[i] = NT ? __builtin_nontemporal_load(q) : *q; }
}
template <bool NT = false>
__device__ __forceinline__ void tile4_load(Tile4& t, const bf16_t* __restrict__ g, int tid) {
#pragma unroll
    for (int i = 0; i < 4; ++i) { const int pc = tid + i * NTHR; const u32x4* q = (const u32x4*)(g + (size_t)pc * 8); t.v[i] = NT ? __builtin_nontemporal_load(q) : *q; }
}
__device__ __forceinline__ void tile_put_rows(const Tile2& t, bf16_t* s, int tid) {
#pragma unroll
    for (int i = 0; i < 2; ++i) { const int pc = tid + i * NTHR; *(u32x4*)(s + (pc >> 4) * 136 + (pc & 15) * 8) = t.v[i]; }
}
__device__ __forceinline__ void tile4_put(const Tile4& t, bf16_t* s, int tid) {
#pragma unroll
    for (int i = 0; i < 4; ++i) { const int pc = tid + i * NTHR; *(u32x4*)(s + (pc >> 4) * 136 + (pc & 15) * 8) = t.v[i]; }
}
__device__ __forceinline__ void tile_put_transposed(const Tile2& t, bf16_t* s, const float* rs, int tid) {
#pragma unroll
    for (int i = 0; i < 2; ++i) {
        const int pc = tid + i * NTHR, l = pc >> 4, d0 = (pc & 15) * 8;
        const unsigned w[4] = {t.v[i].x, t.v[i].y, t.v[i].z, t.v[i].w};
        if (rs) {
            const float sc = rs[l];
#pragma unroll
            for (int q = 0; q < 4; ++q) {
                const unsigned pr = pk2(bf2f(w[q] & 0xffffu) * sc, bf2f(w[q] >> 16) * sc);
                s[tsw(d0 + 2 * q, l)] = (bf16_t)(pr & 0xffffu); s[tsw(d0 + 2 * q + 1, l)] = (bf16_t)(pr >> 16);
            }
        } else {
#pragma unroll
            for (int q = 0; q < 4; ++q) { s[tsw(d0 + 2 * q, l)] = (bf16_t)(w[q] & 0xffffu); s[tsw(d0 + 2 * q + 1, l)] = (bf16_t)(w[q] >> 16); }
        }
    }
}
template <int GATE>
__device__ __forceinline__ void head_norm_out_r(const float* Hs, const float* __restrict__ w, const u32x4 (&og)[2], bf16_t* __restrict__ out, int opitch, int tid) {
    const int l = tid >> 3, part = tid & 7;
    float h[16]; float ss = 0.f;
#pragma unroll
    for (int i = 0; i < 4; ++i) { const f32x4 v = *(const f32x4*)(Hs + l * 132 + part * 16 + i * 4); h[4 * i] = v.x; h[4 * i + 1] = v.y; h[4 * i + 2] = v.z; h[4 * i + 3] = v.w; ss += v.x * v.x + v.y * v.y + v.z * v.z + v.w * v.w; }
    ss += __shfl_xor(ss, 1); ss += __shfl_xor(ss, 2); ss += __shfl_xor(ss, 4);
    const float r = rsqrtf(ss * (1.f / 128.f) + EPS);
    const unsigned gw[8] = {og[0].x, og[0].y, og[0].z, og[0].w, og[1].x, og[1].y, og[1].z, og[1].w};
    unsigned ow[8];
#pragma unroll
    for (int q = 0; q < 8; ++q) {
        const float ga = bf2f(gw[q] & 0xffffu), gb = bf2f(gw[q] >> 16);
        const float a = h[2 * q] * r * w[part * 16 + 2 * q] * (GATE == 0 ? fsigmoid_(ga) : fsilu_(ga));
        const float b = h[2 * q + 1] * r * w[part * 16 + 2 * q + 1] * (GATE == 0 ? fsigmoid_(gb) : fsilu_(gb));
        ow[q] = pk2(a, b);
    }
    *(u32x4*)(out + (size_t)l * opitch + part * 16) = (u32x4){ow[0], ow[1], ow[2], ow[3]};
    *(u32x4*)(out + (size_t)l * opitch + part * 16 + 8) = (u32x4){ow[4], ow[5], ow[6], ow[7]};
}

__device__ __forceinline__ void phase_mlstm_local(const Params& p, unsigned char* lds) {
    const int tid = opaque_tid(), lane = tid & 63, wid = tid >> 6, fr = lane & 15, fq = lane >> 4;
    unsigned char* ws = p.ws;
    const bf16_t* PROJ = (const bf16_t*)(ws + WS_PROJ);
    const float* GATES = (const float*)(ws + WS_GATES);
    bf16_t* Kt = (bf16_t*)lds;
    bf16_t* Vt = (bf16_t*)(lds + 18432);
    float* wk = (float*)(lds + 36864);
    const int NIT = 1024 + 256;
    Tile2 rk, rv; float gi = 0.f, gf = 0.f;
    auto load_item = [&](int it) {
        const int b = it >> 8, h = (it >> 6) & 3, c = it & 63, t0 = b * SEQ + c * 64;
        tile_load(rk, PROJ + (size_t)t0 * PA + 512 + h * 128, PA, tid);
        tile_load(rv, PROJ + (size_t)t0 * PA + 1024 + h * 128, PA, tid);
        gi = GATES[(size_t)(t0 + lane) * 8 + h]; gf = GATES[(size_t)(t0 + lane) * 8 + 4 + h];
    };
    if ((int)blockIdx.x < 1024) load_item(blockIdx.x);
    for (int it = blockIdx.x; it < NIT; it += gridDim.x) {
        if (it < 1024) {
            if (wid == 0) {
                const float lf = logsigmoid_(gf);
                const float bc = wave_incl_sum(lf, lane);
                const float bend = __shfl(bc, 63);
                const float logg = bend - bc + gi;
                const float ml = wave_max(logg);
                wk[lane] = expf(logg - ml);
                if (lane == 0) { ((float*)(ws + WS_MLOC))[it] = ml; ((float*)(ws + WS_BEND))[it] = bend; }
            }
            tile_put_rows(rk, Kt, tid);
            __syncthreads();
            {
#pragma unroll
                for (int i = 0; i < 2; ++i) {
                    const int pc = tid + i * NTHR, l = pc >> 4, d0 = (pc & 15) * 8; const float sc = wk[l];
                    const unsigned w[4] = {rv.v[i].x, rv.v[i].y, rv.v[i].z, rv.v[i].w};
                    u32x4 o; o.x = pk2(bf2f(w[0] & 0xffffu) * sc, bf2f(w[0] >> 16) * sc); o.y = pk2(bf2f(w[1] & 0xffffu) * sc, bf2f(w[1] >> 16) * sc);
                    o.z = pk2(bf2f(w[2] & 0xffffu) * sc, bf2f(w[2] >> 16) * sc); o.w = pk2(bf2f(w[3] & 0xffffu) * sc, bf2f(w[3] >> 16) * sc);
                    *(u32x4*)(Vt + l * 136 + d0) = o;
                }
                if (tid < 64) Vt[tid * 136 + 128] = (bf16_t)f2bf(wk[tid]);
            }
            __syncthreads();
            if (it + (int)gridDim.x < 1024) load_item(it + gridDim.x);
            state_outer_tr<true>(Kt, Vt, (bf16_t*)(ws + WS_U) + (size_t)it * 16384, wid, fr, fq);
            {
                f32x4 acc = (f32x4){0.f, 0.f, 0.f, 0.f};
#pragma unroll
                for (int ls = 0; ls < 2; ++ls) {
                    const bf16x8 bn = frag_tr(Vt, 136, ls * 32, 128, fr, fq);
                    const bf16x8 ak = frag_tr(Kt, 136, ls * 32, wid * 16, fr, fq);
                    acc = __builtin_amdgcn_mfma_f32_16x16x32_bf16(ak, bn, acc, 0, 0, 0);
                }
                if (fr == 0) *(f32x4*)((float*)(ws + WS_NLOC) + (size_t)it * 128 + wid * 16 + fq * 4) = acc;
            }
            __syncthreads();
        } else {
            const int ci = it - 1024, t0 = ci * 64, cq = tid & 63, ts = tid >> 6, c0 = cq * 8, tb = t0 + ts * 8;
            const float* cw = p.in[I_AB_CONVW];
            float w0[8], w1[8], w2[8];
#pragma unroll
            for (int j = 0; j < 8; ++j) { w0[j] = cw[c0 + j]; w1[j] = cw[512 + c0 + j]; w2[j] = cw[1024 + c0 + j]; }
            const bool halo = ((tb & (SEQ - 1)) != 0);
            float zp2[8], zp1[8];
            {
                u32x4 g2 = (u32x4){0u, 0u, 0u, 0u}, x2 = g2, g1 = g2, x1 = g2;
                if (halo) { const bf16_t* r2 = PROJ + (size_t)(tb - 2) * PA; const bf16_t* r1 = PROJ + (size_t)(tb - 1) * PA;
                    g2 = __builtin_nontemporal_load((const u32x4*)(r2 + 2560 + c0)); x2 = __builtin_nontemporal_load((const u32x4*)(r2 + 3072 + c0));
                    g1 = __builtin_nontemporal_load((const u32x4*)(r1 + 2560 + c0)); x1 = __builtin_nontemporal_load((const u32x4*)(r1 + 3072 + c0)); }
                const unsigned a0[4] = {g2.x, g2.y, g2.z, g2.w}, b0[4] = {x2.x, x2.y, x2.z, x2.w}, a1[4] = {g1.x, g1.y, g1.z, g1.w}, b1[4] = {x1.x, x1.y, x1.z, x1.w};
#pragma unroll
                for (int q = 0; q < 4; ++q) {
                    zp2[2 * q] = bf2f(a0[q] & 0xffffu) * bf2f(b0[q] & 0xffffu); zp2[2 * q + 1] = bf2f(a0[q] >> 16) * bf2f(b0[q] >> 16);
                    zp1[2 * q] = bf2f(a1[q] & 0xffffu) * bf2f(b1[q] & 0xffffu); zp1[2 * q + 1] = bf2f(a1[q] >> 16) * bf2f(b1[q] >> 16);
                }
            }
            bf16_t* mix = (bf16_t*)(ws + WS_MIX);
#pragma unroll 1
            for (int ps = 0; ps < 2; ++ps) {
                u32x4 gbv[4], gcv[4], xiv[4];
#pragma unroll
                for (int t = 0; t < 4; ++t) { const bf16_t* r = PROJ + (size_t)(tb + ps * 4 + t) * PA;
                    gbv[t] = __builtin_nontemporal_load((const u32x4*)(r + 2048 + c0)); gcv[t] = __builtin_nontemporal_load((const u32x4*)(r + 2560 + c0)); xiv[t] = __builtin_nontemporal_load((const u32x4*)(r + 3072 + c0)); }
#pragma unroll
                for (int t = 0; t < 4; ++t) {
                    const unsigned ga[4] = {gcv[t].x, gcv[t].y, gcv[t].z, gcv[t].w}, xa[4] = {xiv[t].x, xiv[t].y, xiv[t].z, xiv[t].w}, ba[4] = {gbv[t].x, gbv[t].y, gbv[t].z, gbv[t].w};
                    float y[8];
#pragma unroll
                    for (int q = 0; q < 4; ++q) {
                        const float z0 = bf2f(ga[q] & 0xffffu) * bf2f(xa[q] & 0xffffu), z1 = bf2f(ga[q] >> 16) * bf2f(xa[q] >> 16);
                        y[2 * q] = bf2f(ba[q] & 0xffffu) * (w0[2 * q] * zp2[2 * q] + w1[2 * q] * zp1[2 * q] + w2[2 * q] * z0);
                        y[2 * q + 1] = bf2f(ba[q] >> 16) * (w0[2 * q + 1] * zp2[2 * q + 1] + w1[2 * q + 1] * zp1[2 * q + 1] + w2[2 * q + 1] * z1);
                        zp2[2 * q] = zp1[2 * q]; zp1[2 * q] = z0; zp2[2 * q + 1] = zp1[2 * q + 1]; zp1[2 * q + 1] = z1;
                    }
                    *(u32x4*)(mix + (size_t)(tb + ps * 4 + t) * 1024 + 512 + c0) = (u32x4){pk2(y[0], y[1]), pk2(y[2], y[3]), pk2(y[4], y[5]), pk2(y[6], y[7])};
                }
            }
        }
    }
}

template <bool HG>
__device__ __forceinline__ void phase_scan(const Params& p, unsigned char* lds) {
    unsigned char* ws = p.ws;
    const int tid = opaque_tid();
    const int gt = blockIdx.x * NTHR + tid, NGT = gridDim.x * NTHR;
    const bf16_t* U = (const bf16_t*)(ws + WS_U);
    bf16_t* CP = (bf16_t*)(ws + WS_CPREV);
    const float* MLOC = (const float*)(ws + WS_MLOC); const float* BEND = (const float*)(ws + WS_BEND); const float* BENDV = (const float*)(ws + WS_BENDV);
    float* sd = (float*)lds;
    float* ssu = sd + 64;
    for (int base = blockIdx.x * NTHR; base < 131072; base += NGT) {
        const int idx = base + tid;
        const int bh = idx >> 13, rem = idx & 8191, e = rem >> 6, k = (rem & 63) * 2;
        if (!HG) {
            __syncthreads();
            float* sml = ssu + 64; float* sbe = sml + 64; float* smp = sbe + 64;
            if (tid < 64) { sml[tid] = MLOC[bh * 64 + tid]; sbe[tid] = BEND[bh * 64 + tid]; }
            __syncthreads();
            if (tid == 0) {
                float m = -1e30f;
                for (int c = 0; c < 64; ++c) {
                    const float ml = sml[c], be = sbe[c];
                    smp[c] = m;
                    const float mn = fmaxf(be + m, ml);
                    sd[c] = expf(be + m - mn); ssu[c] = expf(ml - mn); m = mn;
                }
            }
            __syncthreads();
            if (rem < 64 && tid < 64) ((float*)(ws + WS_MPREV))[bh * 64 + tid] = smp[tid];
            if (tid >= 504) {
                const float* NLOC = (const float*)(ws + WS_NLOC); float* NPREV = (float*)(ws + WS_NPREV);
                const int kn = ((base & 8191) >> 9) * 8 + (tid - 504);
                float n = 0.f;
#pragma unroll
                for (int hb = 0; hb < 2; ++hb) {
                    float nl[32];
#pragma unroll
                    for (int c = 0; c < 32; ++c) nl[c] = NLOC[(unsigned)((bh * 64 + hb * 32 + c) * 128 + kn)];
#pragma unroll
                    for (int c = 0; c < 32; ++c) { NPREV[(unsigned)((bh * 64 + hb * 32 + c) * 128 + kn)] = n; n = sd[hb * 32 + c] * n + ssu[hb * 32 + c] * nl[c]; }
                }
            }
        }
        float c0 = 0.f, c1 = 0.f;
#pragma unroll
        for (int half = 0; half < 2; ++half) {
            unsigned uu[32];
#pragma unroll
            for (int c = 0; c < 32; ++c) uu[c] = __builtin_nontemporal_load((const unsigned*)(U + (size_t)(bh * 64 + half * 32 + c) * 16384 + e * 128 + k));
            f32x2 bv[32];
            if (HG) {
#pragma unroll
                for (int c = 0; c < 32; ++c) bv[c] = *(const f32x2*)(BENDV + (size_t)(bh * 64 + half * 32 + c) * 128 + k);
            }
#pragma unroll
            for (int c = 0; c < 32; ++c) {
                const size_t off = (size_t)(bh * 64 + half * 32 + c) * 16384 + e * 128 + k;
                *(unsigned*)(CP + off) = pk2(c0, c1);
                const float u0 = bf2f(uu[c] & 0xffffu), u1 = bf2f(uu[c] >> 16);
                if (!HG) { const float d = sd[half * 32 + c], su = ssu[half * 32 + c]; c0 = d * c0 + su * u0; c1 = d * c1 + su * u1; }
                else { c0 = bv[c].x * c0 + u0; c1 = bv[c].y * c1 + u1; }
            }
        }
    }
    if (HG) {
        const int lane = tid & 63, wv = tid >> 6;
        if (wv < 2) {
            const f32x2* POW = (const f32x2*)(ws + WS_S5POW); const float* XEND = (const float*)(ws + WS_XEND); bf16_t* XPB = (bf16_t*)(ws + WS_XPREVB);
            for (int sb = (blockIdx.x * 2 + wv) * 16; sb < 8192; sb += gridDim.x * 32) {
                const int seq = sb + (lane & 15), seg = lane >> 4;
                const int b = seq >> 11, g = (seq >> 6) & 31, pp = seq & 63;
                const f32x2 l16 = POW[(g * 64 + pp) * 17 + 16];
                float ar = l16.x, ai = l16.y;
#pragma unroll
                for (int q = 0; q < 6; ++q) { const float nr = ar * ar - ai * ai, ni = 2.f * ar * ai; ar = nr; ai = ni; }
                const float* xe = XEND + ((size_t)(b * 256 + seg * 64) * 32 + g) * 128 + pp;
                bf16_t* xo = XPB + ((size_t)(b * 256 + seg * 64) * 32 + g) * 128 + pp;
                float xr = 0.f, xi = 0.f;
                for (int hb = 0; hb < 4; ++hb) {
                    float er[16], ei[16];
#pragma unroll
                    for (int j = 0; j < 16; ++j) { er[j] = xe[(hb * 16 + j) * 4096]; ei[j] = xe[(hb * 16 + j) * 4096 + 64]; }
#pragma unroll
                    for (int j = 0; j < 16; ++j) { const float nr = l16.x * xr - l16.y * xi + er[j], ni = l16.x * xi + l16.y * xr + ei[j]; xr = nr; xi = ni; }
                }
                float cr = 0.f, ci = 0.f;
#pragma unroll
                for (int r = 0; r < 3; ++r) {
                    const float pr = __shfl(xr, (lane & 15) + 16 * r), pi = __shfl(xi, (lane & 15) + 16 * r);
                    if (r < seg) { const float nr = ar * cr - ai * ci + pr, ni = ar * ci + ai * cr + pi; cr = nr; ci = ni; }
                }
                xr = cr; xi = ci;
                for (int hb = 0; hb < 4; ++hb) {
                    float er[16], ei[16];
#pragma unroll
                    for (int j = 0; j < 16; ++j) { er[j] = xe[(hb * 16 + j) * 4096]; ei[j] = xe[(hb * 16 + j) * 4096 + 64]; }
#pragma unroll
                    for (int j = 0; j < 16; ++j) {
                        xo[(hb * 16 + j) * 4096] = (bf16_t)f2bf(xr); xo[(hb * 16 + j) * 4096 + 64] = (bf16_t)f2bf(xi);
                        const float nr = l16.x * xr - l16.y * xi + er[j], ni = l16.x * xi + l16.y * xr + ei[j]; xr = nr; xi = ni;
                    }
                }
            }
        }
    }
}

__device__ __forceinline__ void phase_mlstm_out(const Params& p, unsigned char* lds) {
    const int tid = opaque_tid(), lane = tid & 63, wid = tid >> 6, fr = lane & 15, fq = lane >> 4;
    unsigned char* ws = p.ws;
    const bf16_t* PROJ = (const bf16_t*)(ws + WS_PROJ);
    const float* GATES = (const float*)(ws + WS_GATES);
    bf16_t* Qs = (bf16_t*)lds;
    bf16_t* Ks = (bf16_t*)(lds + 17408);
    float* Hs = (float*)lds;
    bf16_t* Vt = (bf16_t*)(lds + 34816);
    bf16_t* Cs = (bf16_t*)(lds + 53248);
    bf16_t* Ps = (bf16_t*)(lds + 88064);
    float* sa = (float*)(lds + 97280);
    float* sg = sa + 64;
    float* sisc = sg + 64;
    float* semr = sisc + 64;
    float* sdinv = semr + 64;
    float* snp = sdinv + 64;
    Tile2 rq, rk, rv; Tile4 rc; u32x4 rog[2]; float g0 = 0.f, g1 = 0.f, g2 = 0.f, g3 = 0.f, g4 = 0.f;
    auto load_item = [&](int it) {
        const int b = it >> 8, h = (it >> 6) & 3, c = it & 63, t0 = b * SEQ + c * 64;
        tile_load<true>(rq, PROJ + (size_t)t0 * PA + h * 128, PA, tid);
        tile_load<true>(rk, PROJ + (size_t)t0 * PA + 512 + h * 128, PA, tid);
        tile_load<true>(rv, PROJ + (size_t)t0 * PA + 1024 + h * 128, PA, tid);
        tile4_load<true>(rc, (const bf16_t*)(ws + WS_CPREV) + (size_t)it * 16384, tid);
        { const bf16_t* og = PROJ + (size_t)(t0 + (tid >> 3)) * PA + 1536 + h * 128 + (tid & 7) * 16; rog[0] = __builtin_nontemporal_load((const u32x4*)og); rog[1] = __builtin_nontemporal_load((const u32x4*)(og + 8)); }
        g0 = GATES[(size_t)(t0 + lane) * 8 + h]; g1 = GATES[(size_t)(t0 + lane) * 8 + 4 + h]; g2 = ((const float*)(ws + WS_MPREV))[it];
        g3 = ((const float*)(ws + WS_NPREV))[(size_t)it * 128 + lane]; g4 = ((const float*)(ws + WS_NPREV))[(size_t)it * 128 + 64 + lane];
    };
    if ((int)blockIdx.x < 1024) load_item(blockIdx.x);
    for (int it = blockIdx.x; it < 1024; it += gridDim.x) {
        const int b = it >> 8, h = (it >> 6) & 3, c = it & 63, t0 = b * SEQ + c * 64;
        if (wid == 0) {
            const float ip = g0, fp = g1, mprev = g2;
            const float bc = wave_incl_sum(logsigmoid_(fp), lane);
            const float a = ip - bc;
            const float g = fmaxf(wave_incl_max(a, lane), mprev);
            sa[lane] = a; sg[lane] = g; sisc[lane] = expf(mprev - g); semr[lane] = expf(-(bc + g));
        } else if (wid == 1) { snp[lane] = g3; snp[64 + lane] = g4; }
        tile_put_rows(rq, Qs, tid); tile_put_rows(rk, Ks, tid); tile_put_rows(rv, Vt, tid); tile4_put(rc, Cs, tid);
        const u32x4 ogc[2] = {rog[0], rog[1]};
        __syncthreads();
        if (it + (int)gridDim.x < 1024) load_item(it + gridDim.x);
#pragma unroll
        for (int i = 0; i < 2; ++i) {
            const int tix = wid * 2 + i, lt = tix >> 2, st = tix & 3;
            f32x4 acc = (f32x4){0.f, 0.f, 0.f, 0.f};
            if (st <= lt) {
#pragma unroll
                for (int ks = 0; ks < 4; ++ks) {
                    const bf16x8 ak = *(const bf16x8*)(Ks + (st * 16 + fr) * 136 + ks * 32 + fq * 8);
                    const bf16x8 bq = *(const bf16x8*)(Qs + (lt * 16 + fr) * 136 + ks * 32 + fq * 8);
                    acc = __builtin_amdgcn_mfma_f32_16x16x32_bf16(ak, bq, acc, 0, 0, 0);
                }
            }
            const int l = lt * 16 + fr; const float gl = sg[l];
            float pv[4];
#pragma unroll
            for (int r = 0; r < 4; ++r) { const int s = st * 16 + fq * 4 + r; pv[r] = (s <= l) ? acc[r] * fexp_(sa[s] - gl) : 0.f; }
            u32x2 o; o.x = pk2(pv[0], pv[1]); o.y = pk2(pv[2], pv[3]);
            *(u32x2*)(Ps + l * 72 + st * 16 + fq * 4) = o;
        }
        __syncthreads();
        {
            const int l = tid >> 3, part = tid & 7;
            float rs = 0.f, qn = 0.f;
            const u32x4 pw = *(const u32x4*)(Ps + l * 72 + part * 8);
            rs = (bf2f(pw.x & 0xffffu) + bf2f(pw.x >> 16)) + (bf2f(pw.y & 0xffffu) + bf2f(pw.y >> 16)) + (bf2f(pw.z & 0xffffu) + bf2f(pw.z >> 16)) + (bf2f(pw.w & 0xffffu) + bf2f(pw.w >> 16));
            const u32x4 q0 = *(const u32x4*)(Qs + l * 136 + part * 16), q1 = *(const u32x4*)(Qs + l * 136 + part * 16 + 8);
            const unsigned qw[8] = {q0.x, q0.y, q0.z, q0.w, q1.x, q1.y, q1.z, q1.w};
#pragma unroll
            for (int j = 0; j < 8; ++j) qn += bf2f(qw[j] & 0xffffu) * snp[part * 16 + 2 * j] + bf2f(qw[j] >> 16) * snp[part * 16 + 2 * j + 1];
            rs += __shfl_xor(rs, 1); rs += __shfl_xor(rs, 2); rs += __shfl_xor(rs, 4);
            qn += __shfl_xor(qn, 1); qn += __shfl_xor(qn, 2); qn += __shfl_xor(qn, 4);
            if (part == 0) { const float den = rs + sisc[l] * qn; sdinv[l] = 1.f / fmaxf(fabsf(den), semr[l]); }
        }
        f32x4 a1[4], a2[4];
#pragma unroll
        for (int lt = 0; lt < 4; ++lt) { a1[lt] = (f32x4){0.f, 0.f, 0.f, 0.f}; a2[lt] = (f32x4){0.f, 0.f, 0.f, 0.f}; }
        {
            const int e0 = wid * 16;
#pragma unroll
            for (int ss = 0; ss < 2; ++ss) {
                const bf16x8 av = frag_tr(Vt, 136, ss * 32, e0, fr, fq);
#pragma unroll
                for (int lt = 0; lt < 4; ++lt) { const bf16x8 bp = *(const bf16x8*)(Ps + (lt * 16 + fr) * 72 + ss * 32 + fq * 8); a1[lt] = __builtin_amdgcn_mfma_f32_16x16x32_bf16(av, bp, a1[lt], 0, 0, 0); }
            }
#pragma unroll
            for (int ks = 0; ks < 4; ++ks) {
                const bf16x8 ac = *(const bf16x8*)(Cs + (e0 + fr) * 136 + ks * 32 + fq * 8);
#pragma unroll
                for (int lt = 0; lt < 4; ++lt) { const bf16x8 bq = *(const bf16x8*)(Qs + (lt * 16 + fr) * 136 + ks * 32 + fq * 8); a2[lt] = __builtin_amdgcn_mfma_f32_16x16x32_bf16(ac, bq, a2[lt], 0, 0, 0); }
            }
        }
        __syncthreads();
        {
            const int e0 = wid * 16;
#pragma unroll
            for (int lt = 0; lt < 4; ++lt) {
                const int l = lt * 16 + fr; const float is = sisc[l], di = sdinv[l];
                const f32x4 hv = (a1[lt] + a2[lt] * is) * di;
                *(f32x4*)(Hs + l * 132 + e0 + fq * 4) = hv;
            }
        }
        __syncthreads();
        head_norm_out_r<0>(Hs, p.in[I_AB_HNORM] + h * 128, ogc, (bf16_t*)(ws + WS_MIX) + (size_t)t0 * 1024 + h * 128, 1024, tid);
        __syncthreads();
    }
}

__device__ __forceinline__ void load_h_row(const Params& p, int row, int lane, bool combine, f32x4 (&v)[4], int ylayer = 0) {
    const bf16_t* hrow = (const bf16_t*)(p.ws + WS_H16) + (size_t)row * 1024;
#pragma unroll
    for (int j = 0; j < 4; ++j) { const u32x2 a = *(const u32x2*)(hrow + 4 * lane + 256 * j); v[j] = (f32x4){bf2f(a.x & 0xffffu), bf2f(a.x >> 16), bf2f(a.y & 0xffffu), bf2f(a.y >> 16)}; }
    if (combine) {
        const bf16_t* y0 = (const bf16_t*)(p.ws + ws_y(ylayer)) + (size_t)row * 1024;
        const bf16_t* y1 = y0 + (size_t)T * 1024;
#pragma unroll
        for (int j = 0; j < 4; ++j) {
            const u32x2 a = __builtin_nontemporal_load((const u32x2*)(y0 + 4 * lane + 256 * j)), bq = __builtin_nontemporal_load((const u32x2*)(y1 + 4 * lane + 256 * j));
            v[j].x += bf2f(a.x & 0xffffu) + bf2f(bq.x & 0xffffu); v[j].y += bf2f(a.x >> 16) + bf2f(bq.x >> 16);
            v[j].z += bf2f(a.y & 0xffffu) + bf2f(bq.y & 0xffffu); v[j].w += bf2f(a.y >> 16) + bf2f(bq.y >> 16);
        }
    }
}

__device__ __forceinline__ void phase_combine_norm(const Params& p, bool final_) {
    const int tid = opaque_tid(), lane = tid & 63, wid = tid >> 6;
    const int gw = blockIdx.x * 8 + wid, NGW = gridDim.x * 8;
    for (int row = gw; row < T; row += NGW) {
        f32x4 v[4];
        load_h_row(p, row, lane, true, v, final_ ? 1 : 0);
        float* hrow = p.out + (size_t)row * 1024;
        if (!final_) {
            bf16_t* h16 = (bf16_t*)(p.ws + WS_H16) + (size_t)row * 1024;
#pragma unroll
            for (int j = 0; j < 4; ++j) { u32x2 o; o.x = pk2(v[j].x, v[j].y); o.y = pk2(v[j].z, v[j].w); *(u32x2*)(h16 + 4 * lane + 256 * j) = o; }
            rms_row(v, p.in[I_NORM_MIX] + 1024, (bf16_t*)(p.ws + WS_XN) + (size_t)row * 1024, lane);
        } else {
            float ss = 0.f;
#pragma unroll
            for (int j = 0; j < 4; ++j) ss += v[j].x * v[j].x + v[j].y * v[j].y + v[j].z * v[j].z + v[j].w * v[j].w;
            ss = wave_sum(ss);
            const float r = rsqrtf(ss * (1.f / 1024.f) + EPS);
#pragma unroll
            for (int j = 0; j < 4; ++j) { const f32x4 w4 = *(const f32x4*)(p.in[I_NORM_FINAL] + 4 * lane + 256 * j); __builtin_nontemporal_store(v[j] * r * w4, (f32x4*)(hrow + 4 * lane + 256 * j)); }
        }
    }
}

__device__ __forceinline__ void moe_convert(const Params& p, unsigned char* lds, int layer, int it_lo, int it_hi, int gw, int NGW, int wid, int lane) {
    unsigned char* ws = p.ws;
    float* scr = (float*)(lds + wid * 8704);
    const float* wg = p.in[I_MOE_WGATE] + (size_t)layer * 32 * 1024 * 256;
    const float* wu = p.in[I_MOE_WUP] + (size_t)layer * 32 * 1024 * 256;
    const float* wd = p.in[I_MOE_WDOWN] + (size_t)layer * 32 * 256 * 1024;
    bf16_t* WGU = (bf16_t*)(ws + ws_wgu(layer)); bf16_t* WD = (bf16_t*)(ws + ws_wd(layer));
    constexpr int IT_GU = 16 * 16, IT_D = 32 * 4, IT_E = IT_GU + IT_D;
    for (int it0 = it_lo + gw; it0 < it_hi; it0 += NGW) {
        const int e = it0 / IT_E; int it = it0 - e * IT_E;
        const float* src; bf16_t* dst; int ldn, ldk;
        if (it < IT_GU) {
            const int nb = it >> 4, kb = it & 15, n0 = nb * 32, k0 = kb * 64;
            const int pn = n0 >> 8, isup = (n0 >> 7) & 1, f0 = pn * 128 + (n0 & 127);
            src = (isup ? wu : wg) + (size_t)e * 1024 * 256 + (size_t)k0 * 256 + f0; ldn = 256;
            dst = WGU + (size_t)e * 512 * 1024 + (size_t)n0 * 1024 + k0; ldk = 1024;
        } else {
            it -= IT_GU;
            const int nb = it >> 2, kb = it & 3, n0 = nb * 32, k0 = kb * 64;
            src = wd + (size_t)e * 256 * 1024 + (size_t)k0 * 1024 + n0; ldn = 1024;
            dst = WD + (size_t)e * 1024 * 256 + (size_t)n0 * 256 + k0; ldk = 256;
        }
        transpose_tile(src, ldn, dst, ldk, 1.f, scr, lane);
    }
}
template <int RSEL>
__device__ __forceinline__ void phase_route(const Params& p, unsigned char* lds, int layer) {
    const int tid = opaque_tid(), lane = tid & 63, wid = tid >> 6, fr = lane & 15, fq = lane >> 4;
    const int gw = blockIdx.x * 8 + wid, NGW = gridDim.x * 8;
    unsigned char* ws = p.ws;
    if (RSEL == 1) { moe_convert(p, lds, layer, (layer == 1 && (int)gridDim.x > 128) ? MOE_CONV_EARLY : 0, MOE_CONV_ITEMS, gw, NGW, wid, lane); return; }
    float* part = (float*)lds;
    float* ssp = (float*)(lds + 98304);
    float* lg = (float*)(lds + 98304 + 2048);
    int* rexp = (int*)(lds + 98304 + 2048 + 12288 + 256);
    float* rwt = (float*)(rexp + 128);
    const bf16_t* H16 = (const bf16_t*)(ws + WS_H16);
    const bf16_t* wf = (const bf16_t*)(ws + WS_WCAT) + (size_t)layer * 2 * 6144 * 8;
    int* cnt = (int*)(ws + WS_CNT) + layer * 1024;
    int* list = (int*)(ws + WS_LIST); float* wlist = (float*)(ws + WS_WLIST);
    for (int grp = blockIdx.x; grp < T / 64; grp += gridDim.x) {
        const int row0 = grp * 64;
        if (grp != (int)blockIdx.x) __syncthreads();
        bf16x8 bh[4][3], bl[4][3];
#pragma unroll
        for (int s_ = 0; s_ < 4; ++s_)
#pragma unroll
            for (int n = 0; n < 3; ++n) {
                bh[s_][n] = *(const bf16x8*)(wf + ((size_t)((wid * 4 + s_) * 3 + n) * 64 + lane) * 8);
                bl[s_][n] = *(const bf16x8*)(wf + ((size_t)6144 + (size_t)((wid * 4 + s_) * 3 + n) * 64 + lane) * 8);
            }
#pragma unroll
        for (int rt = 0; rt < 4; ++rt) {
            bf16x8 a[4];
#pragma unroll
            for (int s_ = 0; s_ < 4; ++s_) a[s_] = *(const bf16x8*)(H16 + (size_t)(row0 + rt * 16 + fr) * 1024 + wid * 128 + s_ * 32 + fq * 8);
            f32x4 acc[3] = {(f32x4){0.f, 0.f, 0.f, 0.f}, (f32x4){0.f, 0.f, 0.f, 0.f}, (f32x4){0.f, 0.f, 0.f, 0.f}};
            float ss = 0.f;
#pragma unroll
            for (int s_ = 0; s_ < 4; ++s_) {
#pragma unroll
                for (int j = 0; j < 8; ++j) { const float x = bf2f((unsigned short)a[s_][j]); ss += x * x; }
#pragma unroll
                for (int n = 0; n < 3; ++n) {
                    acc[n] = __builtin_amdgcn_mfma_f32_16x16x32_bf16(a[s_], bl[s_][n], acc[n], 0, 0, 0);
                    acc[n] = __builtin_amdgcn_mfma_f32_16x16x32_bf16(a[s_], bh[s_][n], acc[n], 0, 0, 0);
                }
            }
            ss += __shfl_xor(ss, 16); ss += __shfl_xor(ss, 32);
            if (fq == 0) ssp[wid * 64 + rt * 16 + fr] = ss;
#pragma unroll
            for (int n = 0; n < 3; ++n)
#pragma unroll
                for (int r = 0; r < 4; ++r) part[(wid * 64 + rt * 16 + fq * 4 + r) * 48 + n * 16 + fr] = acc[n][r];
        }
        __syncthreads();
        if (tid < 64) {
            float t = 0.f;
#pragma unroll
            for (int w = 0; w < 8; ++w) t += ssp[w * 64 + tid];
            lg[64 * 48 + tid] = rsqrtf(t * (1.f / 1024.f) + EPS);
        }
        for (int i = tid; i < 64 * 48; i += NTHR) {
            float t = 0.f;
#pragma unroll
            for (int w = 0; w < 8; ++w) t += part[w * 3072 + i];
            lg[i] = t;
        }
        __syncthreads();
        if (wid == 0) {
            const int row = row0 + lane;
            const float rs = lg[64 * 48 + lane];
            const float* l = lg + lane * 48;
            const float* bg = p.in[I_MOE_BG] + layer * 4; const float* br = p.in[I_MOE_BR] + layer * 32;
            float gm = l[32] * rs + bg[0]; int gi = 0; float gl[4]; gl[0] = gm;
#pragma unroll
            for (int i = 1; i < 4; ++i) { gl[i] = l[32 + i] * rs + bg[i]; if (gl[i] > gm) { gm = gl[i]; gi = i; } }
            float gs = 0.f;
#pragma unroll
            for (int i = 0; i < 4; ++i) gs += expf(gl[i] - gm);
            const float gval = 1.f / gs;
            float m1 = -3.0e38f, m2 = -3.0e38f; int i1 = 0, i2 = 0;
#pragma unroll
            for (int i = 0; i < 8; ++i) {
                const float v = l[gi * 8 + i] * rs + br[gi * 8 + i];
                if (v > m1) { m2 = m1; i2 = i1; m1 = v; i1 = i; } else if (v > m2) { m2 = v; i2 = i; }
            }
            const float e2 = expf(m2 - m1), inv = gval / (1.f + e2);
            const int x1 = gi * 8 + i1, x2 = gi * 8 + i2;
            const unsigned long long ltm = (1ull << lane) - 1ull;
            int myc = 0, r1 = 0, r2 = 0;
#pragma unroll
            for (int e = 0; e < 32; ++e) {
                const unsigned long long b1 = __ballot(x1 == e), b2 = __ballot(x2 == e);
                const int c1 = __popcll(b1), c = c1 + __popcll(b2);
                if (lane == e) myc = c;
                if (x1 == e) r1 = __popcll(b1 & ltm);
                if (x2 == e) r2 = c1 + __popcll(b2 & ltm);
            }
            int base = 0;
            if (lane < 32 && myc > 0) base = atomicAdd(&cnt[lane * 32], myc);
            const int p1 = x1 * ECAP + __shfl(base, x1) + r1, p2 = x2 * ECAP + __shfl(base, x2) + r2;
            list[p1] = row * 2; wlist[p1] = inv;
            list[p2] = row * 2 + 1; wlist[p2] = inv * e2;
        }
#pragma unroll
        for (int s_ = 0; s_ < 4; ++s_) {
            bf16x8 a[4];
#pragma unroll
            for (int rt = 0; rt < 4; ++rt) a[rt] = *(const bf16x8*)(H16 + (size_t)(row0 + rt * 16 + fr) * 1024 + wid * 128 + s_ * 32 + fq * 8);
            const float* gp = p.in[I_NORM_FFN] + layer * 1024 + wid * 128 + s_ * 32 + fq * 8;
            const f32x4 ga = *(const f32x4*)gp, gb = *(const f32x4*)(gp + 4);
#pragma unroll
            for (int rt = 0; rt < 4; ++rt) {
                const float rs = lg[64 * 48 + rt * 16 + fr];
                const bf16x8 x = a[rt];
                u32x4 o;
                o.x = pk2(bf2f((unsigned short)x[0]) * rs * ga.x, bf2f((unsigned short)x[1]) * rs * ga.y);
                o.y = pk2(bf2f((unsigned short)x[2]) * rs * ga.z, bf2f((unsigned short)x[3]) * rs * ga.w);
                o.z = pk2(bf2f((unsigned short)x[4]) * rs * gb.x, bf2f((unsigned short)x[5]) * rs * gb.y);
                o.w = pk2(bf2f((unsigned short)x[6]) * rs * gb.z, bf2f((unsigned short)x[7]) * rs * gb.w);
                *(u32x4*)((bf16_t*)(ws + WS_XN) + (size_t)(row0 + rt * 16 + fr) * 1024 + wid * 128 + s_ * 32 + fq * 8) = o;
            }
        }
    }
    if (RSEL != 2) moe_convert(p, lds, layer, (layer == 1 && (int)gridDim.x > 128) ? MOE_CONV_EARLY : 0, MOE_CONV_ITEMS, gw, NGW, wid, lane);
}

struct AGather {
    const bf16_t* XN; const int* lst; int n;
    __device__ __forceinline__ const bf16_t* operator()(int r, int kc) const { const int tok = (r < n) ? (lst[r] >> 1) : 0; return XN + (size_t)tok * 1024 + kc * 8; }
};
struct EpiGateUp {
    bf16_t* H;
    __device__ __forceinline__ void operator()(const f32x4 (&acc)[2][4], int wr, int wc, int fr, int fq) const {
#pragma unroll
        for (int m = 0; m < 2; ++m)
#pragma unroll
            for (int n = 0; n < 2; ++n) {
                const f32x4 g = acc[m][n], u = acc[m][n + 2];
                u32x2 o; o.x = pk2(fsilu_(g.x) * u.x, fsilu_(g.y) * u.y); o.y = pk2(fsilu_(g.z) * u.z, fsilu_(g.w) * u.w);
                *(u32x2*)(H + (size_t)(wr * 32 + m * 16 + fr) * 256 + wc * 32 + n * 16 + fq * 4) = o;
            }
    }
};
struct EpiDown {
    bf16_t* Y; const int* lst; const float* wl; int n; int col0;
    __device__ __forceinline__ void operator()(const f32x4 (&acc)[2][4], int wr, int wc, int fr, int fq) const {
#pragma unroll
        for (int m = 0; m < 2; ++m) {
            const int r = wr * 32 + m * 16 + fr;
            if (r < n) {
                const int en = lst[r]; const float w = wl[r];
                bf16_t* yr = Y + ((size_t)(en & 1) * T + (en >> 1)) * 1024 + col0 + wc * 64 + fq * 4;
#pragma unroll
                for (int nn = 0; nn < 4; ++nn) { const f32x4 v = acc[m][nn] * w; u32x2 o; o.x = pk2(v.x, v.y); o.y = pk2(v.z, v.w); *(u32x2*)(yr + nn * 16) = o; }
            }
        }
    }
};
__device__ __forceinline__ void moe_prefix(const Params& p, int layer, int* tp, int* cn) {
    const int* cnt = (const int*)(p.ws + WS_CNT) + layer * 1024;
    int* sp = cn + 32;
    const int tid = opaque_tid();
    __syncthreads();
    if (tid < 32) cn[tid] = cnt[tid * 32];
    __syncthreads();
    if (tid == 0) {
        int s_ = 0, q_ = 0;
        for (int e = 0; e < 32; ++e) {
            const int c = cn[e], rem = c & 255;
            tp[e] = s_; sp[e] = q_;
            s_ += (c >> 8) + (rem > 128 ? 1 : 0); q_ += (rem > 0 && rem <= 128) ? 1 : 0;
        }
        tp[32] = s_; sp[32] = q_;
    }
    __syncthreads();
}
struct BGateUp {
    const bf16_t* W; int f0;
    __device__ __forceinline__ const bf16_t* operator()(int r, int kc) const {
        const int f = f0 + (r >> 6) * 32 + ((r >> 4) & 1) * 16 + (r & 15), isup = (r >> 5) & 1;
        return W + (size_t)((f >> 7) * 256 + isup * 128 + (f & 127)) * 1024 + kc * 8;
    }
};
constexpr int LDS_MOE_TAB = 131072, LDS_MOE_TP = 131072 + 4096;
__device__ __forceinline__ void phase_moe_up(const Params& p, unsigned char* lds, int layer) {
    unsigned* tab = (unsigned*)(lds + LDS_MOE_TAB); int* tp = (int*)(lds + LDS_MOE_TP); int* cn = tp + 64;
    moe_prefix(p, layer, tp, cn);
    pg8::SchedMoe S{tp, cn, tab, 2, tp[32] * 2, (int)gridDim.x, (int)blockIdx.x};
    const int* list = (const int*)(p.ws + WS_LIST);
    const int tid = opaque_tid();
    for (int i = 0; i < pg8::MOE_MAXU; ++i) {
        pg8::Unit u; if (!S.next(i, u)) break;
        const int e = u.pn >> 1, pos = (u.pm - tp[e]) * 256 + tid;
        if (tid < 256) tab[i * 256 + tid] = (pos < cn[e]) ? (unsigned)(list[(size_t)e * ECAP + pos] >> 1) * 2048u : 0u;
    }
    __syncthreads();
    pg8::Gemm g{(const bf16_t*)(p.ws + WS_XN), (const bf16_t*)(p.ws + ws_wgu(layer)), 0, 0, 1024};
    pg8::EpiMoeUp E{(bf16_t*)(p.ws + WS_HID)};
    pg8::gemm_phase_g<pg8::EpiMoeUp, pg8::SchedMoe>((PG8_LAS unsigned char*)lds, g, S, E);
    __syncthreads();
    const int* sp = cn + 32; const int nsm = sp[32], np8 = tp[32];
    for (int u = blockIdx.x; u < nsm * 4; u += gridDim.x) {
        const int si = u >> 2, pn4 = u & 3;
        int e = 0; while (sp[e + 1] <= si) ++e;
        const int pos0 = (tp[e + 1] - tp[e]) * 256, n = cn[e] - pos0;
        AGather ag{(const bf16_t*)(p.ws + WS_XN), list + (size_t)e * ECAP + pos0, n};
        BGateUp bg{(const bf16_t*)(p.ws + ws_wgu(layer)) + (size_t)e * 512 * 1024, pn4 * 64};
        EpiGateUp ep{(bf16_t*)(p.ws + WS_HID) + ((size_t)np8 * 256 + (size_t)si * 128) * 256 + pn4 * 64};
        gemm128b(lds, ag, bg, 1024, ep);
    }
}
__device__ __forceinline__ void phase_moe_down(const Params& p, unsigned char* lds, int layer) {
    unsigned* tab = (unsigned*)(lds + LDS_MOE_TAB); float* wtab = (float*)(lds + LDS_MOE_TAB + 4096); int* tp = (int*)(lds + LDS_MOE_TP + 4096); int* cn = tp + 64;
    moe_prefix(p, layer, tp, cn);
    pg8::SchedMoe S{tp, cn, tab, 4, tp[32] * 4, (int)gridDim.x, (int)blockIdx.x};
    const int* list = (const int*)(p.ws + WS_LIST); const float* wlist = (const float*)(p.ws + WS_WLIST);
    const int tid = opaque_tid();
    for (int i = 0; i < pg8::MOE_MAXU; ++i) {
        pg8::Unit u; if (!S.next(i, u)) break;
        const int e = u.pn >> 2, pos = (u.pm - tp[e]) * 256 + tid;
        if (tid < 256) {
            const bool ok = pos < cn[e];
            const int en = ok ? list[(size_t)e * ECAP + pos] : 0;
            tab[i * 256 + tid] = ok ? (unsigned)((en & 1) * T + (en >> 1)) : 0xffffffffu;
            wtab[i * 256 + tid] = ok ? wlist[(size_t)e * ECAP + pos] : 0.f;
        }
    }
    __syncthreads();
    pg8::Gemm g{(const bf16_t*)(p.ws + WS_HID), (const bf16_t*)(p.ws + ws_wd(layer)), 0, 0, 256};
    pg8::EpiMoeDown E{(bf16_t*)(p.ws + ws_y(layer)), tab, wtab};
    pg8::gemm_phase<pg8::EpiMoeDown, pg8::SchedMoe, true, true>((PG8_LAS unsigned char*)lds, g, S, E);
    __syncthreads();
    const int* sp = cn + 32; const int nsm = sp[32], np8 = tp[32];
    for (int u = blockIdx.x; u < nsm * 8; u += gridDim.x) {
        const int si = u >> 3, pn8 = u & 7;
        int e = 0; while (sp[e + 1] <= si) ++e;
        const int pos0 = (tp[e + 1] - tp[e]) * 256, n = cn[e] - pos0;
        APlain ap{(const bf16_t*)(p.ws + WS_HID) + ((size_t)np8 * 256 + (size_t)si * 128) * 256, 256};
        EpiDown ep{(bf16_t*)(p.ws + ws_y(layer)), list + (size_t)e * ECAP + pos0, wlist + (size_t)e * ECAP + pos0, n, pn8 * 128};
        gemm128(lds, ap, (const bf16_t*)(p.ws + ws_wd(layer)) + (size_t)e * 1024 * 256 + (size_t)pn8 * 128 * 256, 256, ep);
    }
}

constexpr int LDS_HG_SEG = 98304, LDS_HG_LBT = 106496;
struct HgBlk { float bc[4][4]; float kk[4][4]; };
__device__ __forceinline__ void hgrn_lb_table(const Params& p, float* lbt, int tid) {
    const float* lbp = p.in[I_HGRN_LB];
    lbt[tid] = sigmoid_(lbp[512 + tid] - lbp[tid]);
    __syncthreads();
}
__device__ __forceinline__ void hg_block(const bf16_t* __restrict__ fg, const float* lbt, float* seg, int tid, HgBlk& B) {
    const int k0 = (tid & 31) * 4, l0 = (tid >> 5) * 4;
    const f32x4 lb4 = *(const f32x4*)(lbt + k0);
    u32x2 w[4];
#pragma unroll
    for (int i = 0; i < 4; ++i) w[i] = *(const u32x2*)(fg + (size_t)(l0 + i) * PC + k0);
    float run[4] = {1.f, 1.f, 1.f, 1.f};
#pragma unroll
    for (int i = 0; i < 4; ++i) {
        const float x[4] = {bf2f(w[i].x & 0xffffu), bf2f(w[i].x >> 16), bf2f(w[i].y & 0xffffu), bf2f(w[i].y >> 16)};
#pragma unroll
        for (int j = 0; j < 4; ++j) {
            const float lb = lb4[j], sg = fsigmoid_(x[j]), f = lb + (1.f - lb) * sg;
            run[j] *= f; B.bc[i][j] = run[j]; B.kk[i][j] = (1.f - lb) * (1.f - sg);
        }
    }
    *(f32x4*)(seg + (tid >> 5) * 128 + k0) = (f32x4){run[0], run[1], run[2], run[3]};
}
__device__ __forceinline__ void hg_offsets(const float* seg, int tid, HgBlk& B, f32x4& bend) {
    const int k0 = (tid & 31) * 4, ls = tid >> 5;
    f32x4 off = (f32x4){1.f, 1.f, 1.f, 1.f}, tot = off;
#pragma unroll
    for (int r = 0; r < 16; ++r) { const f32x4 v = *(const f32x4*)(seg + r * 128 + k0); if (r < ls) off *= v; tot *= v; }
#pragma unroll
    for (int i = 0; i < 4; ++i)
#pragma unroll
        for (int j = 0; j < 4; ++j) B.bc[i][j] *= off[j];
    bend = tot;
}

__device__ __forceinline__ void phase_cd_local(const Params& p, unsigned char* lds) {
    const int tid = opaque_tid(), lane = tid & 63, wid = tid >> 6, fr = lane & 15, fq = lane >> 4;
    unsigned char* ws = p.ws;
    const bf16_t* PROJ = (const bf16_t*)(ws + WS_PROJ);
    bf16_t* KhT = (bf16_t*)lds;
    bf16_t* Vt = (bf16_t*)(lds + 18432);
    float* seg = (float*)(lds + LDS_HG_SEG); float* lbt = (float*)(lds + LDS_HG_LBT);
    hgrn_lb_table(p, lbt, tid);
    const int k0 = (tid & 31) * 4, l0 = (tid >> 5) * 4;
    for (int it = blockIdx.x; it < 1024 + 256; it += gridDim.x) {
        if (it < 1024) {
            const int b = it >> 8, h = (it >> 6) & 3, c = it & 63, t0 = b * SEQ + c * 64;
            HgBlk B;
            hg_block(PROJ + (size_t)t0 * PC + 1024 + h * 128, lbt + h * 128, seg, tid, B);
            Tile2 rv; tile_load(rv, PROJ + (size_t)t0 * PC + 1536 + h * 128, PC, tid);
            __syncthreads();
            f32x4 bend; hg_offsets(seg, tid, B, bend);
#pragma unroll
            for (int j = 0; j < 4; ++j) {
                u32x2 o; o.x = pk2(B.kk[0][j] * bend[j] * __builtin_amdgcn_rcpf(B.bc[0][j]), B.kk[1][j] * bend[j] * __builtin_amdgcn_rcpf(B.bc[1][j]));
                o.y = pk2(B.kk[2][j] * bend[j] * __builtin_amdgcn_rcpf(B.bc[2][j]), B.kk[3][j] * bend[j] * __builtin_amdgcn_rcpf(B.bc[3][j]));
                *(u32x2*)(KhT + tsw(k0 + j, l0)) = o;
            }
            if (tid < 32) *(f32x4*)((float*)(ws + WS_BENDV) + (size_t)it * 128 + k0) = bend;
            tile_put_rows(rv, Vt, tid);
            __syncthreads();
            state_outer_tr<false>(KhT, Vt, (bf16_t*)(ws + WS_U) + (size_t)it * 16384, wid, fr, fq);
            __syncthreads();
        } else {
            s5_unit_E(p, lds, it - 1024);
        }
    }
}

template <int SEL>
__device__ __forceinline__ void phase_cd_out(const Params& p, unsigned char* lds) {
    const int tid = opaque_tid(), lane = tid & 63, wid = tid >> 6, fr = lane & 15, fq = lane >> 4;
    unsigned char* ws = p.ws;
    const bf16_t* PROJ = (const bf16_t*)(ws + WS_PROJ);
    bf16_t* Qs = (bf16_t*)lds;
    bf16_t* Ks = (bf16_t*)(lds + 17408);
    float* Hs = (float*)lds;
    bf16_t* Vt = (bf16_t*)(lds + 34816);
    bf16_t* Ss = (bf16_t*)(lds + 53248);
    bf16_t* Ps = (bf16_t*)(lds + 88064);
    float* seg = (float*)(lds + LDS_HG_SEG); float* lbt = (float*)(lds + LDS_HG_LBT);
    hgrn_lb_table(p, lbt, tid);
    const int k0 = (tid & 31) * 4, l0 = (tid >> 5) * 4;
    for (int it = blockIdx.x + (SEL == 2 ? 1024 : 0); it < (SEL == 1 ? 1024 : 1024 + 256); it += gridDim.x) {
        if (it < 1024) {
            const int b = it >> 8, h = (it >> 6) & 3, c = it & 63, t0 = b * SEQ + c * 64;
            HgBlk B;
            hg_block(PROJ + (size_t)t0 * PC + 1024 + h * 128, lbt + h * 128, seg, tid, B);
            u32x2 qw[4];
#pragma unroll
            for (int i = 0; i < 4; ++i) qw[i] = __builtin_nontemporal_load((const u32x2*)(PROJ + (size_t)(t0 + l0 + i) * PC + 512 + h * 128 + k0));
            Tile2 rv; Tile4 rs;
            tile_load<true>(rv, PROJ + (size_t)t0 * PC + 1536 + h * 128, PC, tid);
            tile4_load<true>(rs, (const bf16_t*)(ws + WS_CPREV) + (size_t)it * 16384, tid);
            tile_put_rows(rv, Vt, tid); tile4_put(rs, Ss, tid);
            __syncthreads();
            f32x4 bend; hg_offsets(seg, tid, B, bend);
#pragma unroll
            for (int i = 0; i < 4; ++i) {
                const float q0 = bf2f(qw[i].x & 0xffffu), q1 = bf2f(qw[i].x >> 16), q2 = bf2f(qw[i].y & 0xffffu), q3 = bf2f(qw[i].y >> 16);
                const float e0 = B.bc[i][0], e1 = B.bc[i][1], e2 = B.bc[i][2], e3 = B.bc[i][3];
                u32x2 oq; oq.x = pk2(q0 * e0, q1 * e1); oq.y = pk2(q2 * e2, q3 * e3);
                u32x2 ok; ok.x = pk2(B.kk[i][0] * __builtin_amdgcn_rcpf(e0), B.kk[i][1] * __builtin_amdgcn_rcpf(e1)); ok.y = pk2(B.kk[i][2] * __builtin_amdgcn_rcpf(e2), B.kk[i][3] * __builtin_amdgcn_rcpf(e3));
                *(u32x2*)(Qs + (l0 + i) * 136 + k0) = oq; *(u32x2*)(Ks + (l0 + i) * 136 + k0) = ok;
            }
            __syncthreads();
#pragma unroll
            for (int i = 0; i < 2; ++i) {
                const int tix = wid * 2 + i, lt = tix >> 2, st = tix & 3;
                f32x4 acc = (f32x4){0.f, 0.f, 0.f, 0.f};
                if (st <= lt) {
#pragma unroll
                    for (int ks = 0; ks < 4; ++ks) {
                        const bf16x8 ak = *(const bf16x8*)(Ks + (st * 16 + fr) * 136 + ks * 32 + fq * 8);
                        const bf16x8 bq = *(const bf16x8*)(Qs + (lt * 16 + fr) * 136 + ks * 32 + fq * 8);
                        acc = __builtin_amdgcn_mfma_f32_16x16x32_bf16(ak, bq, acc, 0, 0, 0);
                    }
                }
                const int l = lt * 16 + fr;
                float pv[4];
#pragma unroll
                for (int r = 0; r < 4; ++r) { const int s_ = st * 16 + fq * 4 + r; pv[r] = (s_ <= l) ? acc[r] : 0.f; }
                u32x2 o; o.x = pk2(pv[0], pv[1]); o.y = pk2(pv[2], pv[3]);
                *(u32x2*)(Ps + l * 72 + st * 16 + fq * 4) = o;
            }
            __syncthreads();
            f32x4 a1[4];
#pragma unroll
            for (int lt = 0; lt < 4; ++lt) a1[lt] = (f32x4){0.f, 0.f, 0.f, 0.f};
            {
                const int e0 = wid * 16;
#pragma unroll
                for (int ss = 0; ss < 2; ++ss) {
                    const bf16x8 av = frag_tr(Vt, 136, ss * 32, e0, fr, fq);
#pragma unroll
                    for (int lt = 0; lt < 4; ++lt) { const bf16x8 bp = *(const bf16x8*)(Ps + (lt * 16 + fr) * 72 + ss * 32 + fq * 8); a1[lt] = __builtin_amdgcn_mfma_f32_16x16x32_bf16(av, bp, a1[lt], 0, 0, 0); }
                }
#pragma unroll
                for (int ks = 0; ks < 4; ++ks) {
                    const bf16x8 ac = *(const bf16x8*)(Ss + (e0 + fr) * 136 + ks * 32 + fq * 8);
#pragma unroll
                    for (int lt = 0; lt < 4; ++lt) { const bf16x8 bq = *(const bf16x8*)(Qs + (lt * 16 + fr) * 136 + ks * 32 + fq * 8); a1[lt] = __builtin_amdgcn_mfma_f32_16x16x32_bf16(ac, bq, a1[lt], 0, 0, 0); }
                }
            }
            __syncthreads();
            {
                const int e0 = wid * 16;
#pragma unroll
                for (int lt = 0; lt < 4; ++lt) *(f32x4*)(Hs + (lt * 16 + fr) * 132 + e0 + fq * 4) = a1[lt];
            }
            __syncthreads();
            head_norm_out<1>(Hs, p.in[I_HGRN_ONORM] + h * 128, PROJ + (size_t)t0 * PC + 2048 + h * 128, PC, (bf16_t*)(ws + WS_MIX) + (size_t)t0 * 1024 + 512 + h * 128, 1024, tid);
            __syncthreads();
        } else {
            s5_unit_Y(p, lds, it - 1024);
        }
    }
}

#define XB_TMO      128
#define XB_XCNT(j)  (256  + 64 * (j))
#define XB_XSUB(j)  (1280 + 64 * (j))
#define XB_XGEN(j)  (2304 + 64 * (j))
#define XB_TOP      3328
#define XB_TOPGEN   3392
#define XCD_BAR_WORDS 3456
#define XB_SPIN_CAP (1u << 22)
#define LAS __attribute__((address_space(3)))
constexpr size_t WS_BAR = 4096;
constexpr size_t CTL_ZERO_BYTES = 32768;
static_assert(WS_BAR + XCD_BAR_WORDS * 4 <= CTL_ZERO_BYTES, "barrier words outside the zeroed region");
constexpr int LDS_BAR_OFF = LDS_BYTES - 16;
__device__ __forceinline__ unsigned xb_ld(unsigned* p)              { return __hip_atomic_load(p, __ATOMIC_RELAXED, __HIP_MEMORY_SCOPE_AGENT); }
__device__ __forceinline__ unsigned xb_add(unsigned* p, unsigned v) { return __hip_atomic_fetch_add(p, v, __ATOMIC_RELAXED, __HIP_MEMORY_SCOPE_AGENT); }
__device__ __forceinline__ unsigned xb_xcc_id() { return (unsigned)__builtin_amdgcn_s_getreg((3 << 11) | 20) & 0xFu; }
#define XB_SPIN(cond, bar) do { unsigned _sp = 0; while (cond) { __builtin_amdgcn_s_sleep(1); \
    if ((++_sp & 255u) == 0u) { if (xb_ld(&(bar)[XB_TMO])) break; if (_sp > XB_SPIN_CAP) { atomicAdd(&(bar)[XB_TMO], 1u); break; } } } } while (0)
struct XcdBarrier { unsigned* bar; unsigned x; volatile LAS unsigned* st; };
__device__ __forceinline__ XcdBarrier xcd_barrier_post(unsigned* bar, volatile LAS unsigned* st) {
    XcdBarrier b; b.bar = bar; b.x = xb_xcc_id(); b.st = st;
    if (opaque_tid() == 0) (void)xb_add(&bar[XB_XCNT(b.x)], 1u);
    return b;
}
__device__ __forceinline__ void xcd_barrier_complete(unsigned* bar, unsigned x, unsigned& nloc, unsigned& nx) {
    const unsigned G = gridDim.x * gridDim.y * gridDim.z;
    unsigned sum, cnt, mine, sp = 0u;
    for (;;) {
        sum = 0u; cnt = 0u; mine = 0u;
#pragma unroll
        for (unsigned j = 0; j < 16; ++j) { const unsigned c = xb_ld(&bar[XB_XCNT(j)]); sum += c; cnt += (c > 0u) ? 1u : 0u; mine = (j == x) ? c : mine; }
        if (sum == G) break;
        __builtin_amdgcn_s_sleep(1);
        if ((++sp & 255u) == 0u) { if (xb_ld(&bar[XB_TMO])) break; if (sp > XB_SPIN_CAP) { atomicAdd(&bar[XB_TMO], 1u); break; } }
    }
    nloc = mine > 0u ? mine : 1u; nx = cnt > 0u ? cnt : 1u;
}
__device__ __forceinline__ void xcd_barrier(const XcdBarrier& b) {
    asm volatile("s_waitcnt vmcnt(0)" ::: "memory");
    __syncthreads();
    if (opaque_tid() == 0) {
        unsigned* bar = b.bar;
        __builtin_amdgcn_s_waitcnt(0);
        unsigned nloc = b.st[0], nx = b.st[1];
        if (nloc == 0u) { xcd_barrier_complete(bar, b.x, nloc, nx); b.st[0] = nloc; b.st[1] = nx; }
        const unsigned old = xb_add(&bar[XB_XSUB(b.x)], 1u);
        const unsigned gen = old / nloc;
        if (old + 1u == (gen + 1u) * nloc) {
            __builtin_amdgcn_fence(__ATOMIC_RELEASE, "agent");
            asm volatile("s_waitcnt vmcnt(0)" ::: "memory");
            const unsigned og = xb_add(&bar[XB_TOP], 1u);
            const unsigned tg = og / nx;
            if (og + 1u == (tg + 1u) * nx) xb_add(&bar[XB_TOPGEN], 1u);
            else XB_SPIN(xb_ld(&bar[XB_TOPGEN]) == tg, bar);
            __builtin_amdgcn_fence(__ATOMIC_ACQUIRE, "agent");
            xb_add(&bar[XB_XGEN(b.x)], 1u);
            asm volatile("s_waitcnt vmcnt(0)" ::: "memory");
        } else {
            XB_SPIN(xb_ld(&bar[XB_XGEN(b.x)]) == gen, bar);
            __builtin_amdgcn_fence(__ATOMIC_ACQUIRE, "agent");
            asm volatile("s_waitcnt vmcnt(0)" ::: "memory");
        }
    }
    __syncthreads();
}

constexpr int NPHASE = 20;
constexpr unsigned REP_MASK = 0u;
constexpr int PROBE_SEL = 0;
template <int PH>
__device__ __forceinline__ void run_phase(const Params& p, unsigned char* lds) {
    unsigned char* ws = p.ws;
    if constexpr (PH == 0) phase_prep(p, lds);
    else if constexpr (PH == 1) { s5_gen_ktab(p); phase_gemm256_inproj0(lds, p); }
    else if constexpr (PH == 2) { s5_gen_ops(p); phase_mlstm_local(p, lds); }
    else if constexpr (PH == 3) phase_scan<false>(p, lds);
    else if constexpr (PH == 4) phase_mlstm_out(p, lds);
    else if constexpr (PH == 5) phase_gemm256_resid(lds, (const bf16_t*)(ws + WS_MIX), (const bf16_t*)(ws + WS_WOUTA), nullptr, (const bf16_t*)(ws + WS_H16), (bf16_t*)(ws + WS_H16));
    else if constexpr (PH == 6) phase_route<0>(p, lds, 0);
    else if constexpr (PH == 7) phase_moe_up(p, lds, 0);
    else if constexpr (PH == 8) phase_moe_down(p, lds, 0);
    else if constexpr (PH == 9) phase_combine_norm(p, false);
    else if constexpr (PH == 10) phase_gemm256_inproj1(lds, p);
    else if constexpr (PH == 11) phase_cd_local(p, lds);
    else if constexpr (PH == 12) phase_scan<true>(p, lds);
    else if constexpr (PH == 13) phase_cd_out<0>(p, lds);
    else if constexpr (PH == 14) {
        phase_gemm_glu(lds, p);
        if ((int)blockIdx.x >= 128) { const int t_ = opaque_tid(); moe_convert(p, lds, 1, 0, MOE_CONV_EARLY, ((int)blockIdx.x - 128) * 8 + (t_ >> 6), ((int)gridDim.x - 128) * 8, t_ >> 6, t_ & 63); }
    }
    else if constexpr (PH == 15) phase_gemm256_resid(lds, (const bf16_t*)(ws + WS_MIX), (const bf16_t*)(ws + WS_WOUTC), nullptr, (const bf16_t*)(ws + WS_H16), (bf16_t*)(ws + WS_H16));
    else if constexpr (PH == 16) phase_route<0>(p, lds, 1);
    else if constexpr (PH == 17) phase_moe_up(p, lds, 1);
    else if constexpr (PH == 18) phase_moe_down(p, lds, 1);
    else if constexpr (PH == 19) phase_combine_norm(p, true);
}
template <int PH>
__device__ __forceinline__ void run_from(const Params& p, unsigned char* lds, const XcdBarrier& bar) {
    run_phase<PH>(p, lds);
    if constexpr ((REP_MASK >> PH) & 1u) {
        xcd_barrier(bar);
        if constexpr (PH == 6 || PH == 16) { { const int t_ = opaque_tid(); if (blockIdx.x == 0 && t_ < 32) ((int*)(p.ws + WS_CNT))[(PH == 16 ? 1024 : 0) + t_ * 32] = 0; } xcd_barrier(bar); }
        if constexpr (PH == 13 && PROBE_SEL != 0) phase_cd_out<PROBE_SEL>(p, lds); else
        if constexpr (PH == 6 && PROBE_SEL != 0) phase_route<PROBE_SEL>(p, lds, 0); else
        run_phase<PH>(p, lds);
    }
    if constexpr (PH + 1 < NPHASE) {
        xcd_barrier(bar);
        run_from<PH + 1>(p, lds, bar);
    }
}
__global__ void __launch_bounds__(NTHR, 2) mega(Params p) {
    extern __shared__ __attribute__((aligned(16))) unsigned char lds[];
    if (p.use_cg) cg::this_grid().sync();
    { const int t_ = opaque_tid(); if (t_ < 4) ((unsigned*)(lds + LDS_BAR_OFF))[t_] = 0u; }
    __syncthreads();
    const XcdBarrier bar = xcd_barrier_post((unsigned*)(p.ws + WS_BAR), (volatile LAS unsigned*)(lds + LDS_BAR_OFF));
    run_from<0>(p, lds, bar);
}

extern "C" void kernel_launch(void* const* d_in, const int* in_sizes, int n_in, void* d_out, int out_size, void* d_ws, size_t ws_size, hipStream_t stream) {
    static int grid = 0;
    if (grid == 0) {
        if (n_in != 30 || out_size != T * DM || ws_size < WS_END) { fprintf(stderr, "kernel_launch: unexpected shapes (n_in %d out %d ws %zu)\n", n_in, out_size, ws_size); grid = -1; return; }
        int dev = 0, cus = 0, per_cu = 0;
        (void)hipGetDevice(&dev);
        (void)hipDeviceGetAttribute(&cus, hipDeviceAttributeMultiprocessorCount, dev);
        (void)hipFuncSetAttribute((const void*)mega, hipFuncAttributeMaxDynamicSharedMemorySize, LDS_BYTES);
        (void)hipOccupancyMaxActiveBlocksPerMultiprocessor(&per_cu, (const void*)mega, NTHR, LDS_BYTES);
        if (per_cu < 1) { fprintf(stderr, "kernel_launch: occupancy query says %d blocks per CU\n", per_cu); per_cu = 1; }
        grid = cus * 1;
        (void)hipGetLastError();
    }
    if (grid < 0) return;
    Params p{};
    for (int i = 0; i < 30; ++i) p.in[i] = (const float*)d_in[i];
    p.out = (float*)d_out; p.ws = (unsigned char*)d_ws;
    p.use_cg = 0; p.pad = 0;
    (void)hipMemsetAsync((unsigned char*)d_ws + WS_CTL, 0, CTL_ZERO_BYTES, stream);
    void* args[] = {&p};
    hipError_t e = hipLaunchCooperativeKernel((const void*)mega, dim3(grid), dim3(NTHR), args, LDS_BYTES, stream);
    if (e != hipSuccess) fprintf(stderr, "cooperative launch failed: %s (grid %d)\n", hipGetErrorString(e), grid);
}
```

```cpp
#include <hip/hip_runtime.h>
#include <hip/hip_cooperative_groups.h>
#include <cstdio>
#include <cstdint>
namespace cg = cooperative_groups;

typedef unsigned short bf16_t;
typedef short bf16x8 __attribute__((ext_vector_type(8)));
typedef float f32x4 __attribute__((ext_vector_type(4)));
typedef float f32x2 __attribute__((ext_vector_type(2)));
typedef unsigned u32x4 __attribute__((ext_vector_type(4)));
typedef unsigned u32x2 __attribute__((ext_vector_type(2)));

constexpr int T = 16384, DM = 1024, SEQ = 4096;
constexpr int NTHR = 512;
constexpr int PA = 3584;
constexpr int PC = 2560;
constexpr int ECAP = 16384;
constexpr float EPS = 1e-6f;

constexpr size_t KB = 1024, MB = 1024 * 1024;
constexpr size_t WS_CTL = 0;
constexpr size_t WS_CNT = 20480;
constexpr size_t WS_GATES = 64 * KB;
constexpr size_t WS_S5POW = WS_GATES + 512 * KB;
constexpr size_t WS_S5BBAR = WS_S5POW + 272 * KB;
constexpr size_t WS_WCAT = WS_S5BBAR + 256 * KB;
constexpr size_t WS_NLOC = WS_WCAT + 384 * KB;
constexpr size_t WS_NPREV = WS_NLOC + 512 * KB;
constexpr size_t WS_BENDV = WS_NPREV + 512 * KB;
constexpr size_t WS_MLOC = WS_BENDV + 512 * KB;
constexpr size_t WS_BEND = WS_MLOC + 4 * KB;
constexpr size_t WS_MPREV = WS_BEND + 4 * KB;
constexpr size_t WS_KTAB = 3072 * KB;
static_assert(WS_MPREV + 4 * KB <= WS_KTAB && WS_KTAB + 512 * KB <= 4 * MB, "small region overflow");
constexpr size_t WS_S5Y = 4 * MB;
constexpr size_t WS_S5E = 10 * MB;
constexpr size_t WS_WINA = 12 * MB;
constexpr size_t WS_WOUTA = 20 * MB;
constexpr size_t WS_WINC = 22 * MB;
constexpr size_t WS_WOUTC = 27 * MB;
constexpr size_t WS_WGLU = 29 * MB;
constexpr size_t WS_A = 30 * MB;
constexpr size_t WS_B = 142 * MB;
constexpr size_t WS_C = 174 * MB;
constexpr size_t WS_D = 206 * MB;
constexpr size_t WS_H16 = 238 * MB;
constexpr size_t WS_END = 270 * MB;
constexpr size_t WS_PROJ = WS_A, WS_LIST = WS_A, WS_WLIST = WS_A + 2 * MB, WS_HID = WS_A + 4 * MB, WS_Y = WS_A + 28 * MB;
constexpr size_t WS_XN = WS_B, WS_U = WS_B, WS_Z = WS_B;
constexpr size_t WS_XEND = WS_A + 84 * MB;
constexpr size_t WS_XPREVB = WS_A + 100 * MB;
constexpr size_t WS_MIX = WS_C, WS_CPREV = WS_D, WS_WGU = WS_C, WS_WD = WS_C + 32 * MB;

__host__ __device__ constexpr size_t ws_wgu(int layer) { return layer == 0 ? WS_C : WS_A + 64 * MB; }
__host__ __device__ constexpr size_t ws_wd(int layer) { return layer == 0 ? WS_C + 32 * MB : WS_A + 96 * MB; }
__host__ __device__ constexpr size_t ws_y(int layer) { return layer == 0 ? WS_A + 28 * MB : WS_C; }
constexpr int MOE_CONV_ITEMS = 32 * (16 * 16 + 32 * 4);
constexpr int MOE_CONV_EARLY = MOE_CONV_ITEMS / 2;
constexpr int LDS_BYTES = 144 * 1024;

struct Params { const float* in[30]; float* out; unsigned char* ws; int use_cg; int pad; };

enum { I_X = 0, I_NORM_MIX, I_NORM_FFN, I_NORM_FINAL, I_AB_WIN, I_AB_GBIAS, I_AB_HNORM, I_AB_CONVW, I_AB_WOUT, I_CD_WIN, I_S5_LRE, I_S5_LIM, I_S5_BRE, I_S5_BIM,
       I_S5_CRE, I_S5_CIM, I_S5_D, I_S5_LOGDT, I_S5_WGLU, I_S5_BGLU, I_HGRN_LB, I_HGRN_ONORM, I_CD_WOUT, I_MOE_WG, I_MOE_BG, I_MOE_WR, I_MOE_BR, I_MOE_WGATE, I_MOE_WUP, I_MOE_WDOWN };

__device__ __forceinline__ int opaque_tid() { int t = threadIdx.x; asm volatile("" : "+v"(t)); return t; }
__device__ __forceinline__ float bf2f(unsigned v) { return __uint_as_float(v << 16); }
typedef __bf16 bf16x2_t __attribute__((ext_vector_type(2)));
__device__ __forceinline__ unsigned pk2(float lo, float hi) { const f32x2 v = {lo, hi}; return __builtin_bit_cast(unsigned, __builtin_convertvector(v, bf16x2_t)); }
__device__ __forceinline__ unsigned f2bf(float f) { return (unsigned)__builtin_bit_cast(unsigned short, (__bf16)f); }
__device__ __forceinline__ float wave_sum(float v) {
#pragma unroll
    for (int o = 32; o; o >>= 1) v += __shfl_xor(v, o);
    return v;
}
__device__ __forceinline__ float wave_max(float v) {
#pragma unroll
    for (int o = 32; o; o >>= 1) v = fmaxf(v, __shfl_xor(v, o));
    return v;
}
__device__ __forceinline__ float wave_incl_sum(float v, int lane) {
#pragma unroll
    for (int o = 1; o < 64; o <<= 1) { const float t = __shfl_up(v, o); if (lane >= o) v += t; }
    return v;
}
__device__ __forceinline__ float wave_incl_max(float v, int lane) {
#pragma unroll
    for (int o = 1; o < 64; o <<= 1) { const float t = __shfl_up(v, o); if (lane >= o) v = fmaxf(v, t); }
    return v;
}
__device__ __forceinline__ float sigmoid_(float x) { return 1.f / (1.f + expf(-x)); }
__device__ __forceinline__ float fexp_(float x) { return __expf(x); }
__device__ __forceinline__ float fsigmoid_(float x) { return __builtin_amdgcn_rcpf(1.f + __expf(-x)); }
__device__ __forceinline__ float fsilu_(float x) { return x * __builtin_amdgcn_rcpf(1.f + __expf(-x)); }
__device__ __forceinline__ float fgelu_tanh_(float x) { const float u = 0.7978845608028654f * (x + 0.044715f * x * x * x); return x * __builtin_amdgcn_rcpf(1.f + __expf(-2.f * u)); }
__device__ __forceinline__ float logsigmoid_(float x) { return fminf(x, 0.f) - log1pf(expf(-fabsf(x))); }
__device__ __forceinline__ float silu_(float x) { return x / (1.f + expf(-x)); }
__device__ __forceinline__ float gelu_tanh_(float x) { const float u = 0.7978845608028654f * (x + 0.044715f * x * x * x); return 0.5f * x * (1.f + tanhf(u)); }
#define LDS_WAIT() asm volatile("s_waitcnt lgkmcnt(0)" ::: "memory")
__device__ __forceinline__ int tsw(int d, int l) { return d * 72 + (l ^ (((d >> 3) & 7) << 3)); }
__device__ __forceinline__ int tswc(int d, int c) { return d * 72 + ((c ^ ((d >> 3) & 7)) << 3); }
#define LDS_AS __attribute__((address_space(3)))
typedef short s16x4 __attribute__((ext_vector_type(4)));
__device__ __forceinline__ bf16x8 frag_tr(const bf16_t* T, int pitch, int k0, int n0, int fr, int fq) {
    const bf16_t* a = T + (k0 + 8 * fq + (fr >> 2)) * pitch + n0 + 4 * (fr & 3);
    const s16x4 lo = __builtin_amdgcn_ds_read_tr16_b64_v4i16((LDS_AS s16x4*)a);
    const s16x4 hi = __builtin_amdgcn_ds_read_tr16_b64_v4i16((LDS_AS s16x4*)(a + 4 * pitch));
    return (bf16x8){lo[0], lo[1], lo[2], lo[3], hi[0], hi[1], hi[2], hi[3]};
}

struct BPlain {
    const bf16_t* Bt; int K;
    __device__ __forceinline__ const bf16_t* operator()(int r, int kc) const { return Bt + (size_t)r * K + kc * 8; }
};
template <class APiece, class BPiece, class Epi>
__device__ __forceinline__ void gemm128b(unsigned char* lds, const APiece& apiece, const BPiece& bpiece, int K, const Epi& epi) {
    const int tid = opaque_tid(), lane = tid & 63, wid = tid >> 6, wr = wid >> 1, wc = wid & 1, fr = lane & 15, fq = lane >> 4;
    const int nt = K >> 6;
    const int r0 = tid >> 3, c0 = tid & 7;
    const int so0 = r0 * 128 + ((c0 ^ (r0 & 7)) << 4), so1 = so0 + 64 * 128;
    u32x4 xa0 = *(const u32x4*)apiece(r0, c0), xa1 = *(const u32x4*)apiece(r0 + 64, c0), xb0 = *(const u32x4*)bpiece(r0, c0), xb1 = *(const u32x4*)bpiece(r0 + 64, c0);
    u32x4 ya0 = *(const u32x4*)apiece(r0, 8 + c0), ya1 = *(const u32x4*)apiece(r0 + 64, 8 + c0), yb0 = *(const u32x4*)bpiece(r0, 8 + c0), yb1 = *(const u32x4*)bpiece(r0 + 64, 8 + c0);
    f32x4 acc[2][4];
#pragma unroll
    for (int m = 0; m < 2; ++m)
#pragma unroll
        for (int n = 0; n < 4; ++n) acc[m][n] = (f32x4){0.f, 0.f, 0.f, 0.f};
#define G128_PUT(buf, A0, A1, B0, B1) do { unsigned char* d_ = lds + (buf) * 16384; *(u32x4*)(d_ + so0) = A0; *(u32x4*)(d_ + so1) = A1; *(u32x4*)(d_ + 32768 + so0) = B0; *(u32x4*)(d_ + 32768 + so1) = B1; } while (0)
#define G128_GET(t, A0, A1, B0, B1) do { const int kc_ = (t) * 8 + c0; A0 = *(const u32x4*)apiece(r0, kc_); A1 = *(const u32x4*)apiece(r0 + 64, kc_); B0 = *(const u32x4*)bpiece(r0, kc_); B1 = *(const u32x4*)bpiece(r0 + 64, kc_); } while (0)
#define G128_MMA(buf) do { const unsigned char* sa = lds + (buf) * 16384; const unsigned char* sb = lds + 32768 + (buf) * 16384; \
        _Pragma("unroll") for (int kk = 0; kk < 2; ++kk) { bf16x8 a[2], b[4]; \
            _Pragma("unroll") for (int m = 0; m < 2; ++m) { const int row = wr * 32 + m * 16 + fr; a[m] = *(const bf16x8*)(sa + row * 128 + (((kk * 4 + fq) ^ (row & 7)) << 4)); } \
            _Pragma("unroll") for (int n = 0; n < 4; ++n) { const int row = wc * 64 + n * 16 + fr; b[n] = *(const bf16x8*)(sb + row * 128 + (((kk * 4 + fq) ^ (row & 7)) << 4)); } \
            _Pragma("unroll") for (int m = 0; m < 2; ++m) _Pragma("unroll") for (int n = 0; n < 4; ++n) acc[m][n] = __builtin_amdgcn_mfma_f32_16x16x32_bf16(b[n], a[m], acc[m][n], 0, 0, 0); } } while (0)
    G128_PUT(0, xa0, xa1, xb0, xb1);
    __syncthreads();
#pragma unroll 1
    for (int kt = 0; kt < nt; kt += 2) {
        if (kt + 2 < nt) G128_GET(kt + 2, xa0, xa1, xb0, xb1);
        G128_MMA(0);
        G128_PUT(1, ya0, ya1, yb0, yb1);
        __syncthreads();
        if (kt + 3 < nt) G128_GET(kt + 3, ya0, ya1, yb0, yb1);
        G128_MMA(1);
        if (kt + 2 < nt) G128_PUT(0, xa0, xa1, xb0, xb1);
        __syncthreads();
    }
#undef G128_PUT
#undef G128_GET
#undef G128_MMA
    epi(acc, wr, wc, fr, fq);
}

template <class APiece, class Epi>
__device__ __forceinline__ void gemm128(unsigned char* lds, const APiece& apiece, const bf16_t* __restrict__ Bt, int K, const Epi& epi) {
    BPlain b{Bt, K};
    gemm128b(lds, apiece, b, K, epi);
}

template <class APiece, class BPiece, class Epi0, class Epi1>
__device__ __forceinline__ void gemm128x2(unsigned char* lds, const APiece& apiece, const BPiece& bp0f, const BPiece& bp1f, int K, const Epi0& epi0, const Epi1& epi1) {
    const int tid = opaque_tid(), lane = tid & 63, wid = tid >> 6, wr = wid >> 1, wc = wid & 1, fr = lane & 15, fq = lane >> 4;
    const int nt = K >> 6;
    const int r0 = tid >> 3, c0 = tid & 7;
    const int so0 = r0 * 128 + ((c0 ^ (r0 & 7)) << 4), so1 = so0 + 64 * 128;
    u32x4 ra0 = *(const u32x4*)apiece(r0, c0), ra1 = *(const u32x4*)apiece(r0 + 64, c0);
    u32x4 rb0 = *(const u32x4*)bp0f(r0, c0), rb1 = *(const u32x4*)bp0f(r0 + 64, c0);
    u32x4 rc0 = *(const u32x4*)bp1f(r0, c0), rc1 = *(const u32x4*)bp1f(r0 + 64, c0);
    f32x4 acc0[2][4], acc1[2][4];
#pragma unroll
    for (int m = 0; m < 2; ++m)
#pragma unroll
        for (int n = 0; n < 4; ++n) { acc0[m][n] = (f32x4){0.f, 0.f, 0.f, 0.f}; acc1[m][n] = (f32x4){0.f, 0.f, 0.f, 0.f}; }
    *(u32x4*)(lds + so0) = ra0; *(u32x4*)(lds + so1) = ra1;
    *(u32x4*)(lds + 32768 + so0) = rb0; *(u32x4*)(lds + 32768 + so1) = rb1;
    *(u32x4*)(lds + 65536 + so0) = rc0; *(u32x4*)(lds + 65536 + so1) = rc1;
    __syncthreads();
#pragma unroll 1
    for (int kt = 0; kt < nt; ++kt) {
        const int cur = kt & 1;
        if (kt + 1 < nt) {
            const int kc = (kt + 1) * 8 + c0;
            ra0 = *(const u32x4*)apiece(r0, kc); ra1 = *(const u32x4*)apiece(r0 + 64, kc);
            rb0 = *(const u32x4*)bp0f(r0, kc); rb1 = *(const u32x4*)bp0f(r0 + 64, kc);
            rc0 = *(const u32x4*)bp1f(r0, kc); rc1 = *(const u32x4*)bp1f(r0 + 64, kc);
        }
        const unsigned char* sa = lds + cur * 16384;
        const unsigned char* sb = lds + 32768 + cur * 16384;
        const unsigned char* sc = lds + 65536 + cur * 16384;
#pragma unroll
        for (int kk = 0; kk < 2; ++kk) {
            bf16x8 a[2], b[4], c[4];
#pragma unroll
            for (int m = 0; m < 2; ++m) { const int row = wr * 32 + m * 16 + fr; a[m] = *(const bf16x8*)(sa + row * 128 + (((kk * 4 + fq) ^ (row & 7)) << 4)); }
#pragma unroll
            for (int n = 0; n < 4; ++n) { const int row = wc * 64 + n * 16 + fr; const int o = row * 128 + (((kk * 4 + fq) ^ (row & 7)) << 4); b[n] = *(const bf16x8*)(sb + o); c[n] = *(const bf16x8*)(sc + o); }
#pragma unroll
            for (int m = 0; m < 2; ++m)
#pragma unroll
                for (int n = 0; n < 4; ++n) { acc0[m][n] = __builtin_amdgcn_mfma_f32_16x16x32_bf16(b[n], a[m], acc0[m][n], 0, 0, 0); acc1[m][n] = __builtin_amdgcn_mfma_f32_16x16x32_bf16(c[n], a[m], acc1[m][n], 0, 0, 0); }
        }
        if (kt + 1 < nt) {
            unsigned char* da = lds + (cur ^ 1) * 16384;
            *(u32x4*)(da + so0) = ra0; *(u32x4*)(da + so1) = ra1;
            *(u32x4*)(da + 32768 + so0) = rb0; *(u32x4*)(da + 32768 + so1) = rb1;
            *(u32x4*)(da + 65536 + so0) = rc0; *(u32x4*)(da + 65536 + so1) = rc1;
        }
        __syncthreads();
    }
    epi0(acc0, wr, wc, fr, fq);
    epi1(acc1, wr, wc, fr, fq);
}
struct APlain {
    const bf16_t* A; int K;
    __device__ __forceinline__ const bf16_t* operator()(int r, int kc) const { return A + (size_t)r * K + kc * 8; }
};

namespace pg8 {
#define PG8_LAS __attribute__((address_space(3)))
typedef unsigned short bf16_t;
typedef short bf16x8 __attribute__((ext_vector_type(8)));
typedef float f32x4 __attribute__((ext_vector_type(4)));
typedef unsigned u32x4 __attribute__((ext_vector_type(4)));
constexpr int BM = 256, BK = 64, HALF = 128, HTB = HALF * BK * 2  , STAGE_BYTES = 8 * HTB, NXCD = 8, WGM = 8;

__host__ __device__ __forceinline__ int lds_byte(int r, int c) { const int st = (r >> 4) * 2 + (c >> 5), rr = r & 15, cc = c & 31, ob = rr * 64 + cc * 2; return st * 1024 + (ob ^ (((ob >> 9) & 1) << 5)); }
__host__ __device__ __forceinline__ void stage_rc(int b, int& R, int& C) { const int st = b / 1024, sb = b % 1024, swz = sb ^ (((sb >> 9) & 1) << 5); R = (st >> 1) * 16 + swz / 64; C = (st & 1) * 32 + (swz % 64) / 2; }
__host__ __device__ __forceinline__ int perm32(int rho) { const int n = rho >> 4, i = rho & 15; return 8 * (i >> 2) + 4 * n + (i & 3); }

struct Unit { int pm, pn, aux, half, nh; };
struct Gemm { const bf16_t* A; const bf16_t* Bt; int M, N, K; };

struct StaticOrder {
    int nM, nN, nwg, G, c;
    __host__ __device__ void init(int M, int N, int G_, int c_) { nM = M / BM; nN = N / BM; nwg = nM * nN; G = G_; c = c_; }
    __host__ __device__ __forceinline__ bool next(int i, Unit& u) const {
        const long L = (long)i * G + c; if (L >= nwg) return false;
        int wgid = (int)L; { const int q = nwg / NXCD, r = nwg % NXCD, xcd = wgid % NXCD, off = wgid / NXCD; wgid = (xcd < r ? xcd * (q + 1) : r * (q + 1) + (xcd - r) * q) + off; }
        const int nig = WGM * nN, gid = wgid / nig, fm = gid * WGM, gsz = (nM - fm) < WGM ? (nM - fm) : WGM;
        u.pm = fm + ((wgid % nig) % gsz); u.pn = (wgid % nig) / gsz; u.aux = 0; u.half = 0; u.nh = 0; return true;
    }
    __device__ __forceinline__ void a_ready(const Unit&) const {}
    __device__ __forceinline__ void done(const Unit&) const {}
};

struct StaticOrderHalfTail : StaticOrder {
    int nNF, nNT;
    __device__ __forceinline__ bool next(int i, Unit& u) const {
        const long L = (long)i * G + c; const int nw = nM * nNT * 2;
        if (L >= (long)nwg + nw) return false;
        const bool tail = L >= nwg;
        int wgid = tail ? 0 : (int)L; { const int q = nwg / NXCD, r = nwg % NXCD, xcd = wgid % NXCD, off = wgid / NXCD; wgid = (xcd < r ? xcd * (q + 1) : r * (q + 1) + (xcd - r) * q) + off; }
        const int nig = WGM * nN, gid = wgid / nig, fm = gid * WGM, gsz = (nM - fm) < WGM ? (nM - fm) : WGM;
        const int pm_f = fm + ((wgid % nig) % gsz), pn_f = (wgid % nig) / gsz;
        int wg = tail ? (int)(L - nwg) : 0; { const int q = nw / NXCD, rr = nw % NXCD, xcd = wg % NXCD, off = wg / NXCD; wg = (xcd < rr ? xcd * (q + 1) : rr * (q + 1) + (xcd - rr) * q) + off; }
        const int t = wg % (nNT * 2);
        u.pm = tail ? wg / (nNT * 2) : pm_f; u.pn = tail ? nNF + (t >> 1) : pn_f; u.nh = tail ? 1 + (t & 1) : 0; u.aux = 0; u.half = 0;
        return true;
    }
};
__device__ __forceinline__ unsigned cvt_pk_bf16(float lo, float hi) { unsigned r; asm volatile("v_cvt_pk_bf16_f32 %0, %1, %2" : "=v"(r) : "v"(lo), "v"(hi)); return r; }
template <class Epi, class Sched, bool ALIGN_EPI = false, bool SP2 = false>
__device__ __forceinline__ void gemm_phase(PG8_LAS unsigned char* lds, const Gemm g, const Sched& S, const Epi& E) {
    const int tid = opaque_tid(), wid = __builtin_amdgcn_readfirstlane(tid >> 6), lane = tid & 63, wr = wid >> 2, wc = wid & 3, fr = lane & 15, fq = lane >> 4;
    const int K = g.K, nt = K / BK;
    unsigned voffA[2], voffB[2];
#pragma unroll
    for (int i = 0; i < 2; ++i) { int R, C; stage_rc(tid * 16 + i * 8192, R, C); const int Rb = Epi::PERM ? ((R & ~31) + perm32(R & 31)) : R;
        voffA[i] = (unsigned)(R * K + C) * 2u; voffB[i] = (unsigned)(Rb * K + C) * 2u; }
    const size_t kstep = (size_t)(BK * 2);
    const size_t hstep = (size_t)HALF * K * 2;
    const size_t tstep = 2 * hstep;
    const unsigned ldsw = (unsigned)wid * 1024u;
    const int aoff = lds_byte(wr * 64 + fr, fq * 8), boff = lds_byte(wc * 32 + fr, fq * 8);
#define PG8_SA(b, h) (((b) * 2 + (h)) * HTB)
#define PG8_SB(b, h) ((4 + (b) * 2 + (h)) * HTB)
#define PG8_STAGE(bufoff, gbase, voff) do { _Pragma("unroll") for (int _i = 0; _i < 2; ++_i) \
        __builtin_amdgcn_global_load_lds((const unsigned*)((const char*)(gbase) + (voff)[_i]), (PG8_LAS unsigned*)(lds + (bufoff) + ldsw + _i * 8192), 16, 0, 0); } while (0)
#define PG8_LDA(dst, b, h) do { _Pragma("unroll") for (int m = 0; m < 4; ++m) _Pragma("unroll") for (int k = 0; k < 2; ++k) dst[m][k] = *(const PG8_LAS bf16x8*)(lds + PG8_SA(b, h) + aoff + m * 2048 + k * 1024); } while (0)
#define PG8_LDB(dst, b, h) do { _Pragma("unroll") for (int n = 0; n < 2; ++n) _Pragma("unroll") for (int k = 0; k < 2; ++k) dst[n][k] = *(const PG8_LAS bf16x8*)(lds + PG8_SB(b, h) + boff + n * 2048 + k * 1024); } while (0)
#define PG8_MMA(ai, bj, At, Bt) do { __builtin_amdgcn_s_setprio(1); _Pragma("unroll") for (int m = 0; m < 4; ++m) _Pragma("unroll") for (int n = 0; n < 2; ++n) _Pragma("unroll") for (int k = 0; k < 2; ++k) \
        acc[ai][bj][m][n] = __builtin_amdgcn_mfma_f32_16x16x32_bf16(Bt[n][k], At[m][k], acc[ai][bj][m][n], 0, 0, 0); __builtin_amdgcn_s_setprio(0); } while (0)
#define PG8_WAIT_V(n) asm volatile("s_waitcnt vmcnt(" #n ")" ::: "memory")
#define PG8_WAIT_L(n) asm volatile("s_waitcnt lgkmcnt(" #n ")" ::: "memory")
#define PG8_BAR __builtin_amdgcn_s_barrier()
#define PG8_SCHED __builtin_amdgcn_sched_barrier(0)
    Unit cur, nxt; int ui = 0;
    if (!S.next(0, cur)) return;
    f32x4 acc[2][2][4][2];
#pragma unroll
    for (int a = 0; a < 2; ++a)
#pragma unroll
        for (int b = 0; b < 2; ++b)
#pragma unroll
            for (int m = 0; m < 4; ++m)
#pragma unroll
                for (int n = 0; n < 2; ++n) acc[a][b][m][n] = (f32x4){0.f, 0.f, 0.f, 0.f};
    bf16x8 At[4][2], B0[2][2], B1[2][2];
    const char* cA = (const char*)g.A + (size_t)cur.pm * tstep; const char* cB = (const char*)g.Bt + (size_t)cur.pn * tstep;
    S.a_ready(cur);
    if constexpr (SP2) {
        PG8_STAGE(PG8_SB(0, 0), cB, voffB); PG8_STAGE(PG8_SB(0, 1), cB + hstep, voffB); PG8_STAGE(PG8_SA(0, 0), cA, voffA); PG8_STAGE(PG8_SA(0, 1), cA + hstep, voffA);
        if (wr == 1) PG8_BAR;
        PG8_WAIT_V(2); PG8_BAR;
        PG8_STAGE(PG8_SB(1, 0), cB + kstep, voffB); PG8_STAGE(PG8_SA(1, 0), cA + kstep, voffA); PG8_STAGE(PG8_SB(1, 1), cB + hstep + kstep, voffB);
        PG8_WAIT_V(6); PG8_BAR;
    } else {
        PG8_STAGE(PG8_SB(0, 0), cB, voffB); PG8_STAGE(PG8_SA(0, 0), cA, voffA); PG8_STAGE(PG8_SB(0, 1), cB + hstep, voffB); PG8_STAGE(PG8_SA(0, 1), cA + hstep, voffA);
        if (wr == 1) PG8_BAR;
        PG8_WAIT_V(4); PG8_BAR;
        PG8_STAGE(PG8_SB(1, 0), cB + kstep, voffB); PG8_STAGE(PG8_SA(1, 0), cA + kstep, voffA); PG8_STAGE(PG8_SB(1, 1), cB + hstep + kstep, voffB);
        PG8_WAIT_V(6); PG8_BAR;
    }
    for (;;) {
        const bool has_next = S.next(ui + 1, nxt);
        const char* nA = has_next ? (const char*)g.A + (size_t)nxt.pm * tstep : cA; const char* nB = has_next ? (const char*)g.Bt + (size_t)nxt.pn * tstep : cB;
        for (int t = 0; t < nt; t += 2) {
            const bool last = (t == nt - 2);
            const char* a1 = cA + (size_t)(t + 1) * kstep;
            const char* a2 = last ? nA : cA + (size_t)(t + 2) * kstep; const char* b2 = last ? nB : cB + (size_t)(t + 2) * kstep;
            const char* a3 = a2 + kstep; const char* b3 = b2 + kstep;
            if (last && has_next) S.a_ready(nxt);
            if constexpr (SP2) {
            PG8_LDB(B0, 0, 0); PG8_LDB(B1, 0, 1); PG8_SCHED; PG8_LDA(At, 0, 0); PG8_STAGE(PG8_SA(1, 1), a1 + hstep, voffA);
            PG8_WAIT_V(8); PG8_WAIT_L(0); PG8_BAR; if (cur.nh != 2) PG8_MMA(0, 0, At, B0); if (cur.nh != 1) PG8_MMA(0, 1, At, B1); PG8_BAR; PG8_SCHED;
            PG8_LDA(At, 0, 1); PG8_STAGE(PG8_SB(0, 0), b2, voffB); PG8_STAGE(PG8_SB(0, 1), b2 + hstep, voffB); PG8_STAGE(PG8_SA(0, 0), a2, voffA);
            PG8_WAIT_V(8); PG8_WAIT_L(0); PG8_BAR; if (!cur.half) { if (cur.nh != 2) PG8_MMA(1, 0, At, B0); if (cur.nh != 1) PG8_MMA(1, 1, At, B1); } PG8_BAR; PG8_SCHED;
            PG8_LDB(B0, 1, 0); PG8_LDB(B1, 1, 1); PG8_SCHED; PG8_LDA(At, 1, 0); PG8_STAGE(PG8_SA(0, 1), a2 + hstep, voffA);
            PG8_WAIT_V(8); PG8_WAIT_L(0); PG8_BAR; if (cur.nh != 2) PG8_MMA(0, 0, At, B0); if (cur.nh != 1) PG8_MMA(0, 1, At, B1); PG8_BAR; PG8_SCHED;
            PG8_LDA(At, 1, 1); PG8_STAGE(PG8_SB(1, 0), b3, voffB); PG8_STAGE(PG8_SB(1, 1), b3 + hstep, voffB); PG8_STAGE(PG8_SA(1, 0), a3, voffA);
            PG8_WAIT_V(8); PG8_WAIT_L(0); PG8_BAR; if (!cur.half) { if (cur.nh != 2) PG8_MMA(1, 0, At, B0); if (cur.nh != 1) PG8_MMA(1, 1, At, B1); } PG8_BAR; PG8_SCHED;
            } else {
            PG8_LDB(B0, 0, 0); PG8_SCHED; PG8_LDA(At, 0, 0); PG8_STAGE(PG8_SA(1, 1), a1 + hstep, voffA);
            PG8_WAIT_L(8); PG8_BAR; PG8_WAIT_L(0); PG8_MMA(0, 0, At, B0); PG8_BAR; PG8_SCHED;
            PG8_LDB(B1, 0, 1); PG8_STAGE(PG8_SB(0, 0), b2, voffB);
            PG8_BAR; PG8_WAIT_L(0); PG8_MMA(0, 1, At, B1); PG8_BAR;
            PG8_LDA(At, 0, 1); PG8_STAGE(PG8_SA(0, 0), a2, voffA);
            PG8_BAR; PG8_WAIT_L(0); PG8_MMA(1, 0, At, B0); PG8_BAR; PG8_SCHED;
            PG8_STAGE(PG8_SB(0, 1), b2 + hstep, voffB);
            PG8_WAIT_V(6); PG8_BAR; PG8_MMA(1, 1, At, B1); PG8_BAR;
            PG8_LDB(B0, 1, 0); PG8_SCHED; PG8_LDA(At, 1, 0); PG8_STAGE(PG8_SA(0, 1), a2 + hstep, voffA);
            PG8_WAIT_L(8); PG8_BAR; PG8_WAIT_L(0); PG8_MMA(0, 0, At, B0); PG8_BAR; PG8_SCHED;
            PG8_LDB(B1, 1, 1); PG8_STAGE(PG8_SB(1, 0), b3, voffB);
            PG8_BAR; PG8_WAIT_L(0); PG8_MMA(0, 1, At, B1); PG8_BAR;
            PG8_LDA(At, 1, 1); PG8_STAGE(PG8_SA(1, 0), a3, voffA);
            PG8_BAR; PG8_WAIT_L(0); PG8_MMA(1, 0, At, B0); PG8_BAR; PG8_SCHED;
            PG8_STAGE(PG8_SB(1, 1), b3 + hstep, voffB);
            PG8_WAIT_V(6); PG8_BAR; PG8_MMA(1, 1, At, B1); PG8_BAR;
            }
        }
        if constexpr (ALIGN_EPI) { if (wr == 0) PG8_BAR; }
        if constexpr (!Epi::AFTER_DRAIN) { E(acc, cur, wr, wc, fr, fq); S.done(cur); }
        if (!has_next) break;
#pragma unroll
        for (int a = 0; a < 2; ++a)
#pragma unroll
            for (int b = 0; b < 2; ++b)
#pragma unroll
                for (int m = 0; m < 4; ++m)
#pragma unroll
                    for (int n = 0; n < 2; ++n) acc[a][b][m][n] = (f32x4){0.f, 0.f, 0.f, 0.f};
        cur = nxt; cA = nA; cB = nB; ++ui;
        if constexpr (ALIGN_EPI) { if (wr == 1) PG8_BAR; }
    }
    PG8_WAIT_V(0);
    if constexpr (!ALIGN_EPI) { if (wr == 0) PG8_BAR; }
    PG8_BAR;
    if constexpr (Epi::AFTER_DRAIN) { E.fused(acc, cur, wr, wc, fr, fq, lds, wid, lane); S.done(cur); }
#undef PG8_SA
#undef PG8_SB
#undef PG8_STAGE
#undef PG8_LDA
#undef PG8_LDB
#undef PG8_MMA
#undef PG8_WAIT_V
#undef PG8_WAIT_L
#undef PG8_BAR
#undef PG8_SCHED
}

struct EpiStore {
    static constexpr bool PERM = true, AFTER_DRAIN = false;
    bf16_t* O; int ldc;
    __device__ __forceinline__ void operator()(const f32x4 (&acc)[2][2][4][2], const Unit& u, int wr, int wc, int fr, int fq) const {
        asm volatile("s_nop 7\n\ts_nop 7" ::: "memory");
        const int row0 = u.pm * BM + wr * 64 + fr, col0 = u.pn * BM + wc * 32 + 8 * fq;
#pragma unroll
        for (int ai = 0; ai < 2; ++ai)
#pragma unroll
            for (int m = 0; m < 4; ++m) { bf16_t* rowp = O + (size_t)(row0 + ai * HALF + m * 16) * ldc + col0;
#pragma unroll
                for (int bj = 0; bj < 2; ++bj) { if (u.nh == 2 - bj) continue; const f32x4 v0 = acc[ai][bj][m][0], v1 = acc[ai][bj][m][1];
                    u32x4 w; w.x = cvt_pk_bf16(v0[0], v0[1]); w.y = cvt_pk_bf16(v0[2], v0[3]); w.z = cvt_pk_bf16(v1[0], v1[1]); w.w = cvt_pk_bf16(v1[2], v1[3]);
                    *(u32x4*)(rowp + bj * HALF) = w; } }
    }
};
struct EpiStoreGates {
    static constexpr bool PERM = true, AFTER_DRAIN = false;
    bf16_t* O; int ldc; int gate_pn; float* gates; const float* gbias;
    __device__ __forceinline__ void operator()(const f32x4 (&acc)[2][2][4][2], const Unit& u, int wr, int wc, int fr, int fq) const {
        asm volatile("s_nop 7\n\ts_nop 7" ::: "memory");
        const int row0 = u.pm * BM + wr * 64 + fr;
        if (u.pn == gate_pn) {
            if (wc == 0 && fq == 0) {
                const f32x4 b0 = *(const f32x4*)gbias, b1 = *(const f32x4*)(gbias + 4);
#pragma unroll
                for (int ai = 0; ai < 2; ++ai)
#pragma unroll
                    for (int m = 0; m < 4; ++m) { float* g = gates + (size_t)(row0 + ai * HALF + m * 16) * 8;
                        *(f32x4*)g = acc[ai][0][m][0] + b0; *(f32x4*)(g + 4) = acc[ai][0][m][1] + b1; }
            }
            return;
        }
        const int col0 = u.pn * BM + wc * 32 + 8 * fq;
#pragma unroll
        for (int ai = 0; ai < 2; ++ai)
#pragma unroll
            for (int m = 0; m < 4; ++m) { bf16_t* rowp = O + (size_t)(row0 + ai * HALF + m * 16) * ldc + col0;
#pragma unroll
                for (int bj = 0; bj < 2; ++bj) { const f32x4 v0 = acc[ai][bj][m][0], v1 = acc[ai][bj][m][1];
                    u32x4 w; w.x = cvt_pk_bf16(v0[0], v0[1]); w.y = cvt_pk_bf16(v0[2], v0[3]); w.z = cvt_pk_bf16(v1[0], v1[1]); w.w = cvt_pk_bf16(v1[2], v1[3]);
                    *(u32x4*)(rowp + bj * HALF) = w; } }
    }
};
struct EpiResid {
    static constexpr bool PERM = true, AFTER_DRAIN = false;
    const float* rf; const bf16_t* rb; bf16_t* out;
    __device__ __forceinline__ void operator()(const f32x4 (&acc)[2][2][4][2], const Unit& u, int wr, int wc, int fr, int fq) const {
        const int row0 = u.pm * BM + wr * 64 + fr, col0 = u.pn * BM + wc * 32 + 8 * fq;
#pragma unroll
        for (int ai = 0; ai < 2; ++ai)
#pragma unroll
            for (int m = 0; m < 4; ++m) { const size_t off = (size_t)(row0 + ai * HALF + m * 16) * 1024 + col0;
#pragma unroll
                for (int bj = 0; bj < 2; ++bj) {
                    f32x4 r0, r1;
                    if (rf) { r0 = *(const f32x4*)(rf + off + bj * HALF); r1 = *(const f32x4*)(rf + off + bj * HALF + 4); }
                    else { const u32x4 q = *(const u32x4*)(rb + off + bj * HALF);
                        r0 = (f32x4){__uint_as_float(q.x << 16), __uint_as_float(q.x & 0xffff0000u), __uint_as_float(q.y << 16), __uint_as_float(q.y & 0xffff0000u)};
                        r1 = (f32x4){__uint_as_float(q.z << 16), __uint_as_float(q.z & 0xffff0000u), __uint_as_float(q.w << 16), __uint_as_float(q.w & 0xffff0000u)}; }
                    const f32x4 v0 = acc[ai][bj][m][0] + r0, v1 = acc[ai][bj][m][1] + r1;
                    u32x4 w; w.x = cvt_pk_bf16(v0[0], v0[1]); w.y = cvt_pk_bf16(v0[2], v0[3]); w.z = cvt_pk_bf16(v1[0], v1[1]); w.w = cvt_pk_bf16(v1[2], v1[3]);
                    *(u32x4*)(out + off + bj * HALF) = w; } }
    }
};

template <class Epi, class Sched>
__device__ __forceinline__ void gemm_phase_g(PG8_LAS unsigned char* lds, const Gemm g, const Sched& S, const Epi& E) {
    const int tid = opaque_tid(), wid = __builtin_amdgcn_readfirstlane(tid >> 6), lane = tid & 63, wr = wid >> 2, wc = wid & 3, fr = lane & 15, fq = lane >> 4;
    const int K = g.K, nt = K / BK;
    int RA[2], CA[2]; unsigned voffB[2];
#pragma unroll
    for (int i = 0; i < 2; ++i) { int R, C; stage_rc(tid * 16 + i * 8192, R, C); RA[i] = R; CA[i] = C; const int Rb = Epi::PERM ? ((R & ~31) + perm32(R & 31)) : R; voffB[i] = (unsigned)(Rb * K + C) * 2u; }
    const size_t kstep = (size_t)(BK * 2);
    const size_t hstep = (size_t)HALF * K * 2;
    const size_t tstep = 2 * hstep;
    const unsigned ldsw = (unsigned)wid * 1024u;
    const int aoff = lds_byte(wr * 64 + fr, fq * 8), boff = lds_byte(wc * 32 + fr, fq * 8);
#define PG8_SA(b, h) (((b) * 2 + (h)) * HTB)
#define PG8_SB(b, h) ((4 + (b) * 2 + (h)) * HTB)
#define PG8_STAGE(bufoff, gbase, voff) do { _Pragma("unroll") for (int _i = 0; _i < 2; ++_i) \
        __builtin_amdgcn_global_load_lds((const unsigned*)((const char*)(gbase) + (voff)[_i]), (PG8_LAS unsigned*)(lds + (bufoff) + ldsw + _i * 8192), 16, 0, 0); } while (0)
#define PG8_LDA(dst, b, h) do { _Pragma("unroll") for (int m = 0; m < 4; ++m) _Pragma("unroll") for (int k = 0; k < 2; ++k) dst[m][k] = *(const PG8_LAS bf16x8*)(lds + PG8_SA(b, h) + aoff + m * 2048 + k * 1024); } while (0)
#define PG8_LDB(dst, b, h) do { _Pragma("unroll") for (int n = 0; n < 2; ++n) _Pragma("unroll") for (int k = 0; k < 2; ++k) dst[n][k] = *(const PG8_LAS bf16x8*)(lds + PG8_SB(b, h) + boff + n * 2048 + k * 1024); } while (0)
#define PG8_MMA(ai, bj, At, Bt) do { __builtin_amdgcn_s_setprio(1); _Pragma("unroll") for (int m = 0; m < 4; ++m) _Pragma("unroll") for (int n = 0; n < 2; ++n) _Pragma("unroll") for (int k = 0; k < 2; ++k) \
        acc[ai][bj][m][n] = __builtin_amdgcn_mfma_f32_16x16x32_bf16(Bt[n][k], At[m][k], acc[ai][bj][m][n], 0, 0, 0); __builtin_amdgcn_s_setprio(0); } while (0)
#define PG8_WAIT_V(n) asm volatile("s_waitcnt vmcnt(" #n ")" ::: "memory")
#define PG8_WAIT_L(n) asm volatile("s_waitcnt lgkmcnt(" #n ")" ::: "memory")
#define PG8_BAR __builtin_amdgcn_s_barrier()
#define PG8_SCHED __builtin_amdgcn_sched_barrier(0)
    Unit cur, nxt; int ui = 0;
    if (!S.next(0, cur)) return;
    f32x4 acc[2][2][4][2];
#pragma unroll
    for (int a = 0; a < 2; ++a)
#pragma unroll
        for (int b = 0; b < 2; ++b)
#pragma unroll
            for (int m = 0; m < 4; ++m)
#pragma unroll
                for (int n = 0; n < 2; ++n) acc[a][b][m][n] = (f32x4){0.f, 0.f, 0.f, 0.f};
    bf16x8 At[4][2], B0[2][2], B1[2][2];
    unsigned oc[2][2];
    S.aoff(0, RA, CA, oc);
    const char* Ab = (const char*)g.A;
    const char* cB = (const char*)g.Bt + (size_t)cur.pn * tstep;
    PG8_STAGE(PG8_SB(0, 0), cB, voffB); PG8_STAGE(PG8_SB(0, 1), cB + hstep, voffB); PG8_STAGE(PG8_SA(0, 0), Ab, oc[0]); PG8_STAGE(PG8_SA(0, 1), Ab, oc[1]);
    if (wr == 1) PG8_BAR;
    PG8_WAIT_V(2); PG8_BAR;
    PG8_STAGE(PG8_SB(1, 0), cB + kstep, voffB); PG8_STAGE(PG8_SA(1, 0), Ab + kstep, oc[0]); PG8_STAGE(PG8_SB(1, 1), cB + hstep + kstep, voffB);
    PG8_WAIT_V(6); PG8_BAR;
    for (;;) {
        const bool has_next = S.next(ui + 1, nxt);
        const char* nB = has_next ? (const char*)g.Bt + (size_t)nxt.pn * tstep : cB;
        for (int t = 0; t < nt; t += 2) {
            const bool last = (t == nt - 2);
            const char* a1 = Ab + (size_t)(t + 1) * kstep;
            const char* a2 = last ? Ab : Ab + (size_t)(t + 2) * kstep; const char* b2 = last ? nB : cB + (size_t)(t + 2) * kstep;
            const char* a3 = a2 + kstep; const char* b3 = b2 + kstep;
            unsigned o2[2][2];
            if (last && has_next) S.aoff(ui + 1, RA, CA, o2);
            else { o2[0][0] = oc[0][0]; o2[0][1] = oc[0][1]; o2[1][0] = oc[1][0]; o2[1][1] = oc[1][1]; }
            PG8_LDB(B0, 0, 0); PG8_LDB(B1, 0, 1); PG8_SCHED; PG8_LDA(At, 0, 0); PG8_STAGE(PG8_SA(1, 1), a1, oc[1]);
            PG8_WAIT_V(8); PG8_WAIT_L(0); PG8_BAR; if (cur.nh != 2) PG8_MMA(0, 0, At, B0); if (cur.nh != 1) PG8_MMA(0, 1, At, B1); PG8_BAR; PG8_SCHED;
            PG8_LDA(At, 0, 1); PG8_STAGE(PG8_SB(0, 0), b2, voffB); PG8_STAGE(PG8_SB(0, 1), b2 + hstep, voffB); PG8_STAGE(PG8_SA(0, 0), a2, o2[0]);
            PG8_WAIT_V(8); PG8_WAIT_L(0); PG8_BAR; if (!cur.half) { if (cur.nh != 2) PG8_MMA(1, 0, At, B0); if (cur.nh != 1) PG8_MMA(1, 1, At, B1); } PG8_BAR; PG8_SCHED;
            PG8_LDB(B0, 1, 0); PG8_LDB(B1, 1, 1); PG8_SCHED; PG8_LDA(At, 1, 0); PG8_STAGE(PG8_SA(0, 1), a2, o2[1]);
            PG8_WAIT_V(8); PG8_WAIT_L(0); PG8_BAR; if (cur.nh != 2) PG8_MMA(0, 0, At, B0); if (cur.nh != 1) PG8_MMA(0, 1, At, B1); PG8_BAR; PG8_SCHED;
            PG8_LDA(At, 1, 1); PG8_STAGE(PG8_SB(1, 0), b3, voffB); PG8_STAGE(PG8_SB(1, 1), b3 + hstep, voffB); PG8_STAGE(PG8_SA(1, 0), a3, o2[0]);
            PG8_WAIT_V(8); PG8_WAIT_L(0); PG8_BAR; if (!cur.half) { if (cur.nh != 2) PG8_MMA(1, 0, At, B0); if (cur.nh != 1) PG8_MMA(1, 1, At, B1); } PG8_BAR; PG8_SCHED;
        }
        if (wr == 0) PG8_BAR;
        E(acc, cur, wr, wc, fr, fq);
        if (!has_next) break;
#pragma unroll
        for (int a = 0; a < 2; ++a)
#pragma unroll
            for (int b = 0; b < 2; ++b)
#pragma unroll
                for (int m = 0; m < 4; ++m)
#pragma unroll
                    for (int n = 0; n < 2; ++n) acc[a][b][m][n] = (f32x4){0.f, 0.f, 0.f, 0.f};
        cur = nxt; cB = nB; ++ui;
        S.aoff(ui, RA, CA, oc);
        if (wr == 1) PG8_BAR;
    }
    PG8_WAIT_V(0);
    PG8_BAR;
#undef PG8_SA
#undef PG8_SB
#undef PG8_STAGE
#undef PG8_LDA
#undef PG8_LDB
#undef PG8_MMA
#undef PG8_WAIT_V
#undef PG8_WAIT_L
#undef PG8_BAR
#undef PG8_SCHED
}

constexpr int MOE_MAXU = 4;
struct SchedMoe {
    const int* tp; const int* cn; const unsigned* tab;
    int NT, nU, G, c;
    __device__ __forceinline__ bool next(int i, Unit& u) const {
        if (i >= MOE_MAXU) return false;
        const long L = (long)i * G + c; if (L >= nU) return false;
        int wgid = (int)L; { const int q = nU / NXCD, r = nU % NXCD, xcd = wgid % NXCD, off = wgid / NXCD; wgid = (xcd < r ? xcd * (q + 1) : r * (q + 1) + (xcd - r) * q) + off; }
        const int ti = wgid / NT, pn = wgid - ti * NT;
        int e = 0; while (tp[e + 1] <= ti) ++e;
        u.pm = ti; u.pn = e * NT + pn; u.aux = i; u.half = (cn[e] - (ti - tp[e]) * BM <= HALF) ? 1 : 0; u.nh = 0; return true;
    }
    __device__ __forceinline__ void aoff(int ui, const int (&RA)[2], const int (&CA)[2], unsigned (&o)[2][2]) const {
#pragma unroll
        for (int h = 0; h < 2; ++h)
#pragma unroll
            for (int i = 0; i < 2; ++i) o[h][i] = tab[ui * 256 + h * HALF + RA[i]] + (unsigned)CA[i] * 2u;
    }
    __device__ __forceinline__ void a_ready(const Unit&) const {}
    __device__ __forceinline__ void done(const Unit&) const {}
};
__device__ __forceinline__ float silu_f(float x) { return x * __builtin_amdgcn_rcpf(1.f + __expf(-x)); }
__device__ __forceinline__ float sig_f(float x) { return __builtin_amdgcn_rcpf(1.f + __expf(-x)); }
struct EpiGlu256 {
    static constexpr bool PERM = true, AFTER_DRAIN = false;
    const bf16_t* Z; const float* b; bf16_t* mix;
    __device__ __forceinline__ void operator()(const f32x4 (&acc)[2][2][4][2], const Unit& u, int wr, int wc, int fr, int fq) const {
        const int row0 = u.pm * BM + wr * 64 + fr, col0 = u.pn * BM + wc * 32 + 8 * fq;
#pragma unroll
        for (int ai = 0; ai < 2; ++ai)
#pragma unroll
            for (int m = 0; m < 4; ++m) { const size_t r = (size_t)(row0 + ai * HALF + m * 16);
#pragma unroll
                for (int bj = 0; bj < 2; ++bj) { const int c = col0 + bj * HALF;
                    const u32x4 q = *(const u32x4*)(Z + r * 512 + c);
                    const f32x4 b0 = *(const f32x4*)(b + c), b1 = *(const f32x4*)(b + c + 4);
                    const f32x4 v0 = acc[ai][bj][m][0] + b0, v1 = acc[ai][bj][m][1] + b1;
                    const float z0 = __uint_as_float(q.x << 16), z1 = __uint_as_float(q.x & 0xffff0000u), z2 = __uint_as_float(q.y << 16), z3 = __uint_as_float(q.y & 0xffff0000u);
                    const float z4 = __uint_as_float(q.z << 16), z5 = __uint_as_float(q.z & 0xffff0000u), z6 = __uint_as_float(q.w << 16), z7 = __uint_as_float(q.w & 0xffff0000u);
                    u32x4 w; w.x = cvt_pk_bf16(z0 * sig_f(v0[0]), z1 * sig_f(v0[1])); w.y = cvt_pk_bf16(z2 * sig_f(v0[2]), z3 * sig_f(v0[3]));
                    w.z = cvt_pk_bf16(z4 * sig_f(v1[0]), z5 * sig_f(v1[1])); w.w = cvt_pk_bf16(z6 * sig_f(v1[2]), z7 * sig_f(v1[3]));
                    *(u32x4*)(mix + r * 1024 + c) = w; } }
    }
};

struct EpiMoeUp {
    static constexpr bool PERM = true, AFTER_DRAIN = false;
    bf16_t* H;
    __device__ __forceinline__ void operator()(const f32x4 (&acc)[2][2][4][2], const Unit& u, int wr, int wc, int fr, int fq) const {
        const int row0 = u.pm * BM + wr * 64 + fr, f0 = (u.pn & 1) * 128 + wc * 32 + 8 * fq;
#pragma unroll
        for (int ai = 0; ai < 2; ++ai)
#pragma unroll
            for (int m = 0; m < 4; ++m) {
                const f32x4 g0 = acc[ai][0][m][0], g1 = acc[ai][0][m][1], u0 = acc[ai][1][m][0], u1 = acc[ai][1][m][1];
                u32x4 w; w.x = cvt_pk_bf16(silu_f(g0[0]) * u0[0], silu_f(g0[1]) * u0[1]); w.y = cvt_pk_bf16(silu_f(g0[2]) * u0[2], silu_f(g0[3]) * u0[3]);
                w.z = cvt_pk_bf16(silu_f(g1[0]) * u1[0], silu_f(g1[1]) * u1[1]); w.w = cvt_pk_bf16(silu_f(g1[2]) * u1[2], silu_f(g1[3]) * u1[3]);
                *(u32x4*)(H + (size_t)(row0 + ai * HALF + m * 16) * 256 + f0) = w;
            }
    }
};
struct EpiMoeDown {
    static constexpr bool PERM = true, AFTER_DRAIN = false;
    bf16_t* Y; const unsigned* dtab; const float* wtab;
    __device__ __forceinline__ void operator()(const f32x4 (&acc)[2][2][4][2], const Unit& u, int wr, int wc, int fr, int fq) const {
        const int pn = u.pn & 3, tb = u.aux * 256 + wr * 64 + fr, col = pn * BM + wc * 32 + 8 * fq;
#pragma unroll
        for (int ai = 0; ai < 2; ++ai)
#pragma unroll
            for (int m = 0; m < 4; ++m) {
                const unsigned d = dtab[tb + ai * HALF + m * 16]; const float w = wtab[tb + ai * HALF + m * 16];
                if (d != 0xffffffffu) {
                    bf16_t* yr = Y + (size_t)d * 1024 + col;
#pragma unroll
                    for (int bj = 0; bj < 2; ++bj) { const f32x4 v0 = acc[ai][bj][m][0] * w, v1 = acc[ai][bj][m][1] * w;
                        u32x4 o; o.x = cvt_pk_bf16(v0[0], v0[1]); o.y = cvt_pk_bf16(v0[2], v0[3]); o.z = cvt_pk_bf16(v1[0], v1[1]); o.w = cvt_pk_bf16(v1[2], v1[3]);
                        *(u32x4*)(yr + bj * HALF) = o; }
                }
            }
    }
};
}

__device__ __forceinline__ void transpose_tile(const float* __restrict__ src, int ldn, bf16_t* __restrict__ dst, int ldk, float scale, float* scr, int lane) {
    float tv[32];
#pragma unroll
    for (int i = 0; i < 32; ++i) tv[i] = __builtin_nontemporal_load(src + (size_t)(2 * i + (lane >> 5)) * ldn + (lane & 31));
#pragma unroll
    for (int i = 0; i < 32; ++i) scr[(2 * i + (lane >> 5)) * 33 + (lane & 31)] = tv[i];
    LDS_WAIT();
    const int c = lane & 7;
#pragma unroll
    for (int j = 0; j < 4; ++j) {
        const int n = (lane >> 3) + 8 * j; const float* s = scr + (8 * c) * 33 + n;
        u32x4 o; o.x = pk2(s[0] * scale, s[33] * scale); o.y = pk2(s[66] * scale, s[99] * scale); o.z = pk2(s[132] * scale, s[165] * scale); o.w = pk2(s[198] * scale, s[231] * scale);
        *(u32x4*)(dst + (size_t)n * ldk + 8 * c) = o;
    }
    LDS_WAIT();
}

__device__ __forceinline__ void rms_row(f32x4 (&v)[4], const float* __restrict__ w, bf16_t* __restrict__ xn, int lane) {
    float ss = 0.f;
#pragma unroll
    for (int j = 0; j < 4; ++j) ss += v[j].x * v[j].x + v[j].y * v[j].y + v[j].z * v[j].z + v[j].w * v[j].w;
    ss = wave_sum(ss);
    const float r = rsqrtf(ss * (1.f / 1024.f) + EPS);
#pragma unroll
    for (int j = 0; j < 4; ++j) {
        const f32x4 w4 = *(const f32x4*)(w + 4 * lane + 256 * j);
        v[j] = v[j] * r * w4;
        u32x2 o; o.x = pk2(v[j].x, v[j].y); o.y = pk2(v[j].z, v[j].w);
        *(u32x2*)(xn + 4 * lane + 256 * j) = o;
    }
}

__device__ __forceinline__ void phase_prep(const Params& p, unsigned char* lds) {
    const int tid = opaque_tid(), lane = tid & 63, wid = tid >> 6;
    const int gw = blockIdx.x * 8 + wid, NGW = gridDim.x * 8;
    const int gt = blockIdx.x * NTHR + tid, NGT = gridDim.x * NTHR;
    unsigned char* ws = p.ws;
    if (blockIdx.x == 0 && tid < 64) ((int*)(ws + WS_CNT))[(tid >> 5) * 1024 + (tid & 31) * 32] = 0;
    for (int idx = (tid < 8 ? blockIdx.x * 8 + tid : 2048); idx < 2048; idx += gridDim.x * 8) {
        const int g = idx >> 6;
        const double lr = p.in[I_S5_LRE][idx], li = p.in[I_S5_LIM][idx], dt = exp((double)p.in[I_S5_LOGDT][g]);
        const double zr = lr * dt, zi = li * dt, ez = exp(zr);
        const double br = ez * cos(zi), bi = ez * sin(zi);
        double pr = 1.0, pi = 0.0;
        for (int tau = 0; tau <= 16; ++tau) {
            ((f32x2*)(ws + WS_S5POW))[idx * 17 + tau] = (f32x2){(float)pr, (float)pi};
            const double nr = pr * br - pi * bi, ni = pr * bi + pi * br; pr = nr; pi = ni;
        }
        const double ar = br - 1.0, ai = bi, den = lr * lr + li * li;
        const double cr = (ar * lr + ai * li) / den, ci = (ai * lr - ar * li) / den;
        for (int c = 0; c < 16; ++c) {
            const double b_r = p.in[I_S5_BRE][idx * 16 + c], b_i = p.in[I_S5_BIM][idx * 16 + c];
            ((f32x2*)(ws + WS_S5BBAR))[idx * 16 + c] = (f32x2){(float)(cr * b_r - ci * b_i), (float)(cr * b_i + ci * b_r)};
        }
    }
    for (int idx = gt; idx < 2 * 32 * 3 * 64; idx += NGT) {
        const int l = idx / (32 * 3 * 64), rem = idx - l * (32 * 3 * 64), ks = rem / 192, r2 = rem - ks * 192, nt_ = r2 >> 6, ln = r2 & 63, col = nt_ * 16 + (ln & 15);
        float v[8];
#pragma unroll
        for (int j = 0; j < 8; ++j) {
            const int k = ks * 32 + (ln >> 4) * 8 + j;
            float w = 0.f;
            if (col < 32) w = p.in[I_MOE_WR][(size_t)(l * 1024 + k) * 32 + col];
            else if (col < 36) w = p.in[I_MOE_WG][(size_t)(l * 1024 + k) * 4 + (col - 32)];
            v[j] = w * p.in[I_NORM_FFN][l * 1024 + k];
        }
        unsigned hi[4], lo[4];
#pragma unroll
        for (int q = 0; q < 4; ++q) {
            const unsigned h0 = f2bf(v[2 * q]), h1 = f2bf(v[2 * q + 1]);
            hi[q] = h0 | (h1 << 16);
            lo[q] = pk2(v[2 * q] - bf2f(h0), v[2 * q + 1] - bf2f(h1));
        }
        bf16_t* wf = (bf16_t*)(ws + WS_WCAT);
        *(u32x4*)(wf + ((size_t)(l * 2 + 0) * 6144 + (size_t)(ks * 3 + nt_) * 64 + ln) * 8) = (u32x4){hi[0], hi[1], hi[2], hi[3]};
        *(u32x4*)(wf + ((size_t)(l * 2 + 1) * 6144 + (size_t)(ks * 3 + nt_) * 64 + ln) * 8) = (u32x4){lo[0], lo[1], lo[2], lo[3]};
    }
    float* scr = (float*)(lds + wid * 8704);
    constexpr int IT_WINA = 112 * 16, IT_WOUT = 32 * 16, IT_WINC = 80 * 16, IT_WGLU = 16 * 8;
    constexpr int IT_TOTAL = IT_WINA + IT_WOUT + IT_WINC + IT_WOUT + IT_WGLU;
    for (int it0 = gw; it0 < IT_TOTAL; it0 += NGW) {
        int it = it0; const float* src; bf16_t* dst; int ldn, ldk; float scale = 1.f;
        if (it < IT_WINA) {
            const int n0 = (it >> 4) * 32, k0 = (it & 15) * 64, srcn = n0 < 2048 ? n0 : n0 + 8;
            if (n0 >= 512 && n0 < 1024) scale = 0.08838834764831845f;
            src = p.in[I_AB_WIN] + (size_t)k0 * 3592 + srcn; ldn = 3592; dst = (bf16_t*)(ws + WS_WINA) + (size_t)n0 * 1024 + k0; ldk = 1024;
        } else if ((it -= IT_WINA) < IT_WOUT) {
            const int n0 = (it >> 4) * 32, k0 = (it & 15) * 64;
            src = p.in[I_AB_WOUT] + (size_t)k0 * 1024 + n0; ldn = 1024; dst = (bf16_t*)(ws + WS_WOUTA) + (size_t)n0 * 1024 + k0; ldk = 1024;
        } else if ((it -= IT_WOUT) < IT_WINC) {
            const int n0 = (it >> 4) * 32, k0 = (it & 15) * 64;
            src = p.in[I_CD_WIN] + (size_t)k0 * 2560 + n0; ldn = 2560; dst = (bf16_t*)(ws + WS_WINC) + (size_t)n0 * 1024 + k0; ldk = 1024;
        } else if ((it -= IT_WINC) < IT_WOUT) {
            const int n0 = (it >> 4) * 32, k0 = (it & 15) * 64;
            src = p.in[I_CD_WOUT] + (size_t)k0 * 1024 + n0; ldn = 1024; dst = (bf16_t*)(ws + WS_WOUTC) + (size_t)n0 * 1024 + k0; ldk = 1024;
        } else {
            it -= IT_WOUT;
            const int n0 = (it >> 3) * 32, k0 = (it & 7) * 64;
            src = p.in[I_S5_WGLU] + (size_t)k0 * 512 + n0; ldn = 512; dst = (bf16_t*)(ws + WS_WGLU) + (size_t)n0 * 512 + k0; ldk = 512;
        }
        transpose_tile(src, ldn, dst, ldk, scale, scr, lane);
    }
    {
        bf16_t* wg = (bf16_t*)(ws + WS_WINA) + (size_t)3584 * 1024;
        const float* win = p.in[I_AB_WIN];
        for (int idx = gt; idx < 256 * 1024; idx += NGT) {
            const int n = idx >> 10, k = idx & 1023;
            wg[idx] = (bf16_t)(n < 8 ? f2bf(win[(size_t)k * 3592 + 2048 + n]) : 0u);
        }
    }
    const float* x = p.in[I_X];
    f32x4 vn[4];
    if (gw < T) {
#pragma unroll
        for (int j = 0; j < 4; ++j) vn[j] = __builtin_nontemporal_load((const f32x4*)(x + (size_t)gw * 1024 + 4 * lane + 256 * j));
    }
    for (int row = gw; row < T; row += NGW) {
        f32x4 v[4];
#pragma unroll
        for (int j = 0; j < 4; ++j) v[j] = vn[j];
        if (row + NGW < T) {
#pragma unroll
            for (int j = 0; j < 4; ++j) vn[j] = __builtin_nontemporal_load((const f32x4*)(x + (size_t)(row + NGW) * 1024 + 4 * lane + 256 * j));
        }
        {
            bf16_t* h16 = (bf16_t*)(ws + WS_H16) + (size_t)row * 1024;
#pragma unroll
            for (int j = 0; j < 4; ++j) { u32x2 o; o.x = pk2(v[j].x, v[j].y); o.y = pk2(v[j].z, v[j].w); *(u32x2*)(h16 + 4 * lane + 256 * j) = o; }
        }
        rms_row(v, p.in[I_NORM_MIX], (bf16_t*)(ws + WS_XN) + (size_t)row * 1024, lane);
    }
}

struct EpiStoreBf16 {
    bf16_t* O; int ldc;
    __device__ __forceinline__ void operator()(const f32x4 (&acc)[2][4], int wr, int wc, int fr, int fq) const {
#pragma unroll
        for (int m = 0; m < 2; ++m)
#pragma unroll
            for (int n = 0; n < 4; ++n) {
                const f32x4 v = acc[m][n]; u32x2 o; o.x = pk2(v.x, v.y); o.y = pk2(v.z, v.w);
                *(u32x2*)(O + (size_t)(wr * 32 + m * 16 + fr) * ldc + wc * 64 + n * 16 + fq * 4) = o;
            }
    }
};
struct EpiResidF32 {
    const float* resid; float* out;
    __device__ __forceinline__ void operator()(const f32x4 (&acc)[2][4], int wr, int wc, int fr, int fq) const {
#pragma unroll
        for (int m = 0; m < 2; ++m)
#pragma unroll
            for (int n = 0; n < 4; ++n) {
                const size_t off = (size_t)(wr * 32 + m * 16 + fr) * 1024 + wc * 64 + n * 16 + fq * 4;
                const f32x4 r = *(const f32x4*)(resid + off);
                *(f32x4*)(out + off) = r + acc[m][n];
            }
    }
};
struct EpiGlu {
    const bf16_t* Z; const float* b; bf16_t* mix;
    __device__ __forceinline__ void operator()(const f32x4 (&acc)[2][4], int wr, int wc, int fr, int fq) const {
#pragma unroll
        for (int m = 0; m < 2; ++m)
#pragma unroll
            for (int n = 0; n < 4; ++n) {
                const int r = wr * 32 + m * 16 + fr, c = wc * 64 + n * 16 + fq * 4;
                const u32x2 zz = *(const u32x2*)(Z + (size_t)r * 512 + c);
                const f32x4 bb = *(const f32x4*)(b + c);
                const f32x4 v = acc[m][n] + bb;
                const float z0 = bf2f(zz.x & 0xffffu), z1 = bf2f(zz.x >> 16), z2 = bf2f(zz.y & 0xffffu), z3 = bf2f(zz.y >> 16);
                u32x2 o; o.x = pk2(z0 * fsigmoid_(v.x), z1 * fsigmoid_(v.y)); o.y = pk2(z2 * fsigmoid_(v.z), z3 * fsigmoid_(v.w));
                *(u32x2*)(mix + (size_t)r * 1024 + c) = o;
            }
    }
};

__device__ __forceinline__ void phase_gemm_store(unsigned char* lds, const bf16_t* A, const bf16_t* Bt, int N, int K, bf16_t* O, int ldc) {
    const int nN = N >> 7, nU = (T >> 7) * nN;
    for (int u = blockIdx.x; u < nU; u += gridDim.x) {
        const int pm = u / nN, pn = u - pm * nN;
        APlain ap{A + (size_t)pm * 128 * K, K};
        EpiStoreBf16 e{O + (size_t)pm * 128 * ldc + pn * 128, ldc};
        gemm128(lds, ap, Bt + (size_t)pn * 128 * K, K, e);
    }
}
__device__ __forceinline__ void phase_gemm_resid(unsigned char* lds, const bf16_t* A, const bf16_t* Bt, const float* resid, float* out) {
    const int nU = (T >> 7) * 8;
    for (int u = blockIdx.x; u < nU; u += gridDim.x) {
        const int pm = u >> 3, pn = u & 7;
        APlain ap{A + (size_t)pm * 128 * 1024, 1024};
        const size_t off = (size_t)pm * 128 * 1024 + pn * 128;
        EpiResidF32 e{resid + off, out + off};
        gemm128(lds, ap, Bt + (size_t)pn * 128 * 1024, 1024, e);
    }
}
__device__ __forceinline__ void phase_gemm_glu(unsigned char* lds, const Params& p) {
    pg8::Gemm g{(const bf16_t*)(p.ws + WS_Z), (const bf16_t*)(p.ws + WS_WGLU), T, 512, 512}; pg8::StaticOrder S; S.init(T, 512, (int)gridDim.x, (int)blockIdx.x);
    pg8::EpiGlu256 E{(const bf16_t*)(p.ws + WS_Z), p.in[I_S5_BGLU], (bf16_t*)(p.ws + WS_MIX)};
    pg8::gemm_phase<pg8::EpiGlu256, pg8::StaticOrder, true, true>((PG8_LAS unsigned char*)lds, g, S, E);
}
__device__ __forceinline__ void phase_gemm256_store(unsigned char* lds, const bf16_t* A, const bf16_t* Bt, int N, bf16_t* O) {
    pg8::Gemm g{A, Bt, T, N, 1024}; pg8::StaticOrder S; S.init(T, N, (int)gridDim.x, (int)blockIdx.x);
    pg8::EpiStore E{O, N};
    pg8::gemm_phase<pg8::EpiStore, pg8::StaticOrder, true, true>((PG8_LAS unsigned char*)lds, g, S, E);
}
__device__ __forceinline__ void phase_gemm256_inproj1(unsigned char* lds, const Params& p) {
    pg8::Gemm g{(const bf16_t*)(p.ws + WS_XN), (const bf16_t*)(p.ws + WS_WINC), T, PC, 1024}; pg8::StaticOrderHalfTail S; S.init(T, 8 * 256, (int)gridDim.x, (int)blockIdx.x); S.nNF = 8; S.nNT = 2;
    pg8::EpiStore E{(bf16_t*)(p.ws + WS_PROJ), PC};
    pg8::gemm_phase<pg8::EpiStore, pg8::StaticOrderHalfTail, true, true>((PG8_LAS unsigned char*)lds, g, S, E);
}
__device__ __forceinline__ void phase_gemm256_inproj0(unsigned char* lds, const Params& p) {
    pg8::Gemm g{(const bf16_t*)(p.ws + WS_XN), (const bf16_t*)(p.ws + WS_WINA), T, 3840, 1024}; pg8::StaticOrder S; S.init(T, 3840, (int)gridDim.x, (int)blockIdx.x);
    pg8::EpiStoreGates E{(bf16_t*)(p.ws + WS_PROJ), PA, 14, (float*)(p.ws + WS_GATES), p.in[I_AB_GBIAS]};
    pg8::gemm_phase<pg8::EpiStoreGates, pg8::StaticOrder, true, true>((PG8_LAS unsigned char*)lds, g, S, E);
}
__device__ __forceinline__ void phase_gemm256_resid(unsigned char* lds, const bf16_t* A, const bf16_t* Bt, const float* rf, const bf16_t* rb, bf16_t* out) {
    pg8::Gemm g{A, Bt, T, 1024, 1024}; pg8::StaticOrder S; S.init(T, 1024, (int)gridDim.x, (int)blockIdx.x);
    pg8::EpiResid E{rf, rb, out};
    pg8::gemm_phase<pg8::EpiResid, pg8::StaticOrder, true, true>((PG8_LAS unsigned char*)lds, g, S, E);
}

__device__ __forceinline__ void s5_gen_ktab(const Params& p) {
    const int gt = blockIdx.x * NTHR + opaque_tid(), NGT = gridDim.x * NTHR;
    const f32x2* POW = (const f32x2*)(p.ws + WS_S5POW); const f32x2* BB = (const f32x2*)(p.ws + WS_S5BBAR);
    for (int idx = gt; idx < 32 * 4096; idx += NGT) {
        const int g = idx >> 12, tau = (idx >> 8) & 15, ch = (idx >> 4) & 15, c = idx & 15;
        float sum = 0.f;
        for (int pp = 0; pp < 64; ++pp) {
            const f32x2 l = POW[(g * 64 + pp) * 17 + tau], b = BB[(g * 64 + pp) * 16 + c];
            const float wr_ = l.x * b.x - l.y * b.y, wi_ = l.x * b.y + l.y * b.x;
            sum += p.in[I_S5_CRE][(size_t)(g * 16 + ch) * 64 + pp] * wr_ - p.in[I_S5_CIM][(size_t)(g * 16 + ch) * 64 + pp] * wi_;
        }
        if (tau == 0 && ch == c) sum += p.in[I_S5_D][g * 16 + ch];
        ((float*)(p.ws + WS_KTAB))[idx] = sum;
    }
}
__device__ __forceinline__ void s5_gen_ops(const Params& p) {
    const int gt = blockIdx.x * NTHR + opaque_tid(), NGT = gridDim.x * NTHR;
    const f32x2* POW = (const f32x2*)(p.ws + WS_S5POW); const f32x2* BB = (const f32x2*)(p.ws + WS_S5BBAR);
    const float* KT = (const float*)(p.ws + WS_KTAB);
    bf16_t* BY = (bf16_t*)(p.ws + WS_S5Y); bf16_t* BE = (bf16_t*)(p.ws + WS_S5E);
    for (int idx = gt; idx < 32 * 256 * 48; idx += NGT) {
        const int kc = idx % 48, gn = idx / 48, n = gn & 255, g = gn >> 8, t = n >> 4, ch = n & 15, k0 = kc * 8;
        float v[8];
        if (k0 < 256) {
            const int s_ = k0 >> 4, c0 = k0 & 15;
            if (s_ <= t) {
                const f32x4 a = *(const f32x4*)(KT + ((g * 16 + (t - s_)) * 16 + ch) * 16 + c0), b = *(const f32x4*)(KT + ((g * 16 + (t - s_)) * 16 + ch) * 16 + c0 + 4);
                v[0] = a.x; v[1] = a.y; v[2] = a.z; v[3] = a.w; v[4] = b.x; v[5] = b.y; v[6] = b.z; v[7] = b.w;
            } else {
#pragma unroll
                for (int j = 0; j < 8; ++j) v[j] = 0.f;
            }
        } else {
            const int p0 = (k0 - 256) & 63; const bool re = k0 < 320;
#pragma unroll
            for (int j = 0; j < 8; ++j) {
                const int pp = p0 + j; const f32x2 l = POW[(g * 64 + pp) * 17 + t + 1];
                const float cr = p.in[I_S5_CRE][(size_t)(g * 16 + ch) * 64 + pp], ci = p.in[I_S5_CIM][(size_t)(g * 16 + ch) * 64 + pp];
                v[j] = re ? (cr * l.x - ci * l.y) : -(cr * l.y + ci * l.x);
            }
        }
        *(u32x4*)(BY + (size_t)gn * 384 + k0) = (u32x4){pk2(v[0], v[1]), pk2(v[2], v[3]), pk2(v[4], v[5]), pk2(v[6], v[7])};
    }
    for (int idx = gt; idx < 32 * 128 * 32; idx += NGT) {
        const int kc = idx & 31, gn = idx >> 5, n = gn & 127, g = gn >> 7, pp = n & 63, k0 = kc * 8, s_ = k0 >> 4, c0 = k0 & 15;
        const f32x2 l = POW[(g * 64 + pp) * 17 + 15 - s_];
        float v[8];
#pragma unroll
        for (int j = 0; j < 8; ++j) { const f32x2 b = BB[(g * 64 + pp) * 16 + c0 + j]; v[j] = (n < 64) ? (l.x * b.x - l.y * b.y) : (l.x * b.y + l.y * b.x); }
        *(u32x4*)(BE + (size_t)gn * 256 + k0) = (u32x4){pk2(v[0], v[1]), pk2(v[2], v[3]), pk2(v[4], v[5]), pk2(v[6], v[7])};
    }
}
struct AS5 {
    const bf16_t* proj; const bf16_t* xp; int m0, g;
    __device__ __forceinline__ const bf16_t* operator()(int r, int kc) const {
        const int m = m0 + r, k0 = kc * 8;
        return (k0 < 256) ? proj + ((size_t)(m * 16 + (k0 >> 4)) * PC + g * 16 + (k0 & 15)) : xp + ((size_t)m * 32 + g) * 128 + (k0 - 256);
    }
};
struct EpiS5E {
    float* xend; int m0, g;
    __device__ __forceinline__ void operator()(const f32x4 (&acc)[2][4], int wr, int wc, int fr, int fq) const {
#pragma unroll
        for (int m = 0; m < 2; ++m)
#pragma unroll
            for (int n = 0; n < 4; ++n) *(f32x4*)(xend + ((size_t)(m0 + wr * 32 + m * 16 + fr) * 32 + g) * 128 + wc * 64 + n * 16 + fq * 4) = acc[m][n];
    }
};
struct EpiS5Y {
    bf16_t* Z; int m0, g, n0;
    __device__ __forceinline__ void operator()(const f32x4 (&acc)[2][4], int wr, int wc, int fr, int fq) const {
#pragma unroll
        for (int m = 0; m < 2; ++m)
#pragma unroll
            for (int n = 0; n < 4; ++n) {
                const int mm = m0 + wr * 32 + m * 16 + fr, nc = n0 + wc * 64 + n * 16 + fq * 4, t = nc >> 4, ch0 = nc & 15;
                const f32x4 v = acc[m][n];
                u32x2 o; o.x = pk2(fgelu_tanh_(v.x), fgelu_tanh_(v.y)); o.y = pk2(fgelu_tanh_(v.z), fgelu_tanh_(v.w));
                *(u32x2*)(Z + (size_t)(mm * 16 + t) * 512 + g * 16 + ch0) = o;
            }
    }
};
__device__ __forceinline__ void s5_unit_E(const Params& p, unsigned char* lds, int u) {
    const int g = u >> 3, mt = u & 7;
    AS5 a{(const bf16_t*)(p.ws + WS_PROJ), nullptr, mt * 128, g};
    EpiS5E e{(float*)(p.ws + WS_XEND), mt * 128, g};
    gemm128(lds, a, (const bf16_t*)(p.ws + WS_S5E) + (size_t)g * 128 * 256, 256, e);
}
__device__ __forceinline__ void s5_unit_Y(const Params& p, unsigned char* lds, int u) {
    const int g = u >> 3, mt = u & 7;
    AS5 a{(const bf16_t*)(p.ws + WS_PROJ), (const bf16_t*)(p.ws + WS_XPREVB), mt * 128, g};
    EpiS5Y e0{(bf16_t*)(p.ws + WS_Z), mt * 128, g, 0}, e1{(bf16_t*)(p.ws + WS_Z), mt * 128, g, 128};
    BPlain b0{(const bf16_t*)(p.ws + WS_S5Y) + (size_t)g * 256 * 384, 384}, b1{(const bf16_t*)(p.ws + WS_S5Y) + ((size_t)g * 256 + 128) * 384, 384};
    gemm128x2(lds, a, b0, b1, 384, e0, e1);
}

__device__ __forceinline__ void stage_rows(const bf16_t* __restrict__ g, int pitch, bf16_t* s, int tid) {
#pragma unroll
    for (int i = 0; i < 2; ++i) { const int pc = tid + i * NTHR, l = pc >> 4, d0 = (pc & 15) * 8; *(u32x4*)(s + l * 136 + d0) = *(const u32x4*)(g + (size_t)l * pitch + d0); }
}
__device__ __forceinline__ void stage_transposed(const bf16_t* __restrict__ g, int pitch, bf16_t* s, const float* rs, int tid) {
#pragma unroll
    for (int i = 0; i < 2; ++i) {
        const int pc = tid + i * NTHR, l = pc >> 4, d0 = (pc & 15) * 8;
        const u32x4 v = *(const u32x4*)(g + (size_t)l * pitch + d0);
        const float sc = rs ? rs[l] : 1.f;
        const unsigned w[4] = {v.x, v.y, v.z, v.w};
#pragma unroll
        for (int q = 0; q < 4; ++q) {
            s[tsw(d0 + 2 * q, l)] = (bf16_t)f2bf(bf2f(w[q] & 0xffffu) * sc);
            s[tsw(d0 + 2 * q + 1, l)] = (bf16_t)f2bf(bf2f(w[q] >> 16) * sc);
        }
    }
}
__device__ __forceinline__ void state_outer(const bf16_t* Kt, const bf16_t* Vt, bf16_t* __restrict__ Uout, int wid, int fr, int fq) {
    const int v0 = wid * 16;
    bf16x8 bv[2];
#pragma unroll
    for (int ls = 0; ls < 2; ++ls) bv[ls] = *(const bf16x8*)(Vt + tswc(v0 + fr, ls * 4 + fq));
#pragma unroll
    for (int kt = 0; kt < 8; ++kt) {
        f32x4 acc = (f32x4){0.f, 0.f, 0.f, 0.f};
#pragma unroll
        for (int ls = 0; ls < 2; ++ls) {
            const bf16x8 ak = *(const bf16x8*)(Kt + tswc(kt * 16 + fr, ls * 4 + fq));
            acc = __builtin_amdgcn_mfma_f32_16x16x32_bf16(ak, bv[ls], acc, 0, 0, 0);
        }
        u32x2 o; o.x = pk2(acc.x, acc.y); o.y = pk2(acc.z, acc.w);
        *(u32x2*)(Uout + (size_t)(v0 + fr) * 128 + kt * 16 + fq * 4) = o;
    }
}
template <bool KRM>
__device__ __forceinline__ void state_outer_tr(const bf16_t* Kx, const bf16_t* Vs, bf16_t* __restrict__ Uout, int wid, int fr, int fq) {
    const int v0 = wid * 16;
    bf16x8 bv[2];
#pragma unroll
    for (int ls = 0; ls < 2; ++ls) bv[ls] = frag_tr(Vs, 136, ls * 32, v0, fr, fq);
#pragma unroll
    for (int kt = 0; kt < 8; ++kt) {
        f32x4 acc = (f32x4){0.f, 0.f, 0.f, 0.f};
#pragma unroll
        for (int ls = 0; ls < 2; ++ls) {
            const bf16x8 ak = KRM ? frag_tr(Kx, 136, ls * 32, kt * 16, fr, fq) : *(const bf16x8*)(Kx + tswc(kt * 16 + fr, ls * 4 + fq));
            acc = __builtin_amdgcn_mfma_f32_16x16x32_bf16(ak, bv[ls], acc, 0, 0, 0);
        }
        u32x2 o; o.x = pk2(acc.x, acc.y); o.y = pk2(acc.z, acc.w);
        *(u32x2*)(Uout + (size_t)(v0 + fr) * 128 + kt * 16 + fq * 4) = o;
    }
}
template <int GATE>
__device__ __forceinline__ void head_norm_out(const float* Hs, const float* __restrict__ w, const bf16_t* __restrict__ gsrc, int gpitch, bf16_t* __restrict__ out, int opitch, int tid) {
    const int l = tid >> 3, part = tid & 7;
    float h[16]; float ss = 0.f;
#pragma unroll
    for (int i = 0; i < 4; ++i) { const f32x4 v = *(const f32x4*)(Hs + l * 132 + part * 16 + i * 4); h[4 * i] = v.x; h[4 * i + 1] = v.y; h[4 * i + 2] = v.z; h[4 * i + 3] = v.w; ss += v.x * v.x + v.y * v.y + v.z * v.z + v.w * v.w; }
    ss += __shfl_xor(ss, 1); ss += __shfl_xor(ss, 2); ss += __shfl_xor(ss, 4);
    const float r = rsqrtf(ss * (1.f / 128.f) + EPS);
    const u32x4 g0 = *(const u32x4*)(gsrc + (size_t)l * gpitch + part * 16), g1 = *(const u32x4*)(gsrc + (size_t)l * gpitch + part * 16 + 8);
    const unsigned gw[8] = {g0.x, g0.y, g0.z, g0.w, g1.x, g1.y, g1.z, g1.w};
    unsigned ow[8];
#pragma unroll
    for (int q = 0; q < 8; ++q) {
        const float ga = bf2f(gw[q] & 0xffffu), gb = bf2f(gw[q] >> 16);
        const float a = h[2 * q] * r * w[part * 16 + 2 * q] * (GATE == 0 ? fsigmoid_(ga) : fsilu_(ga));
        const float b = h[2 * q + 1] * r * w[part * 16 + 2 * q + 1] * (GATE == 0 ? fsigmoid_(gb) : fsilu_(gb));
        ow[q] = pk2(a, b);
    }
    *(u32x4*)(out + (size_t)l * opitch + part * 16) = (u32x4){ow[0], ow[1], ow[2], ow[3]};
    *(u32x4*)(out + (size_t)l * opitch + part * 16 + 8) = (u32x4){ow[4], ow[5], ow[6], ow[7]};
}


struct Tile2 { u32x4 v[2]; };
struct Tile4 { u32x4 v[4]; };
template <bool NT = false>
__device__ __forceinline__ void tile_load(Tile2& t, const bf16_t* __restrict__ g, int pitch, int tid) {
#pragma unroll
    for (int i = 0; i < 2; ++i) { const int pc = tid + i * NTHR; const u32x4* q = (const u32x4*)(g + (size_t)(pc >> 4) * pitch + (pc & 15) * 8); t.v[i] = NT ? __builtin_nontemporal_load(q) : *q; }
}
template <bool NT = false>
__device__ __forceinline__ void tile4_load(Tile4& t, const bf16_t* __restrict__ g, int tid) {
#pragma unroll
    for (int i = 0; i < 4; ++i) { const int pc = tid + i * NTHR; const u32x4* q = (const u32x4*)(g + (size_t)pc * 8); t.v[i] = NT ? __builtin_nontemporal_load(q) : *q; }
}
__device__ __forceinline__ void tile_put_rows(const Tile2& t, bf16_t* s, int tid) {
#pragma unroll
    for (int i = 0; i < 2; ++i) { const int pc = tid + i * NTHR; *(u32x4*)(s + (pc >> 4) * 136 + (pc & 15) * 8) = t.v[i]; }
}
__device__ __forceinline__ void tile4_put(const Tile4& t, bf16_t* s, int tid) {
#pragma unroll
    for (int i = 0; i < 4; ++i) { const int pc = tid + i * NTHR; *(u32x4*)(s + (pc >> 4) * 136 + (pc & 15) * 8) = t.v[i]; }
}
__device__ __forceinline__ void tile_put_transposed(const Tile2& t, bf16_t* s, const float* rs, int tid) {
#pragma unroll
    for (int i = 0; i < 2; ++i) {
        const int pc = tid + i * NTHR, l = pc >> 4, d0 = (pc & 15) * 8;
        const unsigned w[4] = {t.v[i].x, t.v[i].y, t.v[i].z, t.v[i].w};
        if (rs) {
            const float sc = rs[l];
#pragma unroll
            for (int q = 0; q < 4; ++q) {
                const unsigned pr = pk2(bf2f(w[q] & 0xffffu) * sc, bf2f(w[q] >> 16) * sc);
                s[tsw(d0 + 2 * q, l)] = (bf16_t)(pr & 0xffffu); s[tsw(d0 + 2 * q + 1, l)] = (bf16_t)(pr >> 16);
            }
        } else {
#pragma unroll
            for (int q = 0; q < 4; ++q) { s[tsw(d0 + 2 * q, l)] = (bf16_t)(w[q] & 0xffffu); s[tsw(d0 + 2 * q + 1, l)] = (bf16_t)(w[q] >> 16); }
        }
    }
}
template <int GATE>
__device__ __forceinline__ void head_norm_out_r(const float* Hs, const float* __restrict__ w, const u32x4 (&og)[2], bf16_t* __restrict__ out, int opitch, int tid) {
    const int l = tid >> 3, part = tid & 7;
    float h[16]; float ss = 0.f;
#pragma unroll
    for (int i = 0; i < 4; ++i) { const f32x4 v = *(const f32x4*)(Hs + l * 132 + part * 16 + i * 4); h[4 * i] = v.x; h[4 * i + 1] = v.y; h[4 * i + 2] = v.z; h[4 * i + 3] = v.w; ss += v.x * v.x + v.y * v.y + v.z * v.z + v.w * v.w; }
    ss += __shfl_xor(ss, 1); ss += __shfl_xor(ss, 2); ss += __shfl_xor(ss, 4);
    const float r = rsqrtf(ss * (1.f / 128.f) + EPS);
    const unsigned gw[8] = {og[0].x, og[0].y, og[0].z, og[0].w, og[1].x, og[1].y, og[1].z, og[1].w};
    unsigned ow[8];
#pragma unroll
    for (int q = 0; q < 8; ++q) {
        const float ga = bf2f(gw[q] & 0xffffu), gb = bf2f(gw[q] >> 16);
        const float a = h[2 * q] * r * w[part * 16 + 2 * q] * (GATE == 0 ? fsigmoid_(ga) : fsilu_(ga));
        const float b = h[2 * q + 1] * r * w[part * 16 + 2 * q + 1] * (GATE == 0 ? fsigmoid_(gb) : fsilu_(gb));
        ow[q] = pk2(a, b);
    }
    *(u32x4*)(out + (size_t)l * opitch + part * 16) = (u32x4){ow[0], ow[1], ow[2], ow[3]};
    *(u32x4*)(out + (size_t)l * opitch + part * 16 + 8) = (u32x4){ow[4], ow[5], ow[6], ow[7]};
}

__device__ __forceinline__ void phase_mlstm_local(const Params& p, unsigned char* lds) {
    const int tid = opaque_tid(), lane = tid & 63, wid = tid >> 6, fr = lane & 15, fq = lane >> 4;
    unsigned char* ws = p.ws;
    const bf16_t* PROJ = (const bf16_t*)(ws + WS_PROJ);
    const float* GATES = (const float*)(ws + WS_GATES);
    bf16_t* Kt = (bf16_t*)lds;
    bf16_t* Vt = (bf16_t*)(lds + 18432);
    float* wk = (float*)(lds + 36864);
    const int NIT = 1024 + 256;
    Tile2 rk, rv; float gi = 0.f, gf = 0.f;
    auto load_item = [&](int it) {
        const int b = it >> 8, h = (it >> 6) & 3, c = it & 63, t0 = b * SEQ + c * 64;
        tile_load(rk, PROJ + (size_t)t0 * PA + 512 + h * 128, PA, tid);
        tile_load(rv, PROJ + (size_t)t0 * PA + 1024 + h * 128, PA, tid);
        gi = GATES[(size_t)(t0 + lane) * 8 + h]; gf = GATES[(size_t)(t0 + lane) * 8 + 4 + h];
    };
    if ((int)blockIdx.x < 1024) load_item(blockIdx.x);
    for (int it = blockIdx.x; it < NIT; it += gridDim.x) {
        if (it < 1024) {
            if (wid == 0) {
                const float lf = logsigmoid_(gf);
                const float bc = wave_incl_sum(lf, lane);
                const float bend = __shfl(bc, 63);
                const float logg = bend - bc + gi;
                const float ml = wave_max(logg);
                wk[lane] = expf(logg - ml);
                if (lane == 0) { ((float*)(ws + WS_MLOC))[it] = ml; ((float*)(ws + WS_BEND))[it] = bend; }
            }
            tile_put_rows(rk, Kt, tid);
            __syncthreads();
            {
#pragma unroll
                for (int i = 0; i < 2; ++i) {
                    const int pc = tid + i * NTHR, l = pc >> 4, d0 = (pc & 15) * 8; const float sc = wk[l];
                    const unsigned w[4] = {rv.v[i].x, rv.v[i].y, rv.v[i].z, rv.v[i].w};
                    u32x4 o; o.x = pk2(bf2f(w[0] & 0xffffu) * sc, bf2f(w[0] >> 16) * sc); o.y = pk2(bf2f(w[1] & 0xffffu) * sc, bf2f(w[1] >> 16) * sc);
                    o.z = pk2(bf2f(w[2] & 0xffffu) * sc, bf2f(w[2] >> 16) * sc); o.w = pk2(bf2f(w[3] & 0xffffu) * sc, bf2f(w[3] >> 16) * sc);
                    *(u32x4*)(Vt + l * 136 + d0) = o;
                }
                if (tid < 64) Vt[tid * 136 + 128] = (bf16_t)f2bf(wk[tid]);
            }
            __syncthreads();
            if (it + (int)gridDim.x < 1024) load_item(it + gridDim.x);
            state_outer_tr<true>(Kt, Vt, (bf16_t*)(ws + WS_U) + (size_t)it * 16384, wid, fr, fq);
            {
                f32x4 acc = (f32x4){0.f, 0.f, 0.f, 0.f};
#pragma unroll
                for (int ls = 0; ls < 2; ++ls) {
                    const bf16x8 bn = frag_tr(Vt, 136, ls * 32, 128, fr, fq);
                    const bf16x8 ak = frag_tr(Kt, 136, ls * 32, wid * 16, fr, fq);
                    acc = __builtin_amdgcn_mfma_f32_16x16x32_bf16(ak, bn, acc, 0, 0, 0);
                }
                if (fr == 0) *(f32x4*)((float*)(ws + WS_NLOC) + (size_t)it * 128 + wid * 16 + fq * 4) = acc;
            }
            __syncthreads();
        } else {
            const int ci = it - 1024, t0 = ci * 64, cq = tid & 63, ts = tid >> 6, c0 = cq * 8, tb = t0 + ts * 8;
            const float* cw = p.in[I_AB_CONVW];
            float w0[8], w1[8], w2[8];
#pragma unroll
            for (int j = 0; j < 8; ++j) { w0[j] = cw[c0 + j]; w1[j] = cw[512 + c0 + j]; w2[j] = cw[1024 + c0 + j]; }
            const bool halo = ((tb & (SEQ - 1)) != 0);
            float zp2[8], zp1[8];
            {
                u32x4 g2 = (u32x4){0u, 0u, 0u, 0u}, x2 = g2, g1 = g2, x1 = g2;
                if (halo) { const bf16_t* r2 = PROJ + (size_t)(tb - 2) * PA; const bf16_t* r1 = PROJ + (size_t)(tb - 1) * PA;
                    g2 = __builtin_nontemporal_load((const u32x4*)(r2 + 2560 + c0)); x2 = __builtin_nontemporal_load((const u32x4*)(r2 + 3072 + c0));
                    g1 = __builtin_nontemporal_load((const u32x4*)(r1 + 2560 + c0)); x1 = __builtin_nontemporal_load((const u32x4*)(r1 + 3072 + c0)); }
                const unsigned a0[4] = {g2.x, g2.y, g2.z, g2.w}, b0[4] = {x2.x, x2.y, x2.z, x2.w}, a1[4] = {g1.x, g1.y, g1.z, g1.w}, b1[4] = {x1.x, x1.y, x1.z, x1.w};
#pragma unroll
                for (int q = 0; q < 4; ++q) {
                    zp2[2 * q] = bf2f(a0[q] & 0xffffu) * bf2f(b0[q] & 0xffffu); zp2[2 * q + 1] = bf2f(a0[q] >> 16) * bf2f(b0[q] >> 16);
                    zp1[2 * q] = bf2f(a1[q] & 0xffffu) * bf2f(b1[q] & 0xffffu); zp1[2 * q + 1] = bf2f(a1[q] >> 16) * bf2f(b1[q] >> 16);
                }
            }
            bf16_t* mix = (bf16_t*)(ws + WS_MIX);
#pragma unroll 1
            for (int ps = 0; ps < 2; ++ps) {
                u32x4 gbv[4], gcv[4], xiv[4];
#pragma unroll
                for (int t = 0; t < 4; ++t) { const bf16_t* r = PROJ + (size_t)(tb + ps * 4 + t) * PA;
                    gbv[t] = __builtin_nontemporal_load((const u32x4*)(r + 2048 + c0)); gcv[t] = __builtin_nontemporal_load((const u32x4*)(r + 2560 + c0)); xiv[t] = __builtin_nontemporal_load((const u32x4*)(r + 3072 + c0)); }
#pragma unroll
                for (int t = 0; t < 4; ++t) {
                    const unsigned ga[4] = {gcv[t].x, gcv[t].y, gcv[t].z, gcv[t].w}, xa[4] = {xiv[t].x, xiv[t].y, xiv[t].z, xiv[t].w}, ba[4] = {gbv[t].x, gbv[t].y, gbv[t].z, gbv[t].w};
                    float y[8];
#pragma unroll
                    for (int q = 0; q < 4; ++q) {
                        const float z0 = bf2f(ga[q] & 0xffffu) * bf2f(xa[q] & 0xffffu), z1 = bf2f(ga[q] >> 16) * bf2f(xa[q] >> 16);
                        y[2 * q] = bf2f(ba[q] & 0xffffu) * (w0[2 * q] * zp2[2 * q] + w1[2 * q] * zp1[2 * q] + w2[2 * q] * z0);
                        y[2 * q + 1] = bf2f(ba[q] >> 16) * (w0[2 * q + 1] * zp2[2 * q + 1] + w1[2 * q + 1] * zp1[2 * q + 1] + w2[2 * q + 1] * z1);
                        zp2[2 * q] = zp1[2 * q]; zp1[2 * q] = z0; zp2[2 * q + 1] = zp1[2 * q + 1]; zp1[2 * q + 1] = z1;
                    }
                    *(u32x4*)(mix + (size_t)(tb + ps * 4 + t) * 1024 + 512 + c0) = (u32x4){pk2(y[0], y[1]), pk2(y[2], y[3]), pk2(y[4], y[5]), pk2(y[6], y[7])};
                }
            }
        }
    }
}

template <bool HG>
__device__ __forceinline__ void phase_scan(const Params& p, unsigned char* lds) {
    unsigned char* ws = p.ws;
    const int tid = opaque_tid();
    const int gt = blockIdx.x * NTHR + tid, NGT = gridDim.x * NTHR;
    const bf16_t* U = (const bf16_t*)(ws + WS_U);
    bf16_t* CP = (bf16_t*)(ws + WS_CPREV);
    const float* MLOC = (const float*)(ws + WS_MLOC); const float* BEND = (const float*)(ws + WS_BEND); const float* BENDV = (const float*)(ws + WS_BENDV);
    float* sd = (float*)lds;
    float* ssu = sd + 64;
    for (int base = blockIdx.x * NTHR; base < 131072; base += NGT) {
        const int idx = base + tid;
        const int bh = idx >> 13, rem = idx & 8191, e = rem >> 6, k = (rem & 63) * 2;
        if (!HG) {
            __syncthreads();
            float* sml = ssu + 64; float* sbe = sml + 64; float* smp = sbe + 64;
            if (tid < 64) { sml[tid] = MLOC[bh * 64 + tid]; sbe[tid] = BEND[bh * 64 + tid]; }
            __syncthreads();
            if (tid == 0) {
                float m = -1e30f;
                for (int c = 0; c < 64; ++c) {
                    const float ml = sml[c], be = sbe[c];
                    smp[c] = m;
                    const float mn = fmaxf(be + m, ml);
                    sd[c] = expf(be + m - mn); ssu[c] = expf(ml - mn); m = mn;
                }
            }
            __syncthreads();
            if (rem < 64 && tid < 64) ((float*)(ws + WS_MPREV))[bh * 64 + tid] = smp[tid];
            if (tid >= 504) {
                const float* NLOC = (const float*)(ws + WS_NLOC); float* NPREV = (float*)(ws + WS_NPREV);
                const int kn = ((base & 8191) >> 9) * 8 + (tid - 504);
                float n = 0.f;
#pragma unroll
                for (int hb = 0; hb < 2; ++hb) {
                    float nl[32];
#pragma unroll
                    for (int c = 0; c < 32; ++c) nl[c] = NLOC[(unsigned)((bh * 64 + hb * 32 + c) * 128 + kn)];
#pragma unroll
                    for (int c = 0; c < 32; ++c) { NPREV[(unsigned)((bh * 64 + hb * 32 + c) * 128 + kn)] = n; n = sd[hb * 32 + c] * n + ssu[hb * 32 + c] * nl[c]; }
                }
            }
        }
        float c0 = 0.f, c1 = 0.f;
#pragma unroll
        for (int half = 0; half < 2; ++half) {
            unsigned uu[32];
#pragma unroll
            for (int c = 0; c < 32; ++c) uu[c] = __builtin_nontemporal_load((const unsigned*)(U + (size_t)(bh * 64 + half * 32 + c) * 16384 + e * 128 + k));
            f32x2 bv[32];
            if (HG) {
#pragma unroll
                for (int c = 0; c < 32; ++c) bv[c] = *(const f32x2*)(BENDV + (size_t)(bh * 64 + half * 32 + c) * 128 + k);
            }
#pragma unroll
            for (int c = 0; c < 32; ++c) {
                const size_t off = (size_t)(bh * 64 + half * 32 + c) * 16384 + e * 128 + k;
                *(unsigned*)(CP + off) = pk2(c0, c1);
                const float u0 = bf2f(uu[c] & 0xffffu), u1 = bf2f(uu[c] >> 16);
                if (!HG) { const float d = sd[half * 32 + c], su = ssu[half * 32 + c]; c0 = d * c0 + su * u0; c1 = d * c1 + su * u1; }
                else { c0 = bv[c].x * c0 + u0; c1 = bv[c].y * c1 + u1; }
            }
        }
    }
    if (HG) {
        const int lane = tid & 63, wv = tid >> 6;
        if (wv < 2) {
            const f32x2* POW = (const f32x2*)(ws + WS_S5POW); const float* XEND = (const float*)(ws + WS_XEND); bf16_t* XPB = (bf16_t*)(ws + WS_XPREVB);
            for (int sb = (blockIdx.x * 2 + wv) * 16; sb < 8192; sb += gridDim.x * 32) {
                const int seq = sb + (lane & 15), seg = lane >> 4;
                const int b = seq >> 11, g = (seq >> 6) & 31, pp = seq & 63;
                const f32x2 l16 = POW[(g * 64 + pp) * 17 + 16];
                float ar = l16.x, ai = l16.y;
#pragma unroll
                for (int q = 0; q < 6; ++q) { const float nr = ar * ar - ai * ai, ni = 2.f * ar * ai; ar = nr; ai = ni; }
                const float* xe = XEND + ((size_t)(b * 256 + seg * 64) * 32 + g) * 128 + pp;
                bf16_t* xo = XPB + ((size_t)(b * 256 + seg * 64) * 32 + g) * 128 + pp;
                float xr = 0.f, xi = 0.f;
                for (int hb = 0; hb < 4; ++hb) {
                    float er[16], ei[16];
#pragma unroll
                    for (int j = 0; j < 16; ++j) { er[j] = xe[(hb * 16 + j) * 4096]; ei[j] = xe[(hb * 16 + j) * 4096 + 64]; }
#pragma unroll
                    for (int j = 0; j < 16; ++j) { const float nr = l16.x * xr - l16.y * xi + er[j], ni = l16.x * xi + l16.y * xr + ei[j]; xr = nr; xi = ni; }
                }
                float cr = 0.f, ci = 0.f;
#pragma unroll
                for (int r = 0; r < 3; ++r) {
                    const float pr = __shfl(xr, (lane & 15) + 16 * r), pi = __shfl(xi, (lane & 15) + 16 * r);
                    if (r < seg) { const float nr = ar * cr - ai * ci + pr, ni = ar * ci + ai * cr + pi; cr = nr; ci = ni; }
                }
                xr = cr; xi = ci;
                for (int hb = 0; hb < 4; ++hb) {
                    float er[16], ei[16];
#pragma unroll
                    for (int j = 0; j < 16; ++j) { er[j] = xe[(hb * 16 + j) * 4096]; ei[j] = xe[(hb * 16 + j) * 4096 + 64]; }
#pragma unroll
                    for (int j = 0; j < 16; ++j) {
                        xo[(hb * 16 + j) * 4096] = (bf16_t)f2bf(xr); xo[(hb * 16 + j) * 4096 + 64] = (bf16_t)f2bf(xi);
                        const float nr = l16.x * xr - l16.y * xi + er[j], ni = l16.x * xi + l16.y * xr + ei[j]; xr = nr; xi = ni;
                    }
                }
            }
        }
    }
}

__device__ __forceinline__ void phase_mlstm_out(const Params& p, unsigned char* lds) {
    const int tid = opaque_tid(), lane = tid & 63, wid = tid >> 6, fr = lane & 15, fq = lane >> 4;
    unsigned char* ws = p.ws;
    const bf16_t* PROJ = (const bf16_t*)(ws + WS_PROJ);
    const float* GATES = (const float*)(ws + WS_GATES);
    bf16_t* Qs = (bf16_t*)lds;
    bf16_t* Ks = (bf16_t*)(lds + 17408);
    float* Hs = (float*)lds;
    bf16_t* Vt = (bf16_t*)(lds + 34816);
    bf16_t* Cs = (bf16_t*)(lds + 53248);
    bf16_t* Ps = (bf16_t*)(lds + 88064);
    float* sa = (float*)(lds + 97280);
    float* sg = sa + 64;
    float* sisc = sg + 64;
    float* semr = sisc + 64;
    float* sdinv = semr + 64;
    float* snp = sdinv + 64;
    Tile2 rq, rk, rv; Tile4 rc; u32x4 rog[2]; float g0 = 0.f, g1 = 0.f, g2 = 0.f, g3 = 0.f, g4 = 0.f;
    auto load_item = [&](int it) {
        const int b = it >> 8, h = (it >> 6) & 3, c = it & 63, t0 = b * SEQ + c * 64;
        tile_load<true>(rq, PROJ + (size_t)t0 * PA + h * 128, PA, tid);
        tile_load<true>(rk, PROJ + (size_t)t0 * PA + 512 + h * 128, PA, tid);
        tile_load<true>(rv, PROJ + (size_t)t0 * PA + 1024 + h * 128, PA, tid);
        tile4_load<true>(rc, (const bf16_t*)(ws + WS_CPREV) + (size_t)it * 16384, tid);
        { const bf16_t* og = PROJ + (size_t)(t0 + (tid >> 3)) * PA + 1536 + h * 128 + (tid & 7) * 16; rog[0] = __builtin_nontemporal_load((const u32x4*)og); rog[1] = __builtin_nontemporal_load((const u32x4*)(og + 8)); }
        g0 = GATES[(size_t)(t0 + lane) * 8 + h]; g1 = GATES[(size_t)(t0 + lane) * 8 + 4 + h]; g2 = ((const float*)(ws + WS_MPREV))[it];
        g3 = ((const float*)(ws + WS_NPREV))[(size_t)it * 128 + lane]; g4 = ((const float*)(ws + WS_NPREV))[(size_t)it * 128 + 64 + lane];
    };
    if ((int)blockIdx.x < 1024) load_item(blockIdx.x);
    for (int it = blockIdx.x; it < 1024; it += gridDim.x) {
        const int b = it >> 8, h = (it >> 6) & 3, c = it & 63, t0 = b * SEQ + c * 64;
        if (wid == 0) {
            const float ip = g0, fp = g1, mprev = g2;
            const float bc = wave_incl_sum(logsigmoid_(fp), lane);
            const float a = ip - bc;
            const float g = fmaxf(wave_incl_max(a, lane), mprev);
            sa[lane] = a; sg[lane] = g; sisc[lane] = expf(mprev - g); semr[lane] = expf(-(bc + g));
        } else if (wid == 1) { snp[lane] = g3; snp[64 + lane] = g4; }
        tile_put_rows(rq, Qs, tid); tile_put_rows(rk, Ks, tid); tile_put_rows(rv, Vt, tid); tile4_put(rc, Cs, tid);
        const u32x4 ogc[2] = {rog[0], rog[1]};
        __syncthreads();
        if (it + (int)gridDim.x < 1024) load_item(it + gridDim.x);
#pragma unroll
        for (int i = 0; i < 2; ++i) {
            const int tix = wid * 2 + i, lt = tix >> 2, st = tix & 3;
            f32x4 acc = (f32x4){0.f, 0.f, 0.f, 0.f};
            if (st <= lt) {
#pragma unroll
                for (int ks = 0; ks < 4; ++ks) {
                    const bf16x8 ak = *(const bf16x8*)(Ks + (st * 16 + fr) * 136 + ks * 32 + fq * 8);
                    const bf16x8 bq = *(const bf16x8*)(Qs + (lt * 16 + fr) * 136 + ks * 32 + fq * 8);
                    acc = __builtin_amdgcn_mfma_f32_16x16x32_bf16(ak, bq, acc, 0, 0, 0);
                }
            }
            const int l = lt * 16 + fr; const float gl = sg[l];
            float pv[4];
#pragma unroll
            for (int r = 0; r < 4; ++r) { const int s = st * 16 + fq * 4 + r; pv[r] = (s <= l) ? acc[r] * fexp_(sa[s] - gl) : 0.f; }
            u32x2 o; o.x = pk2(pv[0], pv[1]); o.y = pk2(pv[2], pv[3]);
            *(u32x2*)(Ps + l * 72 + st * 16 + fq * 4) = o;
        }
        __syncthreads();
        {
            const int l = tid >> 3, part = tid & 7;
            float rs = 0.f, qn = 0.f;
            const u32x4 pw = *(const u32x4*)(Ps + l * 72 + part * 8);
            rs = (bf2f(pw.x & 0xffffu) + bf2f(pw.x >> 16)) + (bf2f(pw.y & 0xffffu) + bf2f(pw.y >> 16)) + (bf2f(pw.z & 0xffffu) + bf2f(pw.z >> 16)) + (bf2f(pw.w & 0xffffu) + bf2f(pw.w >> 16));
            const u32x4 q0 = *(const u32x4*)(Qs + l * 136 + part * 16), q1 = *(const u32x4*)(Qs + l * 136 + part * 16 + 8);
            const unsigned qw[8] = {q0.x, q0.y, q0.z, q0.w, q1.x, q1.y, q1.z, q1.w};
#pragma unroll
            for (int j = 0; j < 8; ++j) qn += bf2f(qw[j] & 0xffffu) * snp[part * 16 + 2 * j] + bf2f(qw[j] >> 16) * snp[part * 16 + 2 * j + 1];
            rs += __shfl_xor(rs, 1); rs += __shfl_xor(rs, 2); rs += __shfl_xor(rs, 4);
            qn += __shfl_xor(qn, 1); qn += __shfl_xor(qn, 2); qn += __shfl_xor(qn, 4);
            if (part == 0) { const float den = rs + sisc[l] * qn; sdinv[l] = 1.f / fmaxf(fabsf(den), semr[l]); }
        }
        f32x4 a1[4], a2[4];
#pragma unroll
        for (int lt = 0; lt < 4; ++lt) { a1[lt] = (f32x4){0.f, 0.f, 0.f, 0.f}; a2[lt] = (f32x4){0.f, 0.f, 0.f, 0.f}; }
        {
            const int e0 = wid * 16;
#pragma unroll
            for (int ss = 0; ss < 2; ++ss) {
                const bf16x8 av = frag_tr(Vt, 136, ss * 32, e0, fr, fq);
#pragma unroll
                for (int lt = 0; lt < 4; ++lt) { const bf16x8 bp = *(const bf16x8*)(Ps + (lt * 16 + fr) * 72 + ss * 32 + fq * 8); a1[lt] = __builtin_amdgcn_mfma_f32_16x16x32_bf16(av, bp, a1[lt], 0, 0, 0); }
            }
#pragma unroll
            for (int ks = 0; ks < 4; ++ks) {
                const bf16x8 ac = *(const bf16x8*)(Cs + (e0 + fr) * 136 + ks * 32 + fq * 8);
#pragma unroll
                for (int lt = 0; lt < 4; ++lt) { const bf16x8 bq = *(const bf16x8*)(Qs + (lt * 16 + fr) * 136 + ks * 32 + fq * 8); a2[lt] = __builtin_amdgcn_mfma_f32_16x16x32_bf16(ac, bq, a2[lt], 0, 0, 0); }
            }
        }
        __syncthreads();
        {
            const int e0 = wid * 16;
#pragma unroll
            for (int lt = 0; lt < 4; ++lt) {
                const int l = lt * 16 + fr; const float is = sisc[l], di = sdinv[l];
                const f32x4 hv = (a1[lt] + a2[lt] * is) * di;
                *(f32x4*)(Hs + l * 132 + e0 + fq * 4) = hv;
            }
        }
        __syncthreads();
        head_norm_out_r<0>(Hs, p.in[I_AB_HNORM] + h * 128, ogc, (bf16_t*)(ws + WS_MIX) + (size_t)t0 * 1024 + h * 128, 1024, tid);
        __syncthreads();
    }
}

__device__ __forceinline__ void load_h_row(const Params& p, int row, int lane, bool combine, f32x4 (&v)[4], int ylayer = 0) {
    const bf16_t* hrow = (const bf16_t*)(p.ws + WS_H16) + (size_t)row * 1024;
#pragma unroll
    for (int j = 0; j < 4; ++j) { const u32x2 a = *(const u32x2*)(hrow + 4 * lane + 256 * j); v[j] = (f32x4){bf2f(a.x & 0xffffu), bf2f(a.x >> 16), bf2f(a.y & 0xffffu), bf2f(a.y >> 16)}; }
    if (combine) {
        const bf16_t* y0 = (const bf16_t*)(p.ws + ws_y(ylayer)) + (size_t)row * 1024;
        const bf16_t* y1 = y0 + (size_t)T * 1024;
#pragma unroll
        for (int j = 0; j < 4; ++j) {
            const u32x2 a = __builtin_nontemporal_load((const u32x2*)(y0 + 4 * lane + 256 * j)), bq = __builtin_nontemporal_load((const u32x2*)(y1 + 4 * lane + 256 * j));
            v[j].x += bf2f(a.x & 0xffffu) + bf2f(bq.x & 0xffffu); v[j].y += bf2f(a.x >> 16) + bf2f(bq.x >> 16);
            v[j].z += bf2f(a.y & 0xffffu) + bf2f(bq.y & 0xffffu); v[j].w += bf2f(a.y >> 16) + bf2f(bq.y >> 16);
        }
    }
}

__device__ __forceinline__ void phase_combine_norm(const Params& p, bool final_) {
    const int tid = opaque_tid(), lane = tid & 63, wid = tid >> 6;
    const int gw = blockIdx.x * 8 + wid, NGW = gridDim.x * 8;
    for (int row = gw; row < T; row += NGW) {
        f32x4 v[4];
        load_h_row(p, row, lane, true, v, final_ ? 1 : 0);
        float* hrow = p.out + (size_t)row * 1024;
        if (!final_) {
            bf16_t* h16 = (bf16_t*)(p.ws + WS_H16) + (size_t)row * 1024;
#pragma unroll
            for (int j = 0; j < 4; ++j) { u32x2 o; o.x = pk2(v[j].x, v[j].y); o.y = pk2(v[j].z, v[j].w); *(u32x2*)(h16 + 4 * lane + 256 * j) = o; }
            rms_row(v, p.in[I_NORM_MIX] + 1024, (bf16_t*)(p.ws + WS_XN) + (size_t)row * 1024, lane);
        } else {
            float ss = 0.f;
#pragma unroll
            for (int j = 0; j < 4; ++j) ss += v[j].x * v[j].x + v[j].y * v[j].y + v[j].z * v[j].z + v[j].w * v[j].w;
            ss = wave_sum(ss);
            const float r = rsqrtf(ss * (1.f / 1024.f) + EPS);
#pragma unroll
            for (int j = 0; j < 4; ++j) { const f32x4 w4 = *(const f32x4*)(p.in[I_NORM_FINAL] + 4 * lane + 256 * j); __builtin_nontemporal_store(v[j] * r * w4, (f32x4*)(hrow + 4 * lane + 256 * j)); }
        }
    }
}

template <bool DYN>
__device__ __forceinline__ void moe_convert(const Params& p, unsigned char* lds, int layer, int it_lo, int it_hi, int gw, int NGW, int wid, int lane, int* ctr = nullptr) {
    unsigned char* ws = p.ws;
    float* scr = (float*)(lds + wid * 8704);
    const float* wg = p.in[I_MOE_WGATE] + (size_t)layer * 32 * 1024 * 256;
    const float* wu = p.in[I_MOE_WUP] + (size_t)layer * 32 * 1024 * 256;
    const float* wd = p.in[I_MOE_WDOWN] + (size_t)layer * 32 * 256 * 1024;
    bf16_t* WGU = (bf16_t*)(ws + ws_wgu(layer)); bf16_t* WD = (bf16_t*)(ws + ws_wd(layer));
    constexpr int IT_GU = 16 * 16, IT_D = 32 * 4, IT_E = IT_GU + IT_D;
    for (int it0 = it_lo + gw;; it0 += NGW) {
        if (DYN) { int k = 0; if (lane == 0) k = __hip_atomic_fetch_add((__attribute__((address_space(3))) int*)ctr, 1, __ATOMIC_RELAXED, __HIP_MEMORY_SCOPE_WORKGROUP); it0 = it_lo + gw + __builtin_amdgcn_readfirstlane(k) * NGW; }
        if (it0 >= it_hi) break;
        const int e = it0 / IT_E; int it = it0 - e * IT_E;
        const float* src; bf16_t* dst; int ldn, ldk;
        if (it < IT_GU) {
            const int nb = it >> 4, kb = it & 15, n0 = nb * 32, k0 = kb * 64;
            const int pn = n0 >> 8, isup = (n0 >> 7) & 1, f0 = pn * 128 + (n0 & 127);
            src = (isup ? wu : wg) + (size_t)e * 1024 * 256 + (size_t)k0 * 256 + f0; ldn = 256;
            dst = WGU + (size_t)e * 512 * 1024 + (size_t)n0 * 1024 + k0; ldk = 1024;
        } else {
            it -= IT_GU;
            const int nb = it >> 2, kb = it & 3, n0 = nb * 32, k0 = kb * 64;
            src = wd + (size_t)e * 256 * 1024 + (size_t)k0 * 1024 + n0; ldn = 1024;
            dst = WD + (size_t)e * 1024 * 256 + (size_t)n0 * 256 + k0; ldk = 256;
        }
        transpose_tile(src, ldn, dst, ldk, 1.f, scr, lane);
    }
}
template <int RSEL>
__device__ __forceinline__ void phase_route(const Params& p, unsigned char* lds, int layer) {
    const int tid = opaque_tid(), lane = tid & 63, wid = tid >> 6, fr = lane & 15, fq = lane >> 4;
    unsigned char* ws = p.ws;
    float* part = (float*)lds;
    float* lg = (float*)(lds + 98304 + 2048);
    int* ctr = (int*)(lds + 98304 + 2048 + 12288 + 256);
    if (tid == 0) *ctr = 0;
    if (RSEL == 1) __syncthreads();
    const bf16_t* H16 = (const bf16_t*)(ws + WS_H16);
    const bf16_t* wf = (const bf16_t*)(ws + WS_WCAT) + (size_t)layer * 2 * 6144 * 8;
    int* cnt = (int*)(ws + WS_CNT) + layer * 1024;
    int* list = (int*)(ws + WS_LIST); float* wlist = (float*)(ws + WS_WLIST);
    if (RSEL != 1)
    for (int grp = blockIdx.x; grp < T / 64; grp += gridDim.x) {
        const int row0 = grp * 64;
        if (grp != (int)blockIdx.x) __syncthreads();
        bf16x8 a[4][4];
#pragma unroll
        for (int rt = 0; rt < 3; ++rt)
#pragma unroll
            for (int s_ = 0; s_ < 4; ++s_) a[rt][s_] = *(const bf16x8*)(H16 + (size_t)(row0 + rt * 16 + fr) * 1024 + wid * 128 + s_ * 32 + fq * 8);
        {
            const float* gp = p.in[I_NORM_FFN] + layer * 1024 + lane * 8;
            const f32x4 g0 = *(const f32x4*)gp, g1 = *(const f32x4*)(gp + 4), g2 = *(const f32x4*)(gp + 512), g3 = *(const f32x4*)(gp + 516);
#pragma unroll
            for (int hb = 0; hb < 2; ++hb) {
                bf16x8 x[4][2];
#pragma unroll
                for (int i = 0; i < 4; ++i) {
                    const bf16_t* hrow = H16 + (size_t)(row0 + wid * 8 + hb * 4 + i) * 1024 + lane * 8;
                    x[i][0] = *(const bf16x8*)hrow; x[i][1] = *(const bf16x8*)(hrow + 512);
                }
#pragma unroll
                for (int i = 0; i < 4; ++i) {
                    float f[16];
#pragma unroll
                    for (int j = 0; j < 8; ++j) { f[j] = bf2f((unsigned short)x[i][0][j]); f[8 + j] = bf2f((unsigned short)x[i][1][j]); }
                    float ss = 0.f;
#pragma unroll
                    for (int j = 0; j < 16; ++j) ss += f[j] * f[j];
                    ss = wave_sum(ss);
                    const float rs = rsqrtf(ss * (1.f / 1024.f) + EPS);
                    if (lane == 0) lg[64 * 48 + wid * 8 + hb * 4 + i] = rs;
                    u32x4 o0, o1;
                    o0.x = pk2(f[0] * rs * g0.x, f[1] * rs * g0.y); o0.y = pk2(f[2] * rs * g0.z, f[3] * rs * g0.w);
                    o0.z = pk2(f[4] * rs * g1.x, f[5] * rs * g1.y); o0.w = pk2(f[6] * rs * g1.z, f[7] * rs * g1.w);
                    o1.x = pk2(f[8] * rs * g2.x, f[9] * rs * g2.y); o1.y = pk2(f[10] * rs * g2.z, f[11] * rs * g2.w);
                    o1.z = pk2(f[12] * rs * g3.x, f[13] * rs * g3.y); o1.w = pk2(f[14] * rs * g3.z, f[15] * rs * g3.w);
                    bf16_t* xrow = (bf16_t*)(ws + WS_XN) + (size_t)(row0 + wid * 8 + hb * 4 + i) * 1024 + lane * 8;
                    *(u32x4*)xrow = o0; *(u32x4*)(xrow + 512) = o1;
                }
            }
        }
        bf16x8 bh[4][3], bl[4][3];
#pragma unroll
        for (int s_ = 0; s_ < 4; ++s_) a[3][s_] = *(const bf16x8*)(H16 + (size_t)(row0 + 48 + fr) * 1024 + wid * 128 + s_ * 32 + fq * 8);
#pragma unroll
        for (int s_ = 0; s_ < 4; ++s_)
#pragma unroll
            for (int n = 0; n < 3; ++n) {
                bh[s_][n] = *(const bf16x8*)(wf + ((size_t)((wid * 4 + s_) * 3 + n) * 64 + lane) * 8);
                bl[s_][n] = *(const bf16x8*)(wf + ((size_t)6144 + (size_t)((wid * 4 + s_) * 3 + n) * 64 + lane) * 8);
            }
#pragma unroll
        for (int rt = 0; rt < 4; ++rt) {
            f32x4 acc[3] = {(f32x4){0.f, 0.f, 0.f, 0.f}, (f32x4){0.f, 0.f, 0.f, 0.f}, (f32x4){0.f, 0.f, 0.f, 0.f}};
#pragma unroll
            for (int s_ = 0; s_ < 4; ++s_)
#pragma unroll
                for (int n = 0; n < 3; ++n) {
                    acc[n] = __builtin_amdgcn_mfma_f32_16x16x32_bf16(a[rt][s_], bl[s_][n], acc[n], 0, 0, 0);
                    acc[n] = __builtin_amdgcn_mfma_f32_16x16x32_bf16(a[rt][s_], bh[s_][n], acc[n], 0, 0, 0);
                }
#pragma unroll
            for (int n = 0; n < 3; ++n)
#pragma unroll
                for (int r = 0; r < 4; ++r) part[(wid * 64 + rt * 16 + fq * 4 + r) * 48 + n * 16 + fr] = acc[n][r];
        }
        __syncthreads();
        for (int i = tid; i < 64 * 48; i += NTHR) {
            float t = 0.f;
#pragma unroll
            for (int w = 0; w < 8; ++w) t += part[w * 3072 + i];
            lg[i] = t;
        }
        __syncthreads();
        if (wid == 0) {
            const int row = row0 + lane;
            const float rs = lg[64 * 48 + lane];
            const float* l = lg + lane * 48;
            const float* bg = p.in[I_MOE_BG] + layer * 4; const float* br = p.in[I_MOE_BR] + layer * 32;
            float gm = l[32] * rs + bg[0]; int gi = 0; float gl[4]; gl[0] = gm;
#pragma unroll
            for (int i = 1; i < 4; ++i) { gl[i] = l[32 + i] * rs + bg[i]; if (gl[i] > gm) { gm = gl[i]; gi = i; } }
            float gs = 0.f;
#pragma unroll
            for (int i = 0; i < 4; ++i) gs += expf(gl[i] - gm);
            const float gval = 1.f / gs;
            float m1 = -3.0e38f, m2 = -3.0e38f; int i1 = 0, i2 = 0;
#pragma unroll
            for (int i = 0; i < 8; ++i) {
                const float v = l[gi * 8 + i] * rs + br[gi * 8 + i];
                if (v > m1) { m2 = m1; i2 = i1; m1 = v; i1 = i; } else if (v > m2) { m2 = v; i2 = i; }
            }
            const float e2 = expf(m2 - m1), inv = gval / (1.f + e2);
            const int x1 = gi * 8 + i1, x2 = gi * 8 + i2;
            const unsigned long long ltm = (1ull << lane) - 1ull;
            int myc = 0, r1 = 0, r2 = 0;
#pragma unroll 1
            for (int e = 0; e < 32; ++e) {
                const unsigned long long b1 = __ballot(x1 == e), b2 = __ballot(x2 == e);
                const int c1 = __popcll(b1), c = c1 + __popcll(b2);
                if (lane == e) myc = c;
                if (x1 == e) r1 = __popcll(b1 & ltm);
                if (x2 == e) r2 = c1 + __popcll(b2 & ltm);
            }
            int base = 0;
            if (lane < 32 && myc > 0) base = atomicAdd(&cnt[lane * 32], myc);
            const int p1 = x1 * ECAP + __shfl(base, x1) + r1, p2 = x2 * ECAP + __shfl(base, x2) + r2;
            list[p1] = row * 2; wlist[p1] = inv;
            list[p2] = row * 2 + 1; wlist[p2] = inv * e2;
        }
    }
    if (RSEL < 2) moe_convert<true>(p, lds, layer, (layer == 1 && (int)gridDim.x > 128) ? MOE_CONV_EARLY : 0, MOE_CONV_ITEMS, blockIdx.x, gridDim.x, wid, lane, ctr);
}

struct AGather {
    const bf16_t* XN; const int* lst; int n;
    __device__ __forceinline__ const bf16_t* operator()(int r, int kc) const { const int tok = (r < n) ? (lst[r] >> 1) : 0; return XN + (size_t)tok * 1024 + kc * 8; }
};
struct EpiGateUp {
    bf16_t* H;
    __device__ __forceinline__ void operator()(const f32x4 (&acc)[2][4], int wr, int wc, int fr, int fq) const {
#pragma unroll
        for (int m = 0; m < 2; ++m)
#pragma unroll
            for (int n = 0; n < 2; ++n) {
                const f32x4 g = acc[m][n], u = acc[m][n + 2];
                u32x2 o; o.x = pk2(fsilu_(g.x) * u.x, fsilu_(g.y) * u.y); o.y = pk2(fsilu_(g.z) * u.z, fsilu_(g.w) * u.w);
                *(u32x2*)(H + (size_t)(wr * 32 + m * 16 + fr) * 256 + wc * 32 + n * 16 + fq * 4) = o;
            }
    }
};
struct EpiDown {
    bf16_t* Y; const int* lst; const float* wl; int n; int col0;
    __device__ __forceinline__ void operator()(const f32x4 (&acc)[2][4], int wr, int wc, int fr, int fq) const {
#pragma unroll
        for (int m = 0; m < 2; ++m) {
            const int r = wr * 32 + m * 16 + fr;
            if (r < n) {
                const int en = lst[r]; const float w = wl[r];
                bf16_t* yr = Y + ((size_t)(en & 1) * T + (en >> 1)) * 1024 + col0 + wc * 64 + fq * 4;
#pragma unroll
                for (int nn = 0; nn < 4; ++nn) { const f32x4 v = acc[m][nn] * w; u32x2 o; o.x = pk2(v.x, v.y); o.y = pk2(v.z, v.w); *(u32x2*)(yr + nn * 16) = o; }
            }
        }
    }
};
__device__ __forceinline__ void moe_prefix(const Params& p, int layer, int* tp, int* cn) {
    const int* cnt = (const int*)(p.ws + WS_CNT) + layer * 1024;
    int* sp = cn + 32;
    const int tid = opaque_tid();
    __syncthreads();
    if (tid < 32) cn[tid] = cnt[tid * 32];
    __syncthreads();
    if (tid == 0) {
        int s_ = 0, q_ = 0;
        for (int e = 0; e < 32; ++e) {
            const int c = cn[e], rem = c & 255;
            tp[e] = s_; sp[e] = q_;
            s_ += (c >> 8) + (rem > 128 ? 1 : 0); q_ += (rem > 0 && rem <= 128) ? 1 : 0;
        }
        tp[32] = s_; sp[32] = q_;
    }
    __syncthreads();
}
struct BGateUp {
    const bf16_t* W; int f0;
    __device__ __forceinline__ const bf16_t* operator()(int r, int kc) const {
        const int f = f0 + (r >> 6) * 32 + ((r >> 4) & 1) * 16 + (r & 15), isup = (r >> 5) & 1;
        return W + (size_t)((f >> 7) * 256 + isup * 128 + (f & 127)) * 1024 + kc * 8;
    }
};
constexpr int LDS_MOE_TAB = 131072, LDS_MOE_TP = 131072 + 4096;
__device__ __forceinline__ void phase_moe_up(const Params& p, unsigned char* lds, int layer) {
    unsigned* tab = (unsigned*)(lds + LDS_MOE_TAB); int* tp = (int*)(lds + LDS_MOE_TP); int* cn = tp + 64;
    moe_prefix(p, layer, tp, cn);
    pg8::SchedMoe S{tp, cn, tab, 2, tp[32] * 2, (int)gridDim.x, (int)blockIdx.x};
    const int* list = (const int*)(p.ws + WS_LIST);
    const int tid = opaque_tid();
    for (int i = 0; i < pg8::MOE_MAXU; ++i) {
        pg8::Unit u; if (!S.next(i, u)) break;
        const int e = u.pn >> 1, pos = (u.pm - tp[e]) * 256 + tid;
        if (tid < 256) tab[i * 256 + tid] = (pos < cn[e]) ? (unsigned)(list[(size_t)e * ECAP + pos] >> 1) * 2048u : 0u;
    }
    __syncthreads();
    pg8::Gemm g{(const bf16_t*)(p.ws + WS_XN), (const bf16_t*)(p.ws + ws_wgu(layer)), 0, 0, 1024};
    pg8::EpiMoeUp E{(bf16_t*)(p.ws + WS_HID)};
    pg8::gemm_phase_g<pg8::EpiMoeUp, pg8::SchedMoe>((PG8_LAS unsigned char*)lds, g, S, E);
    __syncthreads();
    const int* sp = cn + 32; const int nsm = sp[32], np8 = tp[32];
    for (int u = blockIdx.x; u < nsm * 4; u += gridDim.x) {
        const int si = u >> 2, pn4 = u & 3;
        int e = 0; while (sp[e + 1] <= si) ++e;
        const int pos0 = (tp[e + 1] - tp[e]) * 256, n = cn[e] - pos0;
        AGather ag{(const bf16_t*)(p.ws + WS_XN), list + (size_t)e * ECAP + pos0, n};
        BGateUp bg{(const bf16_t*)(p.ws + ws_wgu(layer)) + (size_t)e * 512 * 1024, pn4 * 64};
        EpiGateUp ep{(bf16_t*)(p.ws + WS_HID) + ((size_t)np8 * 256 + (size_t)si * 128) * 256 + pn4 * 64};
        gemm128b(lds, ag, bg, 1024, ep);
    }
}
__device__ __forceinline__ void phase_moe_down(const Params& p, unsigned char* lds, int layer) {
    unsigned* tab = (unsigned*)(lds + LDS_MOE_TAB); float* wtab = (float*)(lds + LDS_MOE_TAB + 4096); int* tp = (int*)(lds + LDS_MOE_TP + 4096); int* cn = tp + 64;
    moe_prefix(p, layer, tp, cn);
    pg8::SchedMoe S{tp, cn, tab, 4, tp[32] * 4, (int)gridDim.x, (int)blockIdx.x};
    const int* list = (const int*)(p.ws + WS_LIST); const float* wlist = (const float*)(p.ws + WS_WLIST);
    const int tid = opaque_tid();
    for (int i = 0; i < pg8::MOE_MAXU; ++i) {
        pg8::Unit u; if (!S.next(i, u)) break;
        const int e = u.pn >> 2, pos = (u.pm - tp[e]) * 256 + tid;
        if (tid < 256) {
            const bool ok = pos < cn[e];
            const int en = ok ? list[(size_t)e * ECAP + pos] : 0;
            tab[i * 256 + tid] = ok ? (unsigned)((en & 1) * T + (en >> 1)) : 0xffffffffu;
            wtab[i * 256 + tid] = ok ? wlist[(size_t)e * ECAP + pos] : 0.f;
        }
    }
    __syncthreads();
    pg8::Gemm g{(const bf16_t*)(p.ws + WS_HID), (const bf16_t*)(p.ws + ws_wd(layer)), 0, 0, 256};
    pg8::EpiMoeDown E{(bf16_t*)(p.ws + ws_y(layer)), tab, wtab};
    pg8::gemm_phase<pg8::EpiMoeDown, pg8::SchedMoe, true, true>((PG8_LAS unsigned char*)lds, g, S, E);
    __syncthreads();
    const int* sp = cn + 32; const int nsm = sp[32], np8 = tp[32];
    for (int u = blockIdx.x; u < nsm * 8; u += gridDim.x) {
        const int si = u >> 3, pn8 = u & 7;
        int e = 0; while (sp[e + 1] <= si) ++e;
        const int pos0 = (tp[e + 1] - tp[e]) * 256, n = cn[e] - pos0;
        APlain ap{(const bf16_t*)(p.ws + WS_HID) + ((size_t)np8 * 256 + (size_t)si * 128) * 256, 256};
        EpiDown ep{(bf16_t*)(p.ws + ws_y(layer)), list + (size_t)e * ECAP + pos0, wlist + (size_t)e * ECAP + pos0, n, pn8 * 128};
        gemm128(lds, ap, (const bf16_t*)(p.ws + ws_wd(layer)) + (size_t)e * 1024 * 256 + (size_t)pn8 * 128 * 256, 256, ep);
    }
}

constexpr int LDS_HG_SEG = 98304, LDS_HG_LBT = 106496;
struct HgBlk { float bc[4][4]; float kk[4][4]; };
__device__ __forceinline__ void hgrn_lb_table(const Params& p, float* lbt, int tid) {
    const float* lbp = p.in[I_HGRN_LB];
    lbt[tid] = sigmoid_(lbp[512 + tid] - lbp[tid]);
    __syncthreads();
}
__device__ __forceinline__ void hg_block(const bf16_t* __restrict__ fg, const float* lbt, float* seg, int tid, HgBlk& B) {
    const int k0 = (tid & 31) * 4, l0 = (tid >> 5) * 4;
    const f32x4 lb4 = *(const f32x4*)(lbt + k0);
    u32x2 w[4];
#pragma unroll
    for (int i = 0; i < 4; ++i) w[i] = *(const u32x2*)(fg + (size_t)(l0 + i) * PC + k0);
    float run[4] = {1.f, 1.f, 1.f, 1.f};
#pragma unroll
    for (int i = 0; i < 4; ++i) {
        const float x[4] = {bf2f(w[i].x & 0xffffu), bf2f(w[i].x >> 16), bf2f(w[i].y & 0xffffu), bf2f(w[i].y >> 16)};
#pragma unroll
        for (int j = 0; j < 4; ++j) {
            const float lb = lb4[j], sg = fsigmoid_(x[j]), f = lb + (1.f - lb) * sg;
            run[j] *= f; B.bc[i][j] = run[j]; B.kk[i][j] = (1.f - lb) * (1.f - sg);
        }
    }
    *(f32x4*)(seg + (tid >> 5) * 128 + k0) = (f32x4){run[0], run[1], run[2], run[3]};
}
__device__ __forceinline__ void hg_offsets(const float* seg, int tid, HgBlk& B, f32x4& bend) {
    const int k0 = (tid & 31) * 4, ls = tid >> 5;
    f32x4 off = (f32x4){1.f, 1.f, 1.f, 1.f}, tot = off;
#pragma unroll
    for (int r = 0; r < 16; ++r) { const f32x4 v = *(const f32x4*)(seg + r * 128 + k0); if (r < ls) off *= v; tot *= v; }
#pragma unroll
    for (int i = 0; i < 4; ++i)
#pragma unroll
        for (int j = 0; j < 4; ++j) B.bc[i][j] *= off[j];
    bend = tot;
}

__device__ __forceinline__ void phase_cd_local(const Params& p, unsigned char* lds) {
    const int tid = opaque_tid(), lane = tid & 63, wid = tid >> 6, fr = lane & 15, fq = lane >> 4;
    unsigned char* ws = p.ws;
    const bf16_t* PROJ = (const bf16_t*)(ws + WS_PROJ);
    bf16_t* KhT = (bf16_t*)lds;
    bf16_t* Vt = (bf16_t*)(lds + 18432);
    float* seg = (float*)(lds + LDS_HG_SEG); float* lbt = (float*)(lds + LDS_HG_LBT);
    hgrn_lb_table(p, lbt, tid);
    const int k0 = (tid & 31) * 4, l0 = (tid >> 5) * 4;
    for (int it = blockIdx.x; it < 1024 + 256; it += gridDim.x) {
        if (it < 1024) {
            const int b = it >> 8, h = (it >> 6) & 3, c = it & 63, t0 = b * SEQ + c * 64;
            HgBlk B;
            hg_block(PROJ + (size_t)t0 * PC + 1024 + h * 128, lbt + h * 128, seg, tid, B);
            Tile2 rv; tile_load(rv, PROJ + (size_t)t0 * PC + 1536 + h * 128, PC, tid);
            __syncthreads();
            f32x4 bend; hg_offsets(seg, tid, B, bend);
#pragma unroll
            for (int j = 0; j < 4; ++j) {
                u32x2 o; o.x = pk2(B.kk[0][j] * bend[j] * __builtin_amdgcn_rcpf(B.bc[0][j]), B.kk[1][j] * bend[j] * __builtin_amdgcn_rcpf(B.bc[1][j]));
                o.y = pk2(B.kk[2][j] * bend[j] * __builtin_amdgcn_rcpf(B.bc[2][j]), B.kk[3][j] * bend[j] * __builtin_amdgcn_rcpf(B.bc[3][j]));
                *(u32x2*)(KhT + tsw(k0 + j, l0)) = o;
            }
            if (tid < 32) *(f32x4*)((float*)(ws + WS_BENDV) + (size_t)it * 128 + k0) = bend;
            tile_put_rows(rv, Vt, tid);
            __syncthreads();
            state_outer_tr<false>(KhT, Vt, (bf16_t*)(ws + WS_U) + (size_t)it * 16384, wid, fr, fq);
            __syncthreads();
        } else {
            s5_unit_E(p, lds, it - 1024);
        }
    }
}

template <int SEL>
__device__ __forceinline__ void phase_cd_out(const Params& p, unsigned char* lds) {
    const int tid = opaque_tid(), lane = tid & 63, wid = tid >> 6, fr = lane & 15, fq = lane >> 4;
    unsigned char* ws = p.ws;
    const bf16_t* PROJ = (const bf16_t*)(ws + WS_PROJ);
    bf16_t* Qs = (bf16_t*)lds;
    bf16_t* Ks = (bf16_t*)(lds + 17408);
    float* Hs = (float*)lds;
    bf16_t* Vt = (bf16_t*)(lds + 34816);
    bf16_t* Ss = (bf16_t*)(lds + 53248);
    bf16_t* Ps = (bf16_t*)(lds + 88064);
    float* seg = (float*)(lds + LDS_HG_SEG); float* lbt = (float*)(lds + LDS_HG_LBT);
    hgrn_lb_table(p, lbt, tid);
    const int k0 = (tid & 31) * 4, l0 = (tid >> 5) * 4;
    for (int it = blockIdx.x + (SEL == 2 ? 1024 : 0); it < (SEL == 1 ? 1024 : 1024 + 256); it += gridDim.x) {
        if (it < 1024) {
            const int b = it >> 8, h = (it >> 6) & 3, c = it & 63, t0 = b * SEQ + c * 64;
            HgBlk B;
            hg_block(PROJ + (size_t)t0 * PC + 1024 + h * 128, lbt + h * 128, seg, tid, B);
            u32x2 qw[4];
#pragma unroll
            for (int i = 0; i < 4; ++i) qw[i] = __builtin_nontemporal_load((const u32x2*)(PROJ + (size_t)(t0 + l0 + i) * PC + 512 + h * 128 + k0));
            Tile2 rv; Tile4 rs;
            tile_load<true>(rv, PROJ + (size_t)t0 * PC + 1536 + h * 128, PC, tid);
            tile4_load<true>(rs, (const bf16_t*)(ws + WS_CPREV) + (size_t)it * 16384, tid);
            tile_put_rows(rv, Vt, tid); tile4_put(rs, Ss, tid);
            __syncthreads();
            f32x4 bend; hg_offsets(seg, tid, B, bend);
#pragma unroll
            for (int i = 0; i < 4; ++i) {
                const float q0 = bf2f(qw[i].x & 0xffffu), q1 = bf2f(qw[i].x >> 16), q2 = bf2f(qw[i].y & 0xffffu), q3 = bf2f(qw[i].y >> 16);
                const float e0 = B.bc[i][0], e1 = B.bc[i][1], e2 = B.bc[i][2], e3 = B.bc[i][3];
                u32x2 oq; oq.x = pk2(q0 * e0, q1 * e1); oq.y = pk2(q2 * e2, q3 * e3);
                u32x2 ok; ok.x = pk2(B.kk[i][0] * __builtin_amdgcn_rcpf(e0), B.kk[i][1] * __builtin_amdgcn_rcpf(e1)); ok.y = pk2(B.kk[i][2] * __builtin_amdgcn_rcpf(e2), B.kk[i][3] * __builtin_amdgcn_rcpf(e3));
                *(u32x2*)(Qs + (l0 + i) * 136 + k0) = oq; *(u32x2*)(Ks + (l0 + i) * 136 + k0) = ok;
            }
            __syncthreads();
#pragma unroll
            for (int i = 0; i < 2; ++i) {
                const int tix = wid * 2 + i, lt = tix >> 2, st = tix & 3;
                f32x4 acc = (f32x4){0.f, 0.f, 0.f, 0.f};
                if (st <= lt) {
#pragma unroll
                    for (int ks = 0; ks < 4; ++ks) {
                        const bf16x8 ak = *(const bf16x8*)(Ks + (st * 16 + fr) * 136 + ks * 32 + fq * 8);
                        const bf16x8 bq = *(const bf16x8*)(Qs + (lt * 16 + fr) * 136 + ks * 32 + fq * 8);
                        acc = __builtin_amdgcn_mfma_f32_16x16x32_bf16(ak, bq, acc, 0, 0, 0);
                    }
                }
                const int l = lt * 16 + fr;
                float pv[4];
#pragma unroll
                for (int r = 0; r < 4; ++r) { const int s_ = st * 16 + fq * 4 + r; pv[r] = (s_ <= l) ? acc[r] : 0.f; }
                u32x2 o; o.x = pk2(pv[0], pv[1]); o.y = pk2(pv[2], pv[3]);
                *(u32x2*)(Ps + l * 72 + st * 16 + fq * 4) = o;
            }
            __syncthreads();
            f32x4 a1[4];
#pragma unroll
            for (int lt = 0; lt < 4; ++lt) a1[lt] = (f32x4){0.f, 0.f, 0.f, 0.f};
            {
                const int e0 = wid * 16;
#pragma unroll
                for (int ss = 0; ss < 2; ++ss) {
                    const bf16x8 av = frag_tr(Vt, 136, ss * 32, e0, fr, fq);
#pragma unroll
                    for (int lt = 0; lt < 4; ++lt) { const bf16x8 bp = *(const bf16x8*)(Ps + (lt * 16 + fr) * 72 + ss * 32 + fq * 8); a1[lt] = __builtin_amdgcn_mfma_f32_16x16x32_bf16(av, bp, a1[lt], 0, 0, 0); }
                }
#pragma unroll
                for (int ks = 0; ks < 4; ++ks) {
                    const bf16x8 ac = *(const bf16x8*)(Ss + (e0 + fr) * 136 + ks * 32 + fq * 8);
#pragma unroll
                    for (int lt = 0; lt < 4; ++lt) { const bf16x8 bq = *(const bf16x8*)(Qs + (lt * 16 + fr) * 136 + ks * 32 + fq * 8); a1[lt] = __builtin_amdgcn_mfma_f32_16x16x32_bf16(ac, bq, a1[lt], 0, 0, 0); }
                }
            }
            __syncthreads();
            {
                const int e0 = wid * 16;
#pragma unroll
                for (int lt = 0; lt < 4; ++lt) *(f32x4*)(Hs + (lt * 16 + fr) * 132 + e0 + fq * 4) = a1[lt];
            }
            __syncthreads();
            head_norm_out<1>(Hs, p.in[I_HGRN_ONORM] + h * 128, PROJ + (size_t)t0 * PC + 2048 + h * 128, PC, (bf16_t*)(ws + WS_MIX) + (size_t)t0 * 1024 + 512 + h * 128, 1024, tid);
            __syncthreads();
        } else {
            s5_unit_Y(p, lds, it - 1024);
        }
    }
}

#define XB_TMO      128
#define XB_XCNT(j)  (256  + 64 * (j))
#define XB_XSUB(j)  (1280 + 64 * (j))
#define XB_XGEN(j)  (2304 + 64 * (j))
#define XB_TOP      3328
#define XB_TOPGEN   3392
#define XCD_BAR_WORDS 3456
#define XB_SPIN_CAP (1u << 22)
#define LAS __attribute__((address_space(3)))
constexpr size_t WS_BAR = 4096;
constexpr size_t CTL_ZERO_BYTES = 32768;
static_assert(WS_BAR + XCD_BAR_WORDS * 4 <= CTL_ZERO_BYTES, "barrier words outside the zeroed region");
constexpr int LDS_BAR_OFF = LDS_BYTES - 16;
__device__ __forceinline__ unsigned xb_ld(unsigned* p)              { return __hip_atomic_load(p, __ATOMIC_RELAXED, __HIP_MEMORY_SCOPE_AGENT); }
__device__ __forceinline__ unsigned xb_add(unsigned* p, unsigned v) { return __hip_atomic_fetch_add(p, v, __ATOMIC_RELAXED, __HIP_MEMORY_SCOPE_AGENT); }
__device__ __forceinline__ unsigned xb_xcc_id() { return (unsigned)__builtin_amdgcn_s_getreg((3 << 11) | 20) & 0xFu; }
#define XB_SPIN(cond, bar) do { unsigned _sp = 0; while (cond) { __builtin_amdgcn_s_sleep(1); \
    if ((++_sp & 255u) == 0u) { if (xb_ld(&(bar)[XB_TMO])) break; if (_sp > XB_SPIN_CAP) { atomicAdd(&(bar)[XB_TMO], 1u); break; } } } } while (0)
struct XcdBarrier { unsigned* bar; unsigned x; volatile LAS unsigned* st; };
__device__ __forceinline__ XcdBarrier xcd_barrier_post(unsigned* bar, volatile LAS unsigned* st) {
    XcdBarrier b; b.bar = bar; b.x = xb_xcc_id(); b.st = st;
    if (opaque_tid() == 0) (void)xb_add(&bar[XB_XCNT(b.x)], 1u);
    return b;
}
__device__ __forceinline__ void xcd_barrier_complete(unsigned* bar, unsigned x, unsigned& nloc, unsigned& nx) {
    const unsigned G = gridDim.x * gridDim.y * gridDim.z;
    unsigned sum, cnt, mine, sp = 0u;
    for (;;) {
        sum = 0u; cnt = 0u; mine = 0u;
#pragma unroll
        for (unsigned j = 0; j < 16; ++j) { const unsigned c = xb_ld(&bar[XB_XCNT(j)]); sum += c; cnt += (c > 0u) ? 1u : 0u; mine = (j == x) ? c : mine; }
        if (sum == G) break;
        __builtin_amdgcn_s_sleep(1);
        if ((++sp & 255u) == 0u) { if (xb_ld(&bar[XB_TMO])) break; if (sp > XB_SPIN_CAP) { atomicAdd(&bar[XB_TMO], 1u); break; } }
    }
    nloc = mine > 0u ? mine : 1u; nx = cnt > 0u ? cnt : 1u;
}
__device__ __forceinline__ void xcd_barrier(const XcdBarrier& b) {
    asm volatile("s_waitcnt vmcnt(0)" ::: "memory");
    __syncthreads();
    if (opaque_tid() == 0) {
        unsigned* bar = b.bar;
        __builtin_amdgcn_s_waitcnt(0);
        unsigned nloc = b.st[0], nx = b.st[1];
        if (nloc == 0u) { xcd_barrier_complete(bar, b.x, nloc, nx); b.st[0] = nloc; b.st[1] = nx; }
        const unsigned old = xb_add(&bar[XB_XSUB(b.x)], 1u);
        const unsigned gen = old / nloc;
        if (old + 1u == (gen + 1u) * nloc) {
            __builtin_amdgcn_fence(__ATOMIC_RELEASE, "agent");
            asm volatile("s_waitcnt vmcnt(0)" ::: "memory");
            const unsigned og = xb_add(&bar[XB_TOP], 1u);
            const unsigned tg = og / nx;
            if (og + 1u == (tg + 1u) * nx) xb_add(&bar[XB_TOPGEN], 1u);
            else XB_SPIN(xb_ld(&bar[XB_TOPGEN]) == tg, bar);
            __builtin_amdgcn_fence(__ATOMIC_ACQUIRE, "agent");
            xb_add(&bar[XB_XGEN(b.x)], 1u);
            asm volatile("s_waitcnt vmcnt(0)" ::: "memory");
        } else {
            XB_SPIN(xb_ld(&bar[XB_XGEN(b.x)]) == gen, bar);
            __builtin_amdgcn_fence(__ATOMIC_ACQUIRE, "agent");
            asm volatile("s_waitcnt vmcnt(0)" ::: "memory");
        }
    }
    __syncthreads();
}

constexpr int NPHASE = 20;
constexpr unsigned REP_MASK = 0u;
constexpr int PROBE_SEL = 0;
template <int PH>
__device__ __forceinline__ void run_phase(const Params& p, unsigned char* lds) {
    unsigned char* ws = p.ws;
    if constexpr (PH == 0) phase_prep(p, lds);
    else if constexpr (PH == 1) { s5_gen_ktab(p); phase_gemm256_inproj0(lds, p); }
    else if constexpr (PH == 2) { s5_gen_ops(p); phase_mlstm_local(p, lds); }
    else if constexpr (PH == 3) phase_scan<false>(p, lds);
    else if constexpr (PH == 4) phase_mlstm_out(p, lds);
    else if constexpr (PH == 5) phase_gemm256_resid(lds, (const bf16_t*)(ws + WS_MIX), (const bf16_t*)(ws + WS_WOUTA), nullptr, (const bf16_t*)(ws + WS_H16), (bf16_t*)(ws + WS_H16));
    else if constexpr (PH == 6) phase_route<0>(p, lds, 0);
    else if constexpr (PH == 7) phase_moe_up(p, lds, 0);
    else if constexpr (PH == 8) phase_moe_down(p, lds, 0);
    else if constexpr (PH == 9) phase_combine_norm(p, false);
    else if constexpr (PH == 10) phase_gemm256_inproj1(lds, p);
    else if constexpr (PH == 11) phase_cd_local(p, lds);
    else if constexpr (PH == 12) phase_scan<true>(p, lds);
    else if constexpr (PH == 13) phase_cd_out<0>(p, lds);
    else if constexpr (PH == 14) {
        phase_gemm_glu(lds, p);
        if ((int)blockIdx.x >= 128) { const int t_ = opaque_tid(); moe_convert<false>(p, lds, 1, 0, MOE_CONV_EARLY, ((int)blockIdx.x - 128) * 8 + (t_ >> 6), ((int)gridDim.x - 128) * 8, t_ >> 6, t_ & 63); }
    }
    else if constexpr (PH == 15) phase_gemm256_resid(lds, (const bf16_t*)(ws + WS_MIX), (const bf16_t*)(ws + WS_WOUTC), nullptr, (const bf16_t*)(ws + WS_H16), (bf16_t*)(ws + WS_H16));
    else if constexpr (PH == 16) phase_route<0>(p, lds, 1);
    else if constexpr (PH == 17) phase_moe_up(p, lds, 1);
    else if constexpr (PH == 18) phase_moe_down(p, lds, 1);
    else if constexpr (PH == 19) phase_combine_norm(p, true);
}
template <int PH>
__device__ __forceinline__ void run_from(const Params& p, unsigned char* lds, const XcdBarrier& bar) {
    run_phase<PH>(p, lds);
    if constexpr ((REP_MASK >> PH) & 1u) {
        xcd_barrier(bar);
        if constexpr ((PH == 6 || PH == 16) && PROBE_SEL != 4) { { const int t_ = opaque_tid(); if (blockIdx.x == 0 && t_ < 32) ((int*)(p.ws + WS_CNT))[(PH == 16 ? 1024 : 0) + t_ * 32] = 0; } xcd_barrier(bar); }
        if constexpr (PH == 13 && PROBE_SEL != 0) phase_cd_out<PROBE_SEL>(p, lds); else
        if constexpr (PH == 6 && PROBE_SEL != 0) phase_route<PROBE_SEL>(p, lds, 0); else
        run_phase<PH>(p, lds);
    }
    if constexpr (PH + 1 < NPHASE) {
        xcd_barrier(bar);
        run_from<PH + 1>(p, lds, bar);
    }
}
__global__ void __launch_bounds__(NTHR, 2) mega(Params p) {
    extern __shared__ __attribute__((aligned(16))) unsigned char lds[];
    if (p.use_cg) cg::this_grid().sync();
    { const int t_ = opaque_tid(); if (t_ < 4) ((unsigned*)(lds + LDS_BAR_OFF))[t_] = 0u; }
    __syncthreads();
    const XcdBarrier bar = xcd_barrier_post((unsigned*)(p.ws + WS_BAR), (volatile LAS unsigned*)(lds + LDS_BAR_OFF));
    run_from<0>(p, lds, bar);
}

extern "C" void kernel_launch(void* const* d_in, const int* in_sizes, int n_in, void* d_out, int out_size, void* d_ws, size_t ws_size, hipStream_t stream) {
    static int grid = 0;
    if (grid == 0) {
        if (n_in != 30 || out_size != T * DM || ws_size < WS_END) { fprintf(stderr, "kernel_launch: unexpected shapes (n_in %d out %d ws %zu)\n", n_in, out_size, ws_size); grid = -1; return; }
        int dev = 0, cus = 0, per_cu = 0;
        (void)hipGetDevice(&dev);
        (void)hipDeviceGetAttribute(&cus, hipDeviceAttributeMultiprocessorCount, dev);
        (void)hipFuncSetAttribute((const void*)mega, hipFuncAttributeMaxDynamicSharedMemorySize, LDS_BYTES);
        (void)hipOccupancyMaxActiveBlocksPerMultiprocessor(&per_cu, (const void*)mega, NTHR, LDS_BYTES);
        if (per_cu < 1) { fprintf(stderr, "kernel_launch: occupancy query says %d blocks per CU\n", per_cu); per_cu = 1; }
        grid = cus * 1;
        (void)hipGetLastError();
    }
    if (grid < 0) return;
    Params p{};
    for (int i = 0; i < 30; ++i) p.in[i] = (const float*)d_in[i];
    p.out = (float*)d_out; p.ws = (unsigned char*)d_ws;
    p.use_cg = 0; p.pad = 0;
    (void)hipMemsetAsync((unsigned char*)d_ws + WS_CTL, 0, CTL_ZERO_BYTES, stream);
    void* args[] = {&p};
    hipError_t e = hipLaunchCooperativeKernel((const void*)mega, dim3(grid), dim3(NTHR), args, LDS_BYTES, stream);
    if (e != hipSuccess) fprintf(stderr, "cooperative launch failed: %s (grid %d)\n", hipGetErrorString(e), grid);
}
```

```cpp
#include <hip/hip_runtime.h>
#include <hip/hip_cooperative_groups.h>
#include <cstdio>
#include <cstdint>
namespace cg = cooperative_groups;

typedef unsigned short bf16_t;
typedef short bf16x8 __attribute__((ext_vector_type(8)));
typedef float f32x4 __attribute__((ext_vector_type(4)));
typedef float f32x2 __attribute__((ext_vector_type(2)));
typedef unsigned u32x4 __attribute__((ext_vector_type(4)));
typedef unsigned u32x2 __attribute__((ext_vector_type(2)));

constexpr int T = 16384, DM = 1024, SEQ = 4096;
constexpr int NTHR = 512;
constexpr int PA = 3584;
constexpr int PC = 2560;
constexpr int ECAP = 16384;
constexpr float EPS = 1e-6f;

constexpr size_t KB = 1024, MB = 1024 * 1024;
constexpr size_t WS_CTL = 0;
constexpr size_t WS_CNT = 20480;
constexpr size_t WS_GATES = 64 * KB;
constexpr size_t WS_S5POW = WS_GATES + 512 * KB;
constexpr size_t WS_S5BBAR = WS_S5POW + 272 * KB;
constexpr size_t WS_WCAT = WS_S5BBAR + 256 * KB;
constexpr size_t WS_NLOC = WS_WCAT + 384 * KB;
constexpr size_t WS_NPREV = WS_NLOC + 512 * KB;
constexpr size_t WS_BENDV = WS_NPREV + 512 * KB;
constexpr size_t WS_MLOC = WS_BENDV + 512 * KB;
constexpr size_t WS_BEND = WS_MLOC + 4 * KB;
constexpr size_t WS_MPREV = WS_BEND + 4 * KB;
constexpr size_t WS_KTAB = 3072 * KB;
static_assert(WS_MPREV + 4 * KB <= WS_KTAB && WS_KTAB + 512 * KB <= 4 * MB, "small region overflow");
constexpr size_t WS_S5Y = 4 * MB;
constexpr size_t WS_S5E = 10 * MB;
constexpr size_t WS_WINA = 12 * MB;
constexpr size_t WS_WOUTA = 20 * MB;
constexpr size_t WS_WINC = 22 * MB;
constexpr size_t WS_WOUTC = 27 * MB;
constexpr size_t WS_WGLU = 29 * MB;
constexpr size_t WS_A = 30 * MB;
constexpr size_t WS_B = 142 * MB;
constexpr size_t WS_C = 174 * MB;
constexpr size_t WS_D = 206 * MB;
constexpr size_t WS_H16 = 238 * MB;
constexpr size_t WS_END = 270 * MB;
constexpr size_t WS_PROJ = WS_A, WS_LIST = WS_A, WS_WLIST = WS_A + 2 * MB, WS_HID = WS_A + 4 * MB, WS_Y = WS_A + 28 * MB;
constexpr size_t WS_XN = WS_B, WS_U = WS_B, WS_Z = WS_B;
constexpr size_t WS_XEND = WS_A + 84 * MB;
constexpr size_t WS_XPREVB = WS_A + 100 * MB;
constexpr size_t WS_MIX = WS_C, WS_CPREV = WS_D, WS_WGU = WS_C, WS_WD = WS_C + 32 * MB;

__host__ __device__ constexpr size_t ws_wgu(int layer) { return layer == 0 ? WS_C : WS_A + 64 * MB; }
__host__ __device__ constexpr size_t ws_wd(int layer) { return layer == 0 ? WS_C + 32 * MB : WS_A + 96 * MB; }
__host__ __device__ constexpr size_t ws_y(int layer) { return layer == 0 ? WS_A + 28 * MB : WS_C; }
constexpr int MOE_CONV_ITEMS = 32 * (16 * 16 + 32 * 4);
constexpr int MOE_CONV_EARLY = MOE_CONV_ITEMS / 2;
constexpr int LDS_BYTES = 144 * 1024;

struct Params { const float* in[30]; float* out; unsigned char* ws; int use_cg; int pad; };

enum { I_X = 0, I_NORM_MIX, I_NORM_FFN, I_NORM_FINAL, I_AB_WIN, I_AB_GBIAS, I_AB_HNORM, I_AB_CONVW, I_AB_WOUT, I_CD_WIN, I_S5_LRE, I_S5_LIM, I_S5_BRE, I_S5_BIM,
       I_S5_CRE, I_S5_CIM, I_S5_D, I_S5_LOGDT, I_S5_WGLU, I_S5_BGLU, I_HGRN_LB, I_HGRN_ONORM, I_CD_WOUT, I_MOE_WG, I_MOE_BG, I_MOE_WR, I_MOE_BR, I_MOE_WGATE, I_MOE_WUP, I_MOE_WDOWN };

__device__ __forceinline__ int opaque_tid() { int t = threadIdx.x; asm volatile("" : "+v"(t)); return t; }
__device__ __forceinline__ float bf2f(unsigned v) { return __uint_as_float(v << 16); }
typedef __bf16 bf16x2_t __attribute__((ext_vector_type(2)));
__device__ __forceinline__ unsigned pk2(float lo, float hi) { const f32x2 v = {lo, hi}; return __builtin_bit_cast(unsigned, __builtin_convertvector(v, bf16x2_t)); }
__device__ __forceinline__ unsigned f2bf(float f) { return (unsigned)__builtin_bit_cast(unsigned short, (__bf16)f); }
__device__ __forceinline__ float wave_sum(float v) {
#pragma unroll
    for (int o = 32; o; o >>= 1) v += __shfl_xor(v, o);
    return v;
}
__device__ __forceinline__ float wave_max(float v) {
#pragma unroll
    for (int o = 32; o; o >>= 1) v = fmaxf(v, __shfl_xor(v, o));
    return v;
}
__device__ __forceinline__ float wave_incl_sum(float v, int lane) {
#pragma unroll
    for (int o = 1; o < 64; o <<= 1) { const float t = __shfl_up(v, o); if (lane >= o) v += t; }
    return v;
}
__device__ __forceinline__ float wave_incl_max(float v, int lane) {
#pragma unroll
    for (int o = 1; o < 64; o <<= 1) { const float t = __shfl_up(v, o); if (lane >= o) v = fmaxf(v, t); }
    return v;
}
__device__ __forceinline__ float sigmoid_(float x) { return 1.f / (1.f + expf(-x)); }
__device__ __forceinline__ float fexp_(float x) { return __expf(x); }
__device__ __forceinline__ float fsigmoid_(float x) { return __builtin_amdgcn_rcpf(1.f + __expf(-x)); }
__device__ __forceinline__ float fsilu_(float x) { return x * __builtin_amdgcn_rcpf(1.f + __expf(-x)); }
__device__ __forceinline__ float fgelu_tanh_(float x) { const float u = 0.7978845608028654f * (x + 0.044715f * x * x * x); return x * __builtin_amdgcn_rcpf(1.f + __expf(-2.f * u)); }
__device__ __forceinline__ float logsigmoid_(float x) { return fminf(x, 0.f) - log1pf(expf(-fabsf(x))); }
__device__ __forceinline__ float silu_(float x) { return x / (1.f + expf(-x)); }
__device__ __forceinline__ float gelu_tanh_(float x) { const float u = 0.7978845608028654f * (x + 0.044715f * x * x * x); return 0.5f * x * (1.f + tanhf(u)); }
#define LDS_WAIT() asm volatile("s_waitcnt lgkmcnt(0)" ::: "memory")
__device__ __forceinline__ int tsw(int d, int l) { return d * 72 + (l ^ (((d >> 3) & 7) << 3)); }
__device__ __forceinline__ int tswc(int d, int c) { return d * 72 + ((c ^ ((d >> 3) & 7)) << 3); }
#define LDS_AS __attribute__((address_space(3)))
typedef short s16x4 __attribute__((ext_vector_type(4)));
__device__ __forceinline__ bf16x8 frag_tr(const bf16_t* T, int pitch, int k0, int n0, int fr, int fq) {
    const bf16_t* a = T + (k0 + 8 * fq + (fr >> 2)) * pitch + n0 + 4 * (fr & 3);
    const s16x4 lo = __builtin_amdgcn_ds_read_tr16_b64_v4i16((LDS_AS s16x4*)a);
    const s16x4 hi = __builtin_amdgcn_ds_read_tr16_b64_v4i16((LDS_AS s16x4*)(a + 4 * pitch));
    return (bf16x8){lo[0], lo[1], lo[2], lo[3], hi[0], hi[1], hi[2], hi[3]};
}

struct BPlain {
    const bf16_t* Bt; int K;
    __device__ __forceinline__ const bf16_t* operator()(int r, int kc) const { return Bt + (size_t)r * K + kc * 8; }
};
template <class APiece, class BPiece, class Epi>
__device__ __forceinline__ void gemm128b(unsigned char* lds, const APiece& apiece, const BPiece& bpiece, int K, const Epi& epi) {
    const int tid = opaque_tid(), lane = tid & 63, wid = tid >> 6, wr = wid >> 1, wc = wid & 1, fr = lane & 15, fq = lane >> 4;
    const int nt = K >> 6;
    const int r0 = tid >> 3, c0 = tid & 7;
    const int so0 = r0 * 128 + ((c0 ^ (r0 & 7)) << 4), so1 = so0 + 64 * 128;
    u32x4 xa0 = *(const u32x4*)apiece(r0, c0), xa1 = *(const u32x4*)apiece(r0 + 64, c0), xb0 = *(const u32x4*)bpiece(r0, c0), xb1 = *(const u32x4*)bpiece(r0 + 64, c0);
    u32x4 ya0 = *(const u32x4*)apiece(r0, 8 + c0), ya1 = *(const u32x4*)apiece(r0 + 64, 8 + c0), yb0 = *(const u32x4*)bpiece(r0, 8 + c0), yb1 = *(const u32x4*)bpiece(r0 + 64, 8 + c0);
    f32x4 acc[2][4];
#pragma unroll
    for (int m = 0; m < 2; ++m)
#pragma unroll
        for (int n = 0; n < 4; ++n) acc[m][n] = (f32x4){0.f, 0.f, 0.f, 0.f};
#define G128_PUT(buf, A0, A1, B0, B1) do { unsigned char* d_ = lds + (buf) * 16384; *(u32x4*)(d_ + so0) = A0; *(u32x4*)(d_ + so1) = A1; *(u32x4*)(d_ + 32768 + so0) = B0; *(u32x4*)(d_ + 32768 + so1) = B1; } while (0)
#define G128_GET(t, A0, A1, B0, B1) do { const int kc_ = (t) * 8 + c0; A0 = *(const u32x4*)apiece(r0, kc_); A1 = *(const u32x4*)apiece(r0 + 64, kc_); B0 = *(const u32x4*)bpiece(r0, kc_); B1 = *(const u32x4*)bpiece(r0 + 64, kc_); } while (0)
#define G128_MMA(buf) do { const unsigned char* sa = lds + (buf) * 16384; const unsigned char* sb = lds + 32768 + (buf) * 16384; \
        _Pragma("unroll") for (int kk = 0; kk < 2; ++kk) { bf16x8 a[2], b[4]; \
            _Pragma("unroll") for (int m = 0; m < 2; ++m) { const int row = wr * 32 + m * 16 + fr; a[m] = *(const bf16x8*)(sa + row * 128 + (((kk * 4 + fq) ^ (row & 7)) << 4)); } \
            _Pragma("unroll") for (int n = 0; n < 4; ++n) { const int row = wc * 64 + n * 16 + fr; b[n] = *(const bf16x8*)(sb + row * 128 + (((kk * 4 + fq) ^ (row & 7)) << 4)); } \
            _Pragma("unroll") for (int m = 0; m < 2; ++m) _Pragma("unroll") for (int n = 0; n < 4; ++n) acc[m][n] = __builtin_amdgcn_mfma_f32_16x16x32_bf16(b[n], a[m], acc[m][n], 0, 0, 0); } } while (0)
    G128_PUT(0, xa0, xa1, xb0, xb1);
    __syncthreads();
#pragma unroll 1
    for (int kt = 0; kt < nt; kt += 2) {
        if (kt + 2 < nt) G128_GET(kt + 2, xa0, xa1, xb0, xb1);
        G128_MMA(0);
        G128_PUT(1, ya0, ya1, yb0, yb1);
        __syncthreads();
        if (kt + 3 < nt) G128_GET(kt + 3, ya0, ya1, yb0, yb1);
        G128_MMA(1);
        if (kt + 2 < nt) G128_PUT(0, xa0, xa1, xb0, xb1);
        __syncthreads();
    }
#undef G128_PUT
#undef G128_GET
#undef G128_MMA
    epi(acc, wr, wc, fr, fq);
}

template <class APiece, class Epi>
__device__ __forceinline__ void gemm128(unsigned char* lds, const APiece& apiece, const bf16_t* __restrict__ Bt, int K, const Epi& epi) {
    BPlain b{Bt, K};
    gemm128b(lds, apiece, b, K, epi);
}

template <class APiece, class BPiece, class Epi0, class Epi1>
__device__ __forceinline__ void gemm128x2(unsigned char* lds, const APiece& apiece, const BPiece& bp0f, const BPiece& bp1f, int K, const Epi0& epi0, const Epi1& epi1) {
    const int tid = opaque_tid(), lane = tid & 63, wid = tid >> 6, wr = wid >> 1, wc = wid & 1, fr = lane & 15, fq = lane >> 4;
    const int nt = K >> 6;
    const int r0 = tid >> 3, c0 = tid & 7;
    const int so0 = r0 * 128 + ((c0 ^ (r0 & 7)) << 4), so1 = so0 + 64 * 128;
    u32x4 ra0 = *(const u32x4*)apiece(r0, c0), ra1 = *(const u32x4*)apiece(r0 + 64, c0);
    u32x4 rb0 = *(const u32x4*)bp0f(r0, c0), rb1 = *(const u32x4*)bp0f(r0 + 64, c0);
    u32x4 rc0 = *(const u32x4*)bp1f(r0, c0), rc1 = *(const u32x4*)bp1f(r0 + 64, c0);
    f32x4 acc0[2][4], acc1[2][4];
#pragma unroll
    for (int m = 0; m < 2; ++m)
#pragma unroll
        for (int n = 0; n < 4; ++n) { acc0[m][n] = (f32x4){0.f, 0.f, 0.f, 0.f}; acc1[m][n] = (f32x4){0.f, 0.f, 0.f, 0.f}; }
    *(u32x4*)(lds + so0) = ra0; *(u32x4*)(lds + so1) = ra1;
    *(u32x4*)(lds + 32768 + so0) = rb0; *(u32x4*)(lds + 32768 + so1) = rb1;
    *(u32x4*)(lds + 65536 + so0) = rc0; *(u32x4*)(lds + 65536 + so1) = rc1;
    __syncthreads();
#pragma unroll 1
    for (int kt = 0; kt < nt; ++kt) {
        const int cur = kt & 1;
        if (kt + 1 < nt) {
            const int kc = (kt + 1) * 8 + c0;
            ra0 = *(const u32x4*)apiece(r0, kc); ra1 = *(const u32x4*)apiece(r0 + 64, kc);
            rb0 = *(const u32x4*)bp0f(r0, kc); rb1 = *(const u32x4*)bp0f(r0 + 64, kc);
            rc0 = *(const u32x4*)bp1f(r0, kc); rc1 = *(const u32x4*)bp1f(r0 + 64, kc);
        }
        const unsigned char* sa = lds + cur * 16384;
        const unsigned char* sb = lds + 32768 + cur * 16384;
        const unsigned char* sc = lds + 65536 + cur * 16384;
#pragma unroll
        for (int kk = 0; kk < 2; ++kk) {
            bf16x8 a[2], b[4], c[4];
#pragma unroll
            for (int m = 0; m < 2; ++m) { const int row = wr * 32 + m * 16 + fr; a[m] = *(const bf16x8*)(sa + row * 128 + (((kk * 4 + fq) ^ (row & 7)) << 4)); }
#pragma unroll
            for (int n = 0; n < 4; ++n) { const int row = wc * 64 + n * 16 + fr; const int o = row * 128 + (((kk * 4 + fq) ^ (row & 7)) << 4); b[n] = *(const bf16x8*)(sb + o); c[n] = *(const bf16x8*)(sc + o); }
#pragma unroll
            for (int m = 0; m < 2; ++m)
#pragma unroll
                for (int n = 0; n < 4; ++n) { acc0[m][n] = __builtin_amdgcn_mfma_f32_16x16x32_bf16(b[n], a[m], acc0[m][n], 0, 0, 0); acc1[m][n] = __builtin_amdgcn_mfma_f32_16x16x32_bf16(c[n], a[m], acc1[m][n], 0, 0, 0); }
        }
        if (kt + 1 < nt) {
            unsigned char* da = lds + (cur ^ 1) * 16384;
            *(u32x4*)(da + so0) = ra0; *(u32x4*)(da + so1) = ra1;
            *(u32x4*)(da + 32768 + so0) = rb0; *(u32x4*)(da + 32768 + so1) = rb1;
            *(u32x4*)(da + 65536 + so0) = rc0; *(u32x4*)(da + 65536 + so1) = rc1;
        }
        __syncthreads();
    }
    epi0(acc0, wr, wc, fr, fq);
    epi1(acc1, wr, wc, fr, fq);
}
struct APlain {
    const bf16_t* A; int K;
    __device__ __forceinline__ const bf16_t* operator()(int r, int kc) const { return A + (size_t)r * K + kc * 8; }
};

namespace pg8 {
#define PG8_LAS __attribute__((address_space(3)))
typedef unsigned short bf16_t;
typedef short bf16x8 __attribute__((ext_vector_type(8)));
typedef float f32x4 __attribute__((ext_vector_type(4)));
typedef unsigned u32x4 __attribute__((ext_vector_type(4)));
constexpr int BM = 256, BK = 64, HALF = 128, HTB = HALF * BK * 2  , STAGE_BYTES = 8 * HTB, NXCD = 8, WGM = 8;

__host__ __device__ __forceinline__ int lds_byte(int r, int c) { const int st = (r >> 4) * 2 + (c >> 5), rr = r & 15, cc = c & 31, ob = rr * 64 + cc * 2; return st * 1024 + (ob ^ (((ob >> 9) & 1) << 5)); }
__host__ __device__ __forceinline__ void stage_rc(int b, int& R, int& C) { const int st = b / 1024, sb = b % 1024, swz = sb ^ (((sb >> 9) & 1) << 5); R = (st >> 1) * 16 + swz / 64; C = (st & 1) * 32 + (swz % 64) / 2; }
__host__ __device__ __forceinline__ int perm32(int rho) { const int n = rho >> 4, i = rho & 15; return 8 * (i >> 2) + 4 * n + (i & 3); }

struct Unit { int pm, pn, aux, half, nh; };
struct Gemm { const bf16_t* A; const bf16_t* Bt; int M, N, K; };

struct StaticOrder {
    int nM, nN, nwg, G, c;
    __host__ __device__ void init(int M, int N, int G_, int c_) { nM = M / BM; nN = N / BM; nwg = nM * nN; G = G_; c = c_; }
    __host__ __device__ __forceinline__ bool next(int i, Unit& u) const {
        const long L = (long)i * G + c; if (L >= nwg) return false;
        int wgid = (int)L; { const int q = nwg / NXCD, r = nwg % NXCD, xcd = wgid % NXCD, off = wgid / NXCD; wgid = (xcd < r ? xcd * (q + 1) : r * (q + 1) + (xcd - r) * q) + off; }
        const int nig = WGM * nN, gid = wgid / nig, fm = gid * WGM, gsz = (nM - fm) < WGM ? (nM - fm) : WGM;
        u.pm = fm + ((wgid % nig) % gsz); u.pn = (wgid % nig) / gsz; u.aux = 0; u.half = 0; u.nh = 0; return true;
    }
    __device__ __forceinline__ void a_ready(const Unit&) const {}
    __device__ __forceinline__ void done(const Unit&) const {}
};

struct StaticOrderHalfTail : StaticOrder {
    int nNF, nNT;
    __device__ __forceinline__ bool next(int i, Unit& u) const {
        const long L = (long)i * G + c; const int nw = nM * nNT * 2;
        if (L >= (long)nwg + nw) return false;
        const bool tail = L >= nwg;
        int wgid = tail ? 0 : (int)L; { const int q = nwg / NXCD, r = nwg % NXCD, xcd = wgid % NXCD, off = wgid / NXCD; wgid = (xcd < r ? xcd * (q + 1) : r * (q + 1) + (xcd - r) * q) + off; }
        const int nig = WGM * nN, gid = wgid / nig, fm = gid * WGM, gsz = (nM - fm) < WGM ? (nM - fm) : WGM;
        const int pm_f = fm + ((wgid % nig) % gsz), pn_f = (wgid % nig) / gsz;
        int wg = tail ? (int)(L - nwg) : 0; { const int q = nw / NXCD, rr = nw % NXCD, xcd = wg % NXCD, off = wg / NXCD; wg = (xcd < rr ? xcd * (q + 1) : rr * (q + 1) + (xcd - rr) * q) + off; }
        const int t = wg % (nNT * 2);
        u.pm = tail ? wg / (nNT * 2) : pm_f; u.pn = tail ? nNF + (t >> 1) : pn_f; u.nh = tail ? 1 + (t & 1) : 0; u.aux = 0; u.half = 0;
        return true;
    }
};
__device__ __forceinline__ unsigned cvt_pk_bf16(float lo, float hi) { unsigned r; asm volatile("v_cvt_pk_bf16_f32 %0, %1, %2" : "=v"(r) : "v"(lo), "v"(hi)); return r; }
template <class Epi, class Sched, bool ALIGN_EPI = false, bool SP2 = false>
__device__ __forceinline__ void gemm_phase(PG8_LAS unsigned char* lds, const Gemm g, const Sched& S, const Epi& E) {
    const int tid = opaque_tid(), wid = __builtin_amdgcn_readfirstlane(tid >> 6), lane = tid & 63, wr = wid >> 2, wc = wid & 3, fr = lane & 15, fq = lane >> 4;
    const int K = g.K, nt = K / BK;
    unsigned voffA[2], voffB[2];
#pragma unroll
    for (int i = 0; i < 2; ++i) { int R, C; stage_rc(tid * 16 + i * 8192, R, C); const int Rb = Epi::PERM ? ((R & ~31) + perm32(R & 31)) : R;
        voffA[i] = (unsigned)(R * K + C) * 2u; voffB[i] = (unsigned)(Rb * K + C) * 2u; }
    const size_t kstep = (size_t)(BK * 2);
    const size_t hstep = (size_t)HALF * K * 2;
    const size_t tstep = 2 * hstep;
    const unsigned ldsw = (unsigned)wid * 1024u;
    const int aoff = lds_byte(wr * 64 + fr, fq * 8), boff = lds_byte(wc * 32 + fr, fq * 8);
#define PG8_SA(b, h) (((b) * 2 + (h)) * HTB)
#define PG8_SB(b, h) ((4 + (b) * 2 + (h)) * HTB)
#define PG8_STAGE(bufoff, gbase, voff) do { _Pragma("unroll") for (int _i = 0; _i < 2; ++_i) \
        __builtin_amdgcn_global_load_lds((const unsigned*)((const char*)(gbase) + (voff)[_i]), (PG8_LAS unsigned*)(lds + (bufoff) + ldsw + _i * 8192), 16, 0, 0); } while (0)
#define PG8_LDA(dst, b, h) do { _Pragma("unroll") for (int m = 0; m < 4; ++m) _Pragma("unroll") for (int k = 0; k < 2; ++k) dst[m][k] = *(const PG8_LAS bf16x8*)(lds + PG8_SA(b, h) + aoff + m * 2048 + k * 1024); } while (0)
#define PG8_LDB(dst, b, h) do { _Pragma("unroll") for (int n = 0; n < 2; ++n) _Pragma("unroll") for (int k = 0; k < 2; ++k) dst[n][k] = *(const PG8_LAS bf16x8*)(lds + PG8_SB(b, h) + boff + n * 2048 + k * 1024); } while (0)
#define PG8_MMA(ai, bj, At, Bt) do { __builtin_amdgcn_s_setprio(1); _Pragma("unroll") for (int m = 0; m < 4; ++m) _Pragma("unroll") for (int n = 0; n < 2; ++n) _Pragma("unroll") for (int k = 0; k < 2; ++k) \
        acc[ai][bj][m][n] = __builtin_amdgcn_mfma_f32_16x16x32_bf16(Bt[n][k], At[m][k], acc[ai][bj][m][n], 0, 0, 0); __builtin_amdgcn_s_setprio(0); } while (0)
#define PG8_WAIT_V(n) asm volatile("s_waitcnt vmcnt(" #n ")" ::: "memory")
#define PG8_WAIT_L(n) asm volatile("s_waitcnt lgkmcnt(" #n ")" ::: "memory")
#define PG8_BAR __builtin_amdgcn_s_barrier()
#define PG8_SCHED __builtin_amdgcn_sched_barrier(0)
    Unit cur, nxt; int ui = 0;
    if (!S.next(0, cur)) return;
    f32x4 acc[2][2][4][2];
#pragma unroll
    for (int a = 0; a < 2; ++a)
#pragma unroll
        for (int b = 0; b < 2; ++b)
#pragma unroll
            for (int m = 0; m < 4; ++m)
#pragma unroll
                for (int n = 0; n < 2; ++n) acc[a][b][m][n] = (f32x4){0.f, 0.f, 0.f, 0.f};
    bf16x8 At[4][2], B0[2][2], B1[2][2];
    const char* cA = (const char*)g.A + (size_t)cur.pm * tstep; const char* cB = (const char*)g.Bt + (size_t)cur.pn * tstep;
    S.a_ready(cur);
    if constexpr (SP2) {
        PG8_STAGE(PG8_SB(0, 0), cB, voffB); PG8_STAGE(PG8_SB(0, 1), cB + hstep, voffB); PG8_STAGE(PG8_SA(0, 0), cA, voffA); PG8_STAGE(PG8_SA(0, 1), cA + hstep, voffA);
        if (wr == 1) PG8_BAR;
        PG8_WAIT_V(2); PG8_BAR;
        PG8_STAGE(PG8_SB(1, 0), cB + kstep, voffB); PG8_STAGE(PG8_SA(1, 0), cA + kstep, voffA); PG8_STAGE(PG8_SB(1, 1), cB + hstep + kstep, voffB);
        PG8_WAIT_V(6); PG8_BAR;
    } else {
        PG8_STAGE(PG8_SB(0, 0), cB, voffB); PG8_STAGE(PG8_SA(0, 0), cA, voffA); PG8_STAGE(PG8_SB(0, 1), cB + hstep, voffB); PG8_STAGE(PG8_SA(0, 1), cA + hstep, voffA);
        if (wr == 1) PG8_BAR;
        PG8_WAIT_V(4); PG8_BAR;
        PG8_STAGE(PG8_SB(1, 0), cB + kstep, voffB); PG8_STAGE(PG8_SA(1, 0), cA + kstep, voffA); PG8_STAGE(PG8_SB(1, 1), cB + hstep + kstep, voffB);
        PG8_WAIT_V(6); PG8_BAR;
    }
    for (;;) {
        const bool has_next = S.next(ui + 1, nxt);
        const char* nA = has_next ? (const char*)g.A + (size_t)nxt.pm * tstep : cA; const char* nB = has_next ? (const char*)g.Bt + (size_t)nxt.pn * tstep : cB;
        for (int t = 0; t < nt; t += 2) {
            const bool last = (t == nt - 2);
            const char* a1 = cA + (size_t)(t + 1) * kstep;
            const char* a2 = last ? nA : cA + (size_t)(t + 2) * kstep; const char* b2 = last ? nB : cB + (size_t)(t + 2) * kstep;
            const char* a3 = a2 + kstep; const char* b3 = b2 + kstep;
            if (last && has_next) S.a_ready(nxt);
            if constexpr (SP2) {
            PG8_LDB(B0, 0, 0); PG8_LDB(B1, 0, 1); PG8_SCHED; PG8_LDA(At, 0, 0); PG8_STAGE(PG8_SA(1, 1), a1 + hstep, voffA);
            PG8_WAIT_V(8); PG8_WAIT_L(0); PG8_BAR; if (cur.nh != 2) PG8_MMA(0, 0, At, B0); if (cur.nh != 1) PG8_MMA(0, 1, At, B1); PG8_BAR; PG8_SCHED;
            PG8_LDA(At, 0, 1); PG8_STAGE(PG8_SB(0, 0), b2, voffB); PG8_STAGE(PG8_SB(0, 1), b2 + hstep, voffB); PG8_STAGE(PG8_SA(0, 0), a2, voffA);
            PG8_WAIT_V(8); PG8_WAIT_L(0); PG8_BAR; if (!cur.half) { if (cur.nh != 2) PG8_MMA(1, 0, At, B0); if (cur.nh != 1) PG8_MMA(1, 1, At, B1); } PG8_BAR; PG8_SCHED;
            PG8_LDB(B0, 1, 0); PG8_LDB(B1, 1, 1); PG8_SCHED; PG8_LDA(At, 1, 0); PG8_STAGE(PG8_SA(0, 1), a2 + hstep, voffA);
            PG8_WAIT_V(8); PG8_WAIT_L(0); PG8_BAR; if (cur.nh != 2) PG8_MMA(0, 0, At, B0); if (cur.nh != 1) PG8_MMA(0, 1, At, B1); PG8_BAR; PG8_SCHED;
            PG8_LDA(At, 1, 1); PG8_STAGE(PG8_SB(1, 0), b3, voffB); PG8_STAGE(PG8_SB(1, 1), b3 + hstep, voffB); PG8_STAGE(PG8_SA(1, 0), a3, voffA);
            PG8_WAIT_V(8); PG8_WAIT_L(0); PG8_BAR; if (!cur.half) { if (cur.nh != 2) PG8_MMA(1, 0, At, B0); if (cur.nh != 1) PG8_MMA(1, 1, At, B1); } PG8_BAR; PG8_SCHED;
            } else {
            PG8_LDB(B0, 0, 0); PG8_SCHED; PG8_LDA(At, 0, 0); PG8_STAGE(PG8_SA(1, 1), a1 + hstep, voffA);
            PG8_WAIT_L(8); PG8_BAR; PG8_WAIT_L(0); PG8_MMA(0, 0, At, B0); PG8_BAR; PG8_SCHED;
            PG8_LDB(B1, 0, 1); PG8_STAGE(PG8_SB(0, 0), b2, voffB);
            PG8_BAR; PG8_WAIT_L(0); PG8_MMA(0, 1, At, B1); PG8_BAR;
            PG8_LDA(At, 0, 1); PG8_STAGE(PG8_SA(0, 0), a2, voffA);
            PG8_BAR; PG8_WAIT_L(0); PG8_MMA(1, 0, At, B0); PG8_BAR; PG8_SCHED;
            PG8_STAGE(PG8_SB(0, 1), b2 + hstep, voffB);
            PG8_WAIT_V(6); PG8_BAR; PG8_MMA(1, 1, At, B1); PG8_BAR;
            PG8_LDB(B0, 1, 0); PG8_SCHED; PG8_LDA(At, 1, 0); PG8_STAGE(PG8_SA(0, 1), a2 + hstep, voffA);
            PG8_WAIT_L(8); PG8_BAR; PG8_WAIT_L(0); PG8_MMA(0, 0, At, B0); PG8_BAR; PG8_SCHED;
            PG8_LDB(B1, 1, 1); PG8_STAGE(PG8_SB(1, 0), b3, voffB);
            PG8_BAR; PG8_WAIT_L(0); PG8_MMA(0, 1, At, B1); PG8_BAR;
            PG8_LDA(At, 1, 1); PG8_STAGE(PG8_SA(1, 0), a3, voffA);
            PG8_BAR; PG8_WAIT_L(0); PG8_MMA(1, 0, At, B0); PG8_BAR; PG8_SCHED;
            PG8_STAGE(PG8_SB(1, 1), b3 + hstep, voffB);
            PG8_WAIT_V(6); PG8_BAR; PG8_MMA(1, 1, At, B1); PG8_BAR;
            }
        }
        if constexpr (ALIGN_EPI) { if (wr == 0) PG8_BAR; }
        if constexpr (!Epi::AFTER_DRAIN) { E(acc, cur, wr, wc, fr, fq); S.done(cur); }
        if (!has_next) break;
#pragma unroll
        for (int a = 0; a < 2; ++a)
#pragma unroll
            for (int b = 0; b < 2; ++b)
#pragma unroll
                for (int m = 0; m < 4; ++m)
#pragma unroll
                    for (int n = 0; n < 2; ++n) acc[a][b][m][n] = (f32x4){0.f, 0.f, 0.f, 0.f};
        cur = nxt; cA = nA; cB = nB; ++ui;
        if constexpr (ALIGN_EPI) { if (wr == 1) PG8_BAR; }
    }
    PG8_WAIT_V(0);
    if constexpr (!ALIGN_EPI) { if (wr == 0) PG8_BAR; }
    PG8_BAR;
    if constexpr (Epi::AFTER_DRAIN) { E.fused(acc, cur, wr, wc, fr, fq, lds, wid, lane); S.done(cur); }
#undef PG8_SA
#undef PG8_SB
#undef PG8_STAGE
#undef PG8_LDA
#undef PG8_LDB
#undef PG8_MMA
#undef PG8_WAIT_V
#undef PG8_WAIT_L
#undef PG8_BAR
#undef PG8_SCHED
}

struct EpiStore {
    static constexpr bool PERM = true, AFTER_DRAIN = false;
    bf16_t* O; int ldc;
    __device__ __forceinline__ void operator()(const f32x4 (&acc)[2][2][4][2], const Unit& u, int wr, int wc, int fr, int fq) const {
        asm volatile("s_nop 7\n\ts_nop 7" ::: "memory");
        const int row0 = u.pm * BM + wr * 64 + fr, col0 = u.pn * BM + wc * 32 + 8 * fq;
#pragma unroll
        for (int ai = 0; ai < 2; ++ai)
#pragma unroll
            for (int m = 0; m < 4; ++m) { bf16_t* rowp = O + (size_t)(row0 + ai * HALF + m * 16) * ldc + col0;
#pragma unroll
                for (int bj = 0; bj < 2; ++bj) { if (u.nh == 2 - bj) continue; const f32x4 v0 = acc[ai][bj][m][0], v1 = acc[ai][bj][m][1];
                    u32x4 w; w.x = cvt_pk_bf16(v0[0], v0[1]); w.y = cvt_pk_bf16(v0[2], v0[3]); w.z = cvt_pk_bf16(v1[0], v1[1]); w.w = cvt_pk_bf16(v1[2], v1[3]);
                    *(u32x4*)(rowp + bj * HALF) = w; } }
    }
};
struct EpiStoreGates {
    static constexpr bool PERM = true, AFTER_DRAIN = false;
    bf16_t* O; int ldc; int gate_pn; float* gates; const float* gbias;
    __device__ __forceinline__ void operator()(const f32x4 (&acc)[2][2][4][2], const Unit& u, int wr, int wc, int fr, int fq) const {
        asm volatile("s_nop 7\n\ts_nop 7" ::: "memory");
        const int row0 = u.pm * BM + wr * 64 + fr;
        if (u.pn == gate_pn) {
            if (wc == 0 && fq == 0) {
                const f32x4 b0 = *(const f32x4*)gbias, b1 = *(const f32x4*)(gbias + 4);
#pragma unroll
                for (int ai = 0; ai < 2; ++ai)
#pragma unroll
                    for (int m = 0; m < 4; ++m) { float* g = gates + (size_t)(row0 + ai * HALF + m * 16) * 8;
                        *(f32x4*)g = acc[ai][0][m][0] + b0; *(f32x4*)(g + 4) = acc[ai][0][m][1] + b1; }
            }
            return;
        }
        const int col0 = u.pn * BM + wc * 32 + 8 * fq;
#pragma unroll
        for (int ai = 0; ai < 2; ++ai)
#pragma unroll
            for (int m = 0; m < 4; ++m) { bf16_t* rowp = O + (size_t)(row0 + ai * HALF + m * 16) * ldc + col0;
#pragma unroll
                for (int bj = 0; bj < 2; ++bj) { const f32x4 v0 = acc[ai][bj][m][0], v1 = acc[ai][bj][m][1];
                    u32x4 w; w.x = cvt_pk_bf16(v0[0], v0[1]); w.y = cvt_pk_bf16(v0[2], v0[3]); w.z = cvt_pk_bf16(v1[0], v1[1]); w.w = cvt_pk_bf16(v1[2], v1[3]);
                    *(u32x4*)(rowp + bj * HALF) = w; } }
    }
};
struct EpiResid {
    static constexpr bool PERM = true, AFTER_DRAIN = false;
    const float* rf; const bf16_t* rb; bf16_t* out;
    __device__ __forceinline__ void operator()(const f32x4 (&acc)[2][2][4][2], const Unit& u, int wr, int wc, int fr, int fq) const {
        const int row0 = u.pm * BM + wr * 64 + fr, col0 = u.pn * BM + wc * 32 + 8 * fq;
#pragma unroll
        for (int ai = 0; ai < 2; ++ai)
#pragma unroll
            for (int m = 0; m < 4; ++m) { const size_t off = (size_t)(row0 + ai * HALF + m * 16) * 1024 + col0;
#pragma unroll
                for (int bj = 0; bj < 2; ++bj) {
                    f32x4 r0, r1;
                    if (rf) { r0 = *(const f32x4*)(rf + off + bj * HALF); r1 = *(const f32x4*)(rf + off + bj * HALF + 4); }
                    else { const u32x4 q = *(const u32x4*)(rb + off + bj * HALF);
                        r0 = (f32x4){__uint_as_float(q.x << 16), __uint_as_float(q.x & 0xffff0000u), __uint_as_float(q.y << 16), __uint_as_float(q.y & 0xffff0000u)};
                        r1 = (f32x4){__uint_as_float(q.z << 16), __uint_as_float(q.z & 0xffff0000u), __uint_as_float(q.w << 16), __uint_as_float(q.w & 0xffff0000u)}; }
                    const f32x4 v0 = acc[ai][bj][m][0] + r0, v1 = acc[ai][bj][m][1] + r1;
                    u32x4 w; w.x = cvt_pk_bf16(v0[0], v0[1]); w.y = cvt_pk_bf16(v0[2], v0[3]); w.z = cvt_pk_bf16(v1[0], v1[1]); w.w = cvt_pk_bf16(v1[2], v1[3]);
                    *(u32x4*)(out + off + bj * HALF) = w; } }
    }
};

template <class Epi, class Sched>
__device__ __forceinline__ void gemm_phase_g(PG8_LAS unsigned char* lds, const Gemm g, const Sched& S, const Epi& E) {
    const int tid = opaque_tid(), wid = __builtin_amdgcn_readfirstlane(tid >> 6), lane = tid & 63, wr = wid >> 2, wc = wid & 3, fr = lane & 15, fq = lane >> 4;
    const int K = g.K, nt = K / BK;
    int RA[2], CA[2]; unsigned voffB[2];
#pragma unroll
    for (int i = 0; i < 2; ++i) { int R, C; stage_rc(tid * 16 + i * 8192, R, C); RA[i] = R; CA[i] = C; const int Rb = Epi::PERM ? ((R & ~31) + perm32(R & 31)) : R; voffB[i] = (unsigned)(Rb * K + C) * 2u; }
    const size_t kstep = (size_t)(BK * 2);
    const size_t hstep = (size_t)HALF * K * 2;
    const size_t tstep = 2 * hstep;
    const unsigned ldsw = (unsigned)wid * 1024u;
    const int aoff = lds_byte(wr * 64 + fr, fq * 8), boff = lds_byte(wc * 32 + fr, fq * 8);
#define PG8_SA(b, h) (((b) * 2 + (h)) * HTB)
#define PG8_SB(b, h) ((4 + (b) * 2 + (h)) * HTB)
#define PG8_STAGE(bufoff, gbase, voff) do { _Pragma("unroll") for (int _i = 0; _i < 2; ++_i) \
        __builtin_amdgcn_global_load_lds((const unsigned*)((const char*)(gbase) + (voff)[_i]), (PG8_LAS unsigned*)(lds + (bufoff) + ldsw + _i * 8192), 16, 0, 0); } while (0)
#define PG8_LDA(dst, b, h) do { _Pragma("unroll") for (int m = 0; m < 4; ++m) _Pragma("unroll") for (int k = 0; k < 2; ++k) dst[m][k] = *(const PG8_LAS bf16x8*)(lds + PG8_SA(b, h) + aoff + m * 2048 + k * 1024); } while (0)
#define PG8_LDB(dst, b, h) do { _Pragma("unroll") for (int n = 0; n < 2; ++n) _Pragma("unroll") for (int k = 0; k < 2; ++k) dst[n][k] = *(const PG8_LAS bf16x8*)(lds + PG8_SB(b, h) + boff + n * 2048 + k * 1024); } while (0)
#define PG8_MMA(ai, bj, At, Bt) do { __builtin_amdgcn_s_setprio(1); _Pragma("unroll") for (int m = 0; m < 4; ++m) _Pragma("unroll") for (int n = 0; n < 2; ++n) _Pragma("unroll") for (int k = 0; k < 2; ++k) \
        acc[ai][bj][m][n] = __builtin_amdgcn_mfma_f32_16x16x32_bf16(Bt[n][k], At[m][k], acc[ai][bj][m][n], 0, 0, 0); __builtin_amdgcn_s_setprio(0); } while (0)
#define PG8_WAIT_V(n) asm volatile("s_waitcnt vmcnt(" #n ")" ::: "memory")
#define PG8_WAIT_L(n) asm volatile("s_waitcnt lgkmcnt(" #n ")" ::: "memory")
#define PG8_BAR __builtin_amdgcn_s_barrier()
#define PG8_SCHED __builtin_amdgcn_sched_barrier(0)
    Unit cur, nxt; int ui = 0;
    if (!S.next(0, cur)) return;
    f32x4 acc[2][2][4][2];
#pragma unroll
    for (int a = 0; a < 2; ++a)
#pragma unroll
        for (int b = 0; b < 2; ++b)
#pragma unroll
            for (int m = 0; m < 4; ++m)
#pragma unroll
                for (int n = 0; n < 2; ++n) acc[a][b][m][n] = (f32x4){0.f, 0.f, 0.f, 0.f};
    bf16x8 At[4][2], B0[2][2], B1[2][2];
    unsigned oc[2][2];
    S.aoff(0, RA, CA, oc);
    const char* Ab = (const char*)g.A;
    const char* cB = (const char*)g.Bt + (size_t)cur.pn * tstep;
    PG8_STAGE(PG8_SB(0, 0), cB, voffB); PG8_STAGE(PG8_SB(0, 1), cB + hstep, voffB); PG8_STAGE(PG8_SA(0, 0), Ab, oc[0]); PG8_STAGE(PG8_SA(0, 1), Ab, oc[1]);
    if (wr == 1) PG8_BAR;
    PG8_WAIT_V(2); PG8_BAR;
    PG8_STAGE(PG8_SB(1, 0), cB + kstep, voffB); PG8_STAGE(PG8_SA(1, 0), Ab + kstep, oc[0]); PG8_STAGE(PG8_SB(1, 1), cB + hstep + kstep, voffB);
    PG8_WAIT_V(6); PG8_BAR;
    for (;;) {
        const bool has_next = S.next(ui + 1, nxt);
        const char* nB = has_next ? (const char*)g.Bt + (size_t)nxt.pn * tstep : cB;
        for (int t = 0; t < nt; t += 2) {
            const bool last = (t == nt - 2);
            const char* a1 = Ab + (size_t)(t + 1) * kstep;
            const char* a2 = last ? Ab : Ab + (size_t)(t + 2) * kstep; const char* b2 = last ? nB : cB + (size_t)(t + 2) * kstep;
            const char* a3 = a2 + kstep; const char* b3 = b2 + kstep;
            unsigned o2[2][2];
            if (last && has_next) S.aoff(ui + 1, RA, CA, o2);
            else { o2[0][0] = oc[0][0]; o2[0][1] = oc[0][1]; o2[1][0] = oc[1][0]; o2[1][1] = oc[1][1]; }
            PG8_LDB(B0, 0, 0); PG8_LDB(B1, 0, 1); PG8_SCHED; PG8_LDA(At, 0, 0); PG8_STAGE(PG8_SA(1, 1), a1, oc[1]);
            PG8_WAIT_V(8); PG8_WAIT_L(0); PG8_BAR; if (cur.nh != 2) PG8_MMA(0, 0, At, B0); if (cur.nh != 1) PG8_MMA(0, 1, At, B1); PG8_BAR; PG8_SCHED;
            PG8_LDA(At, 0, 1); PG8_STAGE(PG8_SB(0, 0), b2, voffB); PG8_STAGE(PG8_SB(0, 1), b2 + hstep, voffB); PG8_STAGE(PG8_SA(0, 0), a2, o2[0]);
            PG8_WAIT_V(8); PG8_WAIT_L(0); PG8_BAR; if (!cur.half) { if (cur.nh != 2) PG8_MMA(1, 0, At, B0); if (cur.nh != 1) PG8_MMA(1, 1, At, B1); } PG8_BAR; PG8_SCHED;
            PG8_LDB(B0, 1, 0); PG8_LDB(B1, 1, 1); PG8_SCHED; PG8_LDA(At, 1, 0); PG8_STAGE(PG8_SA(0, 1), a2, o2[1]);
            PG8_WAIT_V(8); PG8_WAIT_L(0); PG8_BAR; if (cur.nh != 2) PG8_MMA(0, 0, At, B0); if (cur.nh != 1) PG8_MMA(0, 1, At, B1); PG8_BAR; PG8_SCHED;
            PG8_LDA(At, 1, 1); PG8_STAGE(PG8_SB(1, 0), b3, voffB); PG8_STAGE(PG8_SB(1, 1), b3 + hstep, voffB); PG8_STAGE(PG8_SA(1, 0), a3, o2[0]);
            PG8_WAIT_V(8); PG8_WAIT_L(0); PG8_BAR; if (!cur.half) { if (cur.nh != 2) PG8_MMA(1, 0, At, B0); if (cur.nh != 1) PG8_MMA(1, 1, At, B1); } PG8_BAR; PG8_SCHED;
        }
        if (wr == 0) PG8_BAR;
        E(acc, cur, wr, wc, fr, fq);
        if (!has_next) break;
#pragma unroll
        for (int a = 0; a < 2; ++a)
#pragma unroll
            for (int b = 0; b < 2; ++b)
#pragma unroll
                for (int m = 0; m < 4; ++m)
#pragma unroll
                    for (int n = 0; n < 2; ++n) acc[a][b][m][n] = (f32x4){0.f, 0.f, 0.f, 0.f};
        cur = nxt; cB = nB; ++ui;
        S.aoff(ui, RA, CA, oc);
        if (wr == 1) PG8_BAR;
    }
    PG8_WAIT_V(0);
    PG8_BAR;
#undef PG8_SA
#undef PG8_SB
#undef PG8_STAGE
#undef PG8_LDA
#undef PG8_LDB
#undef PG8_MMA
#undef PG8_WAIT_V
#undef PG8_WAIT_L
#undef PG8_BAR
#undef PG8_SCHED
}

constexpr int MOE_MAXU = 4;
struct SchedMoe {
    const int* tp; const int* cn; const unsigned* tab;
    int NT, nU, G, c;
    __device__ __forceinline__ bool next(int i, Unit& u) const {
        if (i >= MOE_MAXU) return false;
        const long L = (long)i * G + c; if (L >= nU) return false;
        int wgid = (int)L; { const int q = nU / NXCD, r = nU % NXCD, xcd = wgid % NXCD, off = wgid / NXCD; wgid = (xcd < r ? xcd * (q + 1) : r * (q + 1) + (xcd - r) * q) + off; }
        const int ti = wgid / NT, pn = wgid - ti * NT;
        int e = 0; while (tp[e + 1] <= ti) ++e;
        u.pm = ti; u.pn = e * NT + pn; u.aux = i; u.half = (cn[e] - (ti - tp[e]) * BM <= HALF) ? 1 : 0; u.nh = 0; return true;
    }
    __device__ __forceinline__ void aoff(int ui, const int (&RA)[2], const int (&CA)[2], unsigned (&o)[2][2]) const {
#pragma unroll
        for (int h = 0; h < 2; ++h)
#pragma unroll
            for (int i = 0; i < 2; ++i) o[h][i] = tab[ui * 256 + h * HALF + RA[i]] + (unsigned)CA[i] * 2u;
    }
    __device__ __forceinline__ void a_ready(const Unit&) const {}
    __device__ __forceinline__ void done(const Unit&) const {}
};
__device__ __forceinline__ float silu_f(float x) { return x * __builtin_amdgcn_rcpf(1.f + __expf(-x)); }
__device__ __forceinline__ float sig_f(float x) { return __builtin_amdgcn_rcpf(1.f + __expf(-x)); }
struct EpiGlu256 {
    static constexpr bool PERM = true, AFTER_DRAIN = false;
    const bf16_t* Z; const float* b; bf16_t* mix;
    __device__ __forceinline__ void operator()(const f32x4 (&acc)[2][2][4][2], const Unit& u, int wr, int wc, int fr, int fq) const {
        const int row0 = u.pm * BM + wr * 64 + fr, col0 = u.pn * BM + wc * 32 + 8 * fq;
#pragma unroll
        for (int ai = 0; ai < 2; ++ai)
#pragma unroll
            for (int m = 0; m < 4; ++m) { const size_t r = (size_t)(row0 + ai * HALF + m * 16);
#pragma unroll
                for (int bj = 0; bj < 2; ++bj) { const int c = col0 + bj * HALF;
                    const u32x4 q = *(const u32x4*)(Z + r * 512 + c);
                    const f32x4 b0 = *(const f32x4*)(b + c), b1 = *(const f32x4*)(b + c + 4);
                    const f32x4 v0 = acc[ai][bj][m][0] + b0, v1 = acc[ai][bj][m][1] + b1;
                    const float z0 = __uint_as_float(q.x << 16), z1 = __uint_as_float(q.x & 0xffff0000u), z2 = __uint_as_float(q.y << 16), z3 = __uint_as_float(q.y & 0xffff0000u);
                    const float z4 = __uint_as_float(q.z << 16), z5 = __uint_as_float(q.z & 0xffff0000u), z6 = __uint_as_float(q.w << 16), z7 = __uint_as_float(q.w & 0xffff0000u);
                    u32x4 w; w.x = cvt_pk_bf16(z0 * sig_f(v0[0]), z1 * sig_f(v0[1])); w.y = cvt_pk_bf16(z2 * sig_f(v0[2]), z3 * sig_f(v0[3]));
                    w.z = cvt_pk_bf16(z4 * sig_f(v1[0]), z5 * sig_f(v1[1])); w.w = cvt_pk_bf16(z6 * sig_f(v1[2]), z7 * sig_f(v1[3]));
                    *(u32x4*)(mix + r * 1024 + c) = w; } }
    }
};

struct EpiMoeUp {
    static constexpr bool PERM = true, AFTER_DRAIN = false;
    bf16_t* H;
    __device__ __forceinline__ void operator()(const f32x4 (&acc)[2][2][4][2], const Unit& u, int wr, int wc, int fr, int fq) const {
        const int row0 = u.pm * BM + wr * 64 + fr, f0 = (u.pn & 1) * 128 + wc * 32 + 8 * fq;
#pragma unroll
        for (int ai = 0; ai < 2; ++ai)
#pragma unroll
            for (int m = 0; m < 4; ++m) {
                const f32x4 g0 = acc[ai][0][m][0], g1 = acc[ai][0][m][1], u0 = acc[ai][1][m][0], u1 = acc[ai][1][m][1];
                u32x4 w; w.x = cvt_pk_bf16(silu_f(g0[0]) * u0[0], silu_f(g0[1]) * u0[1]); w.y = cvt_pk_bf16(silu_f(g0[2]) * u0[2], silu_f(g0[3]) * u0[3]);
                w.z = cvt_pk_bf16(silu_f(g1[0]) * u1[0], silu_f(g1[1]) * u1[1]); w.w = cvt_pk_bf16(silu_f(g1[2]) * u1[2], silu_f(g1[3]) * u1[3]);
                *(u32x4*)(H + (size_t)(row0 + ai * HALF + m * 16) * 256 + f0) = w;
            }
    }
};
struct EpiMoeDown {
    static constexpr bool PERM = true, AFTER_DRAIN = false;
    bf16_t* Y; const unsigned* dtab; const float* wtab;
    __device__ __forceinline__ void operator()(const f32x4 (&acc)[2][2][4][2], const Unit& u, int wr, int wc, int fr, int fq) const {
        const int pn = u.pn & 3, tb = u.aux * 256 + wr * 64 + fr, col = pn * BM + wc * 32 + 8 * fq;
#pragma unroll
        for (int ai = 0; ai < 2; ++ai)
#pragma unroll
            for (int m = 0; m < 4; ++m) {
                const unsigned d = dtab[tb + ai * HALF + m * 16]; const float w = wtab[tb + ai * HALF + m * 16];
                if (d != 0xffffffffu) {
                    bf16_t* yr = Y + (size_t)d * 1024 + col;
#pragma unroll
                    for (int bj = 0; bj < 2; ++bj) { const f32x4 v0 = acc[ai][bj][m][0] * w, v1 = acc[ai][bj][m][1] * w;
                        u32x4 o; o.x = cvt_pk_bf16(v0[0], v0[1]); o.y = cvt_pk_bf16(v0[2], v0[3]); o.z = cvt_pk_bf16(v1[0], v1[1]); o.w = cvt_pk_bf16(v1[2], v1[3]);
                        *(u32x4*)(yr + bj * HALF) = o; }
                }
            }
    }
};
}

__device__ __forceinline__ void transpose_tile(const float* __restrict__ src, int ldn, bf16_t* __restrict__ dst, int ldk, float scale, float* scr, int lane) {
    float tv[32];
#pragma unroll
    for (int i = 0; i < 32; ++i) tv[i] = __builtin_nontemporal_load(src + (size_t)(2 * i + (lane >> 5)) * ldn + (lane & 31));
#pragma unroll
    for (int i = 0; i < 32; ++i) scr[(2 * i + (lane >> 5)) * 33 + (lane & 31)] = tv[i];
    LDS_WAIT();
    const int c = lane & 7;
#pragma unroll
    for (int j = 0; j < 4; ++j) {
        const int n = (lane >> 3) + 8 * j; const float* s = scr + (8 * c) * 33 + n;
        u32x4 o; o.x = pk2(s[0] * scale, s[33] * scale); o.y = pk2(s[66] * scale, s[99] * scale); o.z = pk2(s[132] * scale, s[165] * scale); o.w = pk2(s[198] * scale, s[231] * scale);
        *(u32x4*)(dst + (size_t)n * ldk + 8 * c) = o;
    }
    LDS_WAIT();
}

__device__ __forceinline__ void rms_row(f32x4 (&v)[4], const float* __restrict__ w, bf16_t* __restrict__ xn, int lane) {
    float ss = 0.f;
#pragma unroll
    for (int j = 0; j < 4; ++j) ss += v[j].x * v[j].x + v[j].y * v[j].y + v[j].z * v[j].z + v[j].w * v[j].w;
    ss = wave_sum(ss);
    const float r = rsqrtf(ss * (1.f / 1024.f) + EPS);
#pragma unroll
    for (int j = 0; j < 4; ++j) {
        const f32x4 w4 = *(const f32x4*)(w + 4 * lane + 256 * j);
        v[j] = v[j] * r * w4;
        u32x2 o; o.x = pk2(v[j].x, v[j].y); o.y = pk2(v[j].z, v[j].w);
        *(u32x2*)(xn + 4 * lane + 256 * j) = o;
    }
}

__device__ __forceinline__ void phase_prep(const Params& p, unsigned char* lds) {
    const int tid = opaque_tid(), lane = tid & 63, wid = tid >> 6;
    const int gw = blockIdx.x * 8 + wid, NGW = gridDim.x * 8;
    const int gt = blockIdx.x * NTHR + tid, NGT = gridDim.x * NTHR;
    unsigned char* ws = p.ws;
    if (blockIdx.x == 0 && tid < 64) ((int*)(ws + WS_CNT))[(tid >> 5) * 1024 + (tid & 31) * 32] = 0;
    for (int idx = (tid < 8 ? blockIdx.x * 8 + tid : 2048); idx < 2048; idx += gridDim.x * 8) {
        const int g = idx >> 6;
        const double lr = p.in[I_S5_LRE][idx], li = p.in[I_S5_LIM][idx], dt = exp((double)p.in[I_S5_LOGDT][g]);
        const double zr = lr * dt, zi = li * dt, ez = exp(zr);
        const double br = ez * cos(zi), bi = ez * sin(zi);
        double pr = 1.0, pi = 0.0;
        for (int tau = 0; tau <= 16; ++tau) {
            ((f32x2*)(ws + WS_S5POW))[idx * 17 + tau] = (f32x2){(float)pr, (float)pi};
            const double nr = pr * br - pi * bi, ni = pr * bi + pi * br; pr = nr; pi = ni;
        }
        const double ar = br - 1.0, ai = bi, den = lr * lr + li * li;
        const double cr = (ar * lr + ai * li) / den, ci = (ai * lr - ar * li) / den;
        for (int c = 0; c < 16; ++c) {
            const double b_r = p.in[I_S5_BRE][idx * 16 + c], b_i = p.in[I_S5_BIM][idx * 16 + c];
            ((f32x2*)(ws + WS_S5BBAR))[idx * 16 + c] = (f32x2){(float)(cr * b_r - ci * b_i), (float)(cr * b_i + ci * b_r)};
        }
    }
    for (int idx = gt; idx < 2 * 32 * 3 * 64; idx += NGT) {
        const int l = idx / (32 * 3 * 64), rem = idx - l * (32 * 3 * 64), ks = rem / 192, r2 = rem - ks * 192, nt_ = r2 >> 6, ln = r2 & 63, col = nt_ * 16 + (ln & 15);
        float v[8];
#pragma unroll
        for (int j = 0; j < 8; ++j) {
            const int k = ks * 32 + (ln >> 4) * 8 + j;
            float w = 0.f;
            if (col < 32) w = p.in[I_MOE_WR][(size_t)(l * 1024 + k) * 32 + col];
            else if (col < 36) w = p.in[I_MOE_WG][(size_t)(l * 1024 + k) * 4 + (col - 32)];
            v[j] = w * p.in[I_NORM_FFN][l * 1024 + k];
        }
        unsigned hi[4], lo[4];
#pragma unroll
        for (int q = 0; q < 4; ++q) {
            const unsigned h0 = f2bf(v[2 * q]), h1 = f2bf(v[2 * q + 1]);
            hi[q] = h0 | (h1 << 16);
            lo[q] = pk2(v[2 * q] - bf2f(h0), v[2 * q + 1] - bf2f(h1));
        }
        bf16_t* wf = (bf16_t*)(ws + WS_WCAT);
        *(u32x4*)(wf + ((size_t)(l * 2 + 0) * 6144 + (size_t)(ks * 3 + nt_) * 64 + ln) * 8) = (u32x4){hi[0], hi[1], hi[2], hi[3]};
        *(u32x4*)(wf + ((size_t)(l * 2 + 1) * 6144 + (size_t)(ks * 3 + nt_) * 64 + ln) * 8) = (u32x4){lo[0], lo[1], lo[2], lo[3]};
    }
    float* scr = (float*)(lds + wid * 8704);
    constexpr int IT_WINA = 112 * 16, IT_WOUT = 32 * 16, IT_WINC = 80 * 16, IT_WGLU = 16 * 8;
    constexpr int IT_TOTAL = IT_WINA + IT_WOUT + IT_WINC + IT_WOUT + IT_WGLU;
    for (int it0 = gw; it0 < IT_TOTAL; it0 += NGW) {
        int it = it0; const float* src; bf16_t* dst; int ldn, ldk; float scale = 1.f;
        if (it < IT_WINA) {
            const int n0 = (it >> 4) * 32, k0 = (it & 15) * 64, srcn = n0 < 2048 ? n0 : n0 + 8;
            if (n0 >= 512 && n0 < 1024) scale = 0.08838834764831845f;
            src = p.in[I_AB_WIN] + (size_t)k0 * 3592 + srcn; ldn = 3592; dst = (bf16_t*)(ws + WS_WINA) + (size_t)n0 * 1024 + k0; ldk = 1024;
        } else if ((it -= IT_WINA) < IT_WOUT) {
            const int n0 = (it >> 4) * 32, k0 = (it & 15) * 64;
            src = p.in[I_AB_WOUT] + (size_t)k0 * 1024 + n0; ldn = 1024; dst = (bf16_t*)(ws + WS_WOUTA) + (size_t)n0 * 1024 + k0; ldk = 1024;
        } else if ((it -= IT_WOUT) < IT_WINC) {
            const int n0 = (it >> 4) * 32, k0 = (it & 15) * 64;
            src = p.in[I_CD_WIN] + (size_t)k0 * 2560 + n0; ldn = 2560; dst = (bf16_t*)(ws + WS_WINC) + (size_t)n0 * 1024 + k0; ldk = 1024;
        } else if ((it -= IT_WINC) < IT_WOUT) {
            const int n0 = (it >> 4) * 32, k0 = (it & 15) * 64;
            src = p.in[I_CD_WOUT] + (size_t)k0 * 1024 + n0; ldn = 1024; dst = (bf16_t*)(ws + WS_WOUTC) + (size_t)n0 * 1024 + k0; ldk = 1024;
        } else {
            it -= IT_WOUT;
            const int n0 = (it >> 3) * 32, k0 = (it & 7) * 64;
            src = p.in[I_S5_WGLU] + (size_t)k0 * 512 + n0; ldn = 512; dst = (bf16_t*)(ws + WS_WGLU) + (size_t)n0 * 512 + k0; ldk = 512;
        }
        transpose_tile(src, ldn, dst, ldk, scale, scr, lane);
    }
    {
        bf16_t* wg = (bf16_t*)(ws + WS_WINA) + (size_t)3584 * 1024;
        const float* win = p.in[I_AB_WIN];
        for (int idx = gt; idx < 256 * 1024; idx += NGT) {
            const int n = idx >> 10, k = idx & 1023;
            wg[idx] = (bf16_t)(n < 8 ? f2bf(win[(size_t)k * 3592 + 2048 + n]) : 0u);
        }
    }
    const float* x = p.in[I_X];
    f32x4 vn[4];
    if (gw < T) {
#pragma unroll
        for (int j = 0; j < 4; ++j) vn[j] = __builtin_nontemporal_load((const f32x4*)(x + (size_t)gw * 1024 + 4 * lane + 256 * j));
    }
    for (int row = gw; row < T; row += NGW) {
        f32x4 v[4];
#pragma unroll
        for (int j = 0; j < 4; ++j) v[j] = vn[j];
        if (row + NGW < T) {
#pragma unroll
            for (int j = 0; j < 4; ++j) vn[j] = __builtin_nontemporal_load((const f32x4*)(x + (size_t)(row + NGW) * 1024 + 4 * lane + 256 * j));
        }
        {
            bf16_t* h16 = (bf16_t*)(ws + WS_H16) + (size_t)row * 1024;
#pragma unroll
            for (int j = 0; j < 4; ++j) { u32x2 o; o.x = pk2(v[j].x, v[j].y); o.y = pk2(v[j].z, v[j].w); *(u32x2*)(h16 + 4 * lane + 256 * j) = o; }
        }
        rms_row(v, p.in[I_NORM_MIX], (bf16_t*)(ws + WS_XN) + (size_t)row * 1024, lane);
    }
}

struct EpiStoreBf16 {
    bf16_t* O; int ldc;
    __device__ __forceinline__ void operator()(const f32x4 (&acc)[2][4], int wr, int wc, int fr, int fq) const {
#pragma unroll
        for (int m = 0; m < 2; ++m)
#pragma unroll
            for (int n = 0; n < 4; ++n) {
                const f32x4 v = acc[m][n]; u32x2 o; o.x = pk2(v.x, v.y); o.y = pk2(v.z, v.w);
                *(u32x2*)(O + (size_t)(wr * 32 + m * 16 + fr) * ldc + wc * 64 + n * 16 + fq * 4) = o;
            }
    }
};
struct EpiResidF32 {
    const float* resid; float* out;
    __device__ __forceinline__ void operator()(const f32x4 (&acc)[2][4], int wr, int wc, int fr, int fq) const {
#pragma unroll
        for (int m = 0; m < 2; ++m)
#pragma unroll
            for (int n = 0; n < 4; ++n) {
                const size_t off = (size_t)(wr * 32 + m * 16 + fr) * 1024 + wc * 64 + n * 16 + fq * 4;
                const f32x4 r = *(const f32x4*)(resid + off);
                *(f32x4*)(out + off) = r + acc[m][n];
            }
    }
};
struct EpiGlu {
    const bf16_t* Z; const float* b; bf16_t* mix;
    __device__ __forceinline__ void operator()(const f32x4 (&acc)[2][4], int wr, int wc, int fr, int fq) const {
#pragma unroll
        for (int m = 0; m < 2; ++m)
#pragma unroll
            for (int n = 0; n < 4; ++n) {
                const int r = wr * 32 + m * 16 + fr, c = wc * 64 + n * 16 + fq * 4;
                const u32x2 zz = *(const u32x2*)(Z + (size_t)r * 512 + c);
                const f32x4 bb = *(const f32x4*)(b + c);
                const f32x4 v = acc[m][n] + bb;
                const float z0 = bf2f(zz.x & 0xffffu), z1 = bf2f(zz.x >> 16), z2 = bf2f(zz.y & 0xffffu), z3 = bf2f(zz.y >> 16);
                u32x2 o; o.x = pk2(z0 * fsigmoid_(v.x), z1 * fsigmoid_(v.y)); o.y = pk2(z2 * fsigmoid_(v.z), z3 * fsigmoid_(v.w));
                *(u32x2*)(mix + (size_t)r * 1024 + c) = o;
            }
    }
};

__device__ __forceinline__ void phase_gemm_store(unsigned char* lds, const bf16_t* A, const bf16_t* Bt, int N, int K, bf16_t* O, int ldc) {
    const int nN = N >> 7, nU = (T >> 7) * nN;
    for (int u = blockIdx.x; u < nU; u += gridDim.x) {
        const int pm = u / nN, pn = u - pm * nN;
        APlain ap{A + (size_t)pm * 128 * K, K};
        EpiStoreBf16 e{O + (size_t)pm * 128 * ldc + pn * 128, ldc};
        gemm128(lds, ap, Bt + (size_t)pn * 128 * K, K, e);
    }
}
__device__ __forceinline__ void phase_gemm_resid(unsigned char* lds, const bf16_t* A, const bf16_t* Bt, const float* resid, float* out) {
    const int nU = (T >> 7) * 8;
    for (int u = blockIdx.x; u < nU; u += gridDim.x) {
        const int pm = u >> 3, pn = u & 7;
        APlain ap{A + (size_t)pm * 128 * 1024, 1024};
        const size_t off = (size_t)pm * 128 * 1024 + pn * 128;
        EpiResidF32 e{resid + off, out + off};
        gemm128(lds, ap, Bt + (size_t)pn * 128 * 1024, 1024, e);
    }
}
__device__ __forceinline__ void phase_gemm_glu(unsigned char* lds, const Params& p) {
    pg8::Gemm g{(const bf16_t*)(p.ws + WS_Z), (const bf16_t*)(p.ws + WS_WGLU), T, 512, 512}; pg8::StaticOrder S; S.init(T, 512, (int)gridDim.x, (int)blockIdx.x);
    pg8::EpiGlu256 E{(const bf16_t*)(p.ws + WS_Z), p.in[I_S5_BGLU], (bf16_t*)(p.ws + WS_MIX)};
    pg8::gemm_phase<pg8::EpiGlu256, pg8::StaticOrder, true, true>((PG8_LAS unsigned char*)lds, g, S, E);
}
__device__ __forceinline__ void phase_gemm256_store(unsigned char* lds, const bf16_t* A, const bf16_t* Bt, int N, bf16_t* O) {
    pg8::Gemm g{A, Bt, T, N, 1024}; pg8::StaticOrder S; S.init(T, N, (int)gridDim.x, (int)blockIdx.x);
    pg8::EpiStore E{O, N};
    pg8::gemm_phase<pg8::EpiStore, pg8::StaticOrder, true, true>((PG8_LAS unsigned char*)lds, g, S, E);
}
__device__ __forceinline__ void phase_gemm256_inproj1(unsigned char* lds, const Params& p) {
    pg8::Gemm g{(const bf16_t*)(p.ws + WS_XN), (const bf16_t*)(p.ws + WS_WINC), T, PC, 1024}; pg8::StaticOrderHalfTail S; S.init(T, 8 * 256, (int)gridDim.x, (int)blockIdx.x); S.nNF = 8; S.nNT = 2;
    pg8::EpiStore E{(bf16_t*)(p.ws + WS_PROJ), PC};
    pg8::gemm_phase<pg8::EpiStore, pg8::StaticOrderHalfTail, true, true>((PG8_LAS unsigned char*)lds, g, S, E);
}
__device__ __forceinline__ void phase_gemm256_inproj0(unsigned char* lds, const Params& p) {
    pg8::Gemm g{(const bf16_t*)(p.ws + WS_XN), (const bf16_t*)(p.ws + WS_WINA), T, 3840, 1024}; pg8::StaticOrder S; S.init(T, 3840, (int)gridDim.x, (int)blockIdx.x);
    pg8::EpiStoreGates E{(bf16_t*)(p.ws + WS_PROJ), PA, 14, (float*)(p.ws + WS_GATES), p.in[I_AB_GBIAS]};
    pg8::gemm_phase<pg8::EpiStoreGates, pg8::StaticOrder, true, true>((PG8_LAS unsigned char*)lds, g, S, E);
}
__device__ __forceinline__ void phase_gemm256_resid(unsigned char* lds, const bf16_t* A, const bf16_t* Bt, const float* rf, const bf16_t* rb, bf16_t* out) {
    pg8::Gemm g{A, Bt, T, 1024, 1024}; pg8::StaticOrder S; S.init(T, 1024, (int)gridDim.x, (int)blockIdx.x);
    pg8::EpiResid E{rf, rb, out};
    pg8::gemm_phase<pg8::EpiResid, pg8::StaticOrder, true, true>((PG8_LAS unsigned char*)lds, g, S, E);
}

__device__ __forceinline__ void s5_gen_ktab(const Params& p) {
    const int gt = blockIdx.x * NTHR + opaque_tid(), NGT = gridDim.x * NTHR;
    const f32x2* POW = (const f32x2*)(p.ws + WS_S5POW); const f32x2* BB = (const f32x2*)(p.ws + WS_S5BBAR);
    for (int idx = gt; idx < 32 * 4096; idx += NGT) {
        const int g = idx >> 12, tau = (idx >> 8) & 15, ch = (idx >> 4) & 15, c = idx & 15;
        float sum = 0.f;
        for (int pp = 0; pp < 64; ++pp) {
            const f32x2 l = POW[(g * 64 + pp) * 17 + tau], b = BB[(g * 64 + pp) * 16 + c];
            const float wr_ = l.x * b.x - l.y * b.y, wi_ = l.x * b.y + l.y * b.x;
            sum += p.in[I_S5_CRE][(size_t)(g * 16 + ch) * 64 + pp] * wr_ - p.in[I_S5_CIM][(size_t)(g * 16 + ch) * 64 + pp] * wi_;
        }
        if (tau == 0 && ch == c) sum += p.in[I_S5_D][g * 16 + ch];
        ((float*)(p.ws + WS_KTAB))[idx] = sum;
    }
}
__device__ __forceinline__ void s5_gen_ops(const Params& p) {
    const int gt = blockIdx.x * NTHR + opaque_tid(), NGT = gridDim.x * NTHR;
    const f32x2* POW = (const f32x2*)(p.ws + WS_S5POW); const f32x2* BB = (const f32x2*)(p.ws + WS_S5BBAR);
    const float* KT = (const float*)(p.ws + WS_KTAB);
    bf16_t* BY = (bf16_t*)(p.ws + WS_S5Y); bf16_t* BE = (bf16_t*)(p.ws + WS_S5E);
    for (int idx = gt; idx < 32 * 256 * 48; idx += NGT) {
        const int kc = idx % 48, gn = idx / 48, n = gn & 255, g = gn >> 8, t = n >> 4, ch = n & 15, k0 = kc * 8;
        float v[8];
        if (k0 < 256) {
            const int s_ = k0 >> 4, c0 = k0 & 15;
            if (s_ <= t) {
                const f32x4 a = *(const f32x4*)(KT + ((g * 16 + (t - s_)) * 16 + ch) * 16 + c0), b = *(const f32x4*)(KT + ((g * 16 + (t - s_)) * 16 + ch) * 16 + c0 + 4);
                v[0] = a.x; v[1] = a.y; v[2] = a.z; v[3] = a.w; v[4] = b.x; v[5] = b.y; v[6] = b.z; v[7] = b.w;
            } else {
#pragma unroll
                for (int j = 0; j < 8; ++j) v[j] = 0.f;
            }
        } else {
            const int p0 = (k0 - 256) & 63; const bool re = k0 < 320;
#pragma unroll
            for (int j = 0; j < 8; ++j) {
                const int pp = p0 + j; const f32x2 l = POW[(g * 64 + pp) * 17 + t + 1];
                const float cr = p.in[I_S5_CRE][(size_t)(g * 16 + ch) * 64 + pp], ci = p.in[I_S5_CIM][(size_t)(g * 16 + ch) * 64 + pp];
                v[j] = re ? (cr * l.x - ci * l.y) : -(cr * l.y + ci * l.x);
            }
        }
        *(u32x4*)(BY + (size_t)gn * 384 + k0) = (u32x4){pk2(v[0], v[1]), pk2(v[2], v[3]), pk2(v[4], v[5]), pk2(v[6], v[7])};
    }
    for (int idx = gt; idx < 32 * 128 * 32; idx += NGT) {
        const int kc = idx & 31, gn = idx >> 5, n = gn & 127, g = gn >> 7, pp = n & 63, k0 = kc * 8, s_ = k0 >> 4, c0 = k0 & 15;
        const f32x2 l = POW[(g * 64 + pp) * 17 + 15 - s_];
        float v[8];
#pragma unroll
        for (int j = 0; j < 8; ++j) { const f32x2 b = BB[(g * 64 + pp) * 16 + c0 + j]; v[j] = (n < 64) ? (l.x * b.x - l.y * b.y) : (l.x * b.y + l.y * b.x); }
        *(u32x4*)(BE + (size_t)gn * 256 + k0) = (u32x4){pk2(v[0], v[1]), pk2(v[2], v[3]), pk2(v[4], v[5]), pk2(v[6], v[7])};
    }
}
struct AS5 {
    const bf16_t* proj; const bf16_t* xp; int m0, g;
    __device__ __forceinline__ const bf16_t* operator()(int r, int kc) const {
        const int m = m0 + r, k0 = kc * 8;
        return (k0 < 256) ? proj + ((size_t)(m * 16 + (k0 >> 4)) * PC + g * 16 + (k0 & 15)) : xp + ((size_t)m * 32 + g) * 128 + (k0 - 256);
    }
};
struct EpiS5E {
    float* xend; int m0, g;
    __device__ __forceinline__ void operator()(const f32x4 (&acc)[2][4], int wr, int wc, int fr, int fq) const {
#pragma unroll
        for (int m = 0; m < 2; ++m)
#pragma unroll
            for (int n = 0; n < 4; ++n) *(f32x4*)(xend + ((size_t)(m0 + wr * 32 + m * 16 + fr) * 32 + g) * 128 + wc * 64 + n * 16 + fq * 4) = acc[m][n];
    }
};
struct EpiS5Y {
    bf16_t* Z; int m0, g, n0;
    __device__ __forceinline__ void operator()(const f32x4 (&acc)[2][4], int wr, int wc, int fr, int fq) const {
#pragma unroll
        for (int m = 0; m < 2; ++m)
#pragma unroll
            for (int n = 0; n < 4; ++n) {
                const int mm = m0 + wr * 32 + m * 16 + fr, nc = n0 + wc * 64 + n * 16 + fq * 4, t = nc >> 4, ch0 = nc & 15;
                const f32x4 v = acc[m][n];
                u32x2 o; o.x = pk2(fgelu_tanh_(v.x), fgelu_tanh_(v.y)); o.y = pk2(fgelu_tanh_(v.z), fgelu_tanh_(v.w));
                *(u32x2*)(Z + (size_t)(mm * 16 + t) * 512 + g * 16 + ch0) = o;
            }
    }
};
__device__ __forceinline__ void s5_unit_E(const Params& p, unsigned char* lds, int u) {
    const int g = u >> 3, mt = u & 7;
    AS5 a{(const bf16_t*)(p.ws + WS_PROJ), nullptr, mt * 128, g};
    EpiS5E e{(float*)(p.ws + WS_XEND), mt * 128, g};
    gemm128(lds, a, (const bf16_t*)(p.ws + WS_S5E) + (size_t)g * 128 * 256, 256, e);
}
__device__ __forceinline__ void s5_unit_Y(const Params& p, unsigned char* lds, int u) {
    const int g = u >> 3, mt = u & 7;
    AS5 a{(const bf16_t*)(p.ws + WS_PROJ), (const bf16_t*)(p.ws + WS_XPREVB), mt * 128, g};
    EpiS5Y e0{(bf16_t*)(p.ws + WS_Z), mt * 128, g, 0}, e1{(bf16_t*)(p.ws + WS_Z), mt * 128, g, 128};
    BPlain b0{(const bf16_t*)(p.ws + WS_S5Y) + (size_t)g * 256 * 384, 384}, b1{(const bf16_t*)(p.ws + WS_S5Y) + ((size_t)g * 256 + 128) * 384, 384};
    gemm128x2(lds, a, b0, b1, 384, e0, e1);
}

__device__ __forceinline__ void stage_rows(const bf16_t* __restrict__ g, int pitch, bf16_t* s, int tid) {
#pragma unroll
    for (int i = 0; i < 2; ++i) { const int pc = tid + i * NTHR, l = pc >> 4, d0 = (pc & 15) * 8; *(u32x4*)(s + l * 136 + d0) = *(const u32x4*)(g + (size_t)l * pitch + d0); }
}
__device__ __forceinline__ void stage_transposed(const bf16_t* __restrict__ g, int pitch, bf16_t* s, const float* rs, int tid) {
#pragma unroll
    for (int i = 0; i < 2; ++i) {
        const int pc = tid + i * NTHR, l = pc >> 4, d0 = (pc & 15) * 8;
        const u32x4 v = *(const u32x4*)(g + (size_t)l * pitch + d0);
        const float sc = rs ? rs[l] : 1.f;
        const unsigned w[4] = {v.x, v.y, v.z, v.w};
#pragma unroll
        for (int q = 0; q < 4; ++q) {
            s[tsw(d0 + 2 * q, l)] = (bf16_t)f2bf(bf2f(w[q] & 0xffffu) * sc);
            s[tsw(d0 + 2 * q + 1, l)] = (bf16_t)f2bf(bf2f(w[q] >> 16) * sc);
        }
    }
}
__device__ __forceinline__ void state_outer(const bf16_t* Kt, const bf16_t* Vt, bf16_t* __restrict__ Uout, int wid, int fr, int fq) {
    const int v0 = wid * 16;
    bf16x8 bv[2];
#pragma unroll
    for (int ls = 0; ls < 2; ++ls) bv[ls] = *(const bf16x8*)(Vt + tswc(v0 + fr, ls * 4 + fq));
#pragma unroll
    for (int kt = 0; kt < 8; ++kt) {
        f32x4 acc = (f32x4){0.f, 0.f, 0.f, 0.f};
#pragma unroll
        for (int ls = 0; ls < 2; ++ls) {
            const bf16x8 ak = *(const bf16x8*)(Kt + tswc(kt * 16 + fr, ls * 4 + fq));
            acc = __builtin_amdgcn_mfma_f32_16x16x32_bf16(ak, bv[ls], acc, 0, 0, 0);
        }
        u32x2 o; o.x = pk2(acc.x, acc.y); o.y = pk2(acc.z, acc.w);
        *(u32x2*)(Uout + (size_t)(v0 + fr) * 128 + kt * 16 + fq * 4) = o;
    }
}
template <bool KRM>
__device__ __forceinline__ void state_outer_tr(const bf16_t* Kx, const bf16_t* Vs, bf16_t* __restrict__ Uout, int wid, int fr, int fq) {
    const int v0 = wid * 16;
    bf16x8 bv[2];
#pragma unroll
    for (int ls = 0; ls < 2; ++ls) bv[ls] = frag_tr(Vs, 136, ls * 32, v0, fr, fq);
#pragma unroll
    for (int kt = 0; kt < 8; ++kt) {
        f32x4 acc = (f32x4){0.f, 0.f, 0.f, 0.f};
#pragma unroll
        for (int ls = 0; ls < 2; ++ls) {
            const bf16x8 ak = KRM ? frag_tr(Kx, 136, ls * 32, kt * 16, fr, fq) : *(const bf16x8*)(Kx + tswc(kt * 16 + fr, ls * 4 + fq));
            acc = __builtin_amdgcn_mfma_f32_16x16x32_bf16(ak, bv[ls], acc, 0, 0, 0);
        }
        u32x2 o; o.x = pk2(acc.x, acc.y); o.y = pk2(acc.z, acc.w);
        *(u32x2*)(Uout + (size_t)(v0 + fr) * 128 + kt * 16 + fq * 4) = o;
    }
}
template <int GATE>
__device__ __forceinline__ void head_norm_out(const float* Hs, const float* __restrict__ w, const bf16_t* __restrict__ gsrc, int gpitch, bf16_t* __restrict__ out, int opitch, int tid) {
    const int l = tid >> 3, part = tid & 7;
    float h[16]; float ss = 0.f;
#pragma unroll
    for (int i = 0; i < 4; ++i) { const f32x4 v = *(const f32x4*)(Hs + l * 132 + part * 16 + i * 4); h[4 * i] = v.x; h[4 * i + 1] = v.y; h[4 * i + 2] = v.z; h[4 * i + 3] = v.w; ss += v.x * v.x + v.y * v.y + v.z * v.z + v.w * v.w; }
    ss += __shfl_xor(ss, 1); ss += __shfl_xor(ss, 2); ss += __shfl_xor(ss, 4);
    const float r = rsqrtf(ss * (1.f / 128.f) + EPS);
    const u32x4 g0 = *(const u32x4*)(gsrc + (size_t)l * gpitch + part * 16), g1 = *(const u32x4*)(gsrc + (size_t)l * gpitch + part * 16 + 8);
    const unsigned gw[8] = {g0.x, g0.y, g0.z, g0.w, g1.x, g1.y, g1.z, g1.w};
    unsigned ow[8];
#pragma unroll
    for (int q = 0; q < 8; ++q) {
        const float ga = bf2f(gw[q] & 0xffffu), gb = bf2f(gw[q] >> 16);
        const float a = h[2 * q] * r * w[part * 16 + 2 * q] * (GATE == 0 ? fsigmoid_(ga) : fsilu_(ga));
        const float b = h[2 * q + 1] * r * w[part * 16 + 2 * q + 1] * (GATE == 0 ? fsigmoid_(gb) : fsilu_(gb));
        ow[q] = pk2(a, b);
    }
    *(u32x4*)(out + (size_t)l * opitch + part * 16) = (u32x4){ow[0], ow[1], ow[2], ow[3]};
    *(u32x4*)(out + (size_t)l * opitch + part * 16 + 8) = (u32x4){ow[4], ow[5], ow[6], ow[7]};
}


struct Tile2 { u32x4 v[2]; };
struct Tile4 { u32x4 v[4]; };
template <bool NT = false>
__device__ __forceinline__ void tile_load(Tile2& t, const bf16_t* __restrict__ g, int pitch, int tid) {
#pragma unroll
    for (int i = 0; i < 2; ++i) { const int pc = tid + i * NTHR; const u32x4* q = (const u32x4*)(g + (size_t)(pc >> 4) * pitch + (pc & 15) * 8); t.v[i] = NT ? __builtin_nontemporal_load(q) : *q; }
}
template <bool NT = false>
__device__ __forceinline__ void tile4_load(Tile4& t, const bf16_t* __restrict__ g, int tid) {
#pragma unroll
    for (int i = 0; i < 4; ++i) { const int pc = tid + i * NTHR; const u32x4* q = (const u32x4*)(g + (size_t)pc * 8); t.v[i] = NT ? __builtin_nontemporal_load(q) : *q; }
}
__device__ __forceinline__ void tile_put_rows(const Tile2& t, bf16_t* s, int tid) {
#pragma unroll
    for (int i = 0; i < 2; ++i) { const int pc = tid + i * NTHR; *(u32x4*)(s + (pc >> 4) * 136 + (pc & 15) * 8) = t.v[i]; }
}
__device__ __forceinline__ void tile4_put(const Tile4& t, bf16_t* s, int tid) {
#pragma unroll
    for (int i = 0; i < 4; ++i) { const int pc = tid + i * NTHR; *(u32x4*)(s + (pc >> 4) * 136 + (pc & 15) * 8) = t.v[i]; }
}
__device__ __forceinline__ void tile_put_transposed(const Tile2& t, bf16_t* s, const float* rs, int tid) {
#pragma unroll
    for (int i = 0; i < 2; ++i) {
        const int pc = tid + i * NTHR, l = pc >> 4, d0 = (pc & 15) * 8;
        const unsigned w[4] = {t.v[i].x, t.v[i].y, t.v[i].z, t.v[i].w};
        if (rs) {
            const float sc = rs[l];
#pragma unroll
            for (int q = 0; q < 4; ++q) {
                const unsigned pr = pk2(bf2f(w[q] & 0xffffu) * sc, bf2f(w[q] >> 16) * sc);
                s[tsw(d0 + 2 * q, l)] = (bf16_t)(pr & 0xffffu); s[tsw(d0 + 2 * q + 1, l)] = (bf16_t)(pr >> 16);
            }
        } else {
#pragma unroll
            for (int q = 0; q < 4; ++q) { s[tsw(d0 + 2 * q, l)] = (bf16_t)(w[q] & 0xffffu); s[tsw(d0 + 2 * q + 1, l)] = (bf16_t)(w[q] >> 16); }
        }
    }
}
template <int GATE>
__device__ __forceinline__ void head_norm_out_r(const float* Hs, const float* __restrict__ w, const u32x4 (&og)[2], bf16_t* __restrict__ out, int opitch, int tid) {
    const int l = tid >> 3, part = tid & 7;
    float h[16]; float ss = 0.f;
#pragma unroll
    for (int i = 0; i < 4; ++i) { const f32x4 v = *(const f32x4*)(Hs + l * 132 + part * 16 + i * 4); h[4 * i] = v.x; h[4 * i + 1] = v.y; h[4 * i + 2] = v.z; h[4 * i + 3] = v.w; ss += v.x * v.x + v.y * v.y + v.z * v.z + v.w * v.w; }
    ss += __shfl_xor(ss, 1); ss += __shfl_xor(ss, 2); ss += __shfl_xor(ss, 4);
    const float r = rsqrtf(ss * (1.f / 128.f) + EPS);
    const unsigned gw[8] = {og[0].x, og[0].y, og[0].z, og[0].w, og[1].x, og[1].y, og[1].z, og[1].w};
    unsigned ow[8];
#pragma unroll
    for (int q = 0; q < 8; ++q) {
        const float ga = bf2f(gw[q] & 0xffffu), gb = bf2f(gw[q] >> 16);
        const float a = h[2 * q] * r * w[part * 16 + 2 * q] * (GATE == 0 ? fsigmoid_(ga) : fsilu_(ga));
        const float b = h[2 * q + 1] * r * w[part * 16 + 2 * q + 1] * (GATE == 0 ? fsigmoid_(gb) : fsilu_(gb));
        ow[q] = pk2(a, b);
    }
    *(u32x4*)(out + (size_t)l * opitch + part * 16) = (u32x4){ow[0], ow[1], ow[2], ow[3]};
    *(u32x4*)(out + (size_t)l * opitch + part * 16 + 8) = (u32x4){ow[4], ow[5], ow[6], ow[7]};
}

__device__ __forceinline__ void phase_mlstm_local(const Params& p, unsigned char* lds) {
    const int tid = opaque_tid(), lane = tid & 63, wid = tid >> 6, fr = lane & 15, fq = lane >> 4;
    unsigned char* ws = p.ws;
    const bf16_t* PROJ = (const bf16_t*)(ws + WS_PROJ);
    const float* GATES = (const float*)(ws + WS_GATES);
    bf16_t* Kt = (bf16_t*)lds;
    bf16_t* Vt = (bf16_t*)(lds + 18432);
    float* wk = (float*)(lds + 36864);
    const int NIT = 1024 + 256;
    Tile2 rk, rv; float gi = 0.f, gf = 0.f;
    auto load_item = [&](int it) {
        const int b = it >> 8, h = (it >> 6) & 3, c = it & 63, t0 = b * SEQ + c * 64;
        tile_load(rk, PROJ + (size_t)t0 * PA + 512 + h * 128, PA, tid);
        tile_load(rv, PROJ + (size_t)t0 * PA + 1024 + h * 128, PA, tid);
        gi = GATES[(size_t)(t0 + lane) * 8 + h]; gf = GATES[(size_t)(t0 + lane) * 8 + 4 + h];
    };
    if ((int)blockIdx.x < 1024) load_item(blockIdx.x);
    for (int it = blockIdx.x; it < NIT; it += gridDim.x) {
        if (it < 1024) {
            if (wid == 0) {
                const float lf = logsigmoid_(gf);
                const float bc = wave_incl_sum(lf, lane);
                const float bend = __shfl(bc, 63);
                const float logg = bend - bc + gi;
                const float ml = wave_max(logg);
                wk[lane] = expf(logg - ml);
                if (lane == 0) { ((float*)(ws + WS_MLOC))[it] = ml; ((float*)(ws + WS_BEND))[it] = bend; }
            }
            tile_put_rows(rk, Kt, tid);
            __syncthreads();
            {
#pragma unroll
                for (int i = 0; i < 2; ++i) {
                    const int pc = tid + i * NTHR, l = pc >> 4, d0 = (pc & 15) * 8; const float sc = wk[l];
                    const unsigned w[4] = {rv.v[i].x, rv.v[i].y, rv.v[i].z, rv.v[i].w};
                    u32x4 o; o.x = pk2(bf2f(w[0] & 0xffffu) * sc, bf2f(w[0] >> 16) * sc); o.y = pk2(bf2f(w[1] & 0xffffu) * sc, bf2f(w[1] >> 16) * sc);
                    o.z = pk2(bf2f(w[2] & 0xffffu) * sc, bf2f(w[2] >> 16) * sc); o.w = pk2(bf2f(w[3] & 0xffffu) * sc, bf2f(w[3] >> 16) * sc);
                    *(u32x4*)(Vt + l * 136 + d0) = o;
                }
                if (tid < 64) Vt[tid * 136 + 128] = (bf16_t)f2bf(wk[tid]);
            }
            __syncthreads();
            if (it + (int)gridDim.x < 1024) load_item(it + gridDim.x);
            state_outer_tr<true>(Kt, Vt, (bf16_t*)(ws + WS_U) + (size_t)it * 16384, wid, fr, fq);
            {
                f32x4 acc = (f32x4){0.f, 0.f, 0.f, 0.f};
#pragma unroll
                for (int ls = 0; ls < 2; ++ls) {
                    const bf16x8 bn = frag_tr(Vt, 136, ls * 32, 128, fr, fq);
                    const bf16x8 ak = frag_tr(Kt, 136, ls * 32, wid * 16, fr, fq);
                    acc = __builtin_amdgcn_mfma_f32_16x16x32_bf16(ak, bn, acc, 0, 0, 0);
                }
                if (fr == 0) *(f32x4*)((float*)(ws + WS_NLOC) + (size_t)it * 128 + wid * 16 + fq * 4) = acc;
            }
            __syncthreads();
        } else {
            const int ci = it - 1024, t0 = ci * 64, cq = tid & 63, ts = tid >> 6, c0 = cq * 8, tb = t0 + ts * 8;
            const float* cw = p.in[I_AB_CONVW];
            float w0[8], w1[8], w2[8];
#pragma unroll
            for (int j = 0; j < 8; ++j) { w0[j] = cw[c0 + j]; w1[j] = cw[512 + c0 + j]; w2[j] = cw[1024 + c0 + j]; }
            const bool halo = ((tb & (SEQ - 1)) != 0);
            float zp2[8], zp1[8];
            {
                u32x4 g2 = (u32x4){0u, 0u, 0u, 0u}, x2 = g2, g1 = g2, x1 = g2;
                if (halo) { const bf16_t* r2 = PROJ + (size_t)(tb - 2) * PA; const bf16_t* r1 = PROJ + (size_t)(tb - 1) * PA;
                    g2 = __builtin_nontemporal_load((const u32x4*)(r2 + 2560 + c0)); x2 = __builtin_nontemporal_load((const u32x4*)(r2 + 3072 + c0));
                    g1 = __builtin_nontemporal_load((const u32x4*)(r1 + 2560 + c0)); x1 = __builtin_nontemporal_load((const u32x4*)(r1 + 3072 + c0)); }
                const unsigned a0[4] = {g2.x, g2.y, g2.z, g2.w}, b0[4] = {x2.x, x2.y, x2.z, x2.w}, a1[4] = {g1.x, g1.y, g1.z, g1.w}, b1[4] = {x1.x, x1.y, x1.z, x1.w};
#pragma unroll
                for (int q = 0; q < 4; ++q) {
                    zp2[2 * q] = bf2f(a0[q] & 0xffffu) * bf2f(b0[q] & 0xffffu); zp2[2 * q + 1] = bf2f(a0[q] >> 16) * bf2f(b0[q] >> 16);
                    zp1[2 * q] = bf2f(a1[q] & 0xffffu) * bf2f(b1[q] & 0xffffu); zp1[2 * q + 1] = bf2f(a1[q] >> 16) * bf2f(b1[q] >> 16);
                }
            }
            bf16_t* mix = (bf16_t*)(ws + WS_MIX);
#pragma unroll 1
            for (int ps = 0; ps < 2; ++ps) {
                u32x4 gbv[4], gcv[4], xiv[4];
#pragma unroll
                for (int t = 0; t < 4; ++t) { const bf16_t* r = PROJ + (size_t)(tb + ps * 4 + t) * PA;
                    gbv[t] = __builtin_nontemporal_load((const u32x4*)(r + 2048 + c0)); gcv[t] = __builtin_nontemporal_load((const u32x4*)(r + 2560 + c0)); xiv[t] = __builtin_nontemporal_load((const u32x4*)(r + 3072 + c0)); }
#pragma unroll
                for (int t = 0; t < 4; ++t) {
                    const unsigned ga[4] = {gcv[t].x, gcv[t].y, gcv[t].z, gcv[t].w}, xa[4] = {xiv[t].x, xiv[t].y, xiv[t].z, xiv[t].w}, ba[4] = {gbv[t].x, gbv[t].y, gbv[t].z, gbv[t].w};
                    float y[8];
#pragma unroll
                    for (int q = 0; q < 4; ++q) {
                        const float z0 = bf2f(ga[q] & 0xffffu) * bf2f(xa[q] & 0xffffu), z1 = bf2f(ga[q] >> 16) * bf2f(xa[q] >> 16);
                        y[2 * q] = bf2f(ba[q] & 0xffffu) * (w0[2 * q] * zp2[2 * q] + w1[2 * q] * zp1[2 * q] + w2[2 * q] * z0);
                        y[2 * q + 1] = bf2f(ba[q] >> 16) * (w0[2 * q + 1] * zp2[2 * q + 1] + w1[2 * q + 1] * zp1[2 * q + 1] + w2[2 * q + 1] * z1);
                        zp2[2 * q] = zp1[2 * q]; zp1[2 * q] = z0; zp2[2 * q + 1] = zp1[2 * q + 1]; zp1[2 * q + 1] = z1;
                    }
                    *(u32x4*)(mix + (size_t)(tb + ps * 4 + t) * 1024 + 512 + c0) = (u32x4){pk2(y[0], y[1]), pk2(y[2], y[3]), pk2(y[4], y[5]), pk2(y[6], y[7])};
                }
            }
        }
    }
}

template <bool HG>
__device__ __forceinline__ void phase_scan(const Params& p, unsigned char* lds) {
    unsigned char* ws = p.ws;
    const int tid = opaque_tid(), lane = tid & 63, wv = tid >> 6;
    const int NGT = gridDim.x * NTHR;
    const bf16_t* U = (const bf16_t*)(ws + WS_U);
    bf16_t* CP = (bf16_t*)(ws + WS_CPREV);
    const float* MLOC = (const float*)(ws + WS_MLOC); const float* BEND = (const float*)(ws + WS_BEND); const float* BENDV = (const float*)(ws + WS_BENDV);
    float* sd = (float*)lds;
    float* ssu = sd + 64;
    float* sbv = (float*)(lds + 1024);
    const float* XEND = (const float*)(ws + WS_XEND);
    int sb = ((int)blockIdx.x * 8 + wv) * 4;
    float er[16], ei[16];
    if (HG && sb < 8192) {
        const int seq = sb + (lane & 3), seg = lane >> 2;
        const float* xe = XEND + ((size_t)((seq >> 11) * 256 + seg * 16) * 32 + ((seq >> 6) & 31)) * 128 + (seq & 63);
#pragma unroll
        for (int j = 0; j < 16; ++j) { er[j] = xe[j * 4096]; ei[j] = xe[j * 4096 + 64]; }
    }
    for (int base = blockIdx.x * NTHR; base < 131072; base += NGT) {
        const int idx = base + tid;
        const int bh = idx >> 13, rem = idx & 8191, e = rem >> 6, k = (rem & 63) * 2;
        if (base != (int)blockIdx.x * NTHR) __syncthreads();
        unsigned uu[64];
        {
            const bf16_t* up = U + (size_t)(bh * 64) * 16384 + e * 128 + k;
#pragma unroll
            for (int c = 0; c < 64; ++c) uu[c] = __builtin_nontemporal_load((const unsigned*)(up + (size_t)c * 16384));
        }
        const int kn0 = ((base & 8191) >> 9) * 8;
        if (!HG) {
            sbv[tid] = ((const float*)(ws + WS_NLOC))[(unsigned)((bh * 64 + (tid >> 3)) * 128 + kn0 + (tid & 7))];
            if (wv == 0) {
                const float ml = MLOC[bh * 64 + lane], be = BEND[bh * 64 + lane];
                float a = be, b = ml;
#pragma unroll
                for (int d = 1; d < 64; d <<= 1) {
                    const float pa = __shfl_up(a, d), pb = __shfl_up(b, d);
                    if (lane >= d) { b = fmaxf(pb + a, b); a = pa + a; }
                }
                const float m = b;
                float mp = __shfl_up(m, 1); if (lane == 0) mp = -1e30f;
                sd[lane] = expf(be + mp - m); ssu[lane] = expf(ml - m);
                if (rem < 64) ((float*)(ws + WS_MPREV))[bh * 64 + lane] = mp;
            }
        } else {
#pragma unroll
            for (int i = 0; i < 4; ++i) { const int q = tid + NTHR * i; *(f32x4*)(sbv + q * 4) = *(const f32x4*)(BENDV + (size_t)(bh * 64) * 128 + q * 4); }
        }
        __syncthreads();
        if (!HG && tid >= 504) {
            float* np_ = (float*)(ws + WS_NPREV) + (unsigned)((bh * 64) * 128 + kn0 + (tid - 504));
            float n = 0.f;
#pragma unroll
            for (int c = 0; c < 64; ++c) { np_[c * 128] = n; n = sd[c] * n + ssu[c] * sbv[c * 8 + (tid - 504)]; }
        }
        float c0 = 0.f, c1 = 0.f;
        bf16_t* cp = CP + (size_t)(bh * 64) * 16384 + e * 128 + k;
#pragma unroll
        for (int c = 0; c < 64; ++c) {
            *(unsigned*)(cp + (size_t)c * 16384) = pk2(c0, c1);
            const float u0 = bf2f(uu[c] & 0xffffu), u1 = bf2f(uu[c] >> 16);
            if (!HG) { const float d = sd[c], su = ssu[c]; c0 = d * c0 + su * u0; c1 = d * c1 + su * u1; }
            else { const f32x2 bv = *(const f32x2*)(sbv + c * 128 + k); c0 = bv.x * c0 + u0; c1 = bv.y * c1 + u1; }
        }
    }
    if (HG) {
        const f32x2* POW = (const f32x2*)(ws + WS_S5POW); bf16_t* XPB = (bf16_t*)(ws + WS_XPREVB);
        while (sb < 8192) {
            const int seq = sb + (lane & 3), seg = lane >> 2;
            const int b = seq >> 11, g = (seq >> 6) & 31, pp = seq & 63;
            const f32x2 l16 = POW[(g * 64 + pp) * 17 + 16];
            float ar = l16.x, ai = l16.y;
#pragma unroll
            for (int q = 0; q < 4; ++q) { const float nr = ar * ar - ai * ai, ni = 2.f * ar * ai; ar = nr; ai = ni; }
            bf16_t* xo = XPB + ((size_t)(b * 256 + seg * 16) * 32 + g) * 128 + pp;
            float xr = 0.f, xi = 0.f;
#pragma unroll
            for (int j = 0; j < 16; ++j) { const float nr = l16.x * xr - l16.y * xi + er[j], ni = l16.x * xi + l16.y * xr + ei[j]; xr = nr; xi = ni; }
            float cr = 0.f, ci = 0.f;
#pragma unroll
            for (int r = 0; r < 15; ++r) {
                const float pr = __shfl(xr, (lane & 3) + 4 * r), pi = __shfl(xi, (lane & 3) + 4 * r);
                if (r < seg) { const float nr = ar * cr - ai * ci + pr, ni = ar * ci + ai * cr + pi; cr = nr; ci = ni; }
            }
            xr = cr; xi = ci;
#pragma unroll
            for (int j = 0; j < 16; ++j) {
                xo[j * 4096] = (bf16_t)f2bf(xr); xo[j * 4096 + 64] = (bf16_t)f2bf(xi);
                const float nr = l16.x * xr - l16.y * xi + er[j], ni = l16.x * xi + l16.y * xr + ei[j]; xr = nr; xi = ni;
            }
            sb += gridDim.x * 32;
            if (sb < 8192) {
                const int seq2 = sb + (lane & 3);
                const float* xe = XEND + ((size_t)((seq2 >> 11) * 256 + seg * 16) * 32 + ((seq2 >> 6) & 31)) * 128 + (seq2 & 63);
#pragma unroll
                for (int j = 0; j < 16; ++j) { er[j] = xe[j * 4096]; ei[j] = xe[j * 4096 + 64]; }
            }
        }
    }
}

__device__ __forceinline__ void phase_mlstm_out(const Params& p, unsigned char* lds) {
    const int tid = opaque_tid(), lane = tid & 63, wid = tid >> 6, fr = lane & 15, fq = lane >> 4;
    unsigned char* ws = p.ws;
    const bf16_t* PROJ = (const bf16_t*)(ws + WS_PROJ);
    const float* GATES = (const float*)(ws + WS_GATES);
    bf16_t* Qs = (bf16_t*)lds;
    bf16_t* Ks = (bf16_t*)(lds + 17408);
    float* Hs = (float*)lds;
    bf16_t* Vt = (bf16_t*)(lds + 34816);
    bf16_t* Cs = (bf16_t*)(lds + 53248);
    bf16_t* Ps = (bf16_t*)(lds + 88064);
    float* sa = (float*)(lds + 97280);
    float* sg = sa + 64;
    float* sisc = sg + 64;
    float* semr = sisc + 64;
    float* sdinv = semr + 64;
    float* snp = sdinv + 64;
    Tile2 rq, rk, rv; Tile4 rc; u32x4 rog[2]; float g0 = 0.f, g1 = 0.f, g2 = 0.f, g3 = 0.f, g4 = 0.f;
    auto load_item = [&](int it) {
        const int b = it >> 8, h = (it >> 6) & 3, c = it & 63, t0 = b * SEQ + c * 64;
        tile_load<true>(rq, PROJ + (size_t)t0 * PA + h * 128, PA, tid);
        tile_load<true>(rk, PROJ + (size_t)t0 * PA + 512 + h * 128, PA, tid);
        tile_load<true>(rv, PROJ + (size_t)t0 * PA + 1024 + h * 128, PA, tid);
        tile4_load<true>(rc, (const bf16_t*)(ws + WS_CPREV) + (size_t)it * 16384, tid);
        { const bf16_t* og = PROJ + (size_t)(t0 + (tid >> 3)) * PA + 1536 + h * 128 + (tid & 7) * 16; rog[0] = __builtin_nontemporal_load((const u32x4*)og); rog[1] = __builtin_nontemporal_load((const u32x4*)(og + 8)); }
        g0 = GATES[(size_t)(t0 + lane) * 8 + h]; g1 = GATES[(size_t)(t0 + lane) * 8 + 4 + h]; g2 = ((const float*)(ws + WS_MPREV))[it];
        g3 = ((const float*)(ws + WS_NPREV))[(size_t)it * 128 + lane]; g4 = ((const float*)(ws + WS_NPREV))[(size_t)it * 128 + 64 + lane];
    };
    if ((int)blockIdx.x < 1024) load_item(blockIdx.x);
    for (int it = blockIdx.x; it < 1024; it += gridDim.x) {
        const int b = it >> 8, h = (it >> 6) & 3, c = it & 63, t0 = b * SEQ + c * 64;
        if (wid == 0) {
            const float ip = g0, fp = g1, mprev = g2;
            const float bc = wave_incl_sum(logsigmoid_(fp), lane);
            const float a = ip - bc;
            const float g = fmaxf(wave_incl_max(a, lane), mprev);
            sa[lane] = a; sg[lane] = g; sisc[lane] = expf(mprev - g); semr[lane] = expf(-(bc + g));
        } else if (wid == 1) { snp[lane] = g3; snp[64 + lane] = g4; }
        tile_put_rows(rq, Qs, tid); tile_put_rows(rk, Ks, tid); tile_put_rows(rv, Vt, tid); tile4_put(rc, Cs, tid);
        const u32x4 ogc[2] = {rog[0], rog[1]};
        __syncthreads();
        if (it + (int)gridDim.x < 1024) load_item(it + gridDim.x);
#pragma unroll
        for (int i = 0; i < 2; ++i) {
            const int tix = wid * 2 + i, lt = tix >> 2, st = tix & 3;
            f32x4 acc = (f32x4){0.f, 0.f, 0.f, 0.f};
            if (st <= lt) {
#pragma unroll
                for (int ks = 0; ks < 4; ++ks) {
                    const bf16x8 ak = *(const bf16x8*)(Ks + (st * 16 + fr) * 136 + ks * 32 + fq * 8);
                    const bf16x8 bq = *(const bf16x8*)(Qs + (lt * 16 + fr) * 136 + ks * 32 + fq * 8);
                    acc = __builtin_amdgcn_mfma_f32_16x16x32_bf16(ak, bq, acc, 0, 0, 0);
                }
            }
            const int l = lt * 16 + fr; const float gl = sg[l];
            float pv[4];
#pragma unroll
            for (int r = 0; r < 4; ++r) { const int s = st * 16 + fq * 4 + r; pv[r] = (s <= l) ? acc[r] * fexp_(sa[s] - gl) : 0.f; }
            u32x2 o; o.x = pk2(pv[0], pv[1]); o.y = pk2(pv[2], pv[3]);
            *(u32x2*)(Ps + l * 72 + st * 16 + fq * 4) = o;
        }
        __syncthreads();
        {
            const int l = tid >> 3, part = tid & 7;
            float rs = 0.f, qn = 0.f;
            const u32x4 pw = *(const u32x4*)(Ps + l * 72 + part * 8);
            rs = (bf2f(pw.x & 0xffffu) + bf2f(pw.x >> 16)) + (bf2f(pw.y & 0xffffu) + bf2f(pw.y >> 16)) + (bf2f(pw.z & 0xffffu) + bf2f(pw.z >> 16)) + (bf2f(pw.w & 0xffffu) + bf2f(pw.w >> 16));
            const u32x4 q0 = *(const u32x4*)(Qs + l * 136 + part * 16), q1 = *(const u32x4*)(Qs + l * 136 + part * 16 + 8);
            const unsigned qw[8] = {q0.x, q0.y, q0.z, q0.w, q1.x, q1.y, q1.z, q1.w};
#pragma unroll
            for (int j = 0; j < 8; ++j) qn += bf2f(qw[j] & 0xffffu) * snp[part * 16 + 2 * j] + bf2f(qw[j] >> 16) * snp[part * 16 + 2 * j + 1];
            rs += __shfl_xor(rs, 1); rs += __shfl_xor(rs, 2); rs += __shfl_xor(rs, 4);
            qn += __shfl_xor(qn, 1); qn += __shfl_xor(qn, 2); qn += __shfl_xor(qn, 4);
            if (part == 0) { const float den = rs + sisc[l] * qn; sdinv[l] = 1.f / fmaxf(fabsf(den), semr[l]); }
        }
        f32x4 a1[4], a2[4];
#pragma unroll
        for (int lt = 0; lt < 4; ++lt) { a1[lt] = (f32x4){0.f, 0.f, 0.f, 0.f}; a2[lt] = (f32x4){0.f, 0.f, 0.f, 0.f}; }
        {
            const int e0 = wid * 16;
#pragma unroll
            for (int ss = 0; ss < 2; ++ss) {
                const bf16x8 av = frag_tr(Vt, 136, ss * 32, e0, fr, fq);
#pragma unroll
                for (int lt = 0; lt < 4; ++lt) { const bf16x8 bp = *(const bf16x8*)(Ps + (lt * 16 + fr) * 72 + ss * 32 + fq * 8); a1[lt] = __builtin_amdgcn_mfma_f32_16x16x32_bf16(av, bp, a1[lt], 0, 0, 0); }
            }
#pragma unroll
            for (int ks = 0; ks < 4; ++ks) {
                const bf16x8 ac = *(const bf16x8*)(Cs + (e0 + fr) * 136 + ks * 32 + fq * 8);
#pragma unroll
                for (int lt = 0; lt < 4; ++lt) { const bf16x8 bq = *(const bf16x8*)(Qs + (lt * 16 + fr) * 136 + ks * 32 + fq * 8); a2[lt] = __builtin_amdgcn_mfma_f32_16x16x32_bf16(ac, bq, a2[lt], 0, 0, 0); }
            }
        }
        __syncthreads();
        {
            const int e0 = wid * 16;
#pragma unroll
            for (int lt = 0; lt < 4; ++lt) {
                const int l = lt * 16 + fr; const float is = sisc[l], di = sdinv[l];
                const f32x4 hv = (a1[lt] + a2[lt] * is) * di;
                *(f32x4*)(Hs + l * 132 + e0 + fq * 4) = hv;
            }
        }
        __syncthreads();
        head_norm_out_r<0>(Hs, p.in[I_AB_HNORM] + h * 128, ogc, (bf16_t*)(ws + WS_MIX) + (size_t)t0 * 1024 + h * 128, 1024, tid);
        __syncthreads();
    }
}

__device__ __forceinline__ void load_h_row(const Params& p, int row, int lane, bool combine, f32x4 (&v)[4], int ylayer = 0) {
    const bf16_t* hrow = (const bf16_t*)(p.ws + WS_H16) + (size_t)row * 1024;
#pragma unroll
    for (int j = 0; j < 4; ++j) { const u32x2 a = *(const u32x2*)(hrow + 4 * lane + 256 * j); v[j] = (f32x4){bf2f(a.x & 0xffffu), bf2f(a.x >> 16), bf2f(a.y & 0xffffu), bf2f(a.y >> 16)}; }
    if (combine) {
        const bf16_t* y0 = (const bf16_t*)(p.ws + ws_y(ylayer)) + (size_t)row * 1024;
        const bf16_t* y1 = y0 + (size_t)T * 1024;
#pragma unroll
        for (int j = 0; j < 4; ++j) {
            const u32x2 a = __builtin_nontemporal_load((const u32x2*)(y0 + 4 * lane + 256 * j)), bq = __builtin_nontemporal_load((const u32x2*)(y1 + 4 * lane + 256 * j));
            v[j].x += bf2f(a.x & 0xffffu) + bf2f(bq.x & 0xffffu); v[j].y += bf2f(a.x >> 16) + bf2f(bq.x >> 16);
            v[j].z += bf2f(a.y & 0xffffu) + bf2f(bq.y & 0xffffu); v[j].w += bf2f(a.y >> 16) + bf2f(bq.y >> 16);
        }
    }
}

__device__ __forceinline__ void phase_combine_norm(const Params& p, bool final_) {
    const int tid = opaque_tid(), lane = tid & 63, wid = tid >> 6;
    const int gw = blockIdx.x * 8 + wid, NGW = gridDim.x * 8;
    for (int row = gw; row < T; row += NGW) {
        f32x4 v[4];
        load_h_row(p, row, lane, true, v, final_ ? 1 : 0);
        float* hrow = p.out + (size_t)row * 1024;
        if (!final_) {
            bf16_t* h16 = (bf16_t*)(p.ws + WS_H16) + (size_t)row * 1024;
#pragma unroll
            for (int j = 0; j < 4; ++j) { u32x2 o; o.x = pk2(v[j].x, v[j].y); o.y = pk2(v[j].z, v[j].w); *(u32x2*)(h16 + 4 * lane + 256 * j) = o; }
            rms_row(v, p.in[I_NORM_MIX] + 1024, (bf16_t*)(p.ws + WS_XN) + (size_t)row * 1024, lane);
        } else {
            float ss = 0.f;
#pragma unroll
            for (int j = 0; j < 4; ++j) ss += v[j].x * v[j].x + v[j].y * v[j].y + v[j].z * v[j].z + v[j].w * v[j].w;
            ss = wave_sum(ss);
            const float r = rsqrtf(ss * (1.f / 1024.f) + EPS);
#pragma unroll
            for (int j = 0; j < 4; ++j) { const f32x4 w4 = *(const f32x4*)(p.in[I_NORM_FINAL] + 4 * lane + 256 * j); __builtin_nontemporal_store(v[j] * r * w4, (f32x4*)(hrow + 4 * lane + 256 * j)); }
        }
    }
}

template <bool DYN>
__device__ __forceinline__ void moe_convert(const Params& p, unsigned char* lds, int layer, int it_lo, int it_hi, int gw, int NGW, int wid, int lane, int* ctr = nullptr) {
    unsigned char* ws = p.ws;
    float* scr = (float*)(lds + wid * 8704);
    const float* wg = p.in[I_MOE_WGATE] + (size_t)layer * 32 * 1024 * 256;
    const float* wu = p.in[I_MOE_WUP] + (size_t)layer * 32 * 1024 * 256;
    const float* wd = p.in[I_MOE_WDOWN] + (size_t)layer * 32 * 256 * 1024;
    bf16_t* WGU = (bf16_t*)(ws + ws_wgu(layer)); bf16_t* WD = (bf16_t*)(ws + ws_wd(layer));
    constexpr int IT_GU = 16 * 16, IT_D = 32 * 4, IT_E = IT_GU + IT_D;
    for (int it0 = it_lo + gw;; it0 += NGW) {
        if (DYN) { int k = 0; if (lane == 0) k = __hip_atomic_fetch_add((__attribute__((address_space(3))) int*)ctr, 1, __ATOMIC_RELAXED, __HIP_MEMORY_SCOPE_WORKGROUP); it0 = it_lo + gw + __builtin_amdgcn_readfirstlane(k) * NGW; }
        if (it0 >= it_hi) break;
        const int e = it0 / IT_E; int it = it0 - e * IT_E;
        const float* src; bf16_t* dst; int ldn, ldk;
        if (it < IT_GU) {
            const int nb = it >> 4, kb = it & 15, n0 = nb * 32, k0 = kb * 64;
            const int pn = n0 >> 8, isup = (n0 >> 7) & 1, f0 = pn * 128 + (n0 & 127);
            src = (isup ? wu : wg) + (size_t)e * 1024 * 256 + (size_t)k0 * 256 + f0; ldn = 256;
            dst = WGU + (size_t)e * 512 * 1024 + (size_t)n0 * 1024 + k0; ldk = 1024;
        } else {
            it -= IT_GU;
            const int nb = it >> 2, kb = it & 3, n0 = nb * 32, k0 = kb * 64;
            src = wd + (size_t)e * 256 * 1024 + (size_t)k0 * 1024 + n0; ldn = 1024;
            dst = WD + (size_t)e * 1024 * 256 + (size_t)n0 * 256 + k0; ldk = 256;
        }
        transpose_tile(src, ldn, dst, ldk, 1.f, scr, lane);
    }
}
template <int RSEL>
__device__ __forceinline__ void phase_route(const Params& p, unsigned char* lds, int layer) {
    const int tid = opaque_tid(), lane = tid & 63, wid = tid >> 6, fr = lane & 15, fq = lane >> 4;
    unsigned char* ws = p.ws;
    float* part = (float*)lds;
    float* lg = (float*)(lds + 98304 + 2048);
    int* ctr = (int*)(lds + 98304 + 2048 + 12288 + 256);
    if (tid == 0) *ctr = 0;
    if (RSEL == 1) __syncthreads();
    const bf16_t* H16 = (const bf16_t*)(ws + WS_H16);
    const bf16_t* wf = (const bf16_t*)(ws + WS_WCAT) + (size_t)layer * 2 * 6144 * 8;
    int* cnt = (int*)(ws + WS_CNT) + layer * 1024;
    int* list = (int*)(ws + WS_LIST); float* wlist = (float*)(ws + WS_WLIST);
    if (RSEL != 1)
    for (int grp = blockIdx.x; grp < T / 64; grp += gridDim.x) {
        const int row0 = grp * 64;
        if (grp != (int)blockIdx.x) __syncthreads();
        bf16x8 a[4][4];
#pragma unroll
        for (int rt = 0; rt < 3; ++rt)
#pragma unroll
            for (int s_ = 0; s_ < 4; ++s_) a[rt][s_] = *(const bf16x8*)(H16 + (size_t)(row0 + rt * 16 + fr) * 1024 + wid * 128 + s_ * 32 + fq * 8);
        {
            const float* gp = p.in[I_NORM_FFN] + layer * 1024 + lane * 8;
            const f32x4 g0 = *(const f32x4*)gp, g1 = *(const f32x4*)(gp + 4), g2 = *(const f32x4*)(gp + 512), g3 = *(const f32x4*)(gp + 516);
#pragma unroll
            for (int hb = 0; hb < 2; ++hb) {
                bf16x8 x[4][2];
#pragma unroll
                for (int i = 0; i < 4; ++i) {
                    const bf16_t* hrow = H16 + (size_t)(row0 + wid * 8 + hb * 4 + i) * 1024 + lane * 8;
                    x[i][0] = *(const bf16x8*)hrow; x[i][1] = *(const bf16x8*)(hrow + 512);
                }
#pragma unroll
                for (int i = 0; i < 4; ++i) {
                    float f[16];
#pragma unroll
                    for (int j = 0; j < 8; ++j) { f[j] = bf2f((unsigned short)x[i][0][j]); f[8 + j] = bf2f((unsigned short)x[i][1][j]); }
                    float ss = 0.f;
#pragma unroll
                    for (int j = 0; j < 16; ++j) ss += f[j] * f[j];
                    ss = wave_sum(ss);
                    const float rs = rsqrtf(ss * (1.f / 1024.f) + EPS);
                    if (lane == 0) lg[64 * 48 + wid * 8 + hb * 4 + i] = rs;
                    u32x4 o0, o1;
                    o0.x = pk2(f[0] * rs * g0.x, f[1] * rs * g0.y); o0.y = pk2(f[2] * rs * g0.z, f[3] * rs * g0.w);
                    o0.z = pk2(f[4] * rs * g1.x, f[5] * rs * g1.y); o0.w = pk2(f[6] * rs * g1.z, f[7] * rs * g1.w);
                    o1.x = pk2(f[8] * rs * g2.x, f[9] * rs * g2.y); o1.y = pk2(f[10] * rs * g2.z, f[11] * rs * g2.w);
                    o1.z = pk2(f[12] * rs * g3.x, f[13] * rs * g3.y); o1.w = pk2(f[14] * rs * g3.z, f[15] * rs * g3.w);
                    bf16_t* xrow = (bf16_t*)(ws + WS_XN) + (size_t)(row0 + wid * 8 + hb * 4 + i) * 1024 + lane * 8;
                    *(u32x4*)xrow = o0; *(u32x4*)(xrow + 512) = o1;
                }
            }
        }
        bf16x8 bh[4][3], bl[4][3];
#pragma unroll
        for (int s_ = 0; s_ < 4; ++s_) a[3][s_] = *(const bf16x8*)(H16 + (size_t)(row0 + 48 + fr) * 1024 + wid * 128 + s_ * 32 + fq * 8);
#pragma unroll
        for (int s_ = 0; s_ < 4; ++s_)
#pragma unroll
            for (int n = 0; n < 3; ++n) {
                bh[s_][n] = *(const bf16x8*)(wf + ((size_t)((wid * 4 + s_) * 3 + n) * 64 + lane) * 8);
                bl[s_][n] = *(const bf16x8*)(wf + ((size_t)6144 + (size_t)((wid * 4 + s_) * 3 + n) * 64 + lane) * 8);
            }
#pragma unroll
        for (int rt = 0; rt < 4; ++rt) {
            f32x4 acc[3] = {(f32x4){0.f, 0.f, 0.f, 0.f}, (f32x4){0.f, 0.f, 0.f, 0.f}, (f32x4){0.f, 0.f, 0.f, 0.f}};
#pragma unroll
            for (int s_ = 0; s_ < 4; ++s_)
#pragma unroll
                for (int n = 0; n < 3; ++n) {
                    acc[n] = __builtin_amdgcn_mfma_f32_16x16x32_bf16(a[rt][s_], bl[s_][n], acc[n], 0, 0, 0);
                    acc[n] = __builtin_amdgcn_mfma_f32_16x16x32_bf16(a[rt][s_], bh[s_][n], acc[n], 0, 0, 0);
                }
#pragma unroll
            for (int n = 0; n < 3; ++n)
#pragma unroll
                for (int r = 0; r < 4; ++r) part[(wid * 64 + rt * 16 + fq * 4 + r) * 48 + n * 16 + fr] = acc[n][r];
        }
        __syncthreads();
        for (int i = tid; i < 64 * 48; i += NTHR) {
            float t = 0.f;
#pragma unroll
            for (int w = 0; w < 8; ++w) t += part[w * 3072 + i];
            lg[i] = t;
        }
        __syncthreads();
        if (wid == 0) {
            const int row = row0 + lane;
            const float rs = lg[64 * 48 + lane];
            const float* l = lg + lane * 48;
            const float* bg = p.in[I_MOE_BG] + layer * 4; const float* br = p.in[I_MOE_BR] + layer * 32;
            float gm = l[32] * rs + bg[0]; int gi = 0; float gl[4]; gl[0] = gm;
#pragma unroll
            for (int i = 1; i < 4; ++i) { gl[i] = l[32 + i] * rs + bg[i]; if (gl[i] > gm) { gm = gl[i]; gi = i; } }
            float gs = 0.f;
#pragma unroll
            for (int i = 0; i < 4; ++i) gs += expf(gl[i] - gm);
            const float gval = 1.f / gs;
            float m1 = -3.0e38f, m2 = -3.0e38f; int i1 = 0, i2 = 0;
#pragma unroll
            for (int i = 0; i < 8; ++i) {
                const float v = l[gi * 8 + i] * rs + br[gi * 8 + i];
                if (v > m1) { m2 = m1; i2 = i1; m1 = v; i1 = i; } else if (v > m2) { m2 = v; i2 = i; }
            }
            const float e2 = expf(m2 - m1), inv = gval / (1.f + e2);
            const int x1 = gi * 8 + i1, x2 = gi * 8 + i2;
            const unsigned long long ltm = (1ull << lane) - 1ull;
            int myc = 0, r1 = 0, r2 = 0;
#pragma unroll 1
            for (int e = 0; e < 32; ++e) {
                const unsigned long long b1 = __ballot(x1 == e), b2 = __ballot(x2 == e);
                const int c1 = __popcll(b1), c = c1 + __popcll(b2);
                if (lane == e) myc = c;
                if (x1 == e) r1 = __popcll(b1 & ltm);
                if (x2 == e) r2 = c1 + __popcll(b2 & ltm);
            }
            int base = 0;
            if (lane < 32 && myc > 0) base = atomicAdd(&cnt[lane * 32], myc);
            const int p1 = x1 * ECAP + __shfl(base, x1) + r1, p2 = x2 * ECAP + __shfl(base, x2) + r2;
            list[p1] = row * 2; wlist[p1] = inv;
            list[p2] = row * 2 + 1; wlist[p2] = inv * e2;
        }
    }
    if (RSEL < 2) moe_convert<true>(p, lds, layer, (layer == 1 && (int)gridDim.x > 128) ? MOE_CONV_EARLY : 0, MOE_CONV_ITEMS, blockIdx.x, gridDim.x, wid, lane, ctr);
}

struct AGather {
    const bf16_t* XN; const int* lst; int n;
    __device__ __forceinline__ const bf16_t* operator()(int r, int kc) const { const int tok = (r < n) ? (lst[r] >> 1) : 0; return XN + (size_t)tok * 1024 + kc * 8; }
};
struct EpiGateUp {
    bf16_t* H;
    __device__ __forceinline__ void operator()(const f32x4 (&acc)[2][4], int wr, int wc, int fr, int fq) const {
#pragma unroll
        for (int m = 0; m < 2; ++m)
#pragma unroll
            for (int n = 0; n < 2; ++n) {
                const f32x4 g = acc[m][n], u = acc[m][n + 2];
                u32x2 o; o.x = pk2(fsilu_(g.x) * u.x, fsilu_(g.y) * u.y); o.y = pk2(fsilu_(g.z) * u.z, fsilu_(g.w) * u.w);
                *(u32x2*)(H + (size_t)(wr * 32 + m * 16 + fr) * 256 + wc * 32 + n * 16 + fq * 4) = o;
            }
    }
};
struct EpiDown {
    bf16_t* Y; const int* lst; const float* wl; int n; int col0;
    __device__ __forceinline__ void operator()(const f32x4 (&acc)[2][4], int wr, int wc, int fr, int fq) const {
#pragma unroll
        for (int m = 0; m < 2; ++m) {
            const int r = wr * 32 + m * 16 + fr;
            if (r < n) {
                const int en = lst[r]; const float w = wl[r];
                bf16_t* yr = Y + ((size_t)(en & 1) * T + (en >> 1)) * 1024 + col0 + wc * 64 + fq * 4;
#pragma unroll
                for (int nn = 0; nn < 4; ++nn) { const f32x4 v = acc[m][nn] * w; u32x2 o; o.x = pk2(v.x, v.y); o.y = pk2(v.z, v.w); *(u32x2*)(yr + nn * 16) = o; }
            }
        }
    }
};
__device__ __forceinline__ void moe_prefix(const Params& p, int layer, int* tp, int* cn) {
    const int* cnt = (const int*)(p.ws + WS_CNT) + layer * 1024;
    int* sp = cn + 32;
    const int tid = opaque_tid();
    __syncthreads();
    if (tid < 32) cn[tid] = cnt[tid * 32];
    __syncthreads();
    if (tid == 0) {
        int s_ = 0, q_ = 0;
        for (int e = 0; e < 32; ++e) {
            const int c = cn[e], rem = c & 255;
            tp[e] = s_; sp[e] = q_;
            s_ += (c >> 8) + (rem > 128 ? 1 : 0); q_ += (rem > 0 && rem <= 128) ? 1 : 0;
        }
        tp[32] = s_; sp[32] = q_;
    }
    __syncthreads();
}
struct BGateUp {
    const bf16_t* W; int f0;
    __device__ __forceinline__ const bf16_t* operator()(int r, int kc) const {
        const int f = f0 + (r >> 6) * 32 + ((r >> 4) & 1) * 16 + (r & 15), isup = (r >> 5) & 1;
        return W + (size_t)((f >> 7) * 256 + isup * 128 + (f & 127)) * 1024 + kc * 8;
    }
};
constexpr int LDS_MOE_TAB = 131072, LDS_MOE_TP = 131072 + 4096;
__device__ __forceinline__ void phase_moe_up(const Params& p, unsigned char* lds, int layer) {
    unsigned* tab = (unsigned*)(lds + LDS_MOE_TAB); int* tp = (int*)(lds + LDS_MOE_TP); int* cn = tp + 64;
    moe_prefix(p, layer, tp, cn);
    pg8::SchedMoe S{tp, cn, tab, 2, tp[32] * 2, (int)gridDim.x, (int)blockIdx.x};
    const int* list = (const int*)(p.ws + WS_LIST);
    const int tid = opaque_tid();
    for (int i = 0; i < pg8::MOE_MAXU; ++i) {
        pg8::Unit u; if (!S.next(i, u)) break;
        const int e = u.pn >> 1, pos = (u.pm - tp[e]) * 256 + tid;
        if (tid < 256) tab[i * 256 + tid] = (pos < cn[e]) ? (unsigned)(list[(size_t)e * ECAP + pos] >> 1) * 2048u : 0u;
    }
    __syncthreads();
    pg8::Gemm g{(const bf16_t*)(p.ws + WS_XN), (const bf16_t*)(p.ws + ws_wgu(layer)), 0, 0, 1024};
    pg8::EpiMoeUp E{(bf16_t*)(p.ws + WS_HID)};
    pg8::gemm_phase_g<pg8::EpiMoeUp, pg8::SchedMoe>((PG8_LAS unsigned char*)lds, g, S, E);
    __syncthreads();
    const int* sp = cn + 32; const int nsm = sp[32], np8 = tp[32];
    const int G_ = (int)gridDim.x, uoff = (np8 * 2) % G_;
    for (int u = ((int)blockIdx.x - uoff + G_) % G_; u < nsm * 4; u += G_) {
        const int si = u >> 2, pn4 = u & 3;
        int e = 0; while (sp[e + 1] <= si) ++e;
        const int pos0 = (tp[e + 1] - tp[e]) * 256, n = cn[e] - pos0;
        AGather ag{(const bf16_t*)(p.ws + WS_XN), list + (size_t)e * ECAP + pos0, n};
        BGateUp bg{(const bf16_t*)(p.ws + ws_wgu(layer)) + (size_t)e * 512 * 1024, pn4 * 64};
        EpiGateUp ep{(bf16_t*)(p.ws + WS_HID) + ((size_t)np8 * 256 + (size_t)si * 128) * 256 + pn4 * 64};
        gemm128b(lds, ag, bg, 1024, ep);
    }
}
__device__ __forceinline__ void phase_moe_down(const Params& p, unsigned char* lds, int layer) {
    unsigned* tab = (unsigned*)(lds + LDS_MOE_TAB); float* wtab = (float*)(lds + LDS_MOE_TAB + 4096); int* tp = (int*)(lds + LDS_MOE_TP + 4096); int* cn = tp + 64;
    moe_prefix(p, layer, tp, cn);
    pg8::SchedMoe S{tp, cn, tab, 4, tp[32] * 4, (int)gridDim.x, (int)blockIdx.x};
    const int* list = (const int*)(p.ws + WS_LIST); const float* wlist = (const float*)(p.ws + WS_WLIST);
    const int tid = opaque_tid();
    for (int i = 0; i < pg8::MOE_MAXU; ++i) {
        pg8::Unit u; if (!S.next(i, u)) break;
        const int e = u.pn >> 2, pos = (u.pm - tp[e]) * 256 + tid;
        if (tid < 256) {
            const bool ok = pos < cn[e];
            const int en = ok ? list[(size_t)e * ECAP + pos] : 0;
            tab[i * 256 + tid] = ok ? (unsigned)((en & 1) * T + (en >> 1)) : 0xffffffffu;
            wtab[i * 256 + tid] = ok ? wlist[(size_t)e * ECAP + pos] : 0.f;
        }
    }
    __syncthreads();
    pg8::Gemm g{(const bf16_t*)(p.ws + WS_HID), (const bf16_t*)(p.ws + ws_wd(layer)), 0, 0, 256};
    pg8::EpiMoeDown E{(bf16_t*)(p.ws + ws_y(layer)), tab, wtab};
    pg8::gemm_phase<pg8::EpiMoeDown, pg8::SchedMoe, true, true>((PG8_LAS unsigned char*)lds, g, S, E);
    __syncthreads();
    const int* sp = cn + 32; const int nsm = sp[32], np8 = tp[32];
    const int G_ = (int)gridDim.x, uoff = (np8 * 4) % G_;
    for (int u = ((int)blockIdx.x - uoff + G_) % G_; u < nsm * 8; u += G_) {
        const int si = u >> 3, pn8 = u & 7;
        int e = 0; while (sp[e + 1] <= si) ++e;
        const int pos0 = (tp[e + 1] - tp[e]) * 256, n = cn[e] - pos0;
        APlain ap{(const bf16_t*)(p.ws + WS_HID) + ((size_t)np8 * 256 + (size_t)si * 128) * 256, 256};
        EpiDown ep{(bf16_t*)(p.ws + ws_y(layer)), list + (size_t)e * ECAP + pos0, wlist + (size_t)e * ECAP + pos0, n, pn8 * 128};
        gemm128(lds, ap, (const bf16_t*)(p.ws + ws_wd(layer)) + (size_t)e * 1024 * 256 + (size_t)pn8 * 128 * 256, 256, ep);
    }
}

constexpr int LDS_HG_SEG = 98304, LDS_HG_LBT = 106496;
struct HgBlk { float bc[4][4]; float kk[4][4]; };
__device__ __forceinline__ void hgrn_lb_table(const Params& p, float* lbt, int tid) {
    const float* lbp = p.in[I_HGRN_LB];
    lbt[tid] = sigmoid_(lbp[512 + tid] - lbp[tid]);
    __syncthreads();
}
__device__ __forceinline__ void hg_block(const bf16_t* __restrict__ fg, const float* lbt, float* seg, int tid, HgBlk& B) {
    const int k0 = (tid & 31) * 4, l0 = (tid >> 5) * 4;
    const f32x4 lb4 = *(const f32x4*)(lbt + k0);
    u32x2 w[4];
#pragma unroll
    for (int i = 0; i < 4; ++i) w[i] = *(const u32x2*)(fg + (size_t)(l0 + i) * PC + k0);
    float run[4] = {1.f, 1.f, 1.f, 1.f};
#pragma unroll
    for (int i = 0; i < 4; ++i) {
        const float x[4] = {bf2f(w[i].x & 0xffffu), bf2f(w[i].x >> 16), bf2f(w[i].y & 0xffffu), bf2f(w[i].y >> 16)};
#pragma unroll
        for (int j = 0; j < 4; ++j) {
            const float lb = lb4[j], sg = fsigmoid_(x[j]), f = lb + (1.f - lb) * sg;
            run[j] *= f; B.bc[i][j] = run[j]; B.kk[i][j] = (1.f - lb) * (1.f - sg);
        }
    }
    *(f32x4*)(seg + (tid >> 5) * 128 + k0) = (f32x4){run[0], run[1], run[2], run[3]};
}
__device__ __forceinline__ void hg_offsets(const float* seg, int tid, HgBlk& B, f32x4& bend) {
    const int k0 = (tid & 31) * 4, ls = tid >> 5;
    f32x4 off = (f32x4){1.f, 1.f, 1.f, 1.f}, tot = off;
#pragma unroll
    for (int r = 0; r < 16; ++r) { const f32x4 v = *(const f32x4*)(seg + r * 128 + k0); if (r < ls) off *= v; tot *= v; }
#pragma unroll
    for (int i = 0; i < 4; ++i)
#pragma unroll
        for (int j = 0; j < 4; ++j) B.bc[i][j] *= off[j];
    bend = tot;
}

__device__ __forceinline__ void phase_cd_local(const Params& p, unsigned char* lds) {
    const int tid = opaque_tid(), lane = tid & 63, wid = tid >> 6, fr = lane & 15, fq = lane >> 4;
    unsigned char* ws = p.ws;
    const bf16_t* PROJ = (const bf16_t*)(ws + WS_PROJ);
    bf16_t* KhT = (bf16_t*)lds;
    bf16_t* Vt = (bf16_t*)(lds + 18432);
    float* seg = (float*)(lds + LDS_HG_SEG); float* lbt = (float*)(lds + LDS_HG_LBT);
    hgrn_lb_table(p, lbt, tid);
    const int k0 = (tid & 31) * 4, l0 = (tid >> 5) * 4;
    for (int it = blockIdx.x; it < 1024 + 256; it += gridDim.x) {
        if (it < 1024) {
            const int b = it >> 8, h = (it >> 6) & 3, c = it & 63, t0 = b * SEQ + c * 64;
            HgBlk B;
            hg_block(PROJ + (size_t)t0 * PC + 1024 + h * 128, lbt + h * 128, seg, tid, B);
            Tile2 rv; tile_load(rv, PROJ + (size_t)t0 * PC + 1536 + h * 128, PC, tid);
            __syncthreads();
            f32x4 bend; hg_offsets(seg, tid, B, bend);
#pragma unroll
            for (int j = 0; j < 4; ++j) {
                u32x2 o; o.x = pk2(B.kk[0][j] * bend[j] * __builtin_amdgcn_rcpf(B.bc[0][j]), B.kk[1][j] * bend[j] * __builtin_amdgcn_rcpf(B.bc[1][j]));
                o.y = pk2(B.kk[2][j] * bend[j] * __builtin_amdgcn_rcpf(B.bc[2][j]), B.kk[3][j] * bend[j] * __builtin_amdgcn_rcpf(B.bc[3][j]));
                *(u32x2*)(KhT + tsw(k0 + j, l0)) = o;
            }
            if (tid < 32) *(f32x4*)((float*)(ws + WS_BENDV) + (size_t)it * 128 + k0) = bend;
            tile_put_rows(rv, Vt, tid);
            __syncthreads();
            state_outer_tr<false>(KhT, Vt, (bf16_t*)(ws + WS_U) + (size_t)it * 16384, wid, fr, fq);
            __syncthreads();
        } else {
            s5_unit_E(p, lds, it - 1024);
        }
    }
}

template <int SEL>
__device__ __forceinline__ void phase_cd_out(const Params& p, unsigned char* lds) {
    const int tid = opaque_tid(), lane = tid & 63, wid = tid >> 6, fr = lane & 15, fq = lane >> 4;
    unsigned char* ws = p.ws;
    const bf16_t* PROJ = (const bf16_t*)(ws + WS_PROJ);
    bf16_t* Qs = (bf16_t*)lds;
    bf16_t* Ks = (bf16_t*)(lds + 17408);
    float* Hs = (float*)lds;
    bf16_t* Vt = (bf16_t*)(lds + 34816);
    bf16_t* Ss = (bf16_t*)(lds + 53248);
    bf16_t* Ps = (bf16_t*)(lds + 88064);
    float* seg = (float*)(lds + LDS_HG_SEG); float* lbt = (float*)(lds + LDS_HG_LBT);
    hgrn_lb_table(p, lbt, tid);
    const int k0 = (tid & 31) * 4, l0 = (tid >> 5) * 4;
    for (int it = blockIdx.x + (SEL == 2 ? 1024 : 0); it < (SEL == 1 ? 1024 : 1024 + 256); it += gridDim.x) {
        if (it < 1024) {
            const int b = it >> 8, h = (it >> 6) & 3, c = it & 63, t0 = b * SEQ + c * 64;
            HgBlk B;
            hg_block(PROJ + (size_t)t0 * PC + 1024 + h * 128, lbt + h * 128, seg, tid, B);
            u32x2 qw[4];
#pragma unroll
            for (int i = 0; i < 4; ++i) qw[i] = __builtin_nontemporal_load((const u32x2*)(PROJ + (size_t)(t0 + l0 + i) * PC + 512 + h * 128 + k0));
            Tile2 rv; Tile4 rs;
            tile_load<true>(rv, PROJ + (size_t)t0 * PC + 1536 + h * 128, PC, tid);
            tile4_load<true>(rs, (const bf16_t*)(ws + WS_CPREV) + (size_t)it * 16384, tid);
            tile_put_rows(rv, Vt, tid); tile4_put(rs, Ss, tid);
            __syncthreads();
            f32x4 bend; hg_offsets(seg, tid, B, bend);
#pragma unroll
            for (int i = 0; i < 4; ++i) {
                const float q0 = bf2f(qw[i].x & 0xffffu), q1 = bf2f(qw[i].x >> 16), q2 = bf2f(qw[i].y & 0xffffu), q3 = bf2f(qw[i].y >> 16);
                const float e0 = B.bc[i][0], e1 = B.bc[i][1], e2 = B.bc[i][2], e3 = B.bc[i][3];
                u32x2 oq; oq.x = pk2(q0 * e0, q1 * e1); oq.y = pk2(q2 * e2, q3 * e3);
                u32x2 ok; ok.x = pk2(B.kk[i][0] * __builtin_amdgcn_rcpf(e0), B.kk[i][1] * __builtin_amdgcn_rcpf(e1)); ok.y = pk2(B.kk[i][2] * __builtin_amdgcn_rcpf(e2), B.kk[i][3] * __builtin_amdgcn_rcpf(e3));
                *(u32x2*)(Qs + (l0 + i) * 136 + k0) = oq; *(u32x2*)(Ks + (l0 + i) * 136 + k0) = ok;
            }
            __syncthreads();
#pragma unroll
            for (int i = 0; i < 2; ++i) {
                const int tix = wid * 2 + i, lt = tix >> 2, st = tix & 3;
                f32x4 acc = (f32x4){0.f, 0.f, 0.f, 0.f};
                if (st <= lt) {
#pragma unroll
                    for (int ks = 0; ks < 4; ++ks) {
                        const bf16x8 ak = *(const bf16x8*)(Ks + (st * 16 + fr) * 136 + ks * 32 + fq * 8);
                        const bf16x8 bq = *(const bf16x8*)(Qs + (lt * 16 + fr) * 136 + ks * 32 + fq * 8);
                        acc = __builtin_amdgcn_mfma_f32_16x16x32_bf16(ak, bq, acc, 0, 0, 0);
                    }
                }
                const int l = lt * 16 + fr;
                float pv[4];
#pragma unroll
                for (int r = 0; r < 4; ++r) { const int s_ = st * 16 + fq * 4 + r; pv[r] = (s_ <= l) ? acc[r] : 0.f; }
                u32x2 o; o.x = pk2(pv[0], pv[1]); o.y = pk2(pv[2], pv[3]);
                *(u32x2*)(Ps + l * 72 + st * 16 + fq * 4) = o;
            }
            __syncthreads();
            f32x4 a1[4];
#pragma unroll
            for (int lt = 0; lt < 4; ++lt) a1[lt] = (f32x4){0.f, 0.f, 0.f, 0.f};
            {
                const int e0 = wid * 16;
#pragma unroll
                for (int ss = 0; ss < 2; ++ss) {
                    const bf16x8 av = frag_tr(Vt, 136, ss * 32, e0, fr, fq);
#pragma unroll
                    for (int lt = 0; lt < 4; ++lt) { const bf16x8 bp = *(const bf16x8*)(Ps + (lt * 16 + fr) * 72 + ss * 32 + fq * 8); a1[lt] = __builtin_amdgcn_mfma_f32_16x16x32_bf16(av, bp, a1[lt], 0, 0, 0); }
                }
#pragma unroll
                for (int ks = 0; ks < 4; ++ks) {
                    const bf16x8 ac = *(const bf16x8*)(Ss + (e0 + fr) * 136 + ks * 32 + fq * 8);
#pragma unroll
                    for (int lt = 0; lt < 4; ++lt) { const bf16x8 bq = *(const bf16x8*)(Qs + (lt * 16 + fr) * 136 + ks * 32 + fq * 8); a1[lt] = __builtin_amdgcn_mfma_f32_16x16x32_bf16(ac, bq, a1[lt], 0, 0, 0); }
                }
            }
            __syncthreads();
            {
                const int e0 = wid * 16;
#pragma unroll
                for (int lt = 0; lt < 4; ++lt) *(f32x4*)(Hs + (lt * 16 + fr) * 132 + e0 + fq * 4) = a1[lt];
            }
            __syncthreads();
            head_norm_out<1>(Hs, p.in[I_HGRN_ONORM] + h * 128, PROJ + (size_t)t0 * PC + 2048 + h * 128, PC, (bf16_t*)(ws + WS_MIX) + (size_t)t0 * 1024 + 512 + h * 128, 1024, tid);
            __syncthreads();
        } else {
            s5_unit_Y(p, lds, it - 1024);
        }
    }
}

#define XB_TMO      128
#define XB_XCNT(j)  (256  + 64 * (j))
#define XB_XSUB(j)  (1280 + 64 * (j))
#define XB_XGEN(j)  (2304 + 64 * (j))
#define XB_TOP      3328
#define XB_TOPGEN   3392
#define XCD_BAR_WORDS 3456
#define XB_SPIN_CAP (1u << 22)
#define LAS __attribute__((address_space(3)))
constexpr size_t WS_BAR = 4096;
constexpr size_t CTL_ZERO_BYTES = 32768;
static_assert(WS_BAR + XCD_BAR_WORDS * 4 <= CTL_ZERO_BYTES, "barrier words outside the zeroed region");
constexpr int LDS_BAR_OFF = LDS_BYTES - 16;
__device__ __forceinline__ unsigned xb_ld(unsigned* p)              { return __hip_atomic_load(p, __ATOMIC_RELAXED, __HIP_MEMORY_SCOPE_AGENT); }
__device__ __forceinline__ unsigned xb_add(unsigned* p, unsigned v) { return __hip_atomic_fetch_add(p, v, __ATOMIC_RELAXED, __HIP_MEMORY_SCOPE_AGENT); }
__device__ __forceinline__ unsigned xb_xcc_id() { return (unsigned)__builtin_amdgcn_s_getreg((3 << 11) | 20) & 0xFu; }
#define XB_SPIN(cond, bar) do { unsigned _sp = 0; while (cond) { __builtin_amdgcn_s_sleep(1); \
    if ((++_sp & 255u) == 0u) { if (xb_ld(&(bar)[XB_TMO])) break; if (_sp > XB_SPIN_CAP) { atomicAdd(&(bar)[XB_TMO], 1u); break; } } } } while (0)
struct XcdBarrier { unsigned* bar; unsigned x; volatile LAS unsigned* st; };
__device__ __forceinline__ XcdBarrier xcd_barrier_post(unsigned* bar, volatile LAS unsigned* st) {
    XcdBarrier b; b.bar = bar; b.x = xb_xcc_id(); b.st = st;
    if (opaque_tid() == 0) (void)xb_add(&bar[XB_XCNT(b.x)], 1u);
    return b;
}
__device__ __forceinline__ void xcd_barrier_complete(unsigned* bar, unsigned x, unsigned& nloc, unsigned& nx) {
    const unsigned G = gridDim.x * gridDim.y * gridDim.z;
    unsigned sum, cnt, mine, sp = 0u;
    for (;;) {
        sum = 0u; cnt = 0u; mine = 0u;
#pragma unroll
        for (unsigned j = 0; j < 16; ++j) { const unsigned c = xb_ld(&bar[XB_XCNT(j)]); sum += c; cnt += (c > 0u) ? 1u : 0u; mine = (j == x) ? c : mine; }
        if (sum == G) break;
        __builtin_amdgcn_s_sleep(1);
        if ((++sp & 255u) == 0u) { if (xb_ld(&bar[XB_TMO])) break; if (sp > XB_SPIN_CAP) { atomicAdd(&bar[XB_TMO], 1u); break; } }
    }
    nloc = mine > 0u ? mine : 1u; nx = cnt > 0u ? cnt : 1u;
}
__device__ __forceinline__ void xcd_barrier(const XcdBarrier& b) {
    asm volatile("s_waitcnt vmcnt(0)" ::: "memory");
    __syncthreads();
    if (opaque_tid() == 0) {
        unsigned* bar = b.bar;
        __builtin_amdgcn_s_waitcnt(0);
        unsigned nloc = b.st[0], nx = b.st[1];
        if (nloc == 0u) { xcd_barrier_complete(bar, b.x, nloc, nx); b.st[0] = nloc; b.st[1] = nx; }
        const unsigned old = xb_add(&bar[XB_XSUB(b.x)], 1u);
        const unsigned gen = old / nloc;
        if (old + 1u == (gen + 1u) * nloc) {
            __builtin_amdgcn_fence(__ATOMIC_RELEASE, "agent");
            asm volatile("s_waitcnt vmcnt(0)" ::: "memory");
            const unsigned og = xb_add(&bar[XB_TOP], 1u);
            const unsigned tg = og / nx;
            if (og + 1u == (tg + 1u) * nx) xb_add(&bar[XB_TOPGEN], 1u);
            else XB_SPIN(xb_ld(&bar[XB_TOPGEN]) == tg, bar);
            __builtin_amdgcn_fence(__ATOMIC_ACQUIRE, "agent");
            xb_add(&bar[XB_XGEN(b.x)], 1u);
            asm volatile("s_waitcnt vmcnt(0)" ::: "memory");
        } else {
            XB_SPIN(xb_ld(&bar[XB_XGEN(b.x)]) == gen, bar);
            __builtin_amdgcn_fence(__ATOMIC_ACQUIRE, "agent");
            asm volatile("s_waitcnt vmcnt(0)" ::: "memory");
        }
    }
    __syncthreads();
}

constexpr int NPHASE = 20;
constexpr unsigned REP_MASK = 0u;
constexpr int PROBE_SEL = 0;
template <int PH>
__device__ __forceinline__ void run_phase(const Params& p, unsigned char* lds) {
    unsigned char* ws = p.ws;
    if constexpr (PH == 0) phase_prep(p, lds);
    else if constexpr (PH == 1) { s5_gen_ktab(p); phase_gemm256_inproj0(lds, p); }
    else if constexpr (PH == 2) { s5_gen_ops(p); phase_mlstm_local(p, lds); }
    else if constexpr (PH == 3) phase_scan<false>(p, lds);
    else if constexpr (PH == 4) phase_mlstm_out(p, lds);
    else if constexpr (PH == 5) phase_gemm256_resid(lds, (const bf16_t*)(ws + WS_MIX), (const bf16_t*)(ws + WS_WOUTA), nullptr, (const bf16_t*)(ws + WS_H16), (bf16_t*)(ws + WS_H16));
    else if constexpr (PH == 6) phase_route<0>(p, lds, 0);
    else if constexpr (PH == 7) phase_moe_up(p, lds, 0);
    else if constexpr (PH == 8) phase_moe_down(p, lds, 0);
    else if constexpr (PH == 9) phase_combine_norm(p, false);
    else if constexpr (PH == 10) phase_gemm256_inproj1(lds, p);
    else if constexpr (PH == 11) phase_cd_local(p, lds);
    else if constexpr (PH == 12) phase_scan<true>(p, lds);
    else if constexpr (PH == 13) phase_cd_out<0>(p, lds);
    else if constexpr (PH == 14) {
        phase_gemm_glu(lds, p);
        if ((int)blockIdx.x >= 128) { const int t_ = opaque_tid(); moe_convert<false>(p, lds, 1, 0, MOE_CONV_EARLY, ((int)blockIdx.x - 128) * 8 + (t_ >> 6), ((int)gridDim.x - 128) * 8, t_ >> 6, t_ & 63); }
    }
    else if constexpr (PH == 15) phase_gemm256_resid(lds, (const bf16_t*)(ws + WS_MIX), (const bf16_t*)(ws + WS_WOUTC), nullptr, (const bf16_t*)(ws + WS_H16), (bf16_t*)(ws + WS_H16));
    else if constexpr (PH == 16) phase_route<0>(p, lds, 1);
    else if constexpr (PH == 17) phase_moe_up(p, lds, 1);
    else if constexpr (PH == 18) phase_moe_down(p, lds, 1);
    else if constexpr (PH == 19) phase_combine_norm(p, true);
}
template <int PH>
__device__ __forceinline__ void run_from(const Params& p, unsigned char* lds, const XcdBarrier& bar) {
    run_phase<PH>(p, lds);
    if constexpr ((REP_MASK >> PH) & 1u) {
        xcd_barrier(bar);
        if constexpr ((PH == 6 || PH == 16) && PROBE_SEL != 4) { { const int t_ = opaque_tid(); if (blockIdx.x == 0 && t_ < 32) ((int*)(p.ws + WS_CNT))[(PH == 16 ? 1024 : 0) + t_ * 32] = 0; } xcd_barrier(bar); }
        if constexpr (PH == 13 && PROBE_SEL != 0) phase_cd_out<PROBE_SEL>(p, lds); else
        if constexpr (PH == 6 && PROBE_SEL != 0) phase_route<PROBE_SEL>(p, lds, 0); else
        run_phase<PH>(p, lds);
    }
    if constexpr (PH + 1 < NPHASE) {
        xcd_barrier(bar);
        run_from<PH + 1>(p, lds, bar);
    }
}
__global__ void __launch_bounds__(NTHR, 2) mega(Params p) {
    extern __shared__ __attribute__((aligned(16))) unsigned char lds[];
    if (p.use_cg) cg::this_grid().sync();
    { const int t_ = opaque_tid(); if (t_ < 4) ((unsigned*)(lds + LDS_BAR_OFF))[t_] = 0u; }
    __syncthreads();
    const XcdBarrier bar = xcd_barrier_post((unsigned*)(p.ws + WS_BAR), (volatile LAS unsigned*)(lds + LDS_BAR_OFF));
    run_from<0>(p, lds, bar);
}

extern "C" void kernel_launch(void* const* d_in, const int* in_sizes, int n_in, void* d_out, int out_size, void* d_ws, size_t ws_size, hipStream_t stream) {
    static int grid = 0;
    if (grid == 0) {
        if (n_in != 30 || out_size != T * DM || ws_size < WS_END) { fprintf(stderr, "kernel_launch: unexpected shapes (n_in %d out %d ws %zu)\n", n_in, out_size, ws_size); grid = -1; return; }
        int dev = 0, cus = 0, per_cu = 0;
        (void)hipGetDevice(&dev);
        (void)hipDeviceGetAttribute(&cus, hipDeviceAttributeMultiprocessorCount, dev);
        (void)hipFuncSetAttribute((const void*)mega, hipFuncAttributeMaxDynamicSharedMemorySize, LDS_BYTES);
        (void)hipOccupancyMaxActiveBlocksPerMultiprocessor(&per_cu, (const void*)mega, NTHR, LDS_BYTES);
        if (per_cu < 1) { fprintf(stderr, "kernel_launch: occupancy query says %d blocks per CU\n", per_cu); per_cu = 1; }
        grid = cus * 1;
        (void)hipGetLastError();
    }
    if (grid < 0) return;
    Params p{};
    for (int i = 0; i < 30; ++i) p.in[i] = (const float*)d_in[i];
    p.out = (float*)d_out; p.ws = (unsigned char*)d_ws;
    p.use_cg = 0; p.pad = 0;
    (void)hipMemsetAsync((unsigned char*)d_ws + WS_CTL, 0, CTL_ZERO_BYTES, stream);
    void* args[] = {&p};
    hipError_t e = hipLaunchCooperativeKernel((const void*)mega, dim3(grid), dim3(NTHR), args, LDS_BYTES, stream);
    if (e != hipSuccess) fprintf(stderr, "cooperative launch failed: %s (grid %d)\n", hipGetErrorString(e), grid);
}
```

```cpp
#include <hip/hip_runtime.h>
#include <hip/hip_cooperative_groups.h>
#include <cstdio>
#include <cstdint>
namespace cg = cooperative_groups;

typedef unsigned short bf16_t;
typedef short bf16x8 __attribute__((ext_vector_type(8)));
typedef float f32x4 __attribute__((ext_vector_type(4)));
typedef float f32x2 __attribute__((ext_vector_type(2)));
typedef unsigned u32x4 __attribute__((ext_vector_type(4)));
typedef unsigned u32x2 __attribute__((ext_vector_type(2)));

constexpr int T = 16384, DM = 1024, SEQ = 4096;
constexpr int NTHR = 512;
constexpr int PA = 3584;
constexpr int PC = 2560;
constexpr int ECAP = 16384;
constexpr float EPS = 1e-6f;

constexpr size_t KB = 1024, MB = 1024 * 1024;
constexpr size_t WS_CTL = 0;
constexpr size_t WS_CNT = 20480;
constexpr size_t WS_GATES = 64 * KB;
constexpr size_t WS_S5POW = WS_GATES + 512 * KB;
constexpr size_t WS_S5BBAR = WS_S5POW + 272 * KB;
constexpr size_t WS_WCAT = WS_S5BBAR + 256 * KB;
constexpr size_t WS_NLOC = WS_WCAT + 384 * KB;
constexpr size_t WS_NPREV = WS_NLOC + 512 * KB;
constexpr size_t WS_BENDV = WS_NPREV + 512 * KB;
constexpr size_t WS_MLOC = WS_BENDV + 512 * KB;
constexpr size_t WS_BEND = WS_MLOC + 4 * KB;
constexpr size_t WS_MPREV = WS_BEND + 4 * KB;
constexpr size_t WS_KTAB = 3072 * KB;
static_assert(WS_MPREV + 4 * KB <= WS_KTAB && WS_KTAB + 512 * KB <= 4 * MB, "small region overflow");
constexpr size_t WS_S5Y = 4 * MB;
constexpr size_t WS_S5E = 10 * MB;
constexpr size_t WS_WINA = 12 * MB;
constexpr size_t WS_WOUTA = 20 * MB;
constexpr size_t WS_WINC = 22 * MB;
constexpr size_t WS_WOUTC = 27 * MB;
constexpr size_t WS_WGLU = 29 * MB;
constexpr size_t WS_A = 30 * MB;
constexpr size_t WS_B = 142 * MB;
constexpr size_t WS_C = 174 * MB;
constexpr size_t WS_D = 206 * MB;
constexpr size_t WS_H16 = 238 * MB;
constexpr size_t WS_END = 270 * MB;
constexpr size_t WS_PROJ = WS_A, WS_LIST = WS_A, WS_WLIST = WS_A + 2 * MB, WS_HID = WS_A + 4 * MB, WS_Y = WS_A + 28 * MB;
constexpr size_t WS_XN = WS_B, WS_U = WS_B, WS_Z = WS_B;
constexpr size_t WS_XEND = WS_A + 84 * MB;
constexpr size_t WS_XPREVB = WS_A + 100 * MB;
constexpr size_t WS_MIX = WS_C, WS_CPREV = WS_D, WS_WGU = WS_C, WS_WD = WS_C + 32 * MB;

__host__ __device__ constexpr size_t ws_wgu(int layer) { return layer == 0 ? WS_C : WS_A + 64 * MB; }
__host__ __device__ constexpr size_t ws_wd(int layer) { return layer == 0 ? WS_C + 32 * MB : WS_A + 96 * MB; }
__host__ __device__ constexpr size_t ws_y(int layer) { return layer == 0 ? WS_A + 28 * MB : WS_C; }
constexpr int MOE_CONV_ITEMS = 32 * (16 * 16 + 32 * 4);
constexpr int MOE_CONV_EARLY = MOE_CONV_ITEMS / 2;
constexpr int LDS_BYTES = 144 * 1024;

struct Params { const float* in[30]; float* out; unsigned char* ws; int use_cg; int pad; };

enum { I_X = 0, I_NORM_MIX, I_NORM_FFN, I_NORM_FINAL, I_AB_WIN, I_AB_GBIAS, I_AB_HNORM, I_AB_CONVW, I_AB_WOUT, I_CD_WIN, I_S5_LRE, I_S5_LIM, I_S5_BRE, I_S5_BIM,
       I_S5_CRE, I_S5_CIM, I_S5_D, I_S5_LOGDT, I_S5_WGLU, I_S5_BGLU, I_HGRN_LB, I_HGRN_ONORM, I_CD_WOUT, I_MOE_WG, I_MOE_BG, I_MOE_WR, I_MOE_BR, I_MOE_WGATE, I_MOE_WUP, I_MOE_WDOWN };

__device__ __forceinline__ int opaque_tid() { int t = threadIdx.x; asm volatile("" : "+v"(t)); return t; }
__device__ __forceinline__ float bf2f(unsigned v) { return __uint_as_float(v << 16); }
typedef __bf16 bf16x2_t __attribute__((ext_vector_type(2)));
__device__ __forceinline__ unsigned pk2(float lo, float hi) { const f32x2 v = {lo, hi}; return __builtin_bit_cast(unsigned, __builtin_convertvector(v, bf16x2_t)); }
__device__ __forceinline__ unsigned f2bf(float f) { return (unsigned)__builtin_bit_cast(unsigned short, (__bf16)f); }
__device__ __forceinline__ float wave_sum(float v) {
#pragma unroll
    for (int o = 32; o; o >>= 1) v += __shfl_xor(v, o);
    return v;
}
__device__ __forceinline__ float wave_max(float v) {
#pragma unroll
    for (int o = 32; o; o >>= 1) v = fmaxf(v, __shfl_xor(v, o));
    return v;
}
__device__ __forceinline__ float wave_incl_sum(float v, int lane) {
#pragma unroll
    for (int o = 1; o < 64; o <<= 1) { const float t = __shfl_up(v, o); if (lane >= o) v += t; }
    return v;
}
__device__ __forceinline__ float wave_incl_max(float v, int lane) {
#pragma unroll
    for (int o = 1; o < 64; o <<= 1) { const float t = __shfl_up(v, o); if (lane >= o) v = fmaxf(v, t); }
    return v;
}
__device__ __forceinline__ float sigmoid_(float x) { return 1.f / (1.f + expf(-x)); }
__device__ __forceinline__ float fexp_(float x) { return __expf(x); }
__device__ __forceinline__ float fsigmoid_(float x) { return __builtin_amdgcn_rcpf(1.f + __expf(-x)); }
__device__ __forceinline__ float fsilu_(float x) { return x * __builtin_amdgcn_rcpf(1.f + __expf(-x)); }
__device__ __forceinline__ float fgelu_tanh_(float x) { const float u = 0.7978845608028654f * (x + 0.044715f * x * x * x); return x * __builtin_amdgcn_rcpf(1.f + __expf(-2.f * u)); }
__device__ __forceinline__ float logsigmoid_(float x) { return fminf(x, 0.f) - log1pf(expf(-fabsf(x))); }
__device__ __forceinline__ float silu_(float x) { return x / (1.f + expf(-x)); }
__device__ __forceinline__ float gelu_tanh_(float x) { const float u = 0.7978845608028654f * (x + 0.044715f * x * x * x); return 0.5f * x * (1.f + tanhf(u)); }
#define LDS_WAIT() asm volatile("s_waitcnt lgkmcnt(0)" ::: "memory")
__device__ __forceinline__ int tsw(int d, int l) { return d * 72 + (l ^ (((d >> 3) & 7) << 3)); }
__device__ __forceinline__ int tswc(int d, int c) { return d * 72 + ((c ^ ((d >> 3) & 7)) << 3); }
#define LDS_AS __attribute__((address_space(3)))
typedef short s16x4 __attribute__((ext_vector_type(4)));
__device__ __forceinline__ bf16x8 frag_tr(const bf16_t* T, int pitch, int k0, int n0, int fr, int fq) {
    const bf16_t* a = T + (k0 + 8 * fq + (fr >> 2)) * pitch + n0 + 4 * (fr & 3);
    const s16x4 lo = __builtin_amdgcn_ds_read_tr16_b64_v4i16((LDS_AS s16x4*)a);
    const s16x4 hi = __builtin_amdgcn_ds_read_tr16_b64_v4i16((LDS_AS s16x4*)(a + 4 * pitch));
    return (bf16x8){lo[0], lo[1], lo[2], lo[3], hi[0], hi[1], hi[2], hi[3]};
}

struct BPlain {
    const bf16_t* Bt; int K;
    __device__ __forceinline__ const bf16_t* operator()(int r, int kc) const { return Bt + (size_t)r * K + kc * 8; }
};
template <class APiece, class BPiece, class Epi>
__device__ __forceinline__ void gemm128b(unsigned char* lds, const APiece& apiece, const BPiece& bpiece, int K, const Epi& epi) {
    const int tid = opaque_tid(), lane = tid & 63, wid = tid >> 6, wr = wid >> 1, wc = wid & 1, fr = lane & 15, fq = lane >> 4;
    const int nt = K >> 6;
    const int r0 = tid >> 3, c0 = tid & 7;
    const int so0 = r0 * 128 + ((c0 ^ (r0 & 7)) << 4), so1 = so0 + 64 * 128;
    u32x4 xa0 = *(const u32x4*)apiece(r0, c0), xa1 = *(const u32x4*)apiece(r0 + 64, c0), xb0 = *(const u32x4*)bpiece(r0, c0), xb1 = *(const u32x4*)bpiece(r0 + 64, c0);
    u32x4 ya0 = *(const u32x4*)apiece(r0, 8 + c0), ya1 = *(const u32x4*)apiece(r0 + 64, 8 + c0), yb0 = *(const u32x4*)bpiece(r0, 8 + c0), yb1 = *(const u32x4*)bpiece(r0 + 64, 8 + c0);
    f32x4 acc[2][4];
#pragma unroll
    for (int m = 0; m < 2; ++m)
#pragma unroll
        for (int n = 0; n < 4; ++n) acc[m][n] = (f32x4){0.f, 0.f, 0.f, 0.f};
#define G128_PUT(buf, A0, A1, B0, B1) do { unsigned char* d_ = lds + (buf) * 16384; *(u32x4*)(d_ + so0) = A0; *(u32x4*)(d_ + so1) = A1; *(u32x4*)(d_ + 32768 + so0) = B0; *(u32x4*)(d_ + 32768 + so1) = B1; } while (0)
#define G128_GET(t, A0, A1, B0, B1) do { const int kc_ = (t) * 8 + c0; A0 = *(const u32x4*)apiece(r0, kc_); A1 = *(const u32x4*)apiece(r0 + 64, kc_); B0 = *(const u32x4*)bpiece(r0, kc_); B1 = *(const u32x4*)bpiece(r0 + 64, kc_); } while (0)
#define G128_MMA(buf) do { const unsigned char* sa = lds + (buf) * 16384; const unsigned char* sb = lds + 32768 + (buf) * 16384; \
        _Pragma("unroll") for (int kk = 0; kk < 2; ++kk) { bf16x8 a[2], b[4]; \
            _Pragma("unroll") for (int m = 0; m < 2; ++m) { const int row = wr * 32 + m * 16 + fr; a[m] = *(const bf16x8*)(sa + row * 128 + (((kk * 4 + fq) ^ (row & 7)) << 4)); } \
            _Pragma("unroll") for (int n = 0; n < 4; ++n) { const int row = wc * 64 + n * 16 + fr; b[n] = *(const bf16x8*)(sb + row * 128 + (((kk * 4 + fq) ^ (row & 7)) << 4)); } \
            _Pragma("unroll") for (int m = 0; m < 2; ++m) _Pragma("unroll") for (int n = 0; n < 4; ++n) acc[m][n] = __builtin_amdgcn_mfma_f32_16x16x32_bf16(b[n], a[m], acc[m][n], 0, 0, 0); } } while (0)
    G128_PUT(0, xa0, xa1, xb0, xb1);
    __syncthreads();
#pragma unroll 1
    for (int kt = 0; kt < nt; kt += 2) {
        if (kt + 2 < nt) G128_GET(kt + 2, xa0, xa1, xb0, xb1);
        G128_MMA(0);
        G128_PUT(1, ya0, ya1, yb0, yb1);
        __syncthreads();
        if (kt + 3 < nt) G128_GET(kt + 3, ya0, ya1, yb0, yb1);
        G128_MMA(1);
        if (kt + 2 < nt) G128_PUT(0, xa0, xa1, xb0, xb1);
        __syncthreads();
    }
#undef G128_PUT
#undef G128_GET
#undef G128_MMA
    epi(acc, wr, wc, fr, fq);
}

template <class APiece, class Epi>
__device__ __forceinline__ void gemm128(unsigned char* lds, const APiece& apiece, const bf16_t* __restrict__ Bt, int K, const Epi& epi) {
    BPlain b{Bt, K};
    gemm128b(lds, apiece, b, K, epi);
}

template <class APiece, class BPiece, class Epi0, class Epi1>
__device__ __forceinline__ void gemm128x2(unsigned char* lds, const APiece& apiece, const BPiece& bp0f, const BPiece& bp1f, int K, const Epi0& epi0, const Epi1& epi1) {
    const int tid = opaque_tid(), lane = tid & 63, wid = tid >> 6, wr = wid >> 1, wc = wid & 1, fr = lane & 15, fq = lane >> 4;
    const int nt = K >> 6;
    const int r0 = tid >> 3, c0 = tid & 7;
    const int so0 = r0 * 128 + ((c0 ^ (r0 & 7)) << 4), so1 = so0 + 64 * 128;
    u32x4 ra0 = *(const u32x4*)apiece(r0, c0), ra1 = *(const u32x4*)apiece(r0 + 64, c0);
    u32x4 rb0 = *(const u32x4*)bp0f(r0, c0), rb1 = *(const u32x4*)bp0f(r0 + 64, c0);
    u32x4 rc0 = *(const u32x4*)bp1f(r0, c0), rc1 = *(const u32x4*)bp1f(r0 + 64, c0);
    f32x4 acc0[2][4], acc1[2][4];
#pragma unroll
    for (int m = 0; m < 2; ++m)
#pragma unroll
        for (int n = 0; n < 4; ++n) { acc0[m][n] = (f32x4){0.f, 0.f, 0.f, 0.f}; acc1[m][n] = (f32x4){0.f, 0.f, 0.f, 0.f}; }
    *(u32x4*)(lds + so0) = ra0; *(u32x4*)(lds + so1) = ra1;
    *(u32x4*)(lds + 32768 + so0) = rb0; *(u32x4*)(lds + 32768 + so1) = rb1;
    *(u32x4*)(lds + 65536 + so0) = rc0; *(u32x4*)(lds + 65536 + so1) = rc1;
    __syncthreads();
#pragma unroll 1
    for (int kt = 0; kt < nt; ++kt) {
        const int cur = kt & 1;
        if (kt + 1 < nt) {
            const int kc = (kt + 1) * 8 + c0;
            ra0 = *(const u32x4*)apiece(r0, kc); ra1 = *(const u32x4*)apiece(r0 + 64, kc);
            rb0 = *(const u32x4*)bp0f(r0, kc); rb1 = *(const u32x4*)bp0f(r0 + 64, kc);
            rc0 = *(const u32x4*)bp1f(r0, kc); rc1 = *(const u32x4*)bp1f(r0 + 64, kc);
        }
        const unsigned char* sa = lds + cur * 16384;
        const unsigned char* sb = lds + 32768 + cur * 16384;
        const unsigned char* sc = lds + 65536 + cur * 16384;
#pragma unroll
        for (int kk = 0; kk < 2; ++kk) {
            bf16x8 a[2], b[4], c[4];
#pragma unroll
            for (int m = 0; m < 2; ++m) { const int row = wr * 32 + m * 16 + fr; a[m] = *(const bf16x8*)(sa + row * 128 + (((kk * 4 + fq) ^ (row & 7)) << 4)); }
#pragma unroll
            for (int n = 0; n < 4; ++n) { const int row = wc * 64 + n * 16 + fr; const int o = row * 128 + (((kk * 4 + fq) ^ (row & 7)) << 4); b[n] = *(const bf16x8*)(sb + o); c[n] = *(const bf16x8*)(sc + o); }
#pragma unroll
            for (int m = 0; m < 2; ++m)
#pragma unroll
                for (int n = 0; n < 4; ++n) { acc0[m][n] = __builtin_amdgcn_mfma_f32_16x16x32_bf16(b[n], a[m], acc0[m][n], 0, 0, 0); acc1[m][n] = __builtin_amdgcn_mfma_f32_16x16x32_bf16(c[n], a[m], acc1[m][n], 0, 0, 0); }
        }
        if (kt + 1 < nt) {
            unsigned char* da = lds + (cur ^ 1) * 16384;
            *(u32x4*)(da + so0) = ra0; *(u32x4*)(da + so1) = ra1;
            *(u32x4*)(da + 32768 + so0) = rb0; *(u32x4*)(da + 32768 + so1) = rb1;
            *(u32x4*)(da + 65536 + so0) = rc0; *(u32x4*)(da + 65536 + so1) = rc1;
        }
        __syncthreads();
    }
    epi0(acc0, wr, wc, fr, fq);
    epi1(acc1, wr, wc, fr, fq);
}
struct APlain {
    const bf16_t* A; int K;
    __device__ __forceinline__ const bf16_t* operator()(int r, int kc) const { return A + (size_t)r * K + kc * 8; }
};

namespace pg8 {
#define PG8_LAS __attribute__((address_space(3)))
typedef unsigned short bf16_t;
typedef short bf16x8 __attribute__((ext_vector_type(8)));
typedef float f32x4 __attribute__((ext_vector_type(4)));
typedef unsigned u32x4 __attribute__((ext_vector_type(4)));
constexpr int BM = 256, BK = 64, HALF = 128, HTB = HALF * BK * 2  , STAGE_BYTES = 8 * HTB, NXCD = 8, WGM = 8;

__host__ __device__ __forceinline__ int lds_byte(int r, int c) { const int st = (r >> 4) * 2 + (c >> 5), rr = r & 15, cc = c & 31, ob = rr * 64 + cc * 2; return st * 1024 + (ob ^ (((ob >> 9) & 1) << 5)); }
__host__ __device__ __forceinline__ void stage_rc(int b, int& R, int& C) { const int st = b / 1024, sb = b % 1024, swz = sb ^ (((sb >> 9) & 1) << 5); R = (st >> 1) * 16 + swz / 64; C = (st & 1) * 32 + (swz % 64) / 2; }
__host__ __device__ __forceinline__ int perm32(int rho) { const int n = rho >> 4, i = rho & 15; return 8 * (i >> 2) + 4 * n + (i & 3); }

struct Unit { int pm, pn, aux, half, nh; };
struct Gemm { const bf16_t* A; const bf16_t* Bt; int M, N, K; };

struct StaticOrder {
    int nM, nN, nwg, G, c;
    __host__ __device__ void init(int M, int N, int G_, int c_) { nM = M / BM; nN = N / BM; nwg = nM * nN; G = G_; c = c_; }
    __host__ __device__ __forceinline__ bool next(int i, Unit& u) const {
        const long L = (long)i * G + c; if (L >= nwg) return false;
        int wgid = (int)L; { const int q = nwg / NXCD, r = nwg % NXCD, xcd = wgid % NXCD, off = wgid / NXCD; wgid = (xcd < r ? xcd * (q + 1) : r * (q + 1) + (xcd - r) * q) + off; }
        const int nig = WGM * nN, gid = wgid / nig, fm = gid * WGM, gsz = (nM - fm) < WGM ? (nM - fm) : WGM;
        u.pm = fm + ((wgid % nig) % gsz); u.pn = (wgid % nig) / gsz; u.aux = 0; u.half = 0; u.nh = 0; return true;
    }
    __device__ __forceinline__ void a_ready(const Unit&) const {}
    __device__ __forceinline__ void done(const Unit&) const {}
};

struct StaticOrderHalfTail : StaticOrder {
    int nNF, nNT;
    __device__ __forceinline__ bool next(int i, Unit& u) const {
        const long L = (long)i * G + c; const int nw = nM * nNT * 2;
        if (L >= (long)nwg + nw) return false;
        const bool tail = L >= nwg;
        int wgid = tail ? 0 : (int)L; { const int q = nwg / NXCD, r = nwg % NXCD, xcd = wgid % NXCD, off = wgid / NXCD; wgid = (xcd < r ? xcd * (q + 1) : r * (q + 1) + (xcd - r) * q) + off; }
        const int nig = WGM * nN, gid = wgid / nig, fm = gid * WGM, gsz = (nM - fm) < WGM ? (nM - fm) : WGM;
        const int pm_f = fm + ((wgid % nig) % gsz), pn_f = (wgid % nig) / gsz;
        int wg = tail ? (int)(L - nwg) : 0; { const int q = nw / NXCD, rr = nw % NXCD, xcd = wg % NXCD, off = wg / NXCD; wg = (xcd < rr ? xcd * (q + 1) : rr * (q + 1) + (xcd - rr) * q) + off; }
        const int t = wg % (nNT * 2);
        u.pm = tail ? wg / (nNT * 2) : pm_f; u.pn = tail ? nNF + (t >> 1) : pn_f; u.nh = tail ? 1 + (t & 1) : 0; u.aux = 0; u.half = 0;
        return true;
    }
};
__device__ __forceinline__ unsigned cvt_pk_bf16(float lo, float hi) { unsigned r; asm volatile("v_cvt_pk_bf16_f32 %0, %1, %2" : "=v"(r) : "v"(lo), "v"(hi)); return r; }
template <class Epi, class Sched, bool ALIGN_EPI = false, bool SP2 = false>
__device__ __forceinline__ void gemm_phase(PG8_LAS unsigned char* lds, const Gemm g, const Sched& S, const Epi& E) {
    const int tid = opaque_tid(), wid = __builtin_amdgcn_readfirstlane(tid >> 6), lane = tid & 63, wr = wid >> 2, wc = wid & 3, fr = lane & 15, fq = lane >> 4;
    const int K = g.K, nt = K / BK;
    unsigned voffA[2], voffB[2];
#pragma unroll
    for (int i = 0; i < 2; ++i) { int R, C; stage_rc(tid * 16 + i * 8192, R, C); const int Rb = Epi::PERM ? ((R & ~31) + perm32(R & 31)) : R;
        voffA[i] = (unsigned)(R * K + C) * 2u; voffB[i] = (unsigned)(Rb * K + C) * 2u; }
    const size_t kstep = (size_t)(BK * 2);
    const size_t hstep = (size_t)HALF * K * 2;
    const size_t tstep = 2 * hstep;
    const unsigned ldsw = (unsigned)wid * 1024u;
    const int aoff = lds_byte(wr * 64 + fr, fq * 8), boff = lds_byte(wc * 32 + fr, fq * 8);
#define PG8_SA(b, h) (((b) * 2 + (h)) * HTB)
#define PG8_SB(b, h) ((4 + (b) * 2 + (h)) * HTB)
#define PG8_STAGE(bufoff, gbase, voff) do { _Pragma("unroll") for (int _i = 0; _i < 2; ++_i) \
        __builtin_amdgcn_global_load_lds((const unsigned*)((const char*)(gbase) + (voff)[_i]), (PG8_LAS unsigned*)(lds + (bufoff) + ldsw + _i * 8192), 16, 0, 0); } while (0)
#define PG8_LDA(dst, b, h) do { _Pragma("unroll") for (int m = 0; m < 4; ++m) _Pragma("unroll") for (int k = 0; k < 2; ++k) dst[m][k] = *(const PG8_LAS bf16x8*)(lds + PG8_SA(b, h) + aoff + m * 2048 + k * 1024); } while (0)
#define PG8_LDB(dst, b, h) do { _Pragma("unroll") for (int n = 0; n < 2; ++n) _Pragma("unroll") for (int k = 0; k < 2; ++k) dst[n][k] = *(const PG8_LAS bf16x8*)(lds + PG8_SB(b, h) + boff + n * 2048 + k * 1024); } while (0)
#define PG8_MMA(ai, bj, At, Bt) do { __builtin_amdgcn_s_setprio(1); _Pragma("unroll") for (int m = 0; m < 4; ++m) _Pragma("unroll") for (int n = 0; n < 2; ++n) _Pragma("unroll") for (int k = 0; k < 2; ++k) \
        acc[ai][bj][m][n] = __builtin_amdgcn_mfma_f32_16x16x32_bf16(Bt[n][k], At[m][k], acc[ai][bj][m][n], 0, 0, 0); __builtin_amdgcn_s_setprio(0); } while (0)
#define PG8_WAIT_V(n) asm volatile("s_waitcnt vmcnt(" #n ")" ::: "memory")
#define PG8_WAIT_L(n) asm volatile("s_waitcnt lgkmcnt(" #n ")" ::: "memory")
#define PG8_BAR __builtin_amdgcn_s_barrier()
#define PG8_SCHED __builtin_amdgcn_sched_barrier(0)
    Unit cur, nxt; int ui = 0;
    if (!S.next(0, cur)) return;
    f32x4 acc[2][2][4][2];
#pragma unroll
    for (int a = 0; a < 2; ++a)
#pragma unroll
        for (int b = 0; b < 2; ++b)
#pragma unroll
            for (int m = 0; m < 4; ++m)
#pragma unroll
                for (int n = 0; n < 2; ++n) acc[a][b][m][n] = (f32x4){0.f, 0.f, 0.f, 0.f};
    bf16x8 At[4][2], B0[2][2], B1[2][2];
    const char* cA = (const char*)g.A + (size_t)cur.pm * tstep; const char* cB = (const char*)g.Bt + (size_t)cur.pn * tstep;
    S.a_ready(cur);
    if constexpr (SP2) {
        PG8_STAGE(PG8_SB(0, 0), cB, voffB); PG8_STAGE(PG8_SB(0, 1), cB + hstep, voffB); PG8_STAGE(PG8_SA(0, 0), cA, voffA); PG8_STAGE(PG8_SA(0, 1), cA + hstep, voffA);
        if (wr == 1) PG8_BAR;
        PG8_WAIT_V(2); PG8_BAR;
        PG8_STAGE(PG8_SB(1, 0), cB + kstep, voffB); PG8_STAGE(PG8_SA(1, 0), cA + kstep, voffA); PG8_STAGE(PG8_SB(1, 1), cB + hstep + kstep, voffB);
        PG8_WAIT_V(6); PG8_BAR;
    } else {
        PG8_STAGE(PG8_SB(0, 0), cB, voffB); PG8_STAGE(PG8_SA(0, 0), cA, voffA); PG8_STAGE(PG8_SB(0, 1), cB + hstep, voffB); PG8_STAGE(PG8_SA(0, 1), cA + hstep, voffA);
        if (wr == 1) PG8_BAR;
        PG8_WAIT_V(4); PG8_BAR;
        PG8_STAGE(PG8_SB(1, 0), cB + kstep, voffB); PG8_STAGE(PG8_SA(1, 0), cA + kstep, voffA); PG8_STAGE(PG8_SB(1, 1), cB + hstep + kstep, voffB);
        PG8_WAIT_V(6); PG8_BAR;
    }
    for (;;) {
        const bool has_next = S.next(ui + 1, nxt);
        const char* nA = has_next ? (const char*)g.A + (size_t)nxt.pm * tstep : cA; const char* nB = has_next ? (const char*)g.Bt + (size_t)nxt.pn * tstep : cB;
        for (int t = 0; t < nt; t += 2) {
            const bool last = (t == nt - 2);
            const char* a1 = cA + (size_t)(t + 1) * kstep;
            const char* a2 = last ? nA : cA + (size_t)(t + 2) * kstep; const char* b2 = last ? nB : cB + (size_t)(t + 2) * kstep;
            const char* a3 = a2 + kstep; const char* b3 = b2 + kstep;
            if (last && has_next) S.a_ready(nxt);
            if constexpr (SP2) {
            PG8_LDB(B0, 0, 0); PG8_LDB(B1, 0, 1); PG8_SCHED; PG8_LDA(At, 0, 0); PG8_STAGE(PG8_SA(1, 1), a1 + hstep, voffA);
            PG8_WAIT_V(8); PG8_WAIT_L(0); PG8_BAR; if (cur.nh != 2) PG8_MMA(0, 0, At, B0); if (cur.nh != 1) PG8_MMA(0, 1, At, B1); PG8_BAR; PG8_SCHED;
            PG8_LDA(At, 0, 1); PG8_STAGE(PG8_SB(0, 0), b2, voffB); PG8_STAGE(PG8_SB(0, 1), b2 + hstep, voffB); PG8_STAGE(PG8_SA(0, 0), a2, voffA);
            PG8_WAIT_V(8); PG8_WAIT_L(0); PG8_BAR; if (!cur.half) { if (cur.nh != 2) PG8_MMA(1, 0, At, B0); if (cur.nh != 1) PG8_MMA(1, 1, At, B1); } PG8_BAR; PG8_SCHED;
            PG8_LDB(B0, 1, 0); PG8_LDB(B1, 1, 1); PG8_SCHED; PG8_LDA(At, 1, 0); PG8_STAGE(PG8_SA(0, 1), a2 + hstep, voffA);
            PG8_WAIT_V(8); PG8_WAIT_L(0); PG8_BAR; if (cur.nh != 2) PG8_MMA(0, 0, At, B0); if (cur.nh != 1) PG8_MMA(0, 1, At, B1); PG8_BAR; PG8_SCHED;
            PG8_LDA(At, 1, 1); PG8_STAGE(PG8_SB(1, 0), b3, voffB); PG8_STAGE(PG8_SB(1, 1), b3 + hstep, voffB); PG8_STAGE(PG8_SA(1, 0), a3, voffA);
            PG8_WAIT_V(8); PG8_WAIT_L(0); PG8_BAR; if (!cur.half) { if (cur.nh != 2) PG8_MMA(1, 0, At, B0); if (cur.nh != 1) PG8_MMA(1, 1, At, B1); } PG8_BAR; PG8_SCHED;
            } else {
            PG8_LDB(B0, 0, 0); PG8_SCHED; PG8_LDA(At, 0, 0); PG8_STAGE(PG8_SA(1, 1), a1 + hstep, voffA);
            PG8_WAIT_L(8); PG8_BAR; PG8_WAIT_L(0); PG8_MMA(0, 0, At, B0); PG8_BAR; PG8_SCHED;
            PG8_LDB(B1, 0, 1); PG8_STAGE(PG8_SB(0, 0), b2, voffB);
            PG8_BAR; PG8_WAIT_L(0); PG8_MMA(0, 1, At, B1); PG8_BAR;
            PG8_LDA(At, 0, 1); PG8_STAGE(PG8_SA(0, 0), a2, voffA);
            PG8_BAR; PG8_WAIT_L(0); PG8_MMA(1, 0, At, B0); PG8_BAR; PG8_SCHED;
            PG8_STAGE(PG8_SB(0, 1), b2 + hstep, voffB);
            PG8_WAIT_V(6); PG8_BAR; PG8_MMA(1, 1, At, B1); PG8_BAR;
            PG8_LDB(B0, 1, 0); PG8_SCHED; PG8_LDA(At, 1, 0); PG8_STAGE(PG8_SA(0, 1), a2 + hstep, voffA);
            PG8_WAIT_L(8); PG8_BAR; PG8_WAIT_L(0); PG8_MMA(0, 0, At, B0); PG8_BAR; PG8_SCHED;
            PG8_LDB(B1, 1, 1); PG8_STAGE(PG8_SB(1, 0), b3, voffB);
            PG8_BAR; PG8_WAIT_L(0); PG8_MMA(0, 1, At, B1); PG8_BAR;
            PG8_LDA(At, 1, 1); PG8_STAGE(PG8_SA(1, 0), a3, voffA);
            PG8_BAR; PG8_WAIT_L(0); PG8_MMA(1, 0, At, B0); PG8_BAR; PG8_SCHED;
            PG8_STAGE(PG8_SB(1, 1), b3 + hstep, voffB);
            PG8_WAIT_V(6); PG8_BAR; PG8_MMA(1, 1, At, B1); PG8_BAR;
            }
        }
        if constexpr (ALIGN_EPI) { if (wr == 0) PG8_BAR; }
        if constexpr (!Epi::AFTER_DRAIN) { E(acc, cur, wr, wc, fr, fq); S.done(cur); }
        if (!has_next) break;
#pragma unroll
        for (int a = 0; a < 2; ++a)
#pragma unroll
            for (int b = 0; b < 2; ++b)
#pragma unroll
                for (int m = 0; m < 4; ++m)
#pragma unroll
                    for (int n = 0; n < 2; ++n) acc[a][b][m][n] = (f32x4){0.f, 0.f, 0.f, 0.f};
        cur = nxt; cA = nA; cB = nB; ++ui;
        if constexpr (ALIGN_EPI) { if (wr == 1) PG8_BAR; }
    }
    PG8_WAIT_V(0);
    if constexpr (!ALIGN_EPI) { if (wr == 0) PG8_BAR; }
    PG8_BAR;
    if constexpr (Epi::AFTER_DRAIN) { E.fused(acc, cur, wr, wc, fr, fq, lds, wid, lane); S.done(cur); }
#undef PG8_SA
#undef PG8_SB
#undef PG8_STAGE
#undef PG8_LDA
#undef PG8_LDB
#undef PG8_MMA
#undef PG8_WAIT_V
#undef PG8_WAIT_L
#undef PG8_BAR
#undef PG8_SCHED
}

struct EpiStore {
    static constexpr bool PERM = true, AFTER_DRAIN = false;
    bf16_t* O; int ldc;
    __device__ __forceinline__ void operator()(const f32x4 (&acc)[2][2][4][2], const Unit& u, int wr, int wc, int fr, int fq) const {
        asm volatile("s_nop 7\n\ts_nop 7" ::: "memory");
        const int row0 = u.pm * BM + wr * 64 + fr, col0 = u.pn * BM + wc * 32 + 8 * fq;
#pragma unroll
        for (int ai = 0; ai < 2; ++ai)
#pragma unroll
            for (int m = 0; m < 4; ++m) { bf16_t* rowp = O + (size_t)(row0 + ai * HALF + m * 16) * ldc + col0;
#pragma unroll
                for (int bj = 0; bj < 2; ++bj) { if (u.nh == 2 - bj) continue; const f32x4 v0 = acc[ai][bj][m][0], v1 = acc[ai][bj][m][1];
                    u32x4 w; w.x = cvt_pk_bf16(v0[0], v0[1]); w.y = cvt_pk_bf16(v0[2], v0[3]); w.z = cvt_pk_bf16(v1[0], v1[1]); w.w = cvt_pk_bf16(v1[2], v1[3]);
                    *(u32x4*)(rowp + bj * HALF) = w; } }
    }
};
struct EpiStoreGates {
    static constexpr bool PERM = true, AFTER_DRAIN = false;
    bf16_t* O; int ldc; int gate_pn; float* gates; const float* gbias;
    __device__ __forceinline__ void operator()(const f32x4 (&acc)[2][2][4][2], const Unit& u, int wr, int wc, int fr, int fq) const {
        asm volatile("s_nop 7\n\ts_nop 7" ::: "memory");
        const int row0 = u.pm * BM + wr * 64 + fr;
        if (u.pn == gate_pn) {
            if (wc == 0 && fq == 0) {
                const f32x4 b0 = *(const f32x4*)gbias, b1 = *(const f32x4*)(gbias + 4);
#pragma unroll
                for (int ai = 0; ai < 2; ++ai)
#pragma unroll
                    for (int m = 0; m < 4; ++m) { float* g = gates + (size_t)(row0 + ai * HALF + m * 16) * 8;
                        *(f32x4*)g = acc[ai][0][m][0] + b0; *(f32x4*)(g + 4) = acc[ai][0][m][1] + b1; }
            }
            return;
        }
        const int col0 = u.pn * BM + wc * 32 + 8 * fq;
#pragma unroll
        for (int ai = 0; ai < 2; ++ai)
#pragma unroll
            for (int m = 0; m < 4; ++m) { bf16_t* rowp = O + (size_t)(row0 + ai * HALF + m * 16) * ldc + col0;
#pragma unroll
                for (int bj = 0; bj < 2; ++bj) { const f32x4 v0 = acc[ai][bj][m][0], v1 = acc[ai][bj][m][1];
                    u32x4 w; w.x = cvt_pk_bf16(v0[0], v0[1]); w.y = cvt_pk_bf16(v0[2], v0[3]); w.z = cvt_pk_bf16(v1[0], v1[1]); w.w = cvt_pk_bf16(v1[2], v1[3]);
                    *(u32x4*)(rowp + bj * HALF) = w; } }
    }
};
struct EpiResid {
    static constexpr bool PERM = true, AFTER_DRAIN = false;
    const float* rf; const bf16_t* rb; bf16_t* out;
    __device__ __forceinline__ void operator()(const f32x4 (&acc)[2][2][4][2], const Unit& u, int wr, int wc, int fr, int fq) const {
        const int row0 = u.pm * BM + wr * 64 + fr, col0 = u.pn * BM + wc * 32 + 8 * fq;
#pragma unroll
        for (int ai = 0; ai < 2; ++ai)
#pragma unroll
            for (int m = 0; m < 4; ++m) { const size_t off = (size_t)(row0 + ai * HALF + m * 16) * 1024 + col0;
#pragma unroll
                for (int bj = 0; bj < 2; ++bj) {
                    f32x4 r0, r1;
                    if (rf) { r0 = *(const f32x4*)(rf + off + bj * HALF); r1 = *(const f32x4*)(rf + off + bj * HALF + 4); }
                    else { const u32x4 q = *(const u32x4*)(rb + off + bj * HALF);
                        r0 = (f32x4){__uint_as_float(q.x << 16), __uint_as_float(q.x & 0xffff0000u), __uint_as_float(q.y << 16), __uint_as_float(q.y & 0xffff0000u)};
                        r1 = (f32x4){__uint_as_float(q.z << 16), __uint_as_float(q.z & 0xffff0000u), __uint_as_float(q.w << 16), __uint_as_float(q.w & 0xffff0000u)}; }
                    const f32x4 v0 = acc[ai][bj][m][0] + r0, v1 = acc[ai][bj][m][1] + r1;
                    u32x4 w; w.x = cvt_pk_bf16(v0[0], v0[1]); w.y = cvt_pk_bf16(v0[2], v0[3]); w.z = cvt_pk_bf16(v1[0], v1[1]); w.w = cvt_pk_bf16(v1[2], v1[3]);
                    *(u32x4*)(out + off + bj * HALF) = w; } }
    }
};

template <class Epi, class Sched>
__device__ __forceinline__ void gemm_phase_g(PG8_LAS unsigned char* lds, const Gemm g, const Sched& S, const Epi& E) {
    const int tid = opaque_tid(), wid = __builtin_amdgcn_readfirstlane(tid >> 6), lane = tid & 63, wr = wid >> 2, wc = wid & 3, fr = lane & 15, fq = lane >> 4;
    const int K = g.K, nt = K / BK;
    int RA[2], CA[2]; unsigned voffB[2];
#pragma unroll
    for (int i = 0; i < 2; ++i) { int R, C; stage_rc(tid * 16 + i * 8192, R, C); RA[i] = R; CA[i] = C; const int Rb = Epi::PERM ? ((R & ~31) + perm32(R & 31)) : R; voffB[i] = (unsigned)(Rb * K + C) * 2u; }
    const size_t kstep = (size_t)(BK * 2);
    const size_t hstep = (size_t)HALF * K * 2;
    const size_t tstep = 2 * hstep;
    const unsigned ldsw = (unsigned)wid * 1024u;
    const int aoff = lds_byte(wr * 64 + fr, fq * 8), boff = lds_byte(wc * 32 + fr, fq * 8);
#define PG8_SA(b, h) (((b) * 2 + (h)) * HTB)
#define PG8_SB(b, h) ((4 + (b) * 2 + (h)) * HTB)
#define PG8_STAGE(bufoff, gbase, voff) do { _Pragma("unroll") for (int _i = 0; _i < 2; ++_i) \
        __builtin_amdgcn_global_load_lds((const unsigned*)((const char*)(gbase) + (voff)[_i]), (PG8_LAS unsigned*)(lds + (bufoff) + ldsw + _i * 8192), 16, 0, 0); } while (0)
#define PG8_LDA(dst, b, h) do { _Pragma("unroll") for (int m = 0; m < 4; ++m) _Pragma("unroll") for (int k = 0; k < 2; ++k) dst[m][k] = *(const PG8_LAS bf16x8*)(lds + PG8_SA(b, h) + aoff + m * 2048 + k * 1024); } while (0)
#define PG8_LDB(dst, b, h) do { _Pragma("unroll") for (int n = 0; n < 2; ++n) _Pragma("unroll") for (int k = 0; k < 2; ++k) dst[n][k] = *(const PG8_LAS bf16x8*)(lds + PG8_SB(b, h) + boff + n * 2048 + k * 1024); } while (0)
#define PG8_MMA(ai, bj, At, Bt) do { __builtin_amdgcn_s_setprio(1); _Pragma("unroll") for (int m = 0; m < 4; ++m) _Pragma("unroll") for (int n = 0; n < 2; ++n) _Pragma("unroll") for (int k = 0; k < 2; ++k) \
        acc[ai][bj][m][n] = __builtin_amdgcn_mfma_f32_16x16x32_bf16(Bt[n][k], At[m][k], acc[ai][bj][m][n], 0, 0, 0); __builtin_amdgcn_s_setprio(0); } while (0)
#define PG8_WAIT_V(n) asm volatile("s_waitcnt vmcnt(" #n ")" ::: "memory")
#define PG8_WAIT_L(n) asm volatile("s_waitcnt lgkmcnt(" #n ")" ::: "memory")
#define PG8_BAR __builtin_amdgcn_s_barrier()
#define PG8_SCHED __builtin_amdgcn_sched_barrier(0)
    Unit cur, nxt; int ui = 0;
    if (!S.next(0, cur)) return;
    f32x4 acc[2][2][4][2];
#pragma unroll
    for (int a = 0; a < 2; ++a)
#pragma unroll
        for (int b = 0; b < 2; ++b)
#pragma unroll
            for (int m = 0; m < 4; ++m)
#pragma unroll
                for (int n = 0; n < 2; ++n) acc[a][b][m][n] = (f32x4){0.f, 0.f, 0.f, 0.f};
    bf16x8 At[4][2], B0[2][2], B1[2][2];
    unsigned oc[2][2];
    S.aoff(0, RA, CA, oc);
    const char* Ab = (const char*)g.A;
    const char* cB = (const char*)g.Bt + (size_t)cur.pn * tstep;
    PG8_STAGE(PG8_SB(0, 0), cB, voffB); PG8_STAGE(PG8_SB(0, 1), cB + hstep, voffB); PG8_STAGE(PG8_SA(0, 0), Ab, oc[0]); PG8_STAGE(PG8_SA(0, 1), Ab, oc[1]);
    if (wr == 1) PG8_BAR;
    PG8_WAIT_V(2); PG8_BAR;
    PG8_STAGE(PG8_SB(1, 0), cB + kstep, voffB); PG8_STAGE(PG8_SA(1, 0), Ab + kstep, oc[0]); PG8_STAGE(PG8_SB(1, 1), cB + hstep + kstep, voffB);
    PG8_WAIT_V(6); PG8_BAR;
    for (;;) {
        const bool has_next = S.next(ui + 1, nxt);
        const char* nB = has_next ? (const char*)g.Bt + (size_t)nxt.pn * tstep : cB;
        for (int t = 0; t < nt; t += 2) {
            const bool last = (t == nt - 2);
            const char* a1 = Ab + (size_t)(t + 1) * kstep;
            const char* a2 = last ? Ab : Ab + (size_t)(t + 2) * kstep; const char* b2 = last ? nB : cB + (size_t)(t + 2) * kstep;
            const char* a3 = a2 + kstep; const char* b3 = b2 + kstep;
            unsigned o2[2][2];
            if (last && has_next) S.aoff(ui + 1, RA, CA, o2);
            else { o2[0][0] = oc[0][0]; o2[0][1] = oc[0][1]; o2[1][0] = oc[1][0]; o2[1][1] = oc[1][1]; }
            PG8_LDB(B0, 0, 0); PG8_LDB(B1, 0, 1); PG8_SCHED; PG8_LDA(At, 0, 0); PG8_STAGE(PG8_SA(1, 1), a1, oc[1]);
            PG8_WAIT_V(8); PG8_WAIT_L(0); PG8_BAR; if (cur.nh != 2) PG8_MMA(0, 0, At, B0); if (cur.nh != 1) PG8_MMA(0, 1, At, B1); PG8_BAR; PG8_SCHED;
            PG8_LDA(At, 0, 1); PG8_STAGE(PG8_SB(0, 0), b2, voffB); PG8_STAGE(PG8_SB(0, 1), b2 + hstep, voffB); PG8_STAGE(PG8_SA(0, 0), a2, o2[0]);
            PG8_WAIT_V(8); PG8_WAIT_L(0); PG8_BAR; if (!cur.half) { if (cur.nh != 2) PG8_MMA(1, 0, At, B0); if (cur.nh != 1) PG8_MMA(1, 1, At, B1); } PG8_BAR; PG8_SCHED;
            PG8_LDB(B0, 1, 0); PG8_LDB(B1, 1, 1); PG8_SCHED; PG8_LDA(At, 1, 0); PG8_STAGE(PG8_SA(0, 1), a2, o2[1]);
            PG8_WAIT_V(8); PG8_WAIT_L(0); PG8_BAR; if (cur.nh != 2) PG8_MMA(0, 0, At, B0); if (cur.nh != 1) PG8_MMA(0, 1, At, B1); PG8_BAR; PG8_SCHED;
            PG8_LDA(At, 1, 1); PG8_STAGE(PG8_SB(1, 0), b3, voffB); PG8_STAGE(PG8_SB(1, 1), b3 + hstep, voffB); PG8_STAGE(PG8_SA(1, 0), a3, o2[0]);
            PG8_WAIT_V(8); PG8_WAIT_L(0); PG8_BAR; if (!cur.half) { if (cur.nh != 2) PG8_MMA(1, 0, At, B0); if (cur.nh != 1) PG8_MMA(1, 1, At, B1); } PG8_BAR; PG8_SCHED;
        }
        if (wr == 0) PG8_BAR;
        E(acc, cur, wr, wc, fr, fq);
        if (!has_next) break;
#pragma unroll
        for (int a = 0; a < 2; ++a)
#pragma unroll
            for (int b = 0; b < 2; ++b)
#pragma unroll
                for (int m = 0; m < 4; ++m)
#pragma unroll
                    for (int n = 0; n < 2; ++n) acc[a][b][m][n] = (f32x4){0.f, 0.f, 0.f, 0.f};
        cur = nxt; cB = nB; ++ui;
        S.aoff(ui, RA, CA, oc);
        if (wr == 1) PG8_BAR;
    }
    PG8_WAIT_V(0);
    PG8_BAR;
#undef PG8_SA
#undef PG8_SB
#undef PG8_STAGE
#undef PG8_LDA
#undef PG8_LDB
#undef PG8_MMA
#undef PG8_WAIT_V
#undef PG8_WAIT_L
#undef PG8_BAR
#undef PG8_SCHED
}

constexpr int MOE_MAXU = 4;
struct SchedMoe {
    const int* tp; const int* cn; const unsigned* tab;
    int NT, nU, G, c;
    __device__ __forceinline__ bool next(int i, Unit& u) const {
        if (i >= MOE_MAXU) return false;
        const long L = (long)i * G + c; if (L >= nU) return false;
        int wgid = (int)L; { const int q = nU / NXCD, r = nU % NXCD, xcd = wgid % NXCD, off = wgid / NXCD; wgid = (xcd < r ? xcd * (q + 1) : r * (q + 1) + (xcd - r) * q) + off; }
        const int ti = wgid / NT, pn = wgid - ti * NT;
        int e = 0; while (tp[e + 1] <= ti) ++e;
        u.pm = ti; u.pn = e * NT + pn; u.aux = i; u.half = (cn[e] - (ti - tp[e]) * BM <= HALF) ? 1 : 0; u.nh = 0; return true;
    }
    __device__ __forceinline__ void aoff(int ui, const int (&RA)[2], const int (&CA)[2], unsigned (&o)[2][2]) const {
#pragma unroll
        for (int h = 0; h < 2; ++h)
#pragma unroll
            for (int i = 0; i < 2; ++i) o[h][i] = tab[ui * 256 + h * HALF + RA[i]] + (unsigned)CA[i] * 2u;
    }
    __device__ __forceinline__ void a_ready(const Unit&) const {}
    __device__ __forceinline__ void done(const Unit&) const {}
};
__device__ __forceinline__ float silu_f(float x) { return x * __builtin_amdgcn_rcpf(1.f + __expf(-x)); }
__device__ __forceinline__ float sig_f(float x) { return __builtin_amdgcn_rcpf(1.f + __expf(-x)); }
struct EpiGlu256 {
    static constexpr bool PERM = true, AFTER_DRAIN = false;
    const bf16_t* Z; const float* b; bf16_t* mix;
    __device__ __forceinline__ void operator()(const f32x4 (&acc)[2][2][4][2], const Unit& u, int wr, int wc, int fr, int fq) const {
        const int row0 = u.pm * BM + wr * 64 + fr, col0 = u.pn * BM + wc * 32 + 8 * fq;
#pragma unroll
        for (int ai = 0; ai < 2; ++ai)
#pragma unroll
            for (int m = 0; m < 4; ++m) { const size_t r = (size_t)(row0 + ai * HALF + m * 16);
#pragma unroll
                for (int bj = 0; bj < 2; ++bj) { const int c = col0 + bj * HALF;
                    const u32x4 q = *(const u32x4*)(Z + r * 512 + c);
                    const f32x4 b0 = *(const f32x4*)(b + c), b1 = *(const f32x4*)(b + c + 4);
                    const f32x4 v0 = acc[ai][bj][m][0] + b0, v1 = acc[ai][bj][m][1] + b1;
                    const float z0 = __uint_as_float(q.x << 16), z1 = __uint_as_float(q.x & 0xffff0000u), z2 = __uint_as_float(q.y << 16), z3 = __uint_as_float(q.y & 0xffff0000u);
                    const float z4 = __uint_as_float(q.z << 16), z5 = __uint_as_float(q.z & 0xffff0000u), z6 = __uint_as_float(q.w << 16), z7 = __uint_as_float(q.w & 0xffff0000u);
                    u32x4 w; w.x = cvt_pk_bf16(z0 * sig_f(v0[0]), z1 * sig_f(v0[1])); w.y = cvt_pk_bf16(z2 * sig_f(v0[2]), z3 * sig_f(v0[3]));
                    w.z = cvt_pk_bf16(z4 * sig_f(v1[0]), z5 * sig_f(v1[1])); w.w = cvt_pk_bf16(z6 * sig_f(v1[2]), z7 * sig_f(v1[3]));
                    *(u32x4*)(mix + r * 1024 + c) = w; } }
    }
};

struct EpiMoeUp {
    static constexpr bool PERM = true, AFTER_DRAIN = false;
    bf16_t* H;
    __device__ __forceinline__ void operator()(const f32x4 (&acc)[2][2][4][2], const Unit& u, int wr, int wc, int fr, int fq) const {
        const int row0 = u.pm * BM + wr * 64 + fr, f0 = (u.pn & 1) * 128 + wc * 32 + 8 * fq;
#pragma unroll
        for (int ai = 0; ai < 2; ++ai)
#pragma unroll
            for (int m = 0; m < 4; ++m) {
                const f32x4 g0 = acc[ai][0][m][0], g1 = acc[ai][0][m][1], u0 = acc[ai][1][m][0], u1 = acc[ai][1][m][1];
                u32x4 w; w.x = cvt_pk_bf16(silu_f(g0[0]) * u0[0], silu_f(g0[1]) * u0[1]); w.y = cvt_pk_bf16(silu_f(g0[2]) * u0[2], silu_f(g0[3]) * u0[3]);
                w.z = cvt_pk_bf16(silu_f(g1[0]) * u1[0], silu_f(g1[1]) * u1[1]); w.w = cvt_pk_bf16(silu_f(g1[2]) * u1[2], silu_f(g1[3]) * u1[3]);
                *(u32x4*)(H + (size_t)(row0 + ai * HALF + m * 16) * 256 + f0) = w;
            }
    }
};
struct EpiMoeDown {
    static constexpr bool PERM = true, AFTER_DRAIN = false;
    bf16_t* Y; const unsigned* dtab; const float* wtab;
    __device__ __forceinline__ void operator()(const f32x4 (&acc)[2][2][4][2], const Unit& u, int wr, int wc, int fr, int fq) const {
        const int pn = u.pn & 3, tb = u.aux * 256 + wr * 64 + fr, col = pn * BM + wc * 32 + 8 * fq;
#pragma unroll
        for (int ai = 0; ai < 2; ++ai)
#pragma unroll
            for (int m = 0; m < 4; ++m) {
                const unsigned d = dtab[tb + ai * HALF + m * 16]; const float w = wtab[tb + ai * HALF + m * 16];
                if (d != 0xffffffffu) {
                    bf16_t* yr = Y + (size_t)d * 1024 + col;
#pragma unroll
                    for (int bj = 0; bj < 2; ++bj) { const f32x4 v0 = acc[ai][bj][m][0] * w, v1 = acc[ai][bj][m][1] * w;
                        u32x4 o; o.x = cvt_pk_bf16(v0[0], v0[1]); o.y = cvt_pk_bf16(v0[2], v0[3]); o.z = cvt_pk_bf16(v1[0], v1[1]); o.w = cvt_pk_bf16(v1[2], v1[3]);
                        *(u32x4*)(yr + bj * HALF) = o; }
                }
            }
    }
};
}

__device__ __forceinline__ void transpose_tile(const float* __restrict__ src, int ldn, bf16_t* __restrict__ dst, int ldk, float scale, float* scr, int lane) {
    float tv[32];
#pragma unroll
    for (int i = 0; i < 32; ++i) tv[i] = __builtin_nontemporal_load(src + (size_t)(2 * i + (lane >> 5)) * ldn + (lane & 31));
#pragma unroll
    for (int i = 0; i < 32; ++i) scr[(2 * i + (lane >> 5)) * 33 + (lane & 31)] = tv[i];
    LDS_WAIT();
    const int c = lane & 7;
#pragma unroll
    for (int j = 0; j < 4; ++j) {
        const int n = (lane >> 3) + 8 * j; const float* s = scr + (8 * c) * 33 + n;
        u32x4 o; o.x = pk2(s[0] * scale, s[33] * scale); o.y = pk2(s[66] * scale, s[99] * scale); o.z = pk2(s[132] * scale, s[165] * scale); o.w = pk2(s[198] * scale, s[231] * scale);
        *(u32x4*)(dst + (size_t)n * ldk + 8 * c) = o;
    }
    LDS_WAIT();
}

__device__ __forceinline__ void rms_row(f32x4 (&v)[4], const float* __restrict__ w, bf16_t* __restrict__ xn, int lane) {
    float ss = 0.f;
#pragma unroll
    for (int j = 0; j < 4; ++j) ss += v[j].x * v[j].x + v[j].y * v[j].y + v[j].z * v[j].z + v[j].w * v[j].w;
    ss = wave_sum(ss);
    const float r = rsqrtf(ss * (1.f / 1024.f) + EPS);
#pragma unroll
    for (int j = 0; j < 4; ++j) {
        const f32x4 w4 = *(const f32x4*)(w + 4 * lane + 256 * j);
        v[j] = v[j] * r * w4;
        u32x2 o; o.x = pk2(v[j].x, v[j].y); o.y = pk2(v[j].z, v[j].w);
        *(u32x2*)(xn + 4 * lane + 256 * j) = o;
    }
}

__device__ __forceinline__ void phase_prep(const Params& p, unsigned char* lds) {
    const int tid = opaque_tid(), lane = tid & 63, wid = tid >> 6;
    const int gw = blockIdx.x * 8 + wid, NGW = gridDim.x * 8;
    const int gt = blockIdx.x * NTHR + tid, NGT = gridDim.x * NTHR;
    unsigned char* ws = p.ws;
    if (blockIdx.x == 0 && tid < 64) ((int*)(ws + WS_CNT))[(tid >> 5) * 1024 + (tid & 31) * 32] = 0;
    for (int idx = (tid < 8 ? blockIdx.x * 8 + tid : 2048); idx < 2048; idx += gridDim.x * 8) {
        const int g = idx >> 6;
        const double lr = p.in[I_S5_LRE][idx], li = p.in[I_S5_LIM][idx], dt = exp((double)p.in[I_S5_LOGDT][g]);
        const double zr = lr * dt, zi = li * dt, ez = exp(zr);
        const double br = ez * cos(zi), bi = ez * sin(zi);
        double pr = 1.0, pi = 0.0;
        for (int tau = 0; tau <= 16; ++tau) {
            ((f32x2*)(ws + WS_S5POW))[idx * 17 + tau] = (f32x2){(float)pr, (float)pi};
            const double nr = pr * br - pi * bi, ni = pr * bi + pi * br; pr = nr; pi = ni;
        }
        const double ar = br - 1.0, ai = bi, den = lr * lr + li * li;
        const double cr = (ar * lr + ai * li) / den, ci = (ai * lr - ar * li) / den;
        for (int c = 0; c < 16; ++c) {
            const double b_r = p.in[I_S5_BRE][idx * 16 + c], b_i = p.in[I_S5_BIM][idx * 16 + c];
            ((f32x2*)(ws + WS_S5BBAR))[idx * 16 + c] = (f32x2){(float)(cr * b_r - ci * b_i), (float)(cr * b_i + ci * b_r)};
        }
    }
    for (int idx = gt; idx < 2 * 32 * 3 * 64; idx += NGT) {
        const int l = idx / (32 * 3 * 64), rem = idx - l * (32 * 3 * 64), ks = rem / 192, r2 = rem - ks * 192, nt_ = r2 >> 6, ln = r2 & 63, col = nt_ * 16 + (ln & 15);
        float v[8];
#pragma unroll
        for (int j = 0; j < 8; ++j) {
            const int k = ks * 32 + (ln >> 4) * 8 + j;
            float w = 0.f;
            if (col < 32) w = p.in[I_MOE_WR][(size_t)(l * 1024 + k) * 32 + col];
            else if (col < 36) w = p.in[I_MOE_WG][(size_t)(l * 1024 + k) * 4 + (col - 32)];
            v[j] = w * p.in[I_NORM_FFN][l * 1024 + k];
        }
        unsigned hi[4], lo[4];
#pragma unroll
        for (int q = 0; q < 4; ++q) {
            const unsigned h0 = f2bf(v[2 * q]), h1 = f2bf(v[2 * q + 1]);
            hi[q] = h0 | (h1 << 16);
            lo[q] = pk2(v[2 * q] - bf2f(h0), v[2 * q + 1] - bf2f(h1));
        }
        bf16_t* wf = (bf16_t*)(ws + WS_WCAT);
        *(u32x4*)(wf + ((size_t)(l * 2 + 0) * 6144 + (size_t)(ks * 3 + nt_) * 64 + ln) * 8) = (u32x4){hi[0], hi[1], hi[2], hi[3]};
        *(u32x4*)(wf + ((size_t)(l * 2 + 1) * 6144 + (size_t)(ks * 3 + nt_) * 64 + ln) * 8) = (u32x4){lo[0], lo[1], lo[2], lo[3]};
    }
    float* scr = (float*)(lds + wid * 8704);
    constexpr int IT_WINA = 112 * 16, IT_WOUT = 32 * 16, IT_WINC = 80 * 16, IT_WGLU = 16 * 8;
    constexpr int IT_TOTAL = IT_WINA + IT_WOUT + IT_WINC + IT_WOUT + IT_WGLU;
    for (int it0 = gw; it0 < IT_TOTAL; it0 += NGW) {
        int it = it0; const float* src; bf16_t* dst; int ldn, ldk; float scale = 1.f;
        if (it < IT_WINA) {
            const int n0 = (it >> 4) * 32, k0 = (it & 15) * 64, srcn = n0 < 2048 ? n0 : n0 + 8;
            if (n0 >= 512 && n0 < 1024) scale = 0.08838834764831845f;
            src = p.in[I_AB_WIN] + (size_t)k0 * 3592 + srcn; ldn = 3592; dst = (bf16_t*)(ws + WS_WINA) + (size_t)n0 * 1024 + k0; ldk = 1024;
        } else if ((it -= IT_WINA) < IT_WOUT) {
            const int n0 = (it >> 4) * 32, k0 = (it & 15) * 64;
            src = p.in[I_AB_WOUT] + (size_t)k0 * 1024 + n0; ldn = 1024; dst = (bf16_t*)(ws + WS_WOUTA) + (size_t)n0 * 1024 + k0; ldk = 1024;
        } else if ((it -= IT_WOUT) < IT_WINC) {
            const int n0 = (it >> 4) * 32, k0 = (it & 15) * 64;
            src = p.in[I_CD_WIN] + (size_t)k0 * 2560 + n0; ldn = 2560; dst = (bf16_t*)(ws + WS_WINC) + (size_t)n0 * 1024 + k0; ldk = 1024;
        } else if ((it -= IT_WINC) < IT_WOUT) {
            const int n0 = (it >> 4) * 32, k0 = (it & 15) * 64;
            src = p.in[I_CD_WOUT] + (size_t)k0 * 1024 + n0; ldn = 1024; dst = (bf16_t*)(ws + WS_WOUTC) + (size_t)n0 * 1024 + k0; ldk = 1024;
        } else {
            it -= IT_WOUT;
            const int n0 = (it >> 3) * 32, k0 = (it & 7) * 64;
            src = p.in[I_S5_WGLU] + (size_t)k0 * 512 + n0; ldn = 512; dst = (bf16_t*)(ws + WS_WGLU) + (size_t)n0 * 512 + k0; ldk = 512;
        }
        transpose_tile(src, ldn, dst, ldk, scale, scr, lane);
    }
    {
        bf16_t* wg = (bf16_t*)(ws + WS_WINA) + (size_t)3584 * 1024;
        const float* win = p.in[I_AB_WIN];
        for (int idx = gt; idx < 256 * 1024; idx += NGT) {
            const int n = idx >> 10, k = idx & 1023;
            wg[idx] = (bf16_t)(n < 8 ? f2bf(win[(size_t)k * 3592 + 2048 + n]) : 0u);
        }
    }
    const float* x = p.in[I_X];
    f32x4 vn[4];
    if (gw < T) {
#pragma unroll
        for (int j = 0; j < 4; ++j) vn[j] = __builtin_nontemporal_load((const f32x4*)(x + (size_t)gw * 1024 + 4 * lane + 256 * j));
    }
    for (int row = gw; row < T; row += NGW) {
        f32x4 v[4];
#pragma unroll
        for (int j = 0; j < 4; ++j) v[j] = vn[j];
        if (row + NGW < T) {
#pragma unroll
            for (int j = 0; j < 4; ++j) vn[j] = __builtin_nontemporal_load((const f32x4*)(x + (size_t)(row + NGW) * 1024 + 4 * lane + 256 * j));
        }
        {
            bf16_t* h16 = (bf16_t*)(ws + WS_H16) + (size_t)row * 1024;
#pragma unroll
            for (int j = 0; j < 4; ++j) { u32x2 o; o.x = pk2(v[j].x, v[j].y); o.y = pk2(v[j].z, v[j].w); *(u32x2*)(h16 + 4 * lane + 256 * j) = o; }
        }
        rms_row(v, p.in[I_NORM_MIX], (bf16_t*)(ws + WS_XN) + (size_t)row * 1024, lane);
    }
}

struct EpiStoreBf16 {
    bf16_t* O; int ldc;
    __device__ __forceinline__ void operator()(const f32x4 (&acc)[2][4], int wr, int wc, int fr, int fq) const {
#pragma unroll
        for (int m = 0; m < 2; ++m)
#pragma unroll
            for (int n = 0; n < 4; ++n) {
                const f32x4 v = acc[m][n]; u32x2 o; o.x = pk2(v.x, v.y); o.y = pk2(v.z, v.w);
                *(u32x2*)(O + (size_t)(wr * 32 + m * 16 + fr) * ldc + wc * 64 + n * 16 + fq * 4) = o;
            }
    }
};
struct EpiResidF32 {
    const float* resid; float* out;
    __device__ __forceinline__ void operator()(const f32x4 (&acc)[2][4], int wr, int wc, int fr, int fq) const {
#pragma unroll
        for (int m = 0; m < 2; ++m)
#pragma unroll
            for (int n = 0; n < 4; ++n) {
                const size_t off = (size_t)(wr * 32 + m * 16 + fr) * 1024 + wc * 64 + n * 16 + fq * 4;
                const f32x4 r = *(const f32x4*)(resid + off);
                *(f32x4*)(out + off) = r + acc[m][n];
            }
    }
};
struct EpiGlu {
    const bf16_t* Z; const float* b; bf16_t* mix;
    __device__ __forceinline__ void operator()(const f32x4 (&acc)[2][4], int wr, int wc, int fr, int fq) const {
#pragma unroll
        for (int m = 0; m < 2; ++m)
#pragma unroll
            for (int n = 0; n < 4; ++n) {
                const int r = wr * 32 + m * 16 + fr, c = wc * 64 + n * 16 + fq * 4;
                const u32x2 zz = *(const u32x2*)(Z + (size_t)r * 512 + c);
                const f32x4 bb = *(const f32x4*)(b + c);
                const f32x4 v = acc[m][n] + bb;
                const float z0 = bf2f(zz.x & 0xffffu), z1 = bf2f(zz.x >> 16), z2 = bf2f(zz.y & 0xffffu), z3 = bf2f(zz.y >> 16);
                u32x2 o; o.x = pk2(z0 * fsigmoid_(v.x), z1 * fsigmoid_(v.y)); o.y = pk2(z2 * fsigmoid_(v.z), z3 * fsigmoid_(v.w));
                *(u32x2*)(mix + (size_t)r * 1024 + c) = o;
            }
    }
};

__device__ __forceinline__ void phase_gemm_store(unsigned char* lds, const bf16_t* A, const bf16_t* Bt, int N, int K, bf16_t* O, int ldc) {
    const int nN = N >> 7, nU = (T >> 7) * nN;
    for (int u = blockIdx.x; u < nU; u += gridDim.x) {
        const int pm = u / nN, pn = u - pm * nN;
        APlain ap{A + (size_t)pm * 128 * K, K};
        EpiStoreBf16 e{O + (size_t)pm * 128 * ldc + pn * 128, ldc};
        gemm128(lds, ap, Bt + (size_t)pn * 128 * K, K, e);
    }
}
__device__ __forceinline__ void phase_gemm_resid(unsigned char* lds, const bf16_t* A, const bf16_t* Bt, const float* resid, float* out) {
    const int nU = (T >> 7) * 8;
    for (int u = blockIdx.x; u < nU; u += gridDim.x) {
        const int pm = u >> 3, pn = u & 7;
        APlain ap{A + (size_t)pm * 128 * 1024, 1024};
        const size_t off = (size_t)pm * 128 * 1024 + pn * 128;
        EpiResidF32 e{resid + off, out + off};
        gemm128(lds, ap, Bt + (size_t)pn * 128 * 1024, 1024, e);
    }
}
__device__ __forceinline__ void phase_gemm_glu(unsigned char* lds, const Params& p) {
    pg8::Gemm g{(const bf16_t*)(p.ws + WS_Z), (const bf16_t*)(p.ws + WS_WGLU), T, 512, 512}; pg8::StaticOrder S; S.init(T, 512, (int)gridDim.x, (int)blockIdx.x);
    pg8::EpiGlu256 E{(const bf16_t*)(p.ws + WS_Z), p.in[I_S5_BGLU], (bf16_t*)(p.ws + WS_MIX)};
    pg8::gemm_phase<pg8::EpiGlu256, pg8::StaticOrder, true, true>((PG8_LAS unsigned char*)lds, g, S, E);
}
__device__ __forceinline__ void phase_gemm256_store(unsigned char* lds, const bf16_t* A, const bf16_t* Bt, int N, bf16_t* O) {
    pg8::Gemm g{A, Bt, T, N, 1024}; pg8::StaticOrder S; S.init(T, N, (int)gridDim.x, (int)blockIdx.x);
    pg8::EpiStore E{O, N};
    pg8::gemm_phase<pg8::EpiStore, pg8::StaticOrder, true, true>((PG8_LAS unsigned char*)lds, g, S, E);
}
__device__ __forceinline__ void phase_gemm256_inproj1(unsigned char* lds, const Params& p) {
    pg8::Gemm g{(const bf16_t*)(p.ws + WS_XN), (const bf16_t*)(p.ws + WS_WINC), T, PC, 1024}; pg8::StaticOrderHalfTail S; S.init(T, 8 * 256, (int)gridDim.x, (int)blockIdx.x); S.nNF = 8; S.nNT = 2;
    pg8::EpiStore E{(bf16_t*)(p.ws + WS_PROJ), PC};
    pg8::gemm_phase<pg8::EpiStore, pg8::StaticOrderHalfTail, true, true>((PG8_LAS unsigned char*)lds, g, S, E);
}
__device__ __forceinline__ void phase_gemm256_inproj0(unsigned char* lds, const Params& p) {
    pg8::Gemm g{(const bf16_t*)(p.ws + WS_XN), (const bf16_t*)(p.ws + WS_WINA), T, 3840, 1024}; pg8::StaticOrder S; S.init(T, 3840, (int)gridDim.x, (int)blockIdx.x);
    pg8::EpiStoreGates E{(bf16_t*)(p.ws + WS_PROJ), PA, 14, (float*)(p.ws + WS_GATES), p.in[I_AB_GBIAS]};
    pg8::gemm_phase<pg8::EpiStoreGates, pg8::StaticOrder, true, true>((PG8_LAS unsigned char*)lds, g, S, E);
}
__device__ __forceinline__ void phase_gemm256_resid(unsigned char* lds, const bf16_t* A, const bf16_t* Bt, const float* rf, const bf16_t* rb, bf16_t* out) {
    pg8::Gemm g{A, Bt, T, 1024, 1024}; pg8::StaticOrder S; S.init(T, 1024, (int)gridDim.x, (int)blockIdx.x);
    pg8::EpiResid E{rf, rb, out};
    pg8::gemm_phase<pg8::EpiResid, pg8::StaticOrder, true, true>((PG8_LAS unsigned char*)lds, g, S, E);
}

__device__ __forceinline__ void s5_gen_ktab(const Params& p) {
    const int gt = blockIdx.x * NTHR + opaque_tid(), NGT = gridDim.x * NTHR;
    const f32x2* POW = (const f32x2*)(p.ws + WS_S5POW); const f32x2* BB = (const f32x2*)(p.ws + WS_S5BBAR);
    for (int idx = gt; idx < 32 * 4096; idx += NGT) {
        const int g = idx >> 12, tau = (idx >> 8) & 15, ch = (idx >> 4) & 15, c = idx & 15;
        float sum = 0.f;
        for (int pp = 0; pp < 64; ++pp) {
            const f32x2 l = POW[(g * 64 + pp) * 17 + tau], b = BB[(g * 64 + pp) * 16 + c];
            const float wr_ = l.x * b.x - l.y * b.y, wi_ = l.x * b.y + l.y * b.x;
            sum += p.in[I_S5_CRE][(size_t)(g * 16 + ch) * 64 + pp] * wr_ - p.in[I_S5_CIM][(size_t)(g * 16 + ch) * 64 + pp] * wi_;
        }
        if (tau == 0 && ch == c) sum += p.in[I_S5_D][g * 16 + ch];
        ((float*)(p.ws + WS_KTAB))[idx] = sum;
    }
}
__device__ __forceinline__ void s5_gen_ops(const Params& p) {
    const int gt = blockIdx.x * NTHR + opaque_tid(), NGT = gridDim.x * NTHR;
    const f32x2* POW = (const f32x2*)(p.ws + WS_S5POW); const f32x2* BB = (const f32x2*)(p.ws + WS_S5BBAR);
    const float* KT = (const float*)(p.ws + WS_KTAB);
    bf16_t* BY = (bf16_t*)(p.ws + WS_S5Y); bf16_t* BE = (bf16_t*)(p.ws + WS_S5E);
    for (int idx = gt; idx < 32 * 256 * 48; idx += NGT) {
        const int kc = idx % 48, gn = idx / 48, n = gn & 255, g = gn >> 8, t = n >> 4, ch = n & 15, k0 = kc * 8;
        float v[8];
        if (k0 < 256) {
            const int s_ = k0 >> 4, c0 = k0 & 15;
            if (s_ <= t) {
                const f32x4 a = *(const f32x4*)(KT + ((g * 16 + (t - s_)) * 16 + ch) * 16 + c0), b = *(const f32x4*)(KT + ((g * 16 + (t - s_)) * 16 + ch) * 16 + c0 + 4);
                v[0] = a.x; v[1] = a.y; v[2] = a.z; v[3] = a.w; v[4] = b.x; v[5] = b.y; v[6] = b.z; v[7] = b.w;
            } else {
#pragma unroll
                for (int j = 0; j < 8; ++j) v[j] = 0.f;
            }
        } else {
            const int p0 = (k0 - 256) & 63; const bool re = k0 < 320;
#pragma unroll
            for (int j = 0; j < 8; ++j) {
                const int pp = p0 + j; const f32x2 l = POW[(g * 64 + pp) * 17 + t + 1];
                const float cr = p.in[I_S5_CRE][(size_t)(g * 16 + ch) * 64 + pp], ci = p.in[I_S5_CIM][(size_t)(g * 16 + ch) * 64 + pp];
                v[j] = re ? (cr * l.x - ci * l.y) : -(cr * l.y + ci * l.x);
            }
        }
        *(u32x4*)(BY + (size_t)gn * 384 + k0) = (u32x4){pk2(v[0], v[1]), pk2(v[2], v[3]), pk2(v[4], v[5]), pk2(v[6], v[7])};
    }
    for (int idx = gt; idx < 32 * 128 * 32; idx += NGT) {
        const int kc = idx & 31, gn = idx >> 5, n = gn & 127, g = gn >> 7, pp = n & 63, k0 = kc * 8, s_ = k0 >> 4, c0 = k0 & 15;
        const f32x2 l = POW[(g * 64 + pp) * 17 + 15 - s_];
        float v[8];
#pragma unroll
        for (int j = 0; j < 8; ++j) { const f32x2 b = BB[(g * 64 + pp) * 16 + c0 + j]; v[j] = (n < 64) ? (l.x * b.x - l.y * b.y) : (l.x * b.y + l.y * b.x); }
        *(u32x4*)(BE + (size_t)gn * 256 + k0) = (u32x4){pk2(v[0], v[1]), pk2(v[2], v[3]), pk2(v[4], v[5]), pk2(v[6], v[7])};
    }
}
struct AS5 {
    const bf16_t* proj; const bf16_t* xp; int m0, g;
    __device__ __forceinline__ const bf16_t* operator()(int r, int kc) const {
        const int m = m0 + r, k0 = kc * 8;
        return (k0 < 256) ? proj + ((size_t)(m * 16 + (k0 >> 4)) * PC + g * 16 + (k0 & 15)) : xp + ((size_t)m * 32 + g) * 128 + (k0 - 256);
    }
};
struct EpiS5E {
    float* xend; int m0, g;
    __device__ __forceinline__ void operator()(const f32x4 (&acc)[2][4], int wr, int wc, int fr, int fq) const {
#pragma unroll
        for (int m = 0; m < 2; ++m)
#pragma unroll
            for (int n = 0; n < 4; ++n) *(f32x4*)(xend + ((size_t)(m0 + wr * 32 + m * 16 + fr) * 32 + g) * 128 + wc * 64 + n * 16 + fq * 4) = acc[m][n];
    }
};
struct EpiS5Y {
    bf16_t* Z; int m0, g, n0;
    __device__ __forceinline__ void operator()(const f32x4 (&acc)[2][4], int wr, int wc, int fr, int fq) const {
#pragma unroll
        for (int m = 0; m < 2; ++m)
#pragma unroll
            for (int n = 0; n < 4; ++n) {
                const int mm = m0 + wr * 32 + m * 16 + fr, nc = n0 + wc * 64 + n * 16 + fq * 4, t = nc >> 4, ch0 = nc & 15;
                const f32x4 v = acc[m][n];
                u32x2 o; o.x = pk2(fgelu_tanh_(v.x), fgelu_tanh_(v.y)); o.y = pk2(fgelu_tanh_(v.z), fgelu_tanh_(v.w));
                *(u32x2*)(Z + (size_t)(mm * 16 + t) * 512 + g * 16 + ch0) = o;
            }
    }
};
__device__ __forceinline__ void s5_unit_E(const Params& p, unsigned char* lds, int u) {
    const int g = u >> 3, mt = u & 7;
    AS5 a{(const bf16_t*)(p.ws + WS_PROJ), nullptr, mt * 128, g};
    EpiS5E e{(float*)(p.ws + WS_XEND), mt * 128, g};
    gemm128(lds, a, (const bf16_t*)(p.ws + WS_S5E) + (size_t)g * 128 * 256, 256, e);
}
__device__ __forceinline__ void s5_unit_Y(const Params& p, unsigned char* lds, int u) {
    const int g = u >> 3, mt = u & 7;
    AS5 a{(const bf16_t*)(p.ws + WS_PROJ), (const bf16_t*)(p.ws + WS_XPREVB), mt * 128, g};
    EpiS5Y e0{(bf16_t*)(p.ws + WS_Z), mt * 128, g, 0}, e1{(bf16_t*)(p.ws + WS_Z), mt * 128, g, 128};
    BPlain b0{(const bf16_t*)(p.ws + WS_S5Y) + (size_t)g * 256 * 384, 384}, b1{(const bf16_t*)(p.ws + WS_S5Y) + ((size_t)g * 256 + 128) * 384, 384};
    gemm128x2(lds, a, b0, b1, 384, e0, e1);
}

__device__ __forceinline__ void stage_rows(const bf16_t* __restrict__ g, int pitch, bf16_t* s, int tid) {
#pragma unroll
    for (int i = 0; i < 2; ++i) { const int pc = tid + i * NTHR, l = pc >> 4, d0 = (pc & 15) * 8; *(u32x4*)(s + l * 136 + d0) = *(const u32x4*)(g + (size_t)l * pitch + d0); }
}
__device__ __forceinline__ void stage_transposed(const bf16_t* __restrict__ g, int pitch, bf16_t* s, const float* rs, int tid) {
#pragma unroll
    for (int i = 0; i < 2; ++i) {
        const int pc = tid + i * NTHR, l = pc >> 4, d0 = (pc & 15) * 8;
        const u32x4 v = *(const u32x4*)(g + (size_t)l * pitch + d0);
        const float sc = rs ? rs[l] : 1.f;
        const unsigned w[4] = {v.x, v.y, v.z, v.w};
#pragma unroll
        for (int q = 0; q < 4; ++q) {
            s[tsw(d0 + 2 * q, l)] = (bf16_t)f2bf(bf2f(w[q] & 0xffffu) * sc);
            s[tsw(d0 + 2 * q + 1, l)] = (bf16_t)f2bf(bf2f(w[q] >> 16) * sc);
        }
    }
}
__device__ __forceinline__ void state_outer(const bf16_t* Kt, const bf16_t* Vt, bf16_t* __restrict__ Uout, int wid, int fr, int fq) {
    const int v0 = wid * 16;
    bf16x8 bv[2];
#pragma unroll
    for (int ls = 0; ls < 2; ++ls) bv[ls] = *(const bf16x8*)(Vt + tswc(v0 + fr, ls * 4 + fq));
#pragma unroll
    for (int kt = 0; kt < 8; ++kt) {
        f32x4 acc = (f32x4){0.f, 0.f, 0.f, 0.f};
#pragma unroll
        for (int ls = 0; ls < 2; ++ls) {
            const bf16x8 ak = *(const bf16x8*)(Kt + tswc(kt * 16 + fr, ls * 4 + fq));
            acc = __builtin_amdgcn_mfma_f32_16x16x32_bf16(ak, bv[ls], acc, 0, 0, 0);
        }
        u32x2 o; o.x = pk2(acc.x, acc.y); o.y = pk2(acc.z, acc.w);
        *(u32x2*)(Uout + (size_t)(v0 + fr) * 128 + kt * 16 + fq * 4) = o;
    }
}
template <bool KRM>
__device__ __forceinline__ void state_outer_tr(const bf16_t* Kx, const bf16_t* Vs, bf16_t* __restrict__ Uout, int wid, int fr, int fq) {
    const int v0 = wid * 16;
    bf16x8 bv[2];
#pragma unroll
    for (int ls = 0; ls < 2; ++ls) bv[ls] = frag_tr(Vs, 136, ls * 32, v0, fr, fq);
#pragma unroll
    for (int kt = 0; kt < 8; ++kt) {
        f32x4 acc = (f32x4){0.f, 0.f, 0.f, 0.f};
#pragma unroll
        for (int ls = 0; ls < 2; ++ls) {
            const bf16x8 ak = KRM ? frag_tr(Kx, 136, ls * 32, kt * 16, fr, fq) : *(const bf16x8*)(Kx + tswc(kt * 16 + fr, ls * 4 + fq));
            acc = __builtin_amdgcn_mfma_f32_16x16x32_bf16(ak, bv[ls], acc, 0, 0, 0);
        }
        u32x2 o; o.x = pk2(acc.x, acc.y); o.y = pk2(acc.z, acc.w);
        *(u32x2*)(Uout + (size_t)(v0 + fr) * 128 + kt * 16 + fq * 4) = o;
    }
}
template <int GATE>
__device__ __forceinline__ void head_norm_out(const float* Hs, const float* __restrict__ w, const bf16_t* __restrict__ gsrc, int gpitch, bf16_t* __restrict__ out, int opitch, int tid) {
    const int l = tid >> 3, part = tid & 7;
    float h[16]; float ss = 0.f;
#pragma unroll
    for (int i = 0; i < 4; ++i) { const f32x4 v = *(const f32x4*)(Hs + l * 132 + part * 16 + i * 4); h[4 * i] = v.x; h[4 * i + 1] = v.y; h[4 * i + 2] = v.z; h[4 * i + 3] = v.w; ss += v.x * v.x + v.y * v.y + v.z * v.z + v.w * v.w; }
    ss += __shfl_xor(ss, 1); ss += __shfl_xor(ss, 2); ss += __shfl_xor(ss, 4);
    const float r = rsqrtf(ss * (1.f / 128.f) + EPS);
    const u32x4 g0 = *(const u32x4*)(gsrc + (size_t)l * gpitch + part * 16), g1 = *(const u32x4*)(gsrc + (size_t)l * gpitch + part * 16 + 8);
    const unsigned gw[8] = {g0.x, g0.y, g0.z, g0.w, g1.x, g1.y, g1.z, g1.w};
    unsigned ow[8];
#pragma unroll
    for (int q = 0; q < 8; ++q) {
        const float ga = bf2f(gw[q] & 0xffffu), gb = bf2f(gw[q] >> 16);
        const float a = h[2 * q] * r * w[part * 16 + 2 * q] * (GATE == 0 ? fsigmoid_(ga) : fsilu_(ga));
        const float b = h[2 * q + 1] * r * w[part * 16 + 2 * q + 1] * (GATE == 0 ? fsigmoid_(gb) : fsilu_(gb));
        ow[q] = pk2(a, b);
    }
    *(u32x4*)(out + (size_t)l * opitch + part * 16) = (u32x4){ow[0], ow[1], ow[2], ow[3]};
    *(u32x4*)(out + (size_t)l * opitch + part * 16 + 8) = (u32x4){ow[4], ow[5], ow[6], ow[7]};
}


struct Tile2 { u32x4 v[2]; };
struct Tile4 { u32x4 v[4]; };
template <bool NT = false>
__device__ __forceinline__ void tile_load(Tile2& t, const bf16_t* __restrict__ g, int pitch, int tid) {
#pragma unroll
    for (int i = 0; i < 2; ++i) { const int pc = tid + i * NTHR; const u32x4* q = (const u32x4*)(g + (size_t)(pc >> 4) * pitch + (pc & 15) * 8); t.v[i] = NT ? __builtin_nontemporal_load(q) : *q; }
}
template <bool NT = false>
__device__ __forceinline__ void tile4_load(Tile4& t, const bf16_t* __restrict__ g, int tid) {
#pragma unroll
    for (int i = 0; i < 4; ++i) { const int pc = tid + i * NTHR; const u32x4* q = (const u32x4*)(g + (size_t)pc * 8); t.v[i] = NT ? __builtin_nontemporal_load(q) : *q; }
}
__device__ __forceinline__ void tile_put_rows(const Tile2& t, bf16_t* s, int tid) {
#pragma unroll
    for (int i = 0; i < 2; ++i) { const int pc = tid + i * NTHR; *(u32x4*)(s + (pc >> 4) * 136 + (pc & 15) * 8) = t.v[i]; }
}
__device__ __forceinline__ void tile4_put(const Tile4& t, bf16_t* s, int tid) {
#pragma unroll
    for (int i = 0; i < 4; ++i) { const int pc = tid + i * NTHR; *(u32x4*)(s + (pc >> 4) * 136 + (pc & 15) * 8) = t.v[i]; }
}
__device__ __forceinline__ void tile_put_transposed(const Tile2& t, bf16_t* s, const float* rs, int tid) {
#pragma unroll
    for (int i = 0; i < 2; ++i) {
        const int pc = tid + i * NTHR, l = pc >> 4, d0 = (pc & 15) * 8;
        const unsigned w[4] = {t.v[i].x, t.v[i].y, t.v[i].z, t.v[i].w};
        if (rs) {
            const float sc = rs[l];
#pragma unroll
            for (int q = 0; q < 4; ++q) {
                const unsigned pr = pk2(bf2f(w[q] & 0xffffu) * sc, bf2f(w[q] >> 16) * sc);
                s[tsw(d0 + 2 * q, l)] = (bf16_t)(pr & 0xffffu); s[tsw(d0 + 2 * q + 1, l)] = (bf16_t)(pr >> 16);
            }
        } else {
#pragma unroll
            for (int q = 0; q < 4; ++q) { s[tsw(d0 + 2 * q, l)] = (bf16_t)(w[q] & 0xffffu); s[tsw(d0 + 2 * q + 1, l)] = (bf16_t)(w[q] >> 16); }
        }
    }
}
template <int GATE>
__device__ __forceinline__ void head_norm_out_r(const float* Hs, const float* __restrict__ w, const u32x4 (&og)[2], bf16_t* __restrict__ out, int opitch, int tid) {
    const int l = tid >> 3, part = tid & 7;
    float h[16]; float ss = 0.f;
#pragma unroll
    for (int i = 0; i < 4; ++i) { const f32x4 v = *(const f32x4*)(Hs + l * 132 + part * 16 + i * 4); h[4 * i] = v.x; h[4 * i + 1] = v.y; h[4 * i + 2] = v.z; h[4 * i + 3] = v.w; ss += v.x * v.x + v.y * v.y + v.z * v.z + v.w * v.w; }
    ss += __shfl_xor(ss, 1); ss += __shfl_xor(ss, 2); ss += __shfl_xor(ss, 4);
    const float r = rsqrtf(ss * (1.f / 128.f) + EPS);
    const unsigned gw[8] = {og[0].x, og[0].y, og[0].z, og[0].w, og[1].x, og[1].y, og[1].z, og[1].w};
    unsigned ow[8];
#pragma unroll
    for (int q = 0; q < 8; ++q) {
        const float ga = bf2f(gw[q] & 0xffffu), gb = bf2f(gw[q] >> 16);
        const float a = h[2 * q] * r * w[part * 16 + 2 * q] * (GATE == 0 ? fsigmoid_(ga) : fsilu_(ga));
        const float b = h[2 * q + 1] * r * w[part * 16 + 2 * q + 1] * (GATE == 0 ? fsigmoid_(gb) : fsilu_(gb));
        ow[q] = pk2(a, b);
    }
    *(u32x4*)(out + (size_t)l * opitch + part * 16) = (u32x4){ow[0], ow[1], ow[2], ow[3]};
    *(u32x4*)(out + (size_t)l * opitch + part * 16 + 8) = (u32x4){ow[4], ow[5], ow[6], ow[7]};
}

__device__ __forceinline__ void phase_mlstm_local(const Params& p, unsigned char* lds) {
    const int tid = opaque_tid(), lane = tid & 63, wid = tid >> 6, fr = lane & 15, fq = lane >> 4;
    unsigned char* ws = p.ws;
    const bf16_t* PROJ = (const bf16_t*)(ws + WS_PROJ);
    const float* GATES = (const float*)(ws + WS_GATES);
    bf16_t* Kt = (bf16_t*)lds;
    bf16_t* Vt = (bf16_t*)(lds + 18432);
    float* wk = (float*)(lds + 36864);
    const int NIT = 1024 + 256;
    Tile2 rk, rv; float gi = 0.f, gf = 0.f;
    auto load_item = [&](int it) {
        const int b = it >> 8, h = (it >> 6) & 3, c = it & 63, t0 = b * SEQ + c * 64;
        tile_load(rk, PROJ + (size_t)t0 * PA + 512 + h * 128, PA, tid);
        tile_load(rv, PROJ + (size_t)t0 * PA + 1024 + h * 128, PA, tid);
        gi = GATES[(size_t)(t0 + lane) * 8 + h]; gf = GATES[(size_t)(t0 + lane) * 8 + 4 + h];
    };
    if ((int)blockIdx.x < 1024) load_item(blockIdx.x);
    for (int it = blockIdx.x; it < NIT; it += gridDim.x) {
        if (it < 1024) {
            if (wid == 0) {
                const float lf = logsigmoid_(gf);
                const float bc = wave_incl_sum(lf, lane);
                const float bend = __shfl(bc, 63);
                const float logg = bend - bc + gi;
                const float ml = wave_max(logg);
                wk[lane] = expf(logg - ml);
                if (lane == 0) { ((float*)(ws + WS_MLOC))[it] = ml; ((float*)(ws + WS_BEND))[it] = bend; }
            }
            tile_put_rows(rk, Kt, tid);
            __syncthreads();
            {
#pragma unroll
                for (int i = 0; i < 2; ++i) {
                    const int pc = tid + i * NTHR, l = pc >> 4, d0 = (pc & 15) * 8; const float sc = wk[l];
                    const unsigned w[4] = {rv.v[i].x, rv.v[i].y, rv.v[i].z, rv.v[i].w};
                    u32x4 o; o.x = pk2(bf2f(w[0] & 0xffffu) * sc, bf2f(w[0] >> 16) * sc); o.y = pk2(bf2f(w[1] & 0xffffu) * sc, bf2f(w[1] >> 16) * sc);
                    o.z = pk2(bf2f(w[2] & 0xffffu) * sc, bf2f(w[2] >> 16) * sc); o.w = pk2(bf2f(w[3] & 0xffffu) * sc, bf2f(w[3] >> 16) * sc);
                    *(u32x4*)(Vt + l * 136 + d0) = o;
                }
                if (tid < 64) Vt[tid * 136 + 128] = (bf16_t)f2bf(wk[tid]);
            }
            __syncthreads();
            if (it + (int)gridDim.x < 1024) load_item(it + gridDim.x);
            state_outer_tr<true>(Kt, Vt, (bf16_t*)(ws + WS_U) + (size_t)it * 16384, wid, fr, fq);
            {
                f32x4 acc = (f32x4){0.f, 0.f, 0.f, 0.f};
#pragma unroll
                for (int ls = 0; ls < 2; ++ls) {
                    const bf16x8 bn = frag_tr(Vt, 136, ls * 32, 128, fr, fq);
                    const bf16x8 ak = frag_tr(Kt, 136, ls * 32, wid * 16, fr, fq);
                    acc = __builtin_amdgcn_mfma_f32_16x16x32_bf16(ak, bn, acc, 0, 0, 0);
                }
                if (fr == 0) *(f32x4*)((float*)(ws + WS_NLOC) + (size_t)it * 128 + wid * 16 + fq * 4) = acc;
            }
            __syncthreads();
        } else {
            const int ci = it - 1024, t0 = ci * 64, cq = tid & 63, ts = tid >> 6, c0 = cq * 8, tb = t0 + ts * 8;
            const float* cw = p.in[I_AB_CONVW];
            float w0[8], w1[8], w2[8];
#pragma unroll
            for (int j = 0; j < 8; ++j) { w0[j] = cw[c0 + j]; w1[j] = cw[512 + c0 + j]; w2[j] = cw[1024 + c0 + j]; }
            const bool halo = ((tb & (SEQ - 1)) != 0);
            float zp2[8], zp1[8];
            {
                u32x4 g2 = (u32x4){0u, 0u, 0u, 0u}, x2 = g2, g1 = g2, x1 = g2;
                if (halo) { const bf16_t* r2 = PROJ + (size_t)(tb - 2) * PA; const bf16_t* r1 = PROJ + (size_t)(tb - 1) * PA;
                    g2 = __builtin_nontemporal_load((const u32x4*)(r2 + 2560 + c0)); x2 = __builtin_nontemporal_load((const u32x4*)(r2 + 3072 + c0));
                    g1 = __builtin_nontemporal_load((const u32x4*)(r1 + 2560 + c0)); x1 = __builtin_nontemporal_load((const u32x4*)(r1 + 3072 + c0)); }
                const unsigned a0[4] = {g2.x, g2.y, g2.z, g2.w}, b0[4] = {x2.x, x2.y, x2.z, x2.w}, a1[4] = {g1.x, g1.y, g1.z, g1.w}, b1[4] = {x1.x, x1.y, x1.z, x1.w};
#pragma unroll
                for (int q = 0; q < 4; ++q) {
                    zp2[2 * q] = bf2f(a0[q] & 0xffffu) * bf2f(b0[q] & 0xffffu); zp2[2 * q + 1] = bf2f(a0[q] >> 16) * bf2f(b0[q] >> 16);
                    zp1[2 * q] = bf2f(a1[q] & 0xffffu) * bf2f(b1[q] & 0xffffu); zp1[2 * q + 1] = bf2f(a1[q] >> 16) * bf2f(b1[q] >> 16);
                }
            }
            bf16_t* mix = (bf16_t*)(ws + WS_MIX);
#pragma unroll 1
            for (int ps = 0; ps < 2; ++ps) {
                u32x4 gbv[4], gcv[4], xiv[4];
#pragma unroll
                for (int t = 0; t < 4; ++t) { const bf16_t* r = PROJ + (size_t)(tb + ps * 4 + t) * PA;
                    gbv[t] = __builtin_nontemporal_load((const u32x4*)(r + 2048 + c0)); gcv[t] = __builtin_nontemporal_load((const u32x4*)(r + 2560 + c0)); xiv[t] = __builtin_nontemporal_load((const u32x4*)(r + 3072 + c0)); }
#pragma unroll
                for (int t = 0; t < 4; ++t) {
                    const unsigned ga[4] = {gcv[t].x, gcv[t].y, gcv[t].z, gcv[t].w}, xa[4] = {xiv[t].x, xiv[t].y, xiv[t].z, xiv[t].w}, ba[4] = {gbv[t].x, gbv[t].y, gbv[t].z, gbv[t].w};
                    float y[8];
#pragma unroll
                    for (int q = 0; q < 4; ++q) {
                        const float z0 = bf2f(ga[q] & 0xffffu) * bf2f(xa[q] & 0xffffu), z1 = bf2f(ga[q] >> 16) * bf2f(xa[q] >> 16);
                        y[2 * q] = bf2f(ba[q] & 0xffffu) * (w0[2 * q] * zp2[2 * q] + w1[2 * q] * zp1[2 * q] + w2[2 * q] * z0);
                        y[2 * q + 1] = bf2f(ba[q] >> 16) * (w0[2 * q + 1] * zp2[2 * q + 1] + w1[2 * q + 1] * zp1[2 * q + 1] + w2[2 * q + 1] * z1);
                        zp2[2 * q] = zp1[2 * q]; zp1[2 * q] = z0; zp2[2 * q + 1] = zp1[2 * q + 1]; zp1[2 * q + 1] = z1;
                    }
                    *(u32x4*)(mix + (size_t)(tb + ps * 4 + t) * 1024 + 512 + c0) = (u32x4){pk2(y[0], y[1]), pk2(y[2], y[3]), pk2(y[4], y[5]), pk2(y[6], y[7])};
                }
            }
        }
    }
}

template <bool HG>
__device__ __forceinline__ void phase_scan(const Params& p, unsigned char* lds) {
    unsigned char* ws = p.ws;
    const int tid = opaque_tid(), lane = tid & 63, wv = tid >> 6;
    const int NGT = gridDim.x * NTHR;
    const bf16_t* U = (const bf16_t*)(ws + WS_U);
    bf16_t* CP = (bf16_t*)(ws + WS_CPREV);
    const float* MLOC = (const float*)(ws + WS_MLOC); const float* BEND = (const float*)(ws + WS_BEND); const float* BENDV = (const float*)(ws + WS_BENDV);
    float* sd = (float*)lds;
    float* ssu = sd + 64;
    float* sbv = (float*)(lds + 1024);
    const float* XEND = (const float*)(ws + WS_XEND);
    int sb = ((int)blockIdx.x * 8 + wv) * 4;
    float er[16], ei[16];
    if (HG && sb < 8192) {
        const int seq = sb + (lane & 3), seg = lane >> 2;
        const float* xe = XEND + ((size_t)((seq >> 11) * 256 + seg * 16) * 32 + ((seq >> 6) & 31)) * 128 + (seq & 63);
#pragma unroll
        for (int j = 0; j < 16; ++j) { er[j] = xe[j * 4096]; ei[j] = xe[j * 4096 + 64]; }
    }
    for (int base = blockIdx.x * NTHR; base < 131072; base += NGT) {
        const int idx = base + tid;
        const int bh = idx >> 13, rem = idx & 8191, e = rem >> 6, k = (rem & 63) * 2;
        if (base != (int)blockIdx.x * NTHR) __syncthreads();
        unsigned uu[64];
        {
            const bf16_t* up = U + (size_t)(bh * 64) * 16384 + e * 128 + k;
#pragma unroll
            for (int c = 0; c < 64; ++c) uu[c] = __builtin_nontemporal_load((const unsigned*)(up + (size_t)c * 16384));
        }
        const int kn0 = ((base & 8191) >> 9) * 8;
        if (!HG) {
            sbv[tid] = ((const float*)(ws + WS_NLOC))[(unsigned)((bh * 64 + (tid >> 3)) * 128 + kn0 + (tid & 7))];
            if (wv == 0) {
                const float ml = MLOC[bh * 64 + lane], be = BEND[bh * 64 + lane];
                float a = be, b = ml;
#pragma unroll
                for (int d = 1; d < 64; d <<= 1) {
                    const float pa = __shfl_up(a, d), pb = __shfl_up(b, d);
                    if (lane >= d) { b = fmaxf(pb + a, b); a = pa + a; }
                }
                const float m = b;
                float mp = __shfl_up(m, 1); if (lane == 0) mp = -1e30f;
                sd[lane] = expf(be + mp - m); ssu[lane] = expf(ml - m);
                if (rem < 64) ((float*)(ws + WS_MPREV))[bh * 64 + lane] = mp;
            }
        } else {
#pragma unroll
            for (int i = 0; i < 4; ++i) { const int q = tid + NTHR * i; *(f32x4*)(sbv + q * 4) = *(const f32x4*)(BENDV + (size_t)(bh * 64) * 128 + q * 4); }
        }
        __syncthreads();
        if (!HG && tid >= 504) {
            float* np_ = (float*)(ws + WS_NPREV) + (unsigned)((bh * 64) * 128 + kn0 + (tid - 504));
            float n = 0.f;
#pragma unroll
            for (int c = 0; c < 64; ++c) { np_[c * 128] = n; n = sd[c] * n + ssu[c] * sbv[c * 8 + (tid - 504)]; }
        }
        float c0 = 0.f, c1 = 0.f;
        bf16_t* cp = CP + (size_t)(bh * 64) * 16384 + e * 128 + k;
#pragma unroll
        for (int c = 0; c < 64; ++c) {
            *(unsigned*)(cp + (size_t)c * 16384) = pk2(c0, c1);
            const float u0 = bf2f(uu[c] & 0xffffu), u1 = bf2f(uu[c] >> 16);
            if (!HG) { const float d = sd[c], su = ssu[c]; c0 = d * c0 + su * u0; c1 = d * c1 + su * u1; }
            else { const f32x2 bv = *(const f32x2*)(sbv + c * 128 + k); c0 = bv.x * c0 + u0; c1 = bv.y * c1 + u1; }
        }
    }
    if (HG) {
        const f32x2* POW = (const f32x2*)(ws + WS_S5POW); bf16_t* XPB = (bf16_t*)(ws + WS_XPREVB);
        while (sb < 8192) {
            const int seq = sb + (lane & 3), seg = lane >> 2;
            const int b = seq >> 11, g = (seq >> 6) & 31, pp = seq & 63;
            const f32x2 l16 = POW[(g * 64 + pp) * 17 + 16];
            float ar = l16.x, ai = l16.y;
#pragma unroll
            for (int q = 0; q < 4; ++q) { const float nr = ar * ar - ai * ai, ni = 2.f * ar * ai; ar = nr; ai = ni; }
            bf16_t* xo = XPB + ((size_t)(b * 256 + seg * 16) * 32 + g) * 128 + pp;
            float xr = 0.f, xi = 0.f;
#pragma unroll
            for (int j = 0; j < 16; ++j) { const float nr = l16.x * xr - l16.y * xi + er[j], ni = l16.x * xi + l16.y * xr + ei[j]; xr = nr; xi = ni; }
            float cr = 0.f, ci = 0.f;
#pragma unroll
            for (int r = 0; r < 15; ++r) {
                const float pr = __shfl(xr, (lane & 3) + 4 * r), pi = __shfl(xi, (lane & 3) + 4 * r);
                if (r < seg) { const float nr = ar * cr - ai * ci + pr, ni = ar * ci + ai * cr + pi; cr = nr; ci = ni; }
            }
            xr = cr; xi = ci;
#pragma unroll
            for (int j = 0; j < 16; ++j) {
                xo[j * 4096] = (bf16_t)f2bf(xr); xo[j * 4096 + 64] = (bf16_t)f2bf(xi);
                const float nr = l16.x * xr - l16.y * xi + er[j], ni = l16.x * xi + l16.y * xr + ei[j]; xr = nr; xi = ni;
            }
            sb += gridDim.x * 32;
            if (sb < 8192) {
                const int seq2 = sb + (lane & 3);
                const float* xe = XEND + ((size_t)((seq2 >> 11) * 256 + seg * 16) * 32 + ((seq2 >> 6) & 31)) * 128 + (seq2 & 63);
#pragma unroll
                for (int j = 0; j < 16; ++j) { er[j] = xe[j * 4096]; ei[j] = xe[j * 4096 + 64]; }
            }
        }
    }
}

__device__ __forceinline__ void phase_mlstm_out(const Params& p, unsigned char* lds) {
    const int tid = opaque_tid(), lane = tid & 63, wid = tid >> 6, fr = lane & 15, fq = lane >> 4;
    unsigned char* ws = p.ws;
    const bf16_t* PROJ = (const bf16_t*)(ws + WS_PROJ);
    const float* GATES = (const float*)(ws + WS_GATES);
    bf16_t* Qs = (bf16_t*)lds;
    bf16_t* Ks = (bf16_t*)(lds + 17408);
    float* Hs = (float*)lds;
    bf16_t* Vt = (bf16_t*)(lds + 34816);
    bf16_t* Cs = (bf16_t*)(lds + 53248);
    bf16_t* Ps = (bf16_t*)(lds + 88064);
    float* sa = (float*)(lds + 97280);
    float* sg = sa + 64;
    float* sisc = sg + 64;
    float* semr = sisc + 64;
    float* sdinv = semr + 64;
    float* snp = sdinv + 64;
    Tile2 rq, rk, rv; Tile4 rc; u32x4 rog[2]; float g0 = 0.f, g1 = 0.f, g2 = 0.f, g3 = 0.f, g4 = 0.f;
    auto load_item = [&](int it) {
        const int b = it >> 8, h = (it >> 6) & 3, c = it & 63, t0 = b * SEQ + c * 64;
        tile_load<true>(rq, PROJ + (size_t)t0 * PA + h * 128, PA, tid);
        tile_load<true>(rk, PROJ + (size_t)t0 * PA + 512 + h * 128, PA, tid);
        tile_load<true>(rv, PROJ + (size_t)t0 * PA + 1024 + h * 128, PA, tid);
        tile4_load<true>(rc, (const bf16_t*)(ws + WS_CPREV) + (size_t)it * 16384, tid);
        { const bf16_t* og = PROJ + (size_t)(t0 + (tid >> 3)) * PA + 1536 + h * 128 + (tid & 7) * 16; rog[0] = __builtin_nontemporal_load((const u32x4*)og); rog[1] = __builtin_nontemporal_load((const u32x4*)(og + 8)); }
        g0 = GATES[(size_t)(t0 + lane) * 8 + h]; g1 = GATES[(size_t)(t0 + lane) * 8 + 4 + h]; g2 = ((const float*)(ws + WS_MPREV))[it];
        g3 = ((const float*)(ws + WS_NPREV))[(size_t)it * 128 + lane]; g4 = ((const float*)(ws + WS_NPREV))[(size_t)it * 128 + 64 + lane];
    };
    if ((int)blockIdx.x < 1024) load_item(blockIdx.x);
    for (int it = blockIdx.x; it < 1024; it += gridDim.x) {
        const int b = it >> 8, h = (it >> 6) & 3, c = it & 63, t0 = b * SEQ + c * 64;
        if (wid == 0) {
            const float ip = g0, fp = g1, mprev = g2;
            const float bc = wave_incl_sum(logsigmoid_(fp), lane);
            const float a = ip - bc;
            const float g = fmaxf(wave_incl_max(a, lane), mprev);
            sa[lane] = a; sg[lane] = g; sisc[lane] = expf(mprev - g); semr[lane] = expf(-(bc + g));
        } else if (wid == 1) { snp[lane] = g3; snp[64 + lane] = g4; }
        tile_put_rows(rq, Qs, tid); tile_put_rows(rk, Ks, tid); tile_put_rows(rv, Vt, tid); tile4_put(rc, Cs, tid);
        const u32x4 ogc[2] = {rog[0], rog[1]};
        __syncthreads();
        if (it + (int)gridDim.x < 1024) load_item(it + gridDim.x);
#pragma unroll
        for (int i = 0; i < 2; ++i) {
            const int tix = wid * 2 + i, lt = tix >> 2, st = tix & 3;
            f32x4 acc = (f32x4){0.f, 0.f, 0.f, 0.f};
            if (st <= lt) {
#pragma unroll
                for (int ks = 0; ks < 4; ++ks) {
                    const bf16x8 ak = *(const bf16x8*)(Ks + (st * 16 + fr) * 136 + ks * 32 + fq * 8);
                    const bf16x8 bq = *(const bf16x8*)(Qs + (lt * 16 + fr) * 136 + ks * 32 + fq * 8);
                    acc = __builtin_amdgcn_mfma_f32_16x16x32_bf16(ak, bq, acc, 0, 0, 0);
                }
            }
            const int l = lt * 16 + fr; const float gl = sg[l];
            float pv[4];
#pragma unroll
            for (int r = 0; r < 4; ++r) { const int s = st * 16 + fq * 4 + r; pv[r] = (s <= l) ? acc[r] * fexp_(sa[s] - gl) : 0.f; }
            u32x2 o; o.x = pk2(pv[0], pv[1]); o.y = pk2(pv[2], pv[3]);
            *(u32x2*)(Ps + l * 72 + st * 16 + fq * 4) = o;
        }
        __syncthreads();
        {
            const int l = tid >> 3, part = tid & 7;
            float rs = 0.f, qn = 0.f;
            const u32x4 pw = *(const u32x4*)(Ps + l * 72 + part * 8);
            rs = (bf2f(pw.x & 0xffffu) + bf2f(pw.x >> 16)) + (bf2f(pw.y & 0xffffu) + bf2f(pw.y >> 16)) + (bf2f(pw.z & 0xffffu) + bf2f(pw.z >> 16)) + (bf2f(pw.w & 0xffffu) + bf2f(pw.w >> 16));
            const u32x4 q0 = *(const u32x4*)(Qs + l * 136 + part * 16), q1 = *(const u32x4*)(Qs + l * 136 + part * 16 + 8);
            const unsigned qw[8] = {q0.x, q0.y, q0.z, q0.w, q1.x, q1.y, q1.z, q1.w};
#pragma unroll
            for (int j = 0; j < 8; ++j) qn += bf2f(qw[j] & 0xffffu) * snp[part * 16 + 2 * j] + bf2f(qw[j] >> 16) * snp[part * 16 + 2 * j + 1];
            rs += __shfl_xor(rs, 1); rs += __shfl_xor(rs, 2); rs += __shfl_xor(rs, 4);
            qn += __shfl_xor(qn, 1); qn += __shfl_xor(qn, 2); qn += __shfl_xor(qn, 4);
            if (part == 0) { const float den = rs + sisc[l] * qn; sdinv[l] = 1.f / fmaxf(fabsf(den), semr[l]); }
        }
        f32x4 a1[4], a2[4];
#pragma unroll
        for (int lt = 0; lt < 4; ++lt) { a1[lt] = (f32x4){0.f, 0.f, 0.f, 0.f}; a2[lt] = (f32x4){0.f, 0.f, 0.f, 0.f}; }
        {
            const int e0 = wid * 16;
#pragma unroll
            for (int ss = 0; ss < 2; ++ss) {
                const bf16x8 av = frag_tr(Vt, 136, ss * 32, e0, fr, fq);
#pragma unroll
                for (int lt = 0; lt < 4; ++lt) { const bf16x8 bp = *(const bf16x8*)(Ps + (lt * 16 + fr) * 72 + ss * 32 + fq * 8); a1[lt] = __builtin_amdgcn_mfma_f32_16x16x32_bf16(av, bp, a1[lt], 0, 0, 0); }
            }
#pragma unroll
            for (int ks = 0; ks < 4; ++ks) {
                const bf16x8 ac = *(const bf16x8*)(Cs + (e0 + fr) * 136 + ks * 32 + fq * 8);
#pragma unroll
                for (int lt = 0; lt < 4; ++lt) { const bf16x8 bq = *(const bf16x8*)(Qs + (lt * 16 + fr) * 136 + ks * 32 + fq * 8); a2[lt] = __builtin_amdgcn_mfma_f32_16x16x32_bf16(ac, bq, a2[lt], 0, 0, 0); }
            }
        }
        __syncthreads();
        {
            const int e0 = wid * 16;
#pragma unroll
            for (int lt = 0; lt < 4; ++lt) {
                const int l = lt * 16 + fr; const float is = sisc[l], di = sdinv[l];
                const f32x4 hv = (a1[lt] + a2[lt] * is) * di;
                *(f32x4*)(Hs + l * 132 + e0 + fq * 4) = hv;
            }
        }
        __syncthreads();
        head_norm_out_r<0>(Hs, p.in[I_AB_HNORM] + h * 128, ogc, (bf16_t*)(ws + WS_MIX) + (size_t)t0 * 1024 + h * 128, 1024, tid);
        __syncthreads();
    }
}

__device__ __forceinline__ void load_h_row(const Params& p, int row, int lane, bool combine, f32x4 (&v)[4], int ylayer = 0) {
    const bf16_t* hrow = (const bf16_t*)(p.ws + WS_H16) + (size_t)row * 1024;
#pragma unroll
    for (int j = 0; j < 4; ++j) { const u32x2 a = *(const u32x2*)(hrow + 4 * lane + 256 * j); v[j] = (f32x4){bf2f(a.x & 0xffffu), bf2f(a.x >> 16), bf2f(a.y & 0xffffu), bf2f(a.y >> 16)}; }
    if (combine) {
        const bf16_t* y0 = (const bf16_t*)(p.ws + ws_y(ylayer)) + (size_t)row * 1024;
        const bf16_t* y1 = y0 + (size_t)T * 1024;
#pragma unroll
        for (int j = 0; j < 4; ++j) {
            const u32x2 a = __builtin_nontemporal_load((const u32x2*)(y0 + 4 * lane + 256 * j)), bq = __builtin_nontemporal_load((const u32x2*)(y1 + 4 * lane + 256 * j));
            v[j].x += bf2f(a.x & 0xffffu) + bf2f(bq.x & 0xffffu); v[j].y += bf2f(a.x >> 16) + bf2f(bq.x >> 16);
            v[j].z += bf2f(a.y & 0xffffu) + bf2f(bq.y & 0xffffu); v[j].w += bf2f(a.y >> 16) + bf2f(bq.y >> 16);
        }
    }
}

__device__ __forceinline__ void phase_combine_norm(const Params& p, bool final_) {
    const int tid = opaque_tid(), lane = tid & 63, wid = tid >> 6;
    const int gw = blockIdx.x * 8 + wid, NGW = gridDim.x * 8;
    for (int row = gw; row < T; row += NGW) {
        f32x4 v[4];
        load_h_row(p, row, lane, true, v, final_ ? 1 : 0);
        float* hrow = p.out + (size_t)row * 1024;
        if (!final_) {
            bf16_t* h16 = (bf16_t*)(p.ws + WS_H16) + (size_t)row * 1024;
#pragma unroll
            for (int j = 0; j < 4; ++j) { u32x2 o; o.x = pk2(v[j].x, v[j].y); o.y = pk2(v[j].z, v[j].w); *(u32x2*)(h16 + 4 * lane + 256 * j) = o; }
            rms_row(v, p.in[I_NORM_MIX] + 1024, (bf16_t*)(p.ws + WS_XN) + (size_t)row * 1024, lane);
        } else {
            float ss = 0.f;
#pragma unroll
            for (int j = 0; j < 4; ++j) ss += v[j].x * v[j].x + v[j].y * v[j].y + v[j].z * v[j].z + v[j].w * v[j].w;
            ss = wave_sum(ss);
            const float r = rsqrtf(ss * (1.f / 1024.f) + EPS);
#pragma unroll
            for (int j = 0; j < 4; ++j) { const f32x4 w4 = *(const f32x4*)(p.in[I_NORM_FINAL] + 4 * lane + 256 * j); __builtin_nontemporal_store(v[j] * r * w4, (f32x4*)(hrow + 4 * lane + 256 * j)); }
        }
    }
}

template <bool DYN>
__device__ __forceinline__ void moe_convert(const Params& p, unsigned char* lds, int layer, int it_lo, int it_hi, int gw, int NGW, int wid, int lane, int* ctr = nullptr) {
    unsigned char* ws = p.ws;
    float* scr = (float*)(lds + wid * 8704);
    const float* wg = p.in[I_MOE_WGATE] + (size_t)layer * 32 * 1024 * 256;
    const float* wu = p.in[I_MOE_WUP] + (size_t)layer * 32 * 1024 * 256;
    const float* wd = p.in[I_MOE_WDOWN] + (size_t)layer * 32 * 256 * 1024;
    bf16_t* WGU = (bf16_t*)(ws + ws_wgu(layer)); bf16_t* WD = (bf16_t*)(ws + ws_wd(layer));
    constexpr int IT_GU = 16 * 16, IT_D = 32 * 4, IT_E = IT_GU + IT_D;
    for (int it0 = it_lo + gw;; it0 += NGW) {
        if (DYN) { int k = 0; if (lane == 0) k = __hip_atomic_fetch_add((__attribute__((address_space(3))) int*)ctr, 1, __ATOMIC_RELAXED, __HIP_MEMORY_SCOPE_WORKGROUP); it0 = it_lo + gw + __builtin_amdgcn_readfirstlane(k) * NGW; }
        if (it0 >= it_hi) break;
        const int e = it0 / IT_E; int it = it0 - e * IT_E;
        const float* src; bf16_t* dst; int ldn, ldk;
        if (it < IT_GU) {
            const int nb = it >> 4, kb = it & 15, n0 = nb * 32, k0 = kb * 64;
            const int pn = n0 >> 8, isup = (n0 >> 7) & 1, f0 = pn * 128 + (n0 & 127);
            src = (isup ? wu : wg) + (size_t)e * 1024 * 256 + (size_t)k0 * 256 + f0; ldn = 256;
            dst = WGU + (size_t)e * 512 * 1024 + (size_t)n0 * 1024 + k0; ldk = 1024;
        } else {
            it -= IT_GU;
            const int nb = it >> 2, kb = it & 3, n0 = nb * 32, k0 = kb * 64;
            src = wd + (size_t)e * 256 * 1024 + (size_t)k0 * 1024 + n0; ldn = 1024;
            dst = WD + (size_t)e * 1024 * 256 + (size_t)n0 * 256 + k0; ldk = 256;
        }
        transpose_tile(src, ldn, dst, ldk, 1.f, scr, lane);
    }
}
template <int RSEL>
__device__ __forceinline__ void phase_route(const Params& p, unsigned char* lds, int layer) {
    const int tid = opaque_tid(), lane = tid & 63, wid = tid >> 6, fr = lane & 15, fq = lane >> 4;
    unsigned char* ws = p.ws;
    float* part = (float*)lds;
    float* lg = (float*)(lds + 98304 + 2048);
    int* ctr = (int*)(lds + 98304 + 2048 + 12288 + 256);
    if (tid == 0) *ctr = 0;
    if (RSEL == 1) __syncthreads();
    const bf16_t* H16 = (const bf16_t*)(ws + WS_H16);
    const bf16_t* wf = (const bf16_t*)(ws + WS_WCAT) + (size_t)layer * 2 * 6144 * 8;
    int* cnt = (int*)(ws + WS_CNT) + layer * 1024;
    int* list = (int*)(ws + WS_LIST); float* wlist = (float*)(ws + WS_WLIST);
    if (RSEL != 1)
    for (int grp = blockIdx.x; grp < T / 64; grp += gridDim.x) {
        const int row0 = grp * 64;
        if (grp != (int)blockIdx.x) __syncthreads();
        bf16x8 a[4][4];
#pragma unroll
        for (int rt = 0; rt < 3; ++rt)
#pragma unroll
            for (int s_ = 0; s_ < 4; ++s_) a[rt][s_] = *(const bf16x8*)(H16 + (size_t)(row0 + rt * 16 + fr) * 1024 + wid * 128 + s_ * 32 + fq * 8);
        {
            const float* gp = p.in[I_NORM_FFN] + layer * 1024 + lane * 8;
            const f32x4 g0 = *(const f32x4*)gp, g1 = *(const f32x4*)(gp + 4), g2 = *(const f32x4*)(gp + 512), g3 = *(const f32x4*)(gp + 516);
#pragma unroll
            for (int hb = 0; hb < 2; ++hb) {
                bf16x8 x[4][2];
#pragma unroll
                for (int i = 0; i < 4; ++i) {
                    const bf16_t* hrow = H16 + (size_t)(row0 + wid * 8 + hb * 4 + i) * 1024 + lane * 8;
                    x[i][0] = *(const bf16x8*)hrow; x[i][1] = *(const bf16x8*)(hrow + 512);
                }
#pragma unroll
                for (int i = 0; i < 4; ++i) {
                    float f[16];
#pragma unroll
                    for (int j = 0; j < 8; ++j) { f[j] = bf2f((unsigned short)x[i][0][j]); f[8 + j] = bf2f((unsigned short)x[i][1][j]); }
                    float ss = 0.f;
#pragma unroll
                    for (int j = 0; j < 16; ++j) ss += f[j] * f[j];
                    ss = wave_sum(ss);
                    const float rs = rsqrtf(ss * (1.f / 1024.f) + EPS);
                    if (lane == 0) lg[64 * 48 + wid * 8 + hb * 4 + i] = rs;
                    u32x4 o0, o1;
                    o0.x = pk2(f[0] * rs * g0.x, f[1] * rs * g0.y); o0.y = pk2(f[2] * rs * g0.z, f[3] * rs * g0.w);
                    o0.z = pk2(f[4] * rs * g1.x, f[5] * rs * g1.y); o0.w = pk2(f[6] * rs * g1.z, f[7] * rs * g1.w);
                    o1.x = pk2(f[8] * rs * g2.x, f[9] * rs * g2.y); o1.y = pk2(f[10] * rs * g2.z, f[11] * rs * g2.w);
                    o1.z = pk2(f[12] * rs * g3.x, f[13] * rs * g3.y); o1.w = pk2(f[14] * rs * g3.z, f[15] * rs * g3.w);
                    bf16_t* xrow = (bf16_t*)(ws + WS_XN) + (size_t)(row0 + wid * 8 + hb * 4 + i) * 1024 + lane * 8;
                    *(u32x4*)xrow = o0; *(u32x4*)(xrow + 512) = o1;
                }
            }
        }
        bf16x8 bh[4][3], bl[4][3];
#pragma unroll
        for (int s_ = 0; s_ < 4; ++s_) a[3][s_] = *(const bf16x8*)(H16 + (size_t)(row0 + 48 + fr) * 1024 + wid * 128 + s_ * 32 + fq * 8);
#pragma unroll
        for (int s_ = 0; s_ < 4; ++s_)
#pragma unroll
            for (int n = 0; n < 3; ++n) {
                bh[s_][n] = *(const bf16x8*)(wf + ((size_t)((wid * 4 + s_) * 3 + n) * 64 + lane) * 8);
                bl[s_][n] = *(const bf16x8*)(wf + ((size_t)6144 + (size_t)((wid * 4 + s_) * 3 + n) * 64 + lane) * 8);
            }
#pragma unroll
        for (int rt = 0; rt < 4; ++rt) {
            f32x4 acc[3] = {(f32x4){0.f, 0.f, 0.f, 0.f}, (f32x4){0.f, 0.f, 0.f, 0.f}, (f32x4){0.f, 0.f, 0.f, 0.f}};
#pragma unroll
            for (int s_ = 0; s_ < 4; ++s_)
#pragma unroll
                for (int n = 0; n < 3; ++n) {
                    acc[n] = __builtin_amdgcn_mfma_f32_16x16x32_bf16(a[rt][s_], bl[s_][n], acc[n], 0, 0, 0);
                    acc[n] = __builtin_amdgcn_mfma_f32_16x16x32_bf16(a[rt][s_], bh[s_][n], acc[n], 0, 0, 0);
                }
#pragma unroll
            for (int n = 0; n < 3; ++n)
#pragma unroll
                for (int r = 0; r < 4; ++r) part[(wid * 64 + rt * 16 + fq * 4 + r) * 48 + n * 16 + fr] = acc[n][r];
        }
        __syncthreads();
        for (int i = tid; i < 64 * 48; i += NTHR) {
            float t = 0.f;
#pragma unroll
            for (int w = 0; w < 8; ++w) t += part[w * 3072 + i];
            lg[i] = t;
        }
        __syncthreads();
        if (wid == 0) {
            const int row = row0 + lane;
            const float rs = lg[64 * 48 + lane];
            const float* l = lg + lane * 48;
            const float* bg = p.in[I_MOE_BG] + layer * 4; const float* br = p.in[I_MOE_BR] + layer * 32;
            float gm = l[32] * rs + bg[0]; int gi = 0; float gl[4]; gl[0] = gm;
#pragma unroll
            for (int i = 1; i < 4; ++i) { gl[i] = l[32 + i] * rs + bg[i]; if (gl[i] > gm) { gm = gl[i]; gi = i; } }
            float gs = 0.f;
#pragma unroll
            for (int i = 0; i < 4; ++i) gs += expf(gl[i] - gm);
            const float gval = 1.f / gs;
            float m1 = -3.0e38f, m2 = -3.0e38f; int i1 = 0, i2 = 0;
#pragma unroll
            for (int i = 0; i < 8; ++i) {
                const float v = l[gi * 8 + i] * rs + br[gi * 8 + i];
                if (v > m1) { m2 = m1; i2 = i1; m1 = v; i1 = i; } else if (v > m2) { m2 = v; i2 = i; }
            }
            const float e2 = expf(m2 - m1), inv = gval / (1.f + e2);
            const int x1 = gi * 8 + i1, x2 = gi * 8 + i2;
            const unsigned long long ltm = (1ull << lane) - 1ull;
            int myc = 0, r1 = 0, r2 = 0;
#pragma unroll 1
            for (int e = 0; e < 32; ++e) {
                const unsigned long long b1 = __ballot(x1 == e), b2 = __ballot(x2 == e);
                const int c1 = __popcll(b1), c = c1 + __popcll(b2);
                if (lane == e) myc = c;
                if (x1 == e) r1 = __popcll(b1 & ltm);
                if (x2 == e) r2 = c1 + __popcll(b2 & ltm);
            }
            int base = 0;
            if (lane < 32 && myc > 0) base = atomicAdd(&cnt[lane * 32], myc);
            const int p1 = x1 * ECAP + __shfl(base, x1) + r1, p2 = x2 * ECAP + __shfl(base, x2) + r2;
            list[p1] = row * 2; wlist[p1] = inv;
            list[p2] = row * 2 + 1; wlist[p2] = inv * e2;
        }
    }
    if (RSEL < 2) moe_convert<true>(p, lds, layer, (layer == 1 && (int)gridDim.x > 128) ? MOE_CONV_EARLY : 0, MOE_CONV_ITEMS, blockIdx.x, gridDim.x, wid, lane, ctr);
}

struct AGather {
    const bf16_t* XN; const int* lst; int n;
    __device__ __forceinline__ const bf16_t* operator()(int r, int kc) const { const int tok = (r < n) ? (lst[r] >> 1) : 0; return XN + (size_t)tok * 1024 + kc * 8; }
};
struct EpiGateUp {
    bf16_t* H;
    __device__ __forceinline__ void operator()(const f32x4 (&acc)[2][4], int wr, int wc, int fr, int fq) const {
#pragma unroll
        for (int m = 0; m < 2; ++m)
#pragma unroll
            for (int n = 0; n < 2; ++n) {
                const f32x4 g = acc[m][n], u = acc[m][n + 2];
                u32x2 o; o.x = pk2(fsilu_(g.x) * u.x, fsilu_(g.y) * u.y); o.y = pk2(fsilu_(g.z) * u.z, fsilu_(g.w) * u.w);
                *(u32x2*)(H + (size_t)(wr * 32 + m * 16 + fr) * 256 + wc * 32 + n * 16 + fq * 4) = o;
            }
    }
};
struct EpiDown {
    bf16_t* Y; const int* lst; const float* wl; int n; int col0;
    __device__ __forceinline__ void operator()(const f32x4 (&acc)[2][4], int wr, int wc, int fr, int fq) const {
#pragma unroll
        for (int m = 0; m < 2; ++m) {
            const int r = wr * 32 + m * 16 + fr;
            if (r < n) {
                const int en = lst[r]; const float w = wl[r];
                bf16_t* yr = Y + ((size_t)(en & 1) * T + (en >> 1)) * 1024 + col0 + wc * 64 + fq * 4;
#pragma unroll
                for (int nn = 0; nn < 4; ++nn) { const f32x4 v = acc[m][nn] * w; u32x2 o; o.x = pk2(v.x, v.y); o.y = pk2(v.z, v.w); *(u32x2*)(yr + nn * 16) = o; }
            }
        }
    }
};
__device__ __forceinline__ void moe_prefix(const Params& p, int layer, int* tp, int* cn) {
    const int* cnt = (const int*)(p.ws + WS_CNT) + layer * 1024;
    int* sp = cn + 32;
    const int tid = opaque_tid();
    __syncthreads();
    if (tid < 32) cn[tid] = cnt[tid * 32];
    __syncthreads();
    if (tid == 0) {
        int s_ = 0, q_ = 0;
        for (int e = 0; e < 32; ++e) {
            const int c = cn[e], rem = c & 255;
            tp[e] = s_; sp[e] = q_;
            s_ += (c >> 8) + (rem > 128 ? 1 : 0); q_ += (rem > 0 && rem <= 128) ? 1 : 0;
        }
        tp[32] = s_; sp[32] = q_;
    }
    __syncthreads();
}
struct BGateUp {
    const bf16_t* W; int f0;
    __device__ __forceinline__ const bf16_t* operator()(int r, int kc) const {
        const int f = f0 + (r >> 6) * 32 + ((r >> 4) & 1) * 16 + (r & 15), isup = (r >> 5) & 1;
        return W + (size_t)((f >> 7) * 256 + isup * 128 + (f & 127)) * 1024 + kc * 8;
    }
};
constexpr int LDS_MOE_TAB = 131072, LDS_MOE_TP = 131072 + 4096;
__device__ __forceinline__ void phase_moe_up(const Params& p, unsigned char* lds, int layer) {
    unsigned* tab = (unsigned*)(lds + LDS_MOE_TAB); int* tp = (int*)(lds + LDS_MOE_TP); int* cn = tp + 64;
    moe_prefix(p, layer, tp, cn);
    pg8::SchedMoe S{tp, cn, tab, 2, tp[32] * 2, (int)gridDim.x, (int)blockIdx.x};
    const int* list = (const int*)(p.ws + WS_LIST);
    const int tid = opaque_tid();
    for (int i = 0; i < pg8::MOE_MAXU; ++i) {
        pg8::Unit u; if (!S.next(i, u)) break;
        const int e = u.pn >> 1, pos = (u.pm - tp[e]) * 256 + tid;
        if (tid < 256) tab[i * 256 + tid] = (pos < cn[e]) ? (unsigned)(list[(size_t)e * ECAP + pos] >> 1) * 2048u : 0u;
    }
    __syncthreads();
    pg8::Gemm g{(const bf16_t*)(p.ws + WS_XN), (const bf16_t*)(p.ws + ws_wgu(layer)), 0, 0, 1024};
    pg8::EpiMoeUp E{(bf16_t*)(p.ws + WS_HID)};
    pg8::gemm_phase_g<pg8::EpiMoeUp, pg8::SchedMoe>((PG8_LAS unsigned char*)lds, g, S, E);
    __syncthreads();
    const int* sp = cn + 32; const int nsm = sp[32], np8 = tp[32];
    const int G_ = (int)gridDim.x, uoff = (np8 * 2) % G_;
    for (int u = ((int)blockIdx.x - uoff + G_) % G_; u < nsm * 4; u += G_) {
        const int si = u >> 2, pn4 = u & 3;
        int e = 0; while (sp[e + 1] <= si) ++e;
        const int pos0 = (tp[e + 1] - tp[e]) * 256, n = cn[e] - pos0;
        AGather ag{(const bf16_t*)(p.ws + WS_XN), list + (size_t)e * ECAP + pos0, n};
        BGateUp bg{(const bf16_t*)(p.ws + ws_wgu(layer)) + (size_t)e * 512 * 1024, pn4 * 64};
        EpiGateUp ep{(bf16_t*)(p.ws + WS_HID) + ((size_t)np8 * 256 + (size_t)si * 128) * 256 + pn4 * 64};
        gemm128b(lds, ag, bg, 1024, ep);
    }
}
__device__ __forceinline__ void phase_moe_down(const Params& p, unsigned char* lds, int layer) {
    unsigned* tab = (unsigned*)(lds + LDS_MOE_TAB); float* wtab = (float*)(lds + LDS_MOE_TAB + 4096); int* tp = (int*)(lds + LDS_MOE_TP + 4096); int* cn = tp + 64;
    moe_prefix(p, layer, tp, cn);
    pg8::SchedMoe S{tp, cn, tab, 4, tp[32] * 4, (int)gridDim.x, (int)blockIdx.x};
    const int* list = (const int*)(p.ws + WS_LIST); const float* wlist = (const float*)(p.ws + WS_WLIST);
    const int tid = opaque_tid();
    for (int i = 0; i < pg8::MOE_MAXU; ++i) {
        pg8::Unit u; if (!S.next(i, u)) break;
        const int e = u.pn >> 2, pos = (u.pm - tp[e]) * 256 + tid;
        if (tid < 256) {
            const bool ok = pos < cn[e];
            const int en = ok ? list[(size_t)e * ECAP + pos] : 0;
            tab[i * 256 + tid] = ok ? (unsigned)((en & 1) * T + (en >> 1)) : 0xffffffffu;
            wtab[i * 256 + tid] = ok ? wlist[(size_t)e * ECAP + pos] : 0.f;
        }
    }
    __syncthreads();
    pg8::Gemm g{(const bf16_t*)(p.ws + WS_HID), (const bf16_t*)(p.ws + ws_wd(layer)), 0, 0, 256};
    pg8::EpiMoeDown E{(bf16_t*)(p.ws + ws_y(layer)), tab, wtab};
    pg8::gemm_phase<pg8::EpiMoeDown, pg8::SchedMoe, true, true>((PG8_LAS unsigned char*)lds, g, S, E);
    __syncthreads();
    const int* sp = cn + 32; const int nsm = sp[32], np8 = tp[32];
    const int G_ = (int)gridDim.x, uoff = (np8 * 4) % G_;
    for (int u = ((int)blockIdx.x - uoff + G_) % G_; u < nsm * 8; u += G_) {
        const int si = u >> 3, pn8 = u & 7;
        int e = 0; while (sp[e + 1] <= si) ++e;
        const int pos0 = (tp[e + 1] - tp[e]) * 256, n = cn[e] - pos0;
        APlain ap{(const bf16_t*)(p.ws + WS_HID) + ((size_t)np8 * 256 + (size_t)si * 128) * 256, 256};
        EpiDown ep{(bf16_t*)(p.ws + ws_y(layer)), list + (size_t)e * ECAP + pos0, wlist + (size_t)e * ECAP + pos0, n, pn8 * 128};
        gemm128(lds, ap, (const bf16_t*)(p.ws + ws_wd(layer)) + (size_t)e * 1024 * 256 + (size_t)pn8 * 128 * 256, 256, ep);
    }
}

constexpr int LDS_HG_SEG = 98304, LDS_HG_LBT = 106496;
struct HgBlk { float bc[4][4]; float kk[4][4]; };
__device__ __forceinline__ void hgrn_lb_table(const Params& p, float* lbt, int tid) {
    const float* lbp = p.in[I_HGRN_LB];
    lbt[tid] = sigmoid_(lbp[512 + tid] - lbp[tid]);
    __syncthreads();
}
__device__ __forceinline__ void hg_block(const bf16_t* __restrict__ fg, const float* lbt, float* seg, int tid, HgBlk& B) {
    const int k0 = (tid & 31) * 4, l0 = (tid >> 5) * 4;
    const f32x4 lb4 = *(const f32x4*)(lbt + k0);
    u32x2 w[4];
#pragma unroll
    for (int i = 0; i < 4; ++i) w[i] = *(const u32x2*)(fg + (size_t)(l0 + i) * PC + k0);
    float run[4] = {1.f, 1.f, 1.f, 1.f};
#pragma unroll
    for (int i = 0; i < 4; ++i) {
        const float x[4] = {bf2f(w[i].x & 0xffffu), bf2f(w[i].x >> 16), bf2f(w[i].y & 0xffffu), bf2f(w[i].y >> 16)};
#pragma unroll
        for (int j = 0; j < 4; ++j) {
            const float lb = lb4[j], sg = fsigmoid_(x[j]), f = lb + (1.f - lb) * sg;
            run[j] *= f; B.bc[i][j] = run[j]; B.kk[i][j] = (1.f - lb) * (1.f - sg);
        }
    }
    *(f32x4*)(seg + (tid >> 5) * 128 + k0) = (f32x4){run[0], run[1], run[2], run[3]};
}
__device__ __forceinline__ void hg_offsets(const float* seg, int tid, HgBlk& B, f32x4& bend) {
    const int k0 = (tid & 31) * 4, ls = tid >> 5;
    f32x4 off = (f32x4){1.f, 1.f, 1.f, 1.f}, tot = off;
#pragma unroll
    for (int r = 0; r < 16; ++r) { const f32x4 v = *(const f32x4*)(seg + r * 128 + k0); if (r < ls) off *= v; tot *= v; }
#pragma unroll
    for (int i = 0; i < 4; ++i)
#pragma unroll
        for (int j = 0; j < 4; ++j) B.bc[i][j] *= off[j];
    bend = tot;
}

__device__ __forceinline__ void phase_cd_local(const Params& p, unsigned char* lds) {
    const int tid = opaque_tid(), lane = tid & 63, wid = tid >> 6, fr = lane & 15, fq = lane >> 4;
    unsigned char* ws = p.ws;
    const bf16_t* PROJ = (const bf16_t*)(ws + WS_PROJ);
    bf16_t* KhT = (bf16_t*)lds;
    bf16_t* Vt = (bf16_t*)(lds + 18432);
    float* seg = (float*)(lds + LDS_HG_SEG); float* lbt = (float*)(lds + LDS_HG_LBT);
    hgrn_lb_table(p, lbt, tid);
    const int k0 = (tid & 31) * 4, l0 = (tid >> 5) * 4;
    for (int it = blockIdx.x; it < 1024 + 256; it += gridDim.x) {
        if (it < 1024) {
            const int b = it >> 8, h = (it >> 6) & 3, c = it & 63, t0 = b * SEQ + c * 64;
            HgBlk B;
            hg_block(PROJ + (size_t)t0 * PC + 1024 + h * 128, lbt + h * 128, seg, tid, B);
            Tile2 rv; tile_load(rv, PROJ + (size_t)t0 * PC + 1536 + h * 128, PC, tid);
            __syncthreads();
            f32x4 bend; hg_offsets(seg, tid, B, bend);
#pragma unroll
            for (int j = 0; j < 4; ++j) {
                u32x2 o; o.x = pk2(B.kk[0][j] * bend[j] * __builtin_amdgcn_rcpf(B.bc[0][j]), B.kk[1][j] * bend[j] * __builtin_amdgcn_rcpf(B.bc[1][j]));
                o.y = pk2(B.kk[2][j] * bend[j] * __builtin_amdgcn_rcpf(B.bc[2][j]), B.kk[3][j] * bend[j] * __builtin_amdgcn_rcpf(B.bc[3][j]));
                *(u32x2*)(KhT + tsw(k0 + j, l0)) = o;
            }
            if (tid < 32) *(f32x4*)((float*)(ws + WS_BENDV) + (size_t)it * 128 + k0) = bend;
            tile_put_rows(rv, Vt, tid);
            __syncthreads();
            state_outer_tr<false>(KhT, Vt, (bf16_t*)(ws + WS_U) + (size_t)it * 16384, wid, fr, fq);
            __syncthreads();
        } else {
            s5_unit_E(p, lds, it - 1024);
        }
    }
}

template <int SEL>
__device__ __forceinline__ void phase_cd_out(const Params& p, unsigned char* lds) {
    const int tid = opaque_tid(), lane = tid & 63, wid = tid >> 6, fr = lane & 15, fq = lane >> 4;
    unsigned char* ws = p.ws;
    const bf16_t* PROJ = (const bf16_t*)(ws + WS_PROJ);
    bf16_t* Qs = (bf16_t*)lds;
    bf16_t* Ks = (bf16_t*)(lds + 17408);
    float* Hs = (float*)lds;
    bf16_t* Vt = (bf16_t*)(lds + 34816);
    bf16_t* Ss = (bf16_t*)(lds + 53248);
    bf16_t* Ps = (bf16_t*)(lds + 88064);
    float* seg = (float*)(lds + LDS_HG_SEG); float* lbt = (float*)(lds + LDS_HG_LBT);
    hgrn_lb_table(p, lbt, tid);
    const int k0 = (tid & 31) * 4, l0 = (tid >> 5) * 4;
    for (int it = blockIdx.x + (SEL == 2 ? 1024 : 0); it < (SEL == 1 ? 1024 : 1024 + 256); it += gridDim.x) {
        if (it < 1024) {
            const int b = it >> 8, h = (it >> 6) & 3, c = it & 63, t0 = b * SEQ + c * 64;
            HgBlk B;
            hg_block(PROJ + (size_t)t0 * PC + 1024 + h * 128, lbt + h * 128, seg, tid, B);
            u32x2 qw[4];
#pragma unroll
            for (int i = 0; i < 4; ++i) qw[i] = __builtin_nontemporal_load((const u32x2*)(PROJ + (size_t)(t0 + l0 + i) * PC + 512 + h * 128 + k0));
            Tile2 rv; Tile4 rs;
            tile_load<true>(rv, PROJ + (size_t)t0 * PC + 1536 + h * 128, PC, tid);
            tile4_load<true>(rs, (const bf16_t*)(ws + WS_CPREV) + (size_t)it * 16384, tid);
            tile_put_rows(rv, Vt, tid); tile4_put(rs, Ss, tid);
            __syncthreads();
            f32x4 bend; hg_offsets(seg, tid, B, bend);
#pragma unroll
            for (int i = 0; i < 4; ++i) {
                const float q0 = bf2f(qw[i].x & 0xffffu), q1 = bf2f(qw[i].x >> 16), q2 = bf2f(qw[i].y & 0xffffu), q3 = bf2f(qw[i].y >> 16);
                const float e0 = B.bc[i][0], e1 = B.bc[i][1], e2 = B.bc[i][2], e3 = B.bc[i][3];
                u32x2 oq; oq.x = pk2(q0 * e0, q1 * e1); oq.y = pk2(q2 * e2, q3 * e3);
                u32x2 ok; ok.x = pk2(B.kk[i][0] * __builtin_amdgcn_rcpf(e0), B.kk[i][1] * __builtin_amdgcn_rcpf(e1)); ok.y = pk2(B.kk[i][2] * __builtin_amdgcn_rcpf(e2), B.kk[i][3] * __builtin_amdgcn_rcpf(e3));
                *(u32x2*)(Qs + (l0 + i) * 136 + k0) = oq; *(u32x2*)(Ks + (l0 + i) * 136 + k0) = ok;
            }
            __syncthreads();
#pragma unroll
            for (int i = 0; i < 2; ++i) {
                const int tix = wid * 2 + i, lt = tix >> 2, st = tix & 3;
                f32x4 acc = (f32x4){0.f, 0.f, 0.f, 0.f};
                if (st <= lt) {
#pragma unroll
                    for (int ks = 0; ks < 4; ++ks) {
                        const bf16x8 ak = *(const bf16x8*)(Ks + (st * 16 + fr) * 136 + ks * 32 + fq * 8);
                        const bf16x8 bq = *(const bf16x8*)(Qs + (lt * 16 + fr) * 136 + ks * 32 + fq * 8);
                        acc = __builtin_amdgcn_mfma_f32_16x16x32_bf16(ak, bq, acc, 0, 0, 0);
                    }
                }
                const int l = lt * 16 + fr;
                float pv[4];
#pragma unroll
                for (int r = 0; r < 4; ++r) { const int s_ = st * 16 + fq * 4 + r; pv[r] = (s_ <= l) ? acc[r] : 0.f; }
                u32x2 o; o.x = pk2(pv[0], pv[1]); o.y = pk2(pv[2], pv[3]);
                *(u32x2*)(Ps + l * 72 + st * 16 + fq * 4) = o;
            }
            __syncthreads();
            f32x4 a1[4];
#pragma unroll
            for (int lt = 0; lt < 4; ++lt) a1[lt] = (f32x4){0.f, 0.f, 0.f, 0.f};
            {
                const int e0 = wid * 16;
#pragma unroll
                for (int ss = 0; ss < 2; ++ss) {
                    const bf16x8 av = frag_tr(Vt, 136, ss * 32, e0, fr, fq);
#pragma unroll
                    for (int lt = 0; lt < 4; ++lt) { const bf16x8 bp = *(const bf16x8*)(Ps + (lt * 16 + fr) * 72 + ss * 32 + fq * 8); a1[lt] = __builtin_amdgcn_mfma_f32_16x16x32_bf16(av, bp, a1[lt], 0, 0, 0); }
                }
#pragma unroll
                for (int ks = 0; ks < 4; ++ks) {
                    const bf16x8 ac = *(const bf16x8*)(Ss + (e0 + fr) * 136 + ks * 32 + fq * 8);
#pragma unroll
                    for (int lt = 0; lt < 4; ++lt) { const bf16x8 bq = *(const bf16x8*)(Qs + (lt * 16 + fr) * 136 + ks * 32 + fq * 8); a1[lt] = __builtin_amdgcn_mfma_f32_16x16x32_bf16(ac, bq, a1[lt], 0, 0, 0); }
                }
            }
            __syncthreads();
            {
                const int e0 = wid * 16;
#pragma unroll
                for (int lt = 0; lt < 4; ++lt) *(f32x4*)(Hs + (lt * 16 + fr) * 132 + e0 + fq * 4) = a1[lt];
            }
            __syncthreads();
            head_norm_out<1>(Hs, p.in[I_HGRN_ONORM] + h * 128, PROJ + (size_t)t0 * PC + 2048 + h * 128, PC, (bf16_t*)(ws + WS_MIX) + (size_t)t0 * 1024 + 512 + h * 128, 1024, tid);
            __syncthreads();
        } else {
            s5_unit_Y(p, lds, it - 1024);
        }
    }
}

#define XB_TMO      128
#define XB_XCNT(j)  (256  + 64 * (j))
#define XB_XSUB(j)  (1280 + 64 * (j))
#define XB_XGEN(j)  (2304 + 64 * (j))
#define XB_TOP      3328
#define XB_TOPGEN   3392
#define XCD_BAR_WORDS 3456
#define XB_SPIN_CAP (1u << 22)
#define LAS __attribute__((address_space(3)))
constexpr size_t WS_BAR = 4096;
constexpr size_t CTL_ZERO_BYTES = 32768;
static_assert(WS_BAR + XCD_BAR_WORDS * 4 <= CTL_ZERO_BYTES, "barrier words outside the zeroed region");
constexpr int LDS_BAR_OFF = LDS_BYTES - 16;
__device__ __forceinline__ unsigned xb_ld(unsigned* p)              { return __hip_atomic_load(p, __ATOMIC_RELAXED, __HIP_MEMORY_SCOPE_AGENT); }
__device__ __forceinline__ unsigned xb_add(unsigned* p, unsigned v) { return __hip_atomic_fetch_add(p, v, __ATOMIC_RELAXED, __HIP_MEMORY_SCOPE_AGENT); }
__device__ __forceinline__ unsigned xb_xcc_id() { return (unsigned)__builtin_amdgcn_s_getreg((3 << 11) | 20) & 0xFu; }
#define XB_SPIN(cond, bar) do { unsigned _sp = 0; while (cond) { __builtin_amdgcn_s_sleep(1); \
    if ((++_sp & 255u) == 0u) { if (xb_ld(&(bar)[XB_TMO])) break; if (_sp > XB_SPIN_CAP) { atomicAdd(&(bar)[XB_TMO], 1u); break; } } } } while (0)
struct XcdBarrier { unsigned* bar; unsigned x; volatile LAS unsigned* st; };
__device__ __forceinline__ XcdBarrier xcd_barrier_post(unsigned* bar, volatile LAS unsigned* st) {
    XcdBarrier b; b.bar = bar; b.x = xb_xcc_id(); b.st = st;
    if (opaque_tid() == 0) (void)xb_add(&bar[XB_XCNT(b.x)], 1u);
    return b;
}
__device__ __forceinline__ void xcd_barrier_complete(unsigned* bar, unsigned x, unsigned& nloc, unsigned& nx) {
    const unsigned G = gridDim.x * gridDim.y * gridDim.z;
    unsigned sum, cnt, mine, sp = 0u;
    for (;;) {
        sum = 0u; cnt = 0u; mine = 0u;
#pragma unroll
        for (unsigned j = 0; j < 16; ++j) { const unsigned c = xb_ld(&bar[XB_XCNT(j)]); sum += c; cnt += (c > 0u) ? 1u : 0u; mine = (j == x) ? c : mine; }
        if (sum == G) break;
        __builtin_amdgcn_s_sleep(1);
        if ((++sp & 255u) == 0u) { if (xb_ld(&bar[XB_TMO])) break; if (sp > XB_SPIN_CAP) { atomicAdd(&bar[XB_TMO], 1u); break; } }
    }
    nloc = mine > 0u ? mine : 1u; nx = cnt > 0u ? cnt : 1u;
}
__device__ __forceinline__ void xcd_barrier(const XcdBarrier& b) {
    asm volatile("s_waitcnt vmcnt(0)" ::: "memory");
    __syncthreads();
    if (opaque_tid() == 0) {
        unsigned* bar = b.bar;
        __builtin_amdgcn_s_waitcnt(0);
        unsigned nloc = b.st[0], nx = b.st[1];
        if (nloc == 0u) { xcd_barrier_complete(bar, b.x, nloc, nx); b.st[0] = nloc; b.st[1] = nx; }
        const unsigned old = xb_add(&bar[XB_XSUB(b.x)], 1u);
        const unsigned gen = old / nloc;
        if (old + 1u == (gen + 1u) * nloc) {
            __builtin_amdgcn_fence(__ATOMIC_RELEASE, "agent");
            asm volatile("s_waitcnt vmcnt(0)" ::: "memory");
            const unsigned og = xb_add(&bar[XB_TOP], 1u);
            asm volatile("buffer_inv sc1" ::: "memory");
            const unsigned tg = og / nx;
            if (og + 1u == (tg + 1u) * nx) xb_add(&bar[XB_TOPGEN], 1u);
            else XB_SPIN(xb_ld(&bar[XB_TOPGEN]) == tg, bar);
            asm volatile("s_waitcnt vmcnt(0)" ::: "memory");
            xb_add(&bar[XB_XGEN(b.x)], 1u);
            asm volatile("s_waitcnt vmcnt(0)" ::: "memory");
        } else {
            asm volatile("buffer_inv sc1" ::: "memory");
            XB_SPIN(xb_ld(&bar[XB_XGEN(b.x)]) == gen, bar);
            asm volatile("s_waitcnt vmcnt(0)" ::: "memory");
        }
    }
    __syncthreads();
}

constexpr int NPHASE = 20;
constexpr unsigned REP_MASK = 0u;
constexpr int PROBE_SEL = 0;
template <int PH>
__device__ __forceinline__ void run_phase(const Params& p, unsigned char* lds) {
    unsigned char* ws = p.ws;
    if constexpr (PH == 0) phase_prep(p, lds);
    else if constexpr (PH == 1) { s5_gen_ktab(p); phase_gemm256_inproj0(lds, p); }
    else if constexpr (PH == 2) { s5_gen_ops(p); phase_mlstm_local(p, lds); }
    else if constexpr (PH == 3) phase_scan<false>(p, lds);
    else if constexpr (PH == 4) phase_mlstm_out(p, lds);
    else if constexpr (PH == 5) phase_gemm256_resid(lds, (const bf16_t*)(ws + WS_MIX), (const bf16_t*)(ws + WS_WOUTA), nullptr, (const bf16_t*)(ws + WS_H16), (bf16_t*)(ws + WS_H16));
    else if constexpr (PH == 6) phase_route<0>(p, lds, 0);
    else if constexpr (PH == 7) phase_moe_up(p, lds, 0);
    else if constexpr (PH == 8) phase_moe_down(p, lds, 0);
    else if constexpr (PH == 9) phase_combine_norm(p, false);
    else if constexpr (PH == 10) phase_gemm256_inproj1(lds, p);
    else if constexpr (PH == 11) phase_cd_local(p, lds);
    else if constexpr (PH == 12) phase_scan<true>(p, lds);
    else if constexpr (PH == 13) phase_cd_out<0>(p, lds);
    else if constexpr (PH == 14) {
        phase_gemm_glu(lds, p);
        if ((int)blockIdx.x >= 128) { const int t_ = opaque_tid(); moe_convert<false>(p, lds, 1, 0, MOE_CONV_EARLY, ((int)blockIdx.x - 128) * 8 + (t_ >> 6), ((int)gridDim.x - 128) * 8, t_ >> 6, t_ & 63); }
    }
    else if constexpr (PH == 15) phase_gemm256_resid(lds, (const bf16_t*)(ws + WS_MIX), (const bf16_t*)(ws + WS_WOUTC), nullptr, (const bf16_t*)(ws + WS_H16), (bf16_t*)(ws + WS_H16));
    else if constexpr (PH == 16) phase_route<0>(p, lds, 1);
    else if constexpr (PH == 17) phase_moe_up(p, lds, 1);
    else if constexpr (PH == 18) phase_moe_down(p, lds, 1);
    else if constexpr (PH == 19) phase_combine_norm(p, true);
}
template <int PH>
__device__ __forceinline__ void run_from(const Params& p, unsigned char* lds, const XcdBarrier& bar) {
    run_phase<PH>(p, lds);
    if constexpr ((REP_MASK >> PH) & 1u) {
        xcd_barrier(bar);
        if constexpr ((PH == 6 || PH == 16) && PROBE_SEL != 4) { { const int t_ = opaque_tid(); if (blockIdx.x == 0 && t_ < 32) ((int*)(p.ws + WS_CNT))[(PH == 16 ? 1024 : 0) + t_ * 32] = 0; } xcd_barrier(bar); }
        if constexpr (PH == 13 && PROBE_SEL != 0) phase_cd_out<PROBE_SEL>(p, lds); else
        if constexpr (PH == 6 && PROBE_SEL != 0) phase_route<PROBE_SEL>(p, lds, 0); else
        run_phase<PH>(p, lds);
    }
    if constexpr (PH + 1 < NPHASE) {
        xcd_barrier(bar);
        run_from<PH + 1>(p, lds, bar);
    }
}
__global__ void __launch_bounds__(NTHR, 2) mega(Params p) {
    extern __shared__ __attribute__((aligned(16))) unsigned char lds[];
    if (p.use_cg) cg::this_grid().sync();
    { const int t_ = opaque_tid(); if (t_ < 4) ((unsigned*)(lds + LDS_BAR_OFF))[t_] = 0u; }
    __syncthreads();
    const XcdBarrier bar = xcd_barrier_post((unsigned*)(p.ws + WS_BAR), (volatile LAS unsigned*)(lds + LDS_BAR_OFF));
    run_from<0>(p, lds, bar);
}

extern "C" void kernel_launch(void* const* d_in, const int* in_sizes, int n_in, void* d_out, int out_size, void* d_ws, size_t ws_size, hipStream_t stream) {
    static int grid = 0;
    if (grid == 0) {
        if (n_in != 30 || out_size != T * DM || ws_size < WS_END) { fprintf(stderr, "kernel_launch: unexpected shapes (n_in %d out %d ws %zu)\n", n_in, out_size, ws_size); grid = -1; return; }
        int dev = 0, cus = 0, per_cu = 0;
        (void)hipGetDevice(&dev);
        (void)hipDeviceGetAttribute(&cus, hipDeviceAttributeMultiprocessorCount, dev);
        (void)hipFuncSetAttribute((const void*)mega, hipFuncAttributeMaxDynamicSharedMemorySize, LDS_BYTES);
        (void)hipOccupancyMaxActiveBlocksPerMultiprocessor(&per_cu, (const void*)mega, NTHR, LDS_BYTES);
        if (per_cu < 1) { fprintf(stderr, "kernel_launch: occupancy query says %d blocks per CU\n", per_cu); per_cu = 1; }
        grid = cus * 1;
        (void)hipGetLastError();
    }
    if (grid < 0) return;
    Params p{};
    for (int i = 0; i < 30; ++i) p.in[i] = (const float*)d_in[i];
    p.out = (float*)d_out; p.ws = (unsigned char*)d_ws;
    p.use_cg = 0; p.pad = 0;
    (void)hipMemsetAsync((unsigned char*)d_ws + WS_CTL, 0, CTL_ZERO_BYTES, stream);
    void* args[] = {&p};
    hipError_t e = hipLaunchCooperativeKernel((const void*)mega, dim3(grid), dim3(NTHR), args, LDS_BYTES, stream);
    if (e != hipSuccess) fprintf(stderr, "cooperative launch failed: %s (grid %d)\n", hipGetErrorString(e), grid);
}
```

```cpp
#include <hip/hip_runtime.h>
#include <hip/hip_cooperative_groups.h>
#include <cstdio>
#include <cstdint>
namespace cg = cooperative_groups;

typedef unsigned short bf16_t;
typedef short bf16x8 __attribute__((ext_vector_type(8)));
typedef float f32x4 __attribute__((ext_vector_type(4)));
typedef float f32x2 __attribute__((ext_vector_type(2)));
typedef unsigned u32x4 __attribute__((ext_vector_type(4)));
typedef unsigned u32x2 __attribute__((ext_vector_type(2)));

constexpr int T = 16384, DM = 1024, SEQ = 4096;
constexpr int NTHR = 512;
constexpr int PA = 3584;
constexpr int PC = 2560;
constexpr int ECAP = 16384;
constexpr float EPS = 1e-6f;

constexpr size_t KB = 1024, MB = 1024 * 1024;
constexpr size_t WS_CTL = 0;
constexpr size_t WS_CNT = 20480;
constexpr size_t WS_GATES = 64 * KB;
constexpr size_t WS_S5POW = WS_GATES + 512 * KB;
constexpr size_t WS_S5BBAR = WS_S5POW + 272 * KB;
constexpr size_t WS_WCAT = WS_S5BBAR + 256 * KB;
constexpr size_t WS_NLOC = WS_WCAT + 384 * KB;
constexpr size_t WS_NPREV = WS_NLOC + 512 * KB;
constexpr size_t WS_BENDV = WS_NPREV + 512 * KB;
constexpr size_t WS_MLOC = WS_BENDV + 512 * KB;
constexpr size_t WS_BEND = WS_MLOC + 4 * KB;
constexpr size_t WS_MPREV = WS_BEND + 4 * KB;
constexpr size_t WS_KTAB = 3072 * KB;
static_assert(WS_MPREV + 4 * KB <= WS_KTAB && WS_KTAB + 512 * KB <= 4 * MB, "small region overflow");
constexpr size_t WS_S5Y = 4 * MB;
constexpr size_t WS_S5E = 10 * MB;
constexpr size_t WS_WINA = 12 * MB;
constexpr size_t WS_WOUTA = 20 * MB;
constexpr size_t WS_WINC = 22 * MB;
constexpr size_t WS_WOUTC = 27 * MB;
constexpr size_t WS_WGLU = 29 * MB;
constexpr size_t WS_A = 30 * MB;
constexpr size_t WS_B = 142 * MB;
constexpr size_t WS_C = 174 * MB;
constexpr size_t WS_D = 206 * MB;
constexpr size_t WS_H16 = 238 * MB;
constexpr size_t WS_RSTD = 270 * MB;
constexpr size_t WS_UP = 270 * MB + 192 * KB;
constexpr size_t WS_END = 270 * MB + 192 * KB + 16 * MB;
constexpr size_t WS_PROJ = WS_A, WS_LIST = WS_A, WS_WLIST = WS_A + 2 * MB, WS_HID = WS_A + 4 * MB, WS_Y = WS_A + 28 * MB;
constexpr size_t WS_XN = WS_B, WS_U = WS_B, WS_Z = WS_B;
constexpr size_t WS_XEND = WS_A + 84 * MB;
constexpr size_t WS_XPREVB = WS_A + 100 * MB;
constexpr size_t WS_MIX = WS_C, WS_CPREV = WS_D, WS_WGU = WS_C, WS_WD = WS_C + 32 * MB;

__host__ __device__ constexpr size_t ws_wgu(int layer) { return layer == 0 ? WS_C : WS_A + 64 * MB; }
__host__ __device__ constexpr size_t ws_wd(int layer) { return layer == 0 ? WS_C + 32 * MB : WS_A + 96 * MB; }
__host__ __device__ constexpr size_t ws_y(int layer) { return layer == 0 ? WS_A + 28 * MB : WS_C; }
constexpr int MOE_CONV_ITEMS = 32 * (16 * 16 + 32 * 4);
constexpr int MOE_CONV_EARLY = MOE_CONV_ITEMS / 2;
constexpr int LDS_BYTES = 144 * 1024;
__device__ __forceinline__ int moe_first_late_expert(int layer) { return (layer == 1 && (int)gridDim.x > 128) ? MOE_CONV_EARLY / 384 : 0; }

struct Params { const float* in[30]; float* out; unsigned char* ws; int use_cg; int pad; };

enum { I_X = 0, I_NORM_MIX, I_NORM_FFN, I_NORM_FINAL, I_AB_WIN, I_AB_GBIAS, I_AB_HNORM, I_AB_CONVW, I_AB_WOUT, I_CD_WIN, I_S5_LRE, I_S5_LIM, I_S5_BRE, I_S5_BIM,
       I_S5_CRE, I_S5_CIM, I_S5_D, I_S5_LOGDT, I_S5_WGLU, I_S5_BGLU, I_HGRN_LB, I_HGRN_ONORM, I_CD_WOUT, I_MOE_WG, I_MOE_BG, I_MOE_WR, I_MOE_BR, I_MOE_WGATE, I_MOE_WUP, I_MOE_WDOWN };

__device__ __forceinline__ int opaque_tid() { int t = threadIdx.x; asm volatile("" : "+v"(t)); return t; }
__device__ __forceinline__ float bf2f(unsigned v) { return __uint_as_float(v << 16); }
typedef __bf16 bf16x2_t __attribute__((ext_vector_type(2)));
__device__ __forceinline__ unsigned pk2(float lo, float hi) { const f32x2 v = {lo, hi}; return __builtin_bit_cast(unsigned, __builtin_convertvector(v, bf16x2_t)); }
__device__ __forceinline__ unsigned f2bf(float f) { return (unsigned)__builtin_bit_cast(unsigned short, (__bf16)f); }
__device__ __forceinline__ float wave_sum(float v) {
#pragma unroll
    for (int o = 32; o; o >>= 1) v += __shfl_xor(v, o);
    return v;
}
__device__ __forceinline__ float wave_max(float v) {
#pragma unroll
    for (int o = 32; o; o >>= 1) v = fmaxf(v, __shfl_xor(v, o));
    return v;
}
__device__ __forceinline__ float wave_incl_sum(float v, int lane) {
#pragma unroll
    for (int o = 1; o < 64; o <<= 1) { const float t = __shfl_up(v, o); if (lane >= o) v += t; }
    return v;
}
__device__ __forceinline__ float wave_incl_max(float v, int lane) {
#pragma unroll
    for (int o = 1; o < 64; o <<= 1) { const float t = __shfl_up(v, o); if (lane >= o) v = fmaxf(v, t); }
    return v;
}
__device__ __forceinline__ float sigmoid_(float x) { return 1.f / (1.f + expf(-x)); }
__device__ __forceinline__ float fexp_(float x) { return __expf(x); }
__device__ __forceinline__ float fsigmoid_(float x) { return __builtin_amdgcn_rcpf(1.f + __expf(-x)); }
__device__ __forceinline__ float fsilu_(float x) { return x * __builtin_amdgcn_rcpf(1.f + __expf(-x)); }
__device__ __forceinline__ float fgelu_tanh_(float x) { const float u = 0.7978845608028654f * (x + 0.044715f * x * x * x); return x * __builtin_amdgcn_rcpf(1.f + __expf(-2.f * u)); }
__device__ __forceinline__ float logsigmoid_(float x) { return fminf(x, 0.f) - log1pf(expf(-fabsf(x))); }
__device__ __forceinline__ float silu_(float x) { return x / (1.f + expf(-x)); }
__device__ __forceinline__ float gelu_tanh_(float x) { const float u = 0.7978845608028654f * (x + 0.044715f * x * x * x); return 0.5f * x * (1.f + tanhf(u)); }
#define LDS_WAIT() asm volatile("s_waitcnt lgkmcnt(0)" ::: "memory")
__device__ __forceinline__ int tsw(int d, int l) { return d * 72 + (l ^ (((d >> 3) & 7) << 3)); }
__device__ __forceinline__ int tswc(int d, int c) { return d * 72 + ((c ^ ((d >> 3) & 7)) << 3); }
#define LDS_AS __attribute__((address_space(3)))
typedef short s16x4 __attribute__((ext_vector_type(4)));
__device__ __forceinline__ bf16x8 frag_tr(const bf16_t* T, int pitch, int k0, int n0, int fr, int fq) {
    const bf16_t* a = T + (k0 + 8 * fq + (fr >> 2)) * pitch + n0 + 4 * (fr & 3);
    const s16x4 lo = __builtin_amdgcn_ds_read_tr16_b64_v4i16((LDS_AS s16x4*)a);
    const s16x4 hi = __builtin_amdgcn_ds_read_tr16_b64_v4i16((LDS_AS s16x4*)(a + 4 * pitch));
    return (bf16x8){lo[0], lo[1], lo[2], lo[3], hi[0], hi[1], hi[2], hi[3]};
}

struct BPlain {
    const bf16_t* Bt; int K;
    __device__ __forceinline__ const bf16_t* operator()(int r, int kc) const { return Bt + (size_t)r * K + kc * 8; }
};
template <class APiece, class BPiece, class Epi>
__device__ __forceinline__ void gemm128b(unsigned char* lds, const APiece& apiece, const BPiece& bpiece, int K, const Epi& epi) {
    const int tid = opaque_tid(), lane = tid & 63, wid = tid >> 6, wr = wid >> 1, wc = wid & 1, fr = lane & 15, fq = lane >> 4;
    const int nt = K >> 6;
    const int r0 = tid >> 3, c0 = tid & 7;
    const int so0 = r0 * 128 + ((c0 ^ (r0 & 7)) << 4), so1 = so0 + 64 * 128;
    u32x4 xa0 = *(const u32x4*)apiece(r0, c0), xa1 = *(const u32x4*)apiece(r0 + 64, c0), xb0 = *(const u32x4*)bpiece(r0, c0), xb1 = *(const u32x4*)bpiece(r0 + 64, c0);
    u32x4 ya0 = *(const u32x4*)apiece(r0, 8 + c0), ya1 = *(const u32x4*)apiece(r0 + 64, 8 + c0), yb0 = *(const u32x4*)bpiece(r0, 8 + c0), yb1 = *(const u32x4*)bpiece(r0 + 64, 8 + c0);
    f32x4 acc[2][4];
#pragma unroll
    for (int m = 0; m < 2; ++m)
#pragma unroll
        for (int n = 0; n < 4; ++n) acc[m][n] = (f32x4){0.f, 0.f, 0.f, 0.f};
#define G128_PUT(buf, A0, A1, B0, B1) do { unsigned char* d_ = lds + (buf) * 16384; *(u32x4*)(d_ + so0) = A0; *(u32x4*)(d_ + so1) = A1; *(u32x4*)(d_ + 32768 + so0) = B0; *(u32x4*)(d_ + 32768 + so1) = B1; } while (0)
#define G128_GET(t, A0, A1, B0, B1) do { const int kc_ = (t) * 8 + c0; A0 = *(const u32x4*)apiece(r0, kc_); A1 = *(const u32x4*)apiece(r0 + 64, kc_); B0 = *(const u32x4*)bpiece(r0, kc_); B1 = *(const u32x4*)bpiece(r0 + 64, kc_); } while (0)
#define G128_MMA(buf) do { const unsigned char* sa = lds + (buf) * 16384; const unsigned char* sb = lds + 32768 + (buf) * 16384; \
        _Pragma("unroll") for (int kk = 0; kk < 2; ++kk) { bf16x8 a[2], b[4]; \
            _Pragma("unroll") for (int m = 0; m < 2; ++m) { const int row = wr * 32 + m * 16 + fr; a[m] = *(const bf16x8*)(sa + row * 128 + (((kk * 4 + fq) ^ (row & 7)) << 4)); } \
            _Pragma("unroll") for (int n = 0; n < 4; ++n) { const int row = wc * 64 + n * 16 + fr; b[n] = *(const bf16x8*)(sb + row * 128 + (((kk * 4 + fq) ^ (row & 7)) << 4)); } \
            _Pragma("unroll") for (int m = 0; m < 2; ++m) _Pragma("unroll") for (int n = 0; n < 4; ++n) acc[m][n] = __builtin_amdgcn_mfma_f32_16x16x32_bf16(b[n], a[m], acc[m][n], 0, 0, 0); } } while (0)
    G128_PUT(0, xa0, xa1, xb0, xb1);
    __syncthreads();
#pragma unroll 1
    for (int kt = 0; kt < nt; kt += 2) {
        if (kt + 2 < nt) G128_GET(kt + 2, xa0, xa1, xb0, xb1);
        G128_MMA(0);
        G128_PUT(1, ya0, ya1, yb0, yb1);
        __syncthreads();
        if (kt + 3 < nt) G128_GET(kt + 3, ya0, ya1, yb0, yb1);
        G128_MMA(1);
        if (kt + 2 < nt) G128_PUT(0, xa0, xa1, xb0, xb1);
        __syncthreads();
    }
#undef G128_PUT
#undef G128_GET
#undef G128_MMA
    epi(acc, wr, wc, fr, fq);
}

template <class APiece, class Epi>
__device__ __forceinline__ void gemm128(unsigned char* lds, const APiece& apiece, const bf16_t* __restrict__ Bt, int K, const Epi& epi) {
    BPlain b{Bt, K};
    gemm128b(lds, apiece, b, K, epi);
}

template <class APiece, class BPiece, class Epi0, class Epi1>
__device__ __forceinline__ void gemm128x2(unsigned char* lds, const APiece& apiece, const BPiece& bp0f, const BPiece& bp1f, int K, const Epi0& epi0, const Epi1& epi1) {
    const int tid = opaque_tid(), lane = tid & 63, wid = tid >> 6, wr = wid >> 1, wc = wid & 1, fr = lane & 15, fq = lane >> 4;
    const int nt = K >> 6;
    const int r0 = tid >> 3, c0 = tid & 7;
    const int so0 = r0 * 128 + ((c0 ^ (r0 & 7)) << 4), so1 = so0 + 64 * 128;
    u32x4 ra0 = *(const u32x4*)apiece(r0, c0), ra1 = *(const u32x4*)apiece(r0 + 64, c0);
    u32x4 rb0 = *(const u32x4*)bp0f(r0, c0), rb1 = *(const u32x4*)bp0f(r0 + 64, c0);
    u32x4 rc0 = *(const u32x4*)bp1f(r0, c0), rc1 = *(const u32x4*)bp1f(r0 + 64, c0);
    f32x4 acc0[2][4], acc1[2][4];
#pragma unroll
    for (int m = 0; m < 2; ++m)
#pragma unroll
        for (int n = 0; n < 4; ++n) { acc0[m][n] = (f32x4){0.f, 0.f, 0.f, 0.f}; acc1[m][n] = (f32x4){0.f, 0.f, 0.f, 0.f}; }
    *(u32x4*)(lds + so0) = ra0; *(u32x4*)(lds + so1) = ra1;
    *(u32x4*)(lds + 32768 + so0) = rb0; *(u32x4*)(lds + 32768 + so1) = rb1;
    *(u32x4*)(lds + 65536 + so0) = rc0; *(u32x4*)(lds + 65536 + so1) = rc1;
    __syncthreads();
#pragma unroll 1
    for (int kt = 0; kt < nt; ++kt) {
        const int cur = kt & 1;
        if (kt + 1 < nt) {
            const int kc = (kt + 1) * 8 + c0;
            ra0 = *(const u32x4*)apiece(r0, kc); ra1 = *(const u32x4*)apiece(r0 + 64, kc);
            rb0 = *(const u32x4*)bp0f(r0, kc); rb1 = *(const u32x4*)bp0f(r0 + 64, kc);
            rc0 = *(const u32x4*)bp1f(r0, kc); rc1 = *(const u32x4*)bp1f(r0 + 64, kc);
        }
        const unsigned char* sa = lds + cur * 16384;
        const unsigned char* sb = lds + 32768 + cur * 16384;
        const unsigned char* sc = lds + 65536 + cur * 16384;
#pragma unroll
        for (int kk = 0; kk < 2; ++kk) {
            bf16x8 a[2], b[4], c[4];
#pragma unroll
            for (int m = 0; m < 2; ++m) { const int row = wr * 32 + m * 16 + fr; a[m] = *(const bf16x8*)(sa + row * 128 + (((kk * 4 + fq) ^ (row & 7)) << 4)); }
#pragma unroll
            for (int n = 0; n < 4; ++n) { const int row = wc * 64 + n * 16 + fr; const int o = row * 128 + (((kk * 4 + fq) ^ (row & 7)) << 4); b[n] = *(const bf16x8*)(sb + o); c[n] = *(const bf16x8*)(sc + o); }
#pragma unroll
            for (int m = 0; m < 2; ++m)
#pragma unroll
                for (int n = 0; n < 4; ++n) { acc0[m][n] = __builtin_amdgcn_mfma_f32_16x16x32_bf16(b[n], a[m], acc0[m][n], 0, 0, 0); acc1[m][n] = __builtin_amdgcn_mfma_f32_16x16x32_bf16(c[n], a[m], acc1[m][n], 0, 0, 0); }
        }
        if (kt + 1 < nt) {
            unsigned char* da = lds + (cur ^ 1) * 16384;
            *(u32x4*)(da + so0) = ra0; *(u32x4*)(da + so1) = ra1;
            *(u32x4*)(da + 32768 + so0) = rb0; *(u32x4*)(da + 32768 + so1) = rb1;
            *(u32x4*)(da + 65536 + so0) = rc0; *(u32x4*)(da + 65536 + so1) = rc1;
        }
        __syncthreads();
    }
    epi0(acc0, wr, wc, fr, fq);
    epi1(acc1, wr, wc, fr, fq);
}
struct APlain {
    const bf16_t* A; int K;
    __device__ __forceinline__ const bf16_t* operator()(int r, int kc) const { return A + (size_t)r * K + kc * 8; }
};

namespace pg8 {
#define PG8_LAS __attribute__((address_space(3)))
typedef unsigned short bf16_t;
typedef short bf16x8 __attribute__((ext_vector_type(8)));
typedef float f32x4 __attribute__((ext_vector_type(4)));
typedef unsigned u32x4 __attribute__((ext_vector_type(4)));
constexpr int BM = 256, BK = 64, HALF = 128, HTB = HALF * BK * 2  , STAGE_BYTES = 8 * HTB, NXCD = 8, WGM = 8;

__host__ __device__ __forceinline__ int lds_byte(int r, int c) { const int st = (r >> 4) * 2 + (c >> 5), rr = r & 15, cc = c & 31, ob = rr * 64 + cc * 2; return st * 1024 + (ob ^ (((ob >> 9) & 1) << 5)); }
__host__ __device__ __forceinline__ void stage_rc(int b, int& R, int& C) { const int st = b / 1024, sb = b % 1024, swz = sb ^ (((sb >> 9) & 1) << 5); R = (st >> 1) * 16 + swz / 64; C = (st & 1) * 32 + (swz % 64) / 2; }
__host__ __device__ __forceinline__ int perm32(int rho) { const int n = rho >> 4, i = rho & 15; return 8 * (i >> 2) + 4 * n + (i & 3); }

struct Unit { int pm, pn, aux, half, nh; };
struct Gemm { const bf16_t* A; const bf16_t* Bt; int M, N, K; };

struct StaticOrder {
    int nM, nN, nwg, G, c;
    __host__ __device__ void init(int M, int N, int G_, int c_) { nM = M / BM; nN = N / BM; nwg = nM * nN; G = G_; c = c_; }
    __host__ __device__ __forceinline__ bool next(int i, Unit& u) const {
        const long L = (long)i * G + c; if (L >= nwg) return false;
        int wgid = (int)L; { const int q = nwg / NXCD, r = nwg % NXCD, xcd = wgid % NXCD, off = wgid / NXCD; wgid = (xcd < r ? xcd * (q + 1) : r * (q + 1) + (xcd - r) * q) + off; }
        const int nig = WGM * nN, gid = wgid / nig, fm = gid * WGM, gsz = (nM - fm) < WGM ? (nM - fm) : WGM;
        u.pm = fm + ((wgid % nig) % gsz); u.pn = (wgid % nig) / gsz; u.aux = 0; u.half = 0; u.nh = 0; return true;
    }
    __device__ __forceinline__ void a_ready(const Unit&) const {}
    __device__ __forceinline__ void done(const Unit&) const {}
};

struct StaticOrderHalfTail : StaticOrder {
    int nNF, nNT;
    __device__ __forceinline__ bool next(int i, Unit& u) const {
        const long L = (long)i * G + c; const int nw = nM * nNT * 2;
        if (L >= (long)nwg + nw) return false;
        const bool tail = L >= nwg;
        int wgid = tail ? 0 : (int)L; { const int q = nwg / NXCD, r = nwg % NXCD, xcd = wgid % NXCD, off = wgid / NXCD; wgid = (xcd < r ? xcd * (q + 1) : r * (q + 1) + (xcd - r) * q) + off; }
        const int nig = WGM * nN, gid = wgid / nig, fm = gid * WGM, gsz = (nM - fm) < WGM ? (nM - fm) : WGM;
        const int pm_f = fm + ((wgid % nig) % gsz), pn_f = (wgid % nig) / gsz;
        int wg = tail ? (int)(L - nwg) : 0; { const int q = nw / NXCD, rr = nw % NXCD, xcd = wg % NXCD, off = wg / NXCD; wg = (xcd < rr ? xcd * (q + 1) : rr * (q + 1) + (xcd - rr) * q) + off; }
        const int t = wg % (nNT * 2);
        u.pm = tail ? wg / (nNT * 2) : pm_f; u.pn = tail ? nNF + (t >> 1) : pn_f; u.nh = tail ? 1 + (t & 1) : 0; u.aux = 0; u.half = 0;
        return true;
    }
};
__device__ __forceinline__ unsigned cvt_pk_bf16(float lo, float hi) { unsigned r; asm volatile("v_cvt_pk_bf16_f32 %0, %1, %2" : "=v"(r) : "v"(lo), "v"(hi)); return r; }
template <class Epi, class Sched, bool ALIGN_EPI = false, bool SP2 = false>
__device__ __forceinline__ void gemm_phase(PG8_LAS unsigned char* lds, const Gemm g, const Sched& S, const Epi& E) {
    const int tid = opaque_tid(), wid = __builtin_amdgcn_readfirstlane(tid >> 6), lane = tid & 63, wr = wid >> 2, wc = wid & 3, fr = lane & 15, fq = lane >> 4;
    const int K = g.K, nt = K / BK;
    unsigned voffA[2], voffB[2];
#pragma unroll
    for (int i = 0; i < 2; ++i) { int R, C; stage_rc(tid * 16 + i * 8192, R, C); const int Rb = Epi::PERM ? ((R & ~31) + perm32(R & 31)) : R;
        voffA[i] = (unsigned)(R * K + C) * 2u; voffB[i] = (unsigned)(Rb * K + C) * 2u; }
    const size_t kstep = (size_t)(BK * 2);
    const size_t hstep = (size_t)HALF * K * 2;
    const size_t tstep = 2 * hstep;
    const unsigned ldsw = (unsigned)wid * 1024u;
    const int aoff = lds_byte(wr * 64 + fr, fq * 8), boff = lds_byte(wc * 32 + fr, fq * 8);
#define PG8_SA(b, h) (((b) * 2 + (h)) * HTB)
#define PG8_SB(b, h) ((4 + (b) * 2 + (h)) * HTB)
#define PG8_STAGE(bufoff, gbase, voff) do { _Pragma("unroll") for (int _i = 0; _i < 2; ++_i) \
        __builtin_amdgcn_global_load_lds((const unsigned*)((const char*)(gbase) + (voff)[_i]), (PG8_LAS unsigned*)(lds + (bufoff) + ldsw + _i * 8192), 16, 0, 0); } while (0)
#define PG8_LDA(dst, b, h) do { _Pragma("unroll") for (int m = 0; m < 4; ++m) _Pragma("unroll") for (int k = 0; k < 2; ++k) dst[m][k] = *(const PG8_LAS bf16x8*)(lds + PG8_SA(b, h) + aoff + m * 2048 + k * 1024); } while (0)
#define PG8_LDB(dst, b, h) do { _Pragma("unroll") for (int n = 0; n < 2; ++n) _Pragma("unroll") for (int k = 0; k < 2; ++k) dst[n][k] = *(const PG8_LAS bf16x8*)(lds + PG8_SB(b, h) + boff + n * 2048 + k * 1024); } while (0)
#define PG8_MMA(ai, bj, At, Bt) do { __builtin_amdgcn_s_setprio(1); _Pragma("unroll") for (int m = 0; m < 4; ++m) _Pragma("unroll") for (int n = 0; n < 2; ++n) _Pragma("unroll") for (int k = 0; k < 2; ++k) \
        acc[ai][bj][m][n] = __builtin_amdgcn_mfma_f32_16x16x32_bf16(Bt[n][k], At[m][k], acc[ai][bj][m][n], 0, 0, 0); __builtin_amdgcn_s_setprio(0); } while (0)
#define PG8_WAIT_V(n) asm volatile("s_waitcnt vmcnt(" #n ")" ::: "memory")
#define PG8_WAIT_L(n) asm volatile("s_waitcnt lgkmcnt(" #n ")" ::: "memory")
#define PG8_BAR __builtin_amdgcn_s_barrier()
#define PG8_SCHED __builtin_amdgcn_sched_barrier(0)
    Unit cur, nxt; int ui = 0;
    if (!S.next(0, cur)) return;
    f32x4 acc[2][2][4][2];
#pragma unroll
    for (int a = 0; a < 2; ++a)
#pragma unroll
        for (int b = 0; b < 2; ++b)
#pragma unroll
            for (int m = 0; m < 4; ++m)
#pragma unroll
                for (int n = 0; n < 2; ++n) acc[a][b][m][n] = (f32x4){0.f, 0.f, 0.f, 0.f};
    bf16x8 At[4][2], B0[2][2], B1[2][2];
    const char* cA = (const char*)g.A + (size_t)cur.pm * tstep; const char* cB = (const char*)g.Bt + (size_t)cur.pn * tstep;
    S.a_ready(cur);
    if constexpr (SP2) {
        PG8_STAGE(PG8_SB(0, 0), cB, voffB); PG8_STAGE(PG8_SB(0, 1), cB + hstep, voffB); PG8_STAGE(PG8_SA(0, 0), cA, voffA); PG8_STAGE(PG8_SA(0, 1), cA + hstep, voffA);
        if (wr == 1) PG8_BAR;
        PG8_WAIT_V(2); PG8_BAR;
        PG8_STAGE(PG8_SB(1, 0), cB + kstep, voffB); PG8_STAGE(PG8_SA(1, 0), cA + kstep, voffA); PG8_STAGE(PG8_SB(1, 1), cB + hstep + kstep, voffB);
        PG8_WAIT_V(6); PG8_BAR;
    } else {
        PG8_STAGE(PG8_SB(0, 0), cB, voffB); PG8_STAGE(PG8_SA(0, 0), cA, voffA); PG8_STAGE(PG8_SB(0, 1), cB + hstep, voffB); PG8_STAGE(PG8_SA(0, 1), cA + hstep, voffA);
        if (wr == 1) PG8_BAR;
        PG8_WAIT_V(4); PG8_BAR;
        PG8_STAGE(PG8_SB(1, 0), cB + kstep, voffB); PG8_STAGE(PG8_SA(1, 0), cA + kstep, voffA); PG8_STAGE(PG8_SB(1, 1), cB + hstep + kstep, voffB);
        PG8_WAIT_V(6); PG8_BAR;
    }
    for (;;) {
        const bool has_next = S.next(ui + 1, nxt);
        const char* nA = has_next ? (const char*)g.A + (size_t)nxt.pm * tstep : cA; const char* nB = has_next ? (const char*)g.Bt + (size_t)nxt.pn * tstep : cB;
        for (int t = 0; t < nt; t += 2) {
            const bool last = (t == nt - 2);
            const char* a1 = cA + (size_t)(t + 1) * kstep;
            const char* a2 = last ? nA : cA + (size_t)(t + 2) * kstep; const char* b2 = last ? nB : cB + (size_t)(t + 2) * kstep;
            const char* a3 = a2 + kstep; const char* b3 = b2 + kstep;
            if (last && has_next) S.a_ready(nxt);
            if constexpr (SP2) {
            PG8_LDB(B0, 0, 0); PG8_LDB(B1, 0, 1); PG8_SCHED; PG8_LDA(At, 0, 0); PG8_STAGE(PG8_SA(1, 1), a1 + hstep, voffA);
            PG8_WAIT_V(8); PG8_WAIT_L(0); PG8_BAR; if (cur.nh != 2) PG8_MMA(0, 0, At, B0); if (cur.nh != 1) PG8_MMA(0, 1, At, B1); PG8_BAR; PG8_SCHED;
            PG8_LDA(At, 0, 1); PG8_STAGE(PG8_SB(0, 0), b2, voffB); PG8_STAGE(PG8_SB(0, 1), b2 + hstep, voffB); PG8_STAGE(PG8_SA(0, 0), a2, voffA);
            PG8_WAIT_V(8); PG8_WAIT_L(0); PG8_BAR; if (!cur.half) { if (cur.nh != 2) PG8_MMA(1, 0, At, B0); if (cur.nh != 1) PG8_MMA(1, 1, At, B1); } PG8_BAR; PG8_SCHED;
            PG8_LDB(B0, 1, 0); PG8_LDB(B1, 1, 1); PG8_SCHED; PG8_LDA(At, 1, 0); PG8_STAGE(PG8_SA(0, 1), a2 + hstep, voffA);
            PG8_WAIT_V(8); PG8_WAIT_L(0); PG8_BAR; if (cur.nh != 2) PG8_MMA(0, 0, At, B0); if (cur.nh != 1) PG8_MMA(0, 1, At, B1); PG8_BAR; PG8_SCHED;
            PG8_LDA(At, 1, 1); PG8_STAGE(PG8_SB(1, 0), b3, voffB); PG8_STAGE(PG8_SB(1, 1), b3 + hstep, voffB); PG8_STAGE(PG8_SA(1, 0), a3, voffA);
            PG8_WAIT_V(8); PG8_WAIT_L(0); PG8_BAR; if (!cur.half) { if (cur.nh != 2) PG8_MMA(1, 0, At, B0); if (cur.nh != 1) PG8_MMA(1, 1, At, B1); } PG8_BAR; PG8_SCHED;
            } else {
            PG8_LDB(B0, 0, 0); PG8_SCHED; PG8_LDA(At, 0, 0); PG8_STAGE(PG8_SA(1, 1), a1 + hstep, voffA);
            PG8_WAIT_L(8); PG8_BAR; PG8_WAIT_L(0); PG8_MMA(0, 0, At, B0); PG8_BAR; PG8_SCHED;
            PG8_LDB(B1, 0, 1); PG8_STAGE(PG8_SB(0, 0), b2, voffB);
            PG8_BAR; PG8_WAIT_L(0); PG8_MMA(0, 1, At, B1); PG8_BAR;
            PG8_LDA(At, 0, 1); PG8_STAGE(PG8_SA(0, 0), a2, voffA);
            PG8_BAR; PG8_WAIT_L(0); PG8_MMA(1, 0, At, B0); PG8_BAR; PG8_SCHED;
            PG8_STAGE(PG8_SB(0, 1), b2 + hstep, voffB);
            PG8_WAIT_V(6); PG8_BAR; PG8_MMA(1, 1, At, B1); PG8_BAR;
            PG8_LDB(B0, 1, 0); PG8_SCHED; PG8_LDA(At, 1, 0); PG8_STAGE(PG8_SA(0, 1), a2 + hstep, voffA);
            PG8_WAIT_L(8); PG8_BAR; PG8_WAIT_L(0); PG8_MMA(0, 0, At, B0); PG8_BAR; PG8_SCHED;
            PG8_LDB(B1, 1, 1); PG8_STAGE(PG8_SB(1, 0), b3, voffB);
            PG8_BAR; PG8_WAIT_L(0); PG8_MMA(0, 1, At, B1); PG8_BAR;
            PG8_LDA(At, 1, 1); PG8_STAGE(PG8_SA(1, 0), a3, voffA);
            PG8_BAR; PG8_WAIT_L(0); PG8_MMA(1, 0, At, B0); PG8_BAR; PG8_SCHED;
            PG8_STAGE(PG8_SB(1, 1), b3 + hstep, voffB);
            PG8_WAIT_V(6); PG8_BAR; PG8_MMA(1, 1, At, B1); PG8_BAR;
            }
        }
        if constexpr (ALIGN_EPI) { if (wr == 0) PG8_BAR; }
        if constexpr (!Epi::AFTER_DRAIN) { E(acc, cur, wr, wc, fr, fq); S.done(cur); }
        if (!has_next) break;
#pragma unroll
        for (int a = 0; a < 2; ++a)
#pragma unroll
            for (int b = 0; b < 2; ++b)
#pragma unroll
                for (int m = 0; m < 4; ++m)
#pragma unroll
                    for (int n = 0; n < 2; ++n) acc[a][b][m][n] = (f32x4){0.f, 0.f, 0.f, 0.f};
        cur = nxt; cA = nA; cB = nB; ++ui;
        if constexpr (ALIGN_EPI) { if (wr == 1) PG8_BAR; }
    }
    PG8_WAIT_V(0);
    if constexpr (!ALIGN_EPI) { if (wr == 0) PG8_BAR; }
    PG8_BAR;
    if constexpr (Epi::AFTER_DRAIN) { E.fused(acc, cur, wr, wc, fr, fq, lds, wid, lane); S.done(cur); }
#undef PG8_SA
#undef PG8_SB
#undef PG8_STAGE
#undef PG8_LDA
#undef PG8_LDB
#undef PG8_MMA
#undef PG8_WAIT_V
#undef PG8_WAIT_L
#undef PG8_BAR
#undef PG8_SCHED
}

struct EpiStore {
    static constexpr bool PERM = true, AFTER_DRAIN = false;
    bf16_t* O; int ldc; const float* rs; bf16_t* UP;
    __device__ __forceinline__ void operator()(const f32x4 (&acc)[2][2][4][2], const Unit& u, int wr, int wc, int fr, int fq) const {
        const int row0 = u.pm * BM + wr * 64 + fr, col0 = u.pn * BM + wc * 32 + 8 * fq;
        const bool pk = u.pn < 2;
#pragma unroll
        for (int ai = 0; ai < 2; ++ai)
#pragma unroll
            for (int m = 0; m < 4; ++m) { const int row = row0 + ai * HALF + m * 16; const float r_ = rs[row];
                bf16_t* rowp = pk ? UP + ((size_t)(col0 >> 4) * T + row) * 16 + (col0 & 15) : O + (size_t)row * ldc + col0; const size_t bstep = pk ? (size_t)(HALF >> 4) * T * 16 : (size_t)HALF;
#pragma unroll
                for (int bj = 0; bj < 2; ++bj) { if (u.nh == 2 - bj) continue; const f32x4 v0 = acc[ai][bj][m][0] * r_, v1 = acc[ai][bj][m][1] * r_;
                    u32x4 w; w.x = cvt_pk_bf16(v0[0], v0[1]); w.y = cvt_pk_bf16(v0[2], v0[3]); w.z = cvt_pk_bf16(v1[0], v1[1]); w.w = cvt_pk_bf16(v1[2], v1[3]);
                    *(u32x4*)(rowp + bj * bstep) = w; } }
    }
};
struct EpiStoreGates {
    static constexpr bool PERM = true, AFTER_DRAIN = false;
    bf16_t* O; int ldc; int gate_pn; float* gates; const float* gbias; const float* rs;
    __device__ __forceinline__ void operator()(const f32x4 (&acc)[2][2][4][2], const Unit& u, int wr, int wc, int fr, int fq) const {
        const int row0 = u.pm * BM + wr * 64 + fr;
        if (u.pn == gate_pn) {
            if (wc == 0 && fq == 0) {
                const f32x4 b0 = *(const f32x4*)gbias, b1 = *(const f32x4*)(gbias + 4);
#pragma unroll
                for (int ai = 0; ai < 2; ++ai)
#pragma unroll
                    for (int m = 0; m < 4; ++m) { float* g = gates + (size_t)(row0 + ai * HALF + m * 16) * 8; const float r_ = rs[row0 + ai * HALF + m * 16];
                        *(f32x4*)g = acc[ai][0][m][0] * r_ + b0; *(f32x4*)(g + 4) = acc[ai][0][m][1] * r_ + b1; }
            }
            return;
        }
        const int col0 = u.pn * BM + wc * 32 + 8 * fq;
#pragma unroll
        for (int ai = 0; ai < 2; ++ai)
#pragma unroll
            for (int m = 0; m < 4; ++m) { bf16_t* rowp = O + (size_t)(row0 + ai * HALF + m * 16) * ldc + col0; const float r_ = rs[row0 + ai * HALF + m * 16];
#pragma unroll
                for (int bj = 0; bj < 2; ++bj) { const f32x4 v0 = acc[ai][bj][m][0] * r_, v1 = acc[ai][bj][m][1] * r_;
                    u32x4 w; w.x = cvt_pk_bf16(v0[0], v0[1]); w.y = cvt_pk_bf16(v0[2], v0[3]); w.z = cvt_pk_bf16(v1[0], v1[1]); w.w = cvt_pk_bf16(v1[2], v1[3]);
                    *(u32x4*)(rowp + bj * HALF) = w; } }
    }
};
struct EpiResid {
    static constexpr bool PERM = true, AFTER_DRAIN = false;
    const float* rf; const bf16_t* rb; bf16_t* out;
    __device__ __forceinline__ void operator()(const f32x4 (&acc)[2][2][4][2], const Unit& u, int wr, int wc, int fr, int fq) const {
        const int row0 = u.pm * BM + wr * 64 + fr, col0 = u.pn * BM + wc * 32 + 8 * fq;
#pragma unroll
        for (int ai = 0; ai < 2; ++ai)
#pragma unroll
            for (int m = 0; m < 4; ++m) { const size_t off = (size_t)(row0 + ai * HALF + m * 16) * 1024 + col0;
#pragma unroll
                for (int bj = 0; bj < 2; ++bj) {
                    f32x4 r0, r1;
                    if (rf) { r0 = *(const f32x4*)(rf + off + bj * HALF); r1 = *(const f32x4*)(rf + off + bj * HALF + 4); }
                    else { const u32x4 q = *(const u32x4*)(rb + off + bj * HALF);
                        r0 = (f32x4){__uint_as_float(q.x << 16), __uint_as_float(q.x & 0xffff0000u), __uint_as_float(q.y << 16), __uint_as_float(q.y & 0xffff0000u)};
                        r1 = (f32x4){__uint_as_float(q.z << 16), __uint_as_float(q.z & 0xffff0000u), __uint_as_float(q.w << 16), __uint_as_float(q.w & 0xffff0000u)}; }
                    const f32x4 v0 = acc[ai][bj][m][0] + r0, v1 = acc[ai][bj][m][1] + r1;
                    u32x4 w; w.x = cvt_pk_bf16(v0[0], v0[1]); w.y = cvt_pk_bf16(v0[2], v0[3]); w.z = cvt_pk_bf16(v1[0], v1[1]); w.w = cvt_pk_bf16(v1[2], v1[3]);
                    *(u32x4*)(out + off + bj * HALF) = w; } }
    }
};

template <class Epi, class Sched>
__device__ __forceinline__ void gemm_phase_g(PG8_LAS unsigned char* lds, const Gemm g, const Sched& S, const Epi& E) {
    const int tid = opaque_tid(), wid = __builtin_amdgcn_readfirstlane(tid >> 6), lane = tid & 63, wr = wid >> 2, wc = wid & 3, fr = lane & 15, fq = lane >> 4;
    const int K = g.K, nt = K / BK;
    int RA[2], CA[2]; unsigned voffB[2];
#pragma unroll
    for (int i = 0; i < 2; ++i) { int R, C; stage_rc(tid * 16 + i * 8192, R, C); RA[i] = R; CA[i] = C; const int Rb = Epi::PERM ? ((R & ~31) + perm32(R & 31)) : R; voffB[i] = (unsigned)(Rb * K + C) * 2u; }
    const size_t kstep = (size_t)(BK * 2);
    const size_t hstep = (size_t)HALF * K * 2;
    const size_t tstep = 2 * hstep;
    const unsigned ldsw = (unsigned)wid * 1024u;
    const int aoff = lds_byte(wr * 64 + fr, fq * 8), boff = lds_byte(wc * 32 + fr, fq * 8);
#define PG8_SA(b, h) (((b) * 2 + (h)) * HTB)
#define PG8_SB(b, h) ((4 + (b) * 2 + (h)) * HTB)
#define PG8_STAGE(bufoff, gbase, voff) do { _Pragma("unroll") for (int _i = 0; _i < 2; ++_i) \
        __builtin_amdgcn_global_load_lds((const unsigned*)((const char*)(gbase) + (voff)[_i]), (PG8_LAS unsigned*)(lds + (bufoff) + ldsw + _i * 8192), 16, 0, 0); } while (0)
#define PG8_LDA(dst, b, h) do { _Pragma("unroll") for (int m = 0; m < 4; ++m) _Pragma("unroll") for (int k = 0; k < 2; ++k) dst[m][k] = *(const PG8_LAS bf16x8*)(lds + PG8_SA(b, h) + aoff + m * 2048 + k * 1024); } while (0)
#define PG8_LDB(dst, b, h) do { _Pragma("unroll") for (int n = 0; n < 2; ++n) _Pragma("unroll") for (int k = 0; k < 2; ++k) dst[n][k] = *(const PG8_LAS bf16x8*)(lds + PG8_SB(b, h) + boff + n * 2048 + k * 1024); } while (0)
#define PG8_MMA(ai, bj, At, Bt) do { __builtin_amdgcn_s_setprio(1); _Pragma("unroll") for (int m = 0; m < 4; ++m) _Pragma("unroll") for (int n = 0; n < 2; ++n) _Pragma("unroll") for (int k = 0; k < 2; ++k) \
        acc[ai][bj][m][n] = __builtin_amdgcn_mfma_f32_16x16x32_bf16(Bt[n][k], At[m][k], acc[ai][bj][m][n], 0, 0, 0); __builtin_amdgcn_s_setprio(0); } while (0)
#define PG8_WAIT_V(n) asm volatile("s_waitcnt vmcnt(" #n ")" ::: "memory")
#define PG8_WAIT_L(n) asm volatile("s_waitcnt lgkmcnt(" #n ")" ::: "memory")
#define PG8_BAR __builtin_amdgcn_s_barrier()
#define PG8_SCHED __builtin_amdgcn_sched_barrier(0)
    Unit cur, nxt; int ui = 0;
    if (!S.next(0, cur)) return;
    f32x4 acc[2][2][4][2];
#pragma unroll
    for (int a = 0; a < 2; ++a)
#pragma unroll
        for (int b = 0; b < 2; ++b)
#pragma unroll
            for (int m = 0; m < 4; ++m)
#pragma unroll
                for (int n = 0; n < 2; ++n) acc[a][b][m][n] = (f32x4){0.f, 0.f, 0.f, 0.f};
    bf16x8 At[4][2], B0[2][2], B1[2][2];
    unsigned oc[2][2];
    S.aoff(0, RA, CA, oc);
    const char* Ab = (const char*)g.A;
    const char* cB = (const char*)g.Bt + (size_t)cur.pn * tstep;
    PG8_STAGE(PG8_SB(0, 0), cB, voffB); PG8_STAGE(PG8_SB(0, 1), cB + hstep, voffB); PG8_STAGE(PG8_SA(0, 0), Ab, oc[0]); PG8_STAGE(PG8_SA(0, 1), Ab, oc[1]);
    if (wr == 1) PG8_BAR;
    PG8_WAIT_V(2); PG8_BAR;
    PG8_STAGE(PG8_SB(1, 0), cB + kstep, voffB); PG8_STAGE(PG8_SA(1, 0), Ab + kstep, oc[0]); PG8_STAGE(PG8_SB(1, 1), cB + hstep + kstep, voffB);
    PG8_WAIT_V(6); PG8_BAR;
    for (;;) {
        const bool has_next = S.next(ui + 1, nxt);
        const char* nB = has_next ? (const char*)g.Bt + (size_t)nxt.pn * tstep : cB;
        for (int t = 0; t < nt; t += 2) {
            const bool last = (t == nt - 2);
            const char* a1 = Ab + (size_t)(t + 1) * kstep;
            const char* a2 = last ? Ab : Ab + (size_t)(t + 2) * kstep; const char* b2 = last ? nB : cB + (size_t)(t + 2) * kstep;
            const char* a3 = a2 + kstep; const char* b3 = b2 + kstep;
            unsigned o2[2][2];
            if (last && has_next) S.aoff(ui + 1, RA, CA, o2);
            else { o2[0][0] = oc[0][0]; o2[0][1] = oc[0][1]; o2[1][0] = oc[1][0]; o2[1][1] = oc[1][1]; }
            PG8_LDB(B0, 0, 0); PG8_LDB(B1, 0, 1); PG8_SCHED; PG8_LDA(At, 0, 0); PG8_STAGE(PG8_SA(1, 1), a1, oc[1]);
            PG8_WAIT_V(8); PG8_WAIT_L(0); PG8_BAR; if (cur.nh != 2) PG8_MMA(0, 0, At, B0); if (cur.nh != 1) PG8_MMA(0, 1, At, B1); PG8_BAR; PG8_SCHED;
            PG8_LDA(At, 0, 1); PG8_STAGE(PG8_SB(0, 0), b2, voffB); PG8_STAGE(PG8_SB(0, 1), b2 + hstep, voffB); PG8_STAGE(PG8_SA(0, 0), a2, o2[0]);
            PG8_WAIT_V(8); PG8_WAIT_L(0); PG8_BAR; if (!cur.half) { if (cur.nh != 2) PG8_MMA(1, 0, At, B0); if (cur.nh != 1) PG8_MMA(1, 1, At, B1); } PG8_BAR; PG8_SCHED;
            PG8_LDB(B0, 1, 0); PG8_LDB(B1, 1, 1); PG8_SCHED; PG8_LDA(At, 1, 0); PG8_STAGE(PG8_SA(0, 1), a2, o2[1]);
            PG8_WAIT_V(8); PG8_WAIT_L(0); PG8_BAR; if (cur.nh != 2) PG8_MMA(0, 0, At, B0); if (cur.nh != 1) PG8_MMA(0, 1, At, B1); PG8_BAR; PG8_SCHED;
            PG8_LDA(At, 1, 1); PG8_STAGE(PG8_SB(1, 0), b3, voffB); PG8_STAGE(PG8_SB(1, 1), b3 + hstep, voffB); PG8_STAGE(PG8_SA(1, 0), a3, o2[0]);
            PG8_WAIT_V(8); PG8_WAIT_L(0); PG8_BAR; if (!cur.half) { if (cur.nh != 2) PG8_MMA(1, 0, At, B0); if (cur.nh != 1) PG8_MMA(1, 1, At, B1); } PG8_BAR; PG8_SCHED;
        }
        if (wr == 0) PG8_BAR;
        E(acc, cur, wr, wc, fr, fq);
        if (!has_next) break;
#pragma unroll
        for (int a = 0; a < 2; ++a)
#pragma unroll
            for (int b = 0; b < 2; ++b)
#pragma unroll
                for (int m = 0; m < 4; ++m)
#pragma unroll
                    for (int n = 0; n < 2; ++n) acc[a][b][m][n] = (f32x4){0.f, 0.f, 0.f, 0.f};
        cur = nxt; cB = nB; ++ui;
        S.aoff(ui, RA, CA, oc);
        if (wr == 1) PG8_BAR;
    }
    PG8_WAIT_V(0);
    PG8_BAR;
#undef PG8_SA
#undef PG8_SB
#undef PG8_STAGE
#undef PG8_LDA
#undef PG8_LDB
#undef PG8_MMA
#undef PG8_WAIT_V
#undef PG8_WAIT_L
#undef PG8_BAR
#undef PG8_SCHED
}

constexpr int MOE_MAXU = 4;
struct SchedMoe {
    const int* tp; const int* cn; const unsigned* tab;
    int NT, nU, G, c;
    __device__ __forceinline__ bool next(int i, Unit& u) const {
        if (i >= MOE_MAXU) return false;
        const long L = (long)i * G + c; if (L >= nU) return false;
        int wgid = (int)L; { const int q = nU / NXCD, r = nU % NXCD, xcd = wgid % NXCD, off = wgid / NXCD; wgid = (xcd < r ? xcd * (q + 1) : r * (q + 1) + (xcd - r) * q) + off; }
        const int ti = wgid / NT, pn = wgid - ti * NT;
        int e = 0; while (tp[e + 1] <= ti) ++e;
        u.pm = ti; u.pn = e * NT + pn; u.aux = i; u.half = (cn[e] - (ti - tp[e]) * BM <= HALF) ? 1 : 0; u.nh = 0; return true;
    }
    __device__ __forceinline__ void aoff(int ui, const int (&RA)[2], const int (&CA)[2], unsigned (&o)[2][2]) const {
#pragma unroll
        for (int h = 0; h < 2; ++h)
#pragma unroll
            for (int i = 0; i < 2; ++i) o[h][i] = tab[ui * 256 + h * HALF + RA[i]] + (unsigned)CA[i] * 2u;
    }
    __device__ __forceinline__ void a_ready(const Unit&) const {}
    __device__ __forceinline__ void done(const Unit&) const {}
};
__device__ __forceinline__ float silu_f(float x) { return x * __builtin_amdgcn_rcpf(1.f + __expf(-x)); }
__device__ __forceinline__ float sig_f(float x) { return __builtin_amdgcn_rcpf(1.f + __expf(-x)); }
struct EpiGlu256 {
    static constexpr bool PERM = true, AFTER_DRAIN = false;
    const bf16_t* Z; const float* b; bf16_t* mix;
    __device__ __forceinline__ void operator()(const f32x4 (&acc)[2][2][4][2], const Unit& u, int wr, int wc, int fr, int fq) const {
        const int row0 = u.pm * BM + wr * 64 + fr, col0 = u.pn * BM + wc * 32 + 8 * fq;
#pragma unroll
        for (int ai = 0; ai < 2; ++ai)
#pragma unroll
            for (int m = 0; m < 4; ++m) { const size_t r = (size_t)(row0 + ai * HALF + m * 16);
#pragma unroll
                for (int bj = 0; bj < 2; ++bj) { const int c = col0 + bj * HALF;
                    const u32x4 q = *(const u32x4*)(Z + r * 512 + c);
                    const f32x4 b0 = *(const f32x4*)(b + c), b1 = *(const f32x4*)(b + c + 4);
                    const f32x4 v0 = acc[ai][bj][m][0] + b0, v1 = acc[ai][bj][m][1] + b1;
                    const float z0 = __uint_as_float(q.x << 16), z1 = __uint_as_float(q.x & 0xffff0000u), z2 = __uint_as_float(q.y << 16), z3 = __uint_as_float(q.y & 0xffff0000u);
                    const float z4 = __uint_as_float(q.z << 16), z5 = __uint_as_float(q.z & 0xffff0000u), z6 = __uint_as_float(q.w << 16), z7 = __uint_as_float(q.w & 0xffff0000u);
                    u32x4 w; w.x = cvt_pk_bf16(z0 * sig_f(v0[0]), z1 * sig_f(v0[1])); w.y = cvt_pk_bf16(z2 * sig_f(v0[2]), z3 * sig_f(v0[3]));
                    w.z = cvt_pk_bf16(z4 * sig_f(v1[0]), z5 * sig_f(v1[1])); w.w = cvt_pk_bf16(z6 * sig_f(v1[2]), z7 * sig_f(v1[3]));
                    *(u32x4*)(mix + r * 1024 + c) = w; } }
    }
};

struct EpiMoeUp {
    static constexpr bool PERM = true, AFTER_DRAIN = false;
    bf16_t* H; const float* rtab;
    __device__ __forceinline__ void operator()(const f32x4 (&acc)[2][2][4][2], const Unit& u, int wr, int wc, int fr, int fq) const {
        const int row0 = u.pm * BM + wr * 64 + fr, f0 = (u.pn & 1) * 128 + wc * 32 + 8 * fq, tb = u.aux * 256 + wr * 64 + fr;
#pragma unroll
        for (int ai = 0; ai < 2; ++ai)
#pragma unroll
            for (int m = 0; m < 4; ++m) {
                const float r_ = rtab[tb + ai * HALF + m * 16];
                const f32x4 g0 = acc[ai][0][m][0] * r_, g1 = acc[ai][0][m][1] * r_, u0 = acc[ai][1][m][0] * r_, u1 = acc[ai][1][m][1] * r_;
                u32x4 w; w.x = cvt_pk_bf16(silu_f(g0[0]) * u0[0], silu_f(g0[1]) * u0[1]); w.y = cvt_pk_bf16(silu_f(g0[2]) * u0[2], silu_f(g0[3]) * u0[3]);
                w.z = cvt_pk_bf16(silu_f(g1[0]) * u1[0], silu_f(g1[1]) * u1[1]); w.w = cvt_pk_bf16(silu_f(g1[2]) * u1[2], silu_f(g1[3]) * u1[3]);
                *(u32x4*)(H + (size_t)(row0 + ai * HALF + m * 16) * 256 + f0) = w;
            }
    }
};
struct EpiMoeDown {
    static constexpr bool PERM = true, AFTER_DRAIN = false;
    bf16_t* Y; const unsigned* dtab; const float* wtab;
    __device__ __forceinline__ void operator()(const f32x4 (&acc)[2][2][4][2], const Unit& u, int wr, int wc, int fr, int fq) const {
        const int pn = u.pn & 3, tb = u.aux * 256 + wr * 64 + fr, col = pn * BM + wc * 32 + 8 * fq;
#pragma unroll
        for (int ai = 0; ai < 2; ++ai)
#pragma unroll
            for (int m = 0; m < 4; ++m) {
                const unsigned d = dtab[tb + ai * HALF + m * 16]; const float w = wtab[tb + ai * HALF + m * 16];
                if (d != 0xffffffffu) {
                    bf16_t* yr = Y + (size_t)d * 1024 + col;
#pragma unroll
                    for (int bj = 0; bj < 2; ++bj) { const f32x4 v0 = acc[ai][bj][m][0] * w, v1 = acc[ai][bj][m][1] * w;
                        u32x4 o; o.x = cvt_pk_bf16(v0[0], v0[1]); o.y = cvt_pk_bf16(v0[2], v0[3]); o.z = cvt_pk_bf16(v1[0], v1[1]); o.w = cvt_pk_bf16(v1[2], v1[3]);
                        *(u32x4*)(yr + bj * HALF) = o; }
                }
            }
    }
};
}

__device__ __forceinline__ void transpose_tile(const float* __restrict__ src, int ldn, bf16_t* __restrict__ dst, int ldk, float scale, const float* __restrict__ gam, float* scr, int lane) {
    float tv[32];
#pragma unroll
    for (int i = 0; i < 32; ++i) tv[i] = __builtin_nontemporal_load(src + (size_t)(2 * i + (lane >> 5)) * ldn + (lane & 31));
#pragma unroll
    for (int i = 0; i < 32; ++i) scr[(2 * i + (lane >> 5)) * 33 + (lane & 31)] = tv[i];
    LDS_WAIT();
    const int c = lane & 7;
    f32x4 ga = (f32x4){scale, scale, scale, scale}, gb = ga;
    if (gam) { ga = *(const f32x4*)(gam + 8 * c) * scale; gb = *(const f32x4*)(gam + 8 * c + 4) * scale; }
#pragma unroll
    for (int j = 0; j < 4; ++j) {
        const int n = (lane >> 3) + 8 * j; const float* s = scr + (8 * c) * 33 + n;
        u32x4 o; o.x = pk2(s[0] * ga.x, s[33] * ga.y); o.y = pk2(s[66] * ga.z, s[99] * ga.w); o.z = pk2(s[132] * gb.x, s[165] * gb.y); o.w = pk2(s[198] * gb.z, s[231] * gb.w);
        *(u32x4*)(dst + (size_t)n * ldk + 8 * c) = o;
    }
    LDS_WAIT();
}

__device__ __forceinline__ void rms_row(f32x4 (&v)[4], const float* __restrict__ w, bf16_t* __restrict__ xn, int lane) {
    float ss = 0.f;
#pragma unroll
    for (int j = 0; j < 4; ++j) ss += v[j].x * v[j].x + v[j].y * v[j].y + v[j].z * v[j].z + v[j].w * v[j].w;
    ss = wave_sum(ss);
    const float r = rsqrtf(ss * (1.f / 1024.f) + EPS);
#pragma unroll
    for (int j = 0; j < 4; ++j) {
        const f32x4 w4 = *(const f32x4*)(w + 4 * lane + 256 * j);
        v[j] = v[j] * r * w4;
        u32x2 o; o.x = pk2(v[j].x, v[j].y); o.y = pk2(v[j].z, v[j].w);
        *(u32x2*)(xn + 4 * lane + 256 * j) = o;
    }
}

constexpr int DENSE_IT_WINA = 112 * 16, DENSE_IT_TOTAL = 112 * 16 + 32 * 16 + 80 * 16 + 32 * 16 + 16 * 8;
__device__ __forceinline__ void dense_transposes(const Params& p, unsigned char* lds, int it_lo, int it_hi, int gw, int NGW, int wid, int lane) {
    unsigned char* ws = p.ws;
    float* scr = (float*)(lds + wid * 8704);
    constexpr int IT_WINA = 112 * 16, IT_WOUT = 32 * 16, IT_WINC = 80 * 16, IT_WGLU = 16 * 8;
    constexpr int IT_TOTAL = IT_WINA + IT_WOUT + IT_WINC + IT_WOUT + IT_WGLU;
    for (int it0 = it_lo + gw; it0 < it_hi; it0 += NGW) {
        int it = it0; const float* src; bf16_t* dst; int ldn, ldk; float scale = 1.f; const float* gam = nullptr;
        if (it < IT_WINA) {
            const int n0 = (it >> 4) * 32, k0 = (it & 15) * 64, srcn = n0 < 2048 ? n0 : n0 + 8;
            if (n0 >= 512 && n0 < 1024) scale = 0.08838834764831845f;
            src = p.in[I_AB_WIN] + (size_t)k0 * 3592 + srcn; ldn = 3592; dst = (bf16_t*)(ws + WS_WINA) + (size_t)n0 * 1024 + k0; ldk = 1024; gam = p.in[I_NORM_MIX] + k0;
        } else if ((it -= IT_WINA) < IT_WOUT) {
            const int n0 = (it >> 4) * 32, k0 = (it & 15) * 64;
            src = p.in[I_AB_WOUT] + (size_t)k0 * 1024 + n0; ldn = 1024; dst = (bf16_t*)(ws + WS_WOUTA) + (size_t)n0 * 1024 + k0; ldk = 1024;
        } else if ((it -= IT_WOUT) < IT_WINC) {
            const int n0 = (it >> 4) * 32, k0 = (it & 15) * 64;
            src = p.in[I_CD_WIN] + (size_t)k0 * 2560 + n0; ldn = 2560; dst = (bf16_t*)(ws + WS_WINC) + (size_t)n0 * 1024 + k0; ldk = 1024; gam = p.in[I_NORM_MIX] + 1024 + k0;
        } else if ((it -= IT_WINC) < IT_WOUT) {
            const int n0 = (it >> 4) * 32, k0 = (it & 15) * 64;
            src = p.in[I_CD_WOUT] + (size_t)k0 * 1024 + n0; ldn = 1024; dst = (bf16_t*)(ws + WS_WOUTC) + (size_t)n0 * 1024 + k0; ldk = 1024;
        } else {
            it -= IT_WOUT;
            const int n0 = (it >> 3) * 32, k0 = (it & 7) * 64;
            src = p.in[I_S5_WGLU] + (size_t)k0 * 512 + n0; ldn = 512; dst = (bf16_t*)(ws + WS_WGLU) + (size_t)n0 * 512 + k0; ldk = 512;
        }
        transpose_tile(src, ldn, dst, ldk, scale, gam, scr, lane);
    }
}

__device__ __forceinline__ void phase_prep(const Params& p, unsigned char* lds) {
    const int tid = opaque_tid(), lane = tid & 63, wid = tid >> 6;
    const int gw = blockIdx.x * 8 + wid, NGW = gridDim.x * 8;
    const int gt = blockIdx.x * NTHR + tid, NGT = gridDim.x * NTHR;
    unsigned char* ws = p.ws;
    if (blockIdx.x == 0 && tid < 64) ((int*)(ws + WS_CNT))[(tid >> 5) * 1024 + (tid & 31) * 32] = 0;
    for (int idx = (tid < 8 ? blockIdx.x * 8 + tid : 2048); idx < 2048; idx += gridDim.x * 8) {
        const int g = idx >> 6;
        f32x4 bre[4], bim[4];
#pragma unroll
        for (int q = 0; q < 4; ++q) { bre[q] = *(const f32x4*)(p.in[I_S5_BRE] + (size_t)idx * 16 + q * 4); bim[q] = *(const f32x4*)(p.in[I_S5_BIM] + (size_t)idx * 16 + q * 4); }
        const double lr = p.in[I_S5_LRE][idx], li = p.in[I_S5_LIM][idx], dt = exp((double)p.in[I_S5_LOGDT][g]);
        const double zr = lr * dt, zi = li * dt, ez = exp(zr);
        const double br = ez * cos(zi), bi = ez * sin(zi);
        double pr = 1.0, pi = 0.0;
        for (int tau = 0; tau <= 16; ++tau) {
            ((f32x2*)(ws + WS_S5POW))[idx * 17 + tau] = (f32x2){(float)pr, (float)pi};
            const double nr = pr * br - pi * bi, ni = pr * bi + pi * br; pr = nr; pi = ni;
        }
        const double ar = br - 1.0, ai = bi, den = lr * lr + li * li;
        const double cr = (ar * lr + ai * li) / den, ci = (ai * lr - ar * li) / den;
#pragma unroll
        for (int c = 0; c < 16; ++c) {
            const double b_r = bre[c >> 2][c & 3], b_i = bim[c >> 2][c & 3];
            ((f32x2*)(ws + WS_S5BBAR))[idx * 16 + c] = (f32x2){(float)(cr * b_r - ci * b_i), (float)(cr * b_i + ci * b_r)};
        }
    }
    const int rf_per = (2 * 32 * 3 * 64 + (int)gridDim.x - 1) / (int)gridDim.x;
    for (int idx = (tid >= 64 && tid - 64 < rf_per) ? (int)blockIdx.x * rf_per + (tid - 64) : 2 * 32 * 3 * 64; idx < min(((int)blockIdx.x + 1) * rf_per, 2 * 32 * 3 * 64); idx += 2 * 32 * 3 * 64) {
        const int l = idx / (32 * 3 * 64), rem = idx - l * (32 * 3 * 64), ks = rem / 192, r2 = rem - ks * 192, nt_ = r2 >> 6, ln = r2 & 63, col = nt_ * 16 + (ln & 15);
        float v[8];
#pragma unroll
        for (int j = 0; j < 8; ++j) {
            const int k = ks * 32 + (ln >> 4) * 8 + j;
            float w = 0.f;
            if (col < 32) w = p.in[I_MOE_WR][(size_t)(l * 1024 + k) * 32 + col];
            else if (col < 36) w = p.in[I_MOE_WG][(size_t)(l * 1024 + k) * 4 + (col - 32)];
            v[j] = w * p.in[I_NORM_FFN][l * 1024 + k];
        }
        unsigned hi[4], lo[4];
#pragma unroll
        for (int q = 0; q < 4; ++q) {
            const unsigned h0 = f2bf(v[2 * q]), h1 = f2bf(v[2 * q + 1]);
            hi[q] = h0 | (h1 << 16);
            lo[q] = pk2(v[2 * q] - bf2f(h0), v[2 * q + 1] - bf2f(h1));
        }
        bf16_t* wf = (bf16_t*)(ws + WS_WCAT);
        *(u32x4*)(wf + ((size_t)(l * 2 + 0) * 6144 + (size_t)(ks * 3 + nt_) * 64 + ln) * 8) = (u32x4){hi[0], hi[1], hi[2], hi[3]};
        *(u32x4*)(wf + ((size_t)(l * 2 + 1) * 6144 + (size_t)(ks * 3 + nt_) * 64 + ln) * 8) = (u32x4){lo[0], lo[1], lo[2], lo[3]};
    }
    dense_transposes(p, lds, 0, ((int)gridDim.x > 960 % (int)gridDim.x && 960 % (int)gridDim.x != 0) ? DENSE_IT_WINA : DENSE_IT_TOTAL, gw, NGW, wid, lane);
    {
        bf16_t* wg = (bf16_t*)(ws + WS_WINA) + (size_t)3584 * 1024;
        const float* win = p.in[I_AB_WIN];
        for (int idx = gt; idx < 256 * 1024; idx += NGT) {
            const int n = idx >> 10, k = idx & 1023;
            wg[idx] = (bf16_t)(n < 8 ? f2bf(win[(size_t)k * 3592 + 2048 + n] * p.in[I_NORM_MIX][k]) : 0u);
        }
    }
    const float* x = p.in[I_X];
    f32x4 vn[4];
    if (gw < T) {
#pragma unroll
        for (int j = 0; j < 4; ++j) vn[j] = __builtin_nontemporal_load((const f32x4*)(x + (size_t)gw * 1024 + 4 * lane + 256 * j));
    }
    for (int row = gw; row < T; row += NGW) {
        f32x4 v[4];
#pragma unroll
        for (int j = 0; j < 4; ++j) v[j] = vn[j];
        if (row + NGW < T) {
#pragma unroll
            for (int j = 0; j < 4; ++j) vn[j] = __builtin_nontemporal_load((const f32x4*)(x + (size_t)(row + NGW) * 1024 + 4 * lane + 256 * j));
        }
        {
            bf16_t* h16 = (bf16_t*)(ws + WS_H16) + (size_t)row * 1024;
#pragma unroll
            for (int j = 0; j < 4; ++j) { u32x2 o; o.x = pk2(v[j].x, v[j].y); o.y = pk2(v[j].z, v[j].w); *(u32x2*)(h16 + 4 * lane + 256 * j) = o; }
        }
        float ss = 0.f;
#pragma unroll
        for (int j = 0; j < 4; ++j) ss += v[j].x * v[j].x + v[j].y * v[j].y + v[j].z * v[j].z + v[j].w * v[j].w;
        ss = wave_sum(ss);
        if (lane == 0) ((float*)(ws + WS_RSTD))[row] = rsqrtf(ss * (1.f / 1024.f) + EPS);
    }
}

struct EpiStoreBf16 {
    bf16_t* O; int ldc;
    __device__ __forceinline__ void operator()(const f32x4 (&acc)[2][4], int wr, int wc, int fr, int fq) const {
#pragma unroll
        for (int m = 0; m < 2; ++m)
#pragma unroll
            for (int n = 0; n < 4; ++n) {
                const f32x4 v = acc[m][n]; u32x2 o; o.x = pk2(v.x, v.y); o.y = pk2(v.z, v.w);
                *(u32x2*)(O + (size_t)(wr * 32 + m * 16 + fr) * ldc + wc * 64 + n * 16 + fq * 4) = o;
            }
    }
};
struct EpiResidF32 {
    const float* resid; float* out;
    __device__ __forceinline__ void operator()(const f32x4 (&acc)[2][4], int wr, int wc, int fr, int fq) const {
#pragma unroll
        for (int m = 0; m < 2; ++m)
#pragma unroll
            for (int n = 0; n < 4; ++n) {
                const size_t off = (size_t)(wr * 32 + m * 16 + fr) * 1024 + wc * 64 + n * 16 + fq * 4;
                const f32x4 r = *(const f32x4*)(resid + off);
                *(f32x4*)(out + off) = r + acc[m][n];
            }
    }
};
struct EpiGlu {
    const bf16_t* Z; const float* b; bf16_t* mix;
    __device__ __forceinline__ void operator()(const f32x4 (&acc)[2][4], int wr, int wc, int fr, int fq) const {
#pragma unroll
        for (int m = 0; m < 2; ++m)
#pragma unroll
            for (int n = 0; n < 4; ++n) {
                const int r = wr * 32 + m * 16 + fr, c = wc * 64 + n * 16 + fq * 4;
                const u32x2 zz = *(const u32x2*)(Z + (size_t)r * 512 + c);
                const f32x4 bb = *(const f32x4*)(b + c);
                const f32x4 v = acc[m][n] + bb;
                const float z0 = bf2f(zz.x & 0xffffu), z1 = bf2f(zz.x >> 16), z2 = bf2f(zz.y & 0xffffu), z3 = bf2f(zz.y >> 16);
                u32x2 o; o.x = pk2(z0 * fsigmoid_(v.x), z1 * fsigmoid_(v.y)); o.y = pk2(z2 * fsigmoid_(v.z), z3 * fsigmoid_(v.w));
                *(u32x2*)(mix + (size_t)r * 1024 + c) = o;
            }
    }
};

__device__ __forceinline__ void phase_gemm_store(unsigned char* lds, const bf16_t* A, const bf16_t* Bt, int N, int K, bf16_t* O, int ldc) {
    const int nN = N >> 7, nU = (T >> 7) * nN;
    for (int u = blockIdx.x; u < nU; u += gridDim.x) {
        const int pm = u / nN, pn = u - pm * nN;
        APlain ap{A + (size_t)pm * 128 * K, K};
        EpiStoreBf16 e{O + (size_t)pm * 128 * ldc + pn * 128, ldc};
        gemm128(lds, ap, Bt + (size_t)pn * 128 * K, K, e);
    }
}
__device__ __forceinline__ void phase_gemm_resid(unsigned char* lds, const bf16_t* A, const bf16_t* Bt, const float* resid, float* out) {
    const int nU = (T >> 7) * 8;
    for (int u = blockIdx.x; u < nU; u += gridDim.x) {
        const int pm = u >> 3, pn = u & 7;
        APlain ap{A + (size_t)pm * 128 * 1024, 1024};
        const size_t off = (size_t)pm * 128 * 1024 + pn * 128;
        EpiResidF32 e{resid + off, out + off};
        gemm128(lds, ap, Bt + (size_t)pn * 128 * 1024, 1024, e);
    }
}
__device__ __forceinline__ void phase_gemm_glu(unsigned char* lds, const Params& p) {
    pg8::Gemm g{(const bf16_t*)(p.ws + WS_Z), (const bf16_t*)(p.ws + WS_WGLU), T, 512, 512}; pg8::StaticOrder S; S.init(T, 512, (int)gridDim.x, (int)blockIdx.x);
    pg8::EpiGlu256 E{(const bf16_t*)(p.ws + WS_Z), p.in[I_S5_BGLU], (bf16_t*)(p.ws + WS_MIX)};
    pg8::gemm_phase<pg8::EpiGlu256, pg8::StaticOrder, true, true>((PG8_LAS unsigned char*)lds, g, S, E);
}
__device__ __forceinline__ void phase_gemm256_store(unsigned char* lds, const bf16_t* A, const bf16_t* Bt, int N, bf16_t* O) {
    pg8::Gemm g{A, Bt, T, N, 1024}; pg8::StaticOrder S; S.init(T, N, (int)gridDim.x, (int)blockIdx.x);
    pg8::EpiStore E{O, N, nullptr, nullptr};
    pg8::gemm_phase<pg8::EpiStore, pg8::StaticOrder, true, true>((PG8_LAS unsigned char*)lds, g, S, E);
}
__device__ __forceinline__ void phase_gemm256_inproj1(unsigned char* lds, const Params& p) {
    pg8::Gemm g{(const bf16_t*)(p.ws + WS_H16), (const bf16_t*)(p.ws + WS_WINC), T, PC, 1024}; pg8::StaticOrderHalfTail S; S.init(T, 8 * 256, (int)gridDim.x, (int)blockIdx.x); S.nNF = 8; S.nNT = 2;
    pg8::EpiStore E{(bf16_t*)(p.ws + WS_PROJ), PC, (const float*)(p.ws + WS_RSTD) + T, (bf16_t*)(p.ws + WS_UP)};
    pg8::gemm_phase<pg8::EpiStore, pg8::StaticOrderHalfTail, true, true>((PG8_LAS unsigned char*)lds, g, S, E);
}
__device__ __forceinline__ void phase_gemm256_inproj0(unsigned char* lds, const Params& p) {
    pg8::Gemm g{(const bf16_t*)(p.ws + WS_H16), (const bf16_t*)(p.ws + WS_WINA), T, 3840, 1024}; pg8::StaticOrder S; S.init(T, 3840, (int)gridDim.x, (int)blockIdx.x);
    pg8::EpiStoreGates E{(bf16_t*)(p.ws + WS_PROJ), PA, 14, (float*)(p.ws + WS_GATES), p.in[I_AB_GBIAS], (const float*)(p.ws + WS_RSTD)};
    pg8::gemm_phase<pg8::EpiStoreGates, pg8::StaticOrder, true, true>((PG8_LAS unsigned char*)lds, g, S, E);
}
__device__ __forceinline__ void phase_gemm256_resid(unsigned char* lds, const bf16_t* A, const bf16_t* Bt, const float* rf, const bf16_t* rb, bf16_t* out) {
    pg8::Gemm g{A, Bt, T, 1024, 1024}; pg8::StaticOrder S; S.init(T, 1024, (int)gridDim.x, (int)blockIdx.x);
    pg8::EpiResid E{rf, rb, out};
    pg8::gemm_phase<pg8::EpiResid, pg8::StaticOrder, true, true>((PG8_LAS unsigned char*)lds, g, S, E);
}

__device__ __forceinline__ void s5_gen_ktab(const Params& p) {
    const int tid = opaque_tid(), lane = tid & 63, wid = tid >> 6, i = lane & 15, kq = lane >> 4;
    const f32x2* POW = (const f32x2*)(p.ws + WS_S5POW); const f32x2* BB = (const f32x2*)(p.ws + WS_S5BBAR);
    for (int u = wid * (int)gridDim.x + (int)blockIdx.x; u < 512; u += 8 * (int)gridDim.x) {
        const int g = u >> 4, tau = u & 15;
        f32x4 acc = (f32x4){0.f, 0.f, 0.f, 0.f};
#pragma unroll 8
        for (int s_ = 0; s_ < 16; ++s_) {
            const int pp = 4 * s_ + kq;
            const f32x2 l = POW[(g * 64 + pp) * 17 + tau], b = BB[(g * 64 + pp) * 16 + i];
            const float wre = l.x * b.x - l.y * b.y, wim = l.x * b.y + l.y * b.x;
            const float cre = p.in[I_S5_CRE][(size_t)(g * 16 + i) * 64 + pp], cim = p.in[I_S5_CIM][(size_t)(g * 16 + i) * 64 + pp];
            acc = __builtin_amdgcn_mfma_f32_16x16x4f32(cre, wre, acc, 0, 0, 0);
            acc = __builtin_amdgcn_mfma_f32_16x16x4f32(-cim, wim, acc, 0, 0, 0);
        }
#pragma unroll
        for (int r = 0; r < 4; ++r) {
            const int ch = 4 * kq + r;
            float v = acc[r];
            if (tau == 0 && ch == i) v += p.in[I_S5_D][g * 16 + ch];
            ((float*)(p.ws + WS_KTAB))[((g * 16 + tau) * 16 + ch) * 16 + i] = v;
        }
    }
}
__device__ __forceinline__ void s5_gen_ops(const Params& p) {
    const int gt = blockIdx.x * NTHR + opaque_tid(), NGT = gridDim.x * NTHR;
    const f32x2* POW = (const f32x2*)(p.ws + WS_S5POW); const f32x2* BB = (const f32x2*)(p.ws + WS_S5BBAR);
    const float* KT = (const float*)(p.ws + WS_KTAB);
    bf16_t* BY = (bf16_t*)(p.ws + WS_S5Y); bf16_t* BE = (bf16_t*)(p.ws + WS_S5E);
    constexpr int NA = 32 * 256 * 32, NB = 32 * 256 * 8, NE = 32 * 128 * 32;
    for (int r = 0;; ++r) {
        const int ia0 = gt + 2 * r * NGT, ia1 = ia0 + NGT, ib = gt + r * NGT;
        if (ia0 >= NA && ib >= NE) break;
        f32x4 ta[2][2];
#pragma unroll
        for (int q = 0; q < 2; ++q) {
            const int idx = q ? ia1 : ia0;
            ta[q][0] = (f32x4){0.f, 0.f, 0.f, 0.f}; ta[q][1] = ta[q][0];
            if (idx < NA) {
                const int kc = idx & 31, gn = idx >> 5, n = gn & 255, g = gn >> 8, t = n >> 4, ch = n & 15, k0 = kc * 8, s_ = k0 >> 4, c0 = k0 & 15;
                if (s_ <= t) { const float* kp = KT + ((g * 16 + (t - s_)) * 16 + ch) * 16 + c0; ta[q][0] = *(const f32x4*)kp; ta[q][1] = *(const f32x4*)(kp + 4); }
            }
        }
        f32x4 cr0, cr1, ci0, ci1; f32x2 lb[8];
        if (ib < NB) {
            const int pc = ib & 7, gn = ib >> 3, n = gn & 255, g = gn >> 8, t = n >> 4, ch = n & 15, p0 = pc * 8;
            const float* crp = p.in[I_S5_CRE] + (size_t)(g * 16 + ch) * 64 + p0; const float* cip = p.in[I_S5_CIM] + (size_t)(g * 16 + ch) * 64 + p0;
            cr0 = *(const f32x4*)crp; cr1 = *(const f32x4*)(crp + 4); ci0 = *(const f32x4*)cip; ci1 = *(const f32x4*)(cip + 4);
#pragma unroll
            for (int j = 0; j < 8; ++j) lb[j] = POW[(g * 64 + p0 + j) * 17 + t + 1];
        }
        f32x2 le, be[8];
        if (ib < NE) {
            const int kc = ib & 31, gn = ib >> 5, n = gn & 127, g = gn >> 7, pp = n & 63, k0 = kc * 8, s_ = k0 >> 4, c0 = k0 & 15;
            le = POW[(g * 64 + pp) * 17 + 15 - s_];
#pragma unroll
            for (int j = 0; j < 8; ++j) be[j] = BB[(g * 64 + pp) * 16 + c0 + j];
        }
#pragma unroll
        for (int q = 0; q < 2; ++q) {
            const int idx = q ? ia1 : ia0;
            if (idx < NA) { const f32x4 a = ta[q][0], b = ta[q][1]; *(u32x4*)(BY + (size_t)(idx >> 5) * 384 + (idx & 31) * 8) = (u32x4){pk2(a.x, a.y), pk2(a.z, a.w), pk2(b.x, b.y), pk2(b.z, b.w)}; }
        }
        if (ib < NB) {
            const int p0 = (ib & 7) * 8, gn = ib >> 3;
            const float cr[8] = {cr0.x, cr0.y, cr0.z, cr0.w, cr1.x, cr1.y, cr1.z, cr1.w}, ci[8] = {ci0.x, ci0.y, ci0.z, ci0.w, ci1.x, ci1.y, ci1.z, ci1.w};
            float vr[8], vi[8];
#pragma unroll
            for (int j = 0; j < 8; ++j) { vr[j] = cr[j] * lb[j].x - ci[j] * lb[j].y; vi[j] = -(cr[j] * lb[j].y + ci[j] * lb[j].x); }
            *(u32x4*)(BY + (size_t)gn * 384 + 256 + p0) = (u32x4){pk2(vr[0], vr[1]), pk2(vr[2], vr[3]), pk2(vr[4], vr[5]), pk2(vr[6], vr[7])};
            *(u32x4*)(BY + (size_t)gn * 384 + 320 + p0) = (u32x4){pk2(vi[0], vi[1]), pk2(vi[2], vi[3]), pk2(vi[4], vi[5]), pk2(vi[6], vi[7])};
        }
        if (ib < NE) {
            const int gn = ib >> 5, n = gn & 127, k0 = (ib & 31) * 8;
            float v[8];
#pragma unroll
            for (int j = 0; j < 8; ++j) v[j] = (n < 64) ? (le.x * be[j].x - le.y * be[j].y) : (le.x * be[j].y + le.y * be[j].x);
            *(u32x4*)(BE + (size_t)gn * 256 + k0) = (u32x4){pk2(v[0], v[1]), pk2(v[2], v[3]), pk2(v[4], v[5]), pk2(v[6], v[7])};
        }
    }
}
struct AS5 {
    const bf16_t* up; const bf16_t* xp; int m0, g;
    __device__ __forceinline__ const bf16_t* operator()(int r, int kc) const {
        const int m = m0 + r, k0 = kc * 8;
        return (k0 < 256) ? up + ((size_t)g * T * 16 + (size_t)m * 256 + k0) : xp + ((size_t)m * 32 + g) * 128 + (k0 - 256);
    }
};
struct EpiS5E {
    float* xend; int m0, g;
    __device__ __forceinline__ void operator()(const f32x4 (&acc)[2][4], int wr, int wc, int fr, int fq) const {
#pragma unroll
        for (int m = 0; m < 2; ++m)
#pragma unroll
            for (int n = 0; n < 4; ++n) *(f32x4*)(xend + ((size_t)(m0 + wr * 32 + m * 16 + fr) * 32 + g) * 128 + wc * 64 + n * 16 + fq * 4) = acc[m][n];
    }
};
struct EpiS5Y {
    bf16_t* Z; int m0, g, n0;
    __device__ __forceinline__ void operator()(const f32x4 (&acc)[2][4], int wr, int wc, int fr, int fq) const {
#pragma unroll
        for (int m = 0; m < 2; ++m)
#pragma unroll
            for (int n = 0; n < 4; ++n) {
                const int mm = m0 + wr * 32 + m * 16 + fr, nc = n0 + wc * 64 + n * 16 + fq * 4, t = nc >> 4, ch0 = nc & 15;
                const f32x4 v = acc[m][n];
                u32x2 o; o.x = pk2(fgelu_tanh_(v.x), fgelu_tanh_(v.y)); o.y = pk2(fgelu_tanh_(v.z), fgelu_tanh_(v.w));
                *(u32x2*)(Z + (size_t)(mm * 16 + t) * 512 + g * 16 + ch0) = o;
            }
    }
};
__device__ __forceinline__ void s5_unit_E(const Params& p, unsigned char* lds, int u) {
    const int g = 4 * (u & 7) + ((u >> 3) & 3), mt = u >> 5;
    AS5 a{(const bf16_t*)(p.ws + WS_UP), nullptr, mt * 128, g};
    EpiS5E e{(float*)(p.ws + WS_XEND), mt * 128, g};
    gemm128(lds, a, (const bf16_t*)(p.ws + WS_S5E) + (size_t)g * 128 * 256, 256, e);
}
__device__ __forceinline__ void s5_unit_Y(const Params& p, unsigned char* lds, int u) {
    const int g = 4 * (u & 7) + ((u >> 3) & 3), mt = u >> 5;
    AS5 a{(const bf16_t*)(p.ws + WS_UP), (const bf16_t*)(p.ws + WS_XPREVB), mt * 128, g};
    EpiS5Y e0{(bf16_t*)(p.ws + WS_Z), mt * 128, g, 0}, e1{(bf16_t*)(p.ws + WS_Z), mt * 128, g, 128};
    BPlain b0{(const bf16_t*)(p.ws + WS_S5Y) + (size_t)g * 256 * 384, 384}, b1{(const bf16_t*)(p.ws + WS_S5Y) + ((size_t)g * 256 + 128) * 384, 384};
    gemm128x2(lds, a, b0, b1, 384, e0, e1);
}

__device__ __forceinline__ void stage_rows(const bf16_t* __restrict__ g, int pitch, bf16_t* s, int tid) {
#pragma unroll
    for (int i = 0; i < 2; ++i) { const int pc = tid + i * NTHR, l = pc >> 4, d0 = (pc & 15) * 8; *(u32x4*)(s + l * 136 + d0) = *(const u32x4*)(g + (size_t)l * pitch + d0); }
}
__device__ __forceinline__ void stage_transposed(const bf16_t* __restrict__ g, int pitch, bf16_t* s, const float* rs, int tid) {
#pragma unroll
    for (int i = 0; i < 2; ++i) {
        const int pc = tid + i * NTHR, l = pc >> 4, d0 = (pc & 15) * 8;
        const u32x4 v = *(const u32x4*)(g + (size_t)l * pitch + d0);
        const float sc = rs ? rs[l] : 1.f;
        const unsigned w[4] = {v.x, v.y, v.z, v.w};
#pragma unroll
        for (int q = 0; q < 4; ++q) {
            s[tsw(d0 + 2 * q, l)] = (bf16_t)f2bf(bf2f(w[q] & 0xffffu) * sc);
            s[tsw(d0 + 2 * q + 1, l)] = (bf16_t)f2bf(bf2f(w[q] >> 16) * sc);
        }
    }
}
__device__ __forceinline__ void state_outer(const bf16_t* Kt, const bf16_t* Vt, bf16_t* __restrict__ Uout, int wid, int fr, int fq) {
    const int v0 = wid * 16;
    bf16x8 bv[2];
#pragma unroll
    for (int ls = 0; ls < 2; ++ls) bv[ls] = *(const bf16x8*)(Vt + tswc(v0 + fr, ls * 4 + fq));
#pragma unroll
    for (int kt = 0; kt < 8; ++kt) {
        f32x4 acc = (f32x4){0.f, 0.f, 0.f, 0.f};
#pragma unroll
        for (int ls = 0; ls < 2; ++ls) {
            const bf16x8 ak = *(const bf16x8*)(Kt + tswc(kt * 16 + fr, ls * 4 + fq));
            acc = __builtin_amdgcn_mfma_f32_16x16x32_bf16(ak, bv[ls], acc, 0, 0, 0);
        }
        u32x2 o; o.x = pk2(acc.x, acc.y); o.y = pk2(acc.z, acc.w);
        *(u32x2*)(Uout + (size_t)(v0 + fr) * 128 + kt * 16 + fq * 4) = o;
    }
}
template <bool KRM>
__device__ __forceinline__ void state_outer_tr(const bf16_t* Kx, const bf16_t* Vs, bf16_t* __restrict__ Uout, int wid, int fr, int fq) {
    const int v0 = wid * 16;
    bf16x8 bv[2];
#pragma unroll
    for (int ls = 0; ls < 2; ++ls) bv[ls] = frag_tr(Vs, 136, ls * 32, v0, fr, fq);
#pragma unroll
    for (int kt = 0; kt < 8; ++kt) {
        f32x4 acc = (f32x4){0.f, 0.f, 0.f, 0.f};
#pragma unroll
        for (int ls = 0; ls < 2; ++ls) {
            const bf16x8 ak = KRM ? frag_tr(Kx, 136, ls * 32, kt * 16, fr, fq) : *(const bf16x8*)(Kx + tswc(kt * 16 + fr, ls * 4 + fq));
            acc = __builtin_amdgcn_mfma_f32_16x16x32_bf16(ak, bv[ls], acc, 0, 0, 0);
        }
        u32x2 o; o.x = pk2(acc.x, acc.y); o.y = pk2(acc.z, acc.w);
        *(u32x2*)(Uout + (size_t)(v0 + fr) * 128 + kt * 16 + fq * 4) = o;
    }
}
template <int GATE>
__device__ __forceinline__ void head_norm_out(const float* Hs, const float* __restrict__ w, const bf16_t* __restrict__ gsrc, int gpitch, bf16_t* __restrict__ out, int opitch, int tid) {
    const int l = tid >> 3, part = tid & 7;
    float h[16]; float ss = 0.f;
#pragma unroll
    for (int i = 0; i < 4; ++i) { const f32x4 v = *(const f32x4*)(Hs + l * 132 + part * 16 + i * 4); h[4 * i] = v.x; h[4 * i + 1] = v.y; h[4 * i + 2] = v.z; h[4 * i + 3] = v.w; ss += v.x * v.x + v.y * v.y + v.z * v.z + v.w * v.w; }
    ss += __shfl_xor(ss, 1); ss += __shfl_xor(ss, 2); ss += __shfl_xor(ss, 4);
    const float r = rsqrtf(ss * (1.f / 128.f) + EPS);
    const u32x4 g0 = *(const u32x4*)(gsrc + (size_t)l * gpitch + part * 16), g1 = *(const u32x4*)(gsrc + (size_t)l * gpitch + part * 16 + 8);
    const unsigned gw[8] = {g0.x, g0.y, g0.z, g0.w, g1.x, g1.y, g1.z, g1.w};
    unsigned ow[8];
#pragma unroll
    for (int q = 0; q < 8; ++q) {
        const float ga = bf2f(gw[q] & 0xffffu), gb = bf2f(gw[q] >> 16);
        const float a = h[2 * q] * r * w[part * 16 + 2 * q] * (GATE == 0 ? fsigmoid_(ga) : fsilu_(ga));
        const float b = h[2 * q + 1] * r * w[part * 16 + 2 * q + 1] * (GATE == 0 ? fsigmoid_(gb) : fsilu_(gb));
        ow[q] = pk2(a, b);
    }
    *(u32x4*)(out + (size_t)l * opitch + part * 16) = (u32x4){ow[0], ow[1], ow[2], ow[3]};
    *(u32x4*)(out + (size_t)l * opitch + part * 16 + 8) = (u32x4){ow[4], ow[5], ow[6], ow[7]};
}


struct Tile2 { u32x4 v[2]; };
struct Tile4 { u32x4 v[4]; };
template <bool NT = false>
__device__ __forceinline__ void tile_load(Tile2& t, const bf16_t* __restrict__ g, int pitch, int tid) {
#pragma unroll
    for (int i = 0; i < 2; ++i) { const int pc = tid + i * NTHR; const u32x4* q = (const u32x4*)(g + (size_t)(pc >> 4) * pitch + (pc & 15) * 8); t.v[i] = NT ? __builtin_nontemporal_load(q) : *q; }
}
template <bool NT = false>
__device__ __forceinline__ void tile4_load(Tile4& t, const bf16_t* __restrict__ g, int tid) {
#pragma unroll
    for (int i = 0; i < 4; ++i) { const int pc = tid + i * NTHR; const u32x4* q = (const u32x4*)(g + (size_t)pc * 8); t.v[i] = NT ? __builtin_nontemporal_load(q) : *q; }
}
__device__ __forceinline__ void tile_put_rows(const Tile2& t, bf16_t* s, int tid) {
#pragma unroll
    for (int i = 0; i < 2; ++i) { const int pc = tid + i * NTHR; *(u32x4*)(s + (pc >> 4) * 136 + (pc & 15) * 8) = t.v[i]; }
}
__device__ __forceinline__ void tile4_put(const Tile4& t, bf16_t* s, int tid) {
#pragma unroll
    for (int i = 0; i < 4; ++i) { const int pc = tid + i * NTHR; *(u32x4*)(s + (pc >> 4) * 136 + (pc & 15) * 8) = t.v[i]; }
}
__device__ __forceinline__ void tile_put_transposed(const Tile2& t, bf16_t* s, const float* rs, int tid) {
#pragma unroll
    for (int i = 0; i < 2; ++i) {
        const int pc = tid + i * NTHR, l = pc >> 4, d0 = (pc & 15) * 8;
        const unsigned w[4] = {t.v[i].x, t.v[i].y, t.v[i].z, t.v[i].w};
        if (rs) {
            const float sc = rs[l];
#pragma unroll
            for (int q = 0; q < 4; ++q) {
                const unsigned pr = pk2(bf2f(w[q] & 0xffffu) * sc, bf2f(w[q] >> 16) * sc);
                s[tsw(d0 + 2 * q, l)] = (bf16_t)(pr & 0xffffu); s[tsw(d0 + 2 * q + 1, l)] = (bf16_t)(pr >> 16);
            }
        } else {
#pragma unroll
            for (int q = 0; q < 4; ++q) { s[tsw(d0 + 2 * q, l)] = (bf16_t)(w[q] & 0xffffu); s[tsw(d0 + 2 * q + 1, l)] = (bf16_t)(w[q] >> 16); }
        }
    }
}
template <int GATE>
__device__ __forceinline__ void head_norm_out_r(const float* Hs, const float* __restrict__ w, const u32x4 (&og)[2], bf16_t* __restrict__ out, int opitch, int tid) {
    const int l = tid >> 3, part = tid & 7;
    float h[16]; float ss = 0.f;
#pragma unroll
    for (int i = 0; i < 4; ++i) { const f32x4 v = *(const f32x4*)(Hs + l * 132 + part * 16 + i * 4); h[4 * i] = v.x; h[4 * i + 1] = v.y; h[4 * i + 2] = v.z; h[4 * i + 3] = v.w; ss += v.x * v.x + v.y * v.y + v.z * v.z + v.w * v.w; }
    ss += __shfl_xor(ss, 1); ss += __shfl_xor(ss, 2); ss += __shfl_xor(ss, 4);
    const float r = rsqrtf(ss * (1.f / 128.f) + EPS);
    const unsigned gw[8] = {og[0].x, og[0].y, og[0].z, og[0].w, og[1].x, og[1].y, og[1].z, og[1].w};
    unsigned ow[8];
#pragma unroll
    for (int q = 0; q < 8; ++q) {
        const float ga = bf2f(gw[q] & 0xffffu), gb = bf2f(gw[q] >> 16);
        const float a = h[2 * q] * r * w[part * 16 + 2 * q] * (GATE == 0 ? fsigmoid_(ga) : fsilu_(ga));
        const float b = h[2 * q + 1] * r * w[part * 16 + 2 * q + 1] * (GATE == 0 ? fsigmoid_(gb) : fsilu_(gb));
        ow[q] = pk2(a, b);
    }
    *(u32x4*)(out + (size_t)l * opitch + part * 16) = (u32x4){ow[0], ow[1], ow[2], ow[3]};
    *(u32x4*)(out + (size_t)l * opitch + part * 16 + 8) = (u32x4){ow[4], ow[5], ow[6], ow[7]};
}

__device__ __forceinline__ void phase_mlstm_local(const Params& p, unsigned char* lds) {
    const int tid = opaque_tid(), lane = tid & 63, wid = tid >> 6, fr = lane & 15, fq = lane >> 4;
    unsigned char* ws = p.ws;
    const bf16_t* PROJ = (const bf16_t*)(ws + WS_PROJ);
    const float* GATES = (const float*)(ws + WS_GATES);
    bf16_t* Kt = (bf16_t*)lds;
    bf16_t* Vt = (bf16_t*)(lds + 18432);
    float* wk = (float*)(lds + 36864);
    const int NIT = 1024 + 256;
    Tile2 rk, rv; float gi = 0.f, gf = 0.f;
    auto load_item = [&](int it) {
        const int b = it >> 8, h = (it >> 6) & 3, c = it & 63, t0 = b * SEQ + c * 64;
        tile_load(rk, PROJ + (size_t)t0 * PA + 512 + h * 128, PA, tid);
        tile_load(rv, PROJ + (size_t)t0 * PA + 1024 + h * 128, PA, tid);
        gi = GATES[(size_t)(t0 + lane) * 8 + h]; gf = GATES[(size_t)(t0 + lane) * 8 + 4 + h];
    };
    if ((int)blockIdx.x < 1024) load_item(blockIdx.x);
    for (int it = blockIdx.x; it < NIT; it += gridDim.x) {
        if (it < 1024) {
            if (wid == 0) {
                const float lf = logsigmoid_(gf);
                const float bc = wave_incl_sum(lf, lane);
                const float bend = __shfl(bc, 63);
                const float logg = bend - bc + gi;
                const float ml = wave_max(logg);
                wk[lane] = expf(logg - ml);
                if (lane == 0) { ((float*)(ws + WS_MLOC))[it] = ml; ((float*)(ws + WS_BEND))[it] = bend; }
            }
            tile_put_rows(rk, Kt, tid);
            __syncthreads();
            {
#pragma unroll
                for (int i = 0; i < 2; ++i) {
                    const int pc = tid + i * NTHR, l = pc >> 4, d0 = (pc & 15) * 8; const float sc = wk[l];
                    const unsigned w[4] = {rv.v[i].x, rv.v[i].y, rv.v[i].z, rv.v[i].w};
                    u32x4 o; o.x = pk2(bf2f(w[0] & 0xffffu) * sc, bf2f(w[0] >> 16) * sc); o.y = pk2(bf2f(w[1] & 0xffffu) * sc, bf2f(w[1] >> 16) * sc);
                    o.z = pk2(bf2f(w[2] & 0xffffu) * sc, bf2f(w[2] >> 16) * sc); o.w = pk2(bf2f(w[3] & 0xffffu) * sc, bf2f(w[3] >> 16) * sc);
                    *(u32x4*)(Vt + l * 136 + d0) = o;
                }
                if (tid < 64) Vt[tid * 136 + 128] = (bf16_t)f2bf(wk[tid]);
            }
            __syncthreads();
            if (it + (int)gridDim.x < 1024) load_item(it + gridDim.x);
            state_outer_tr<true>(Kt, Vt, (bf16_t*)(ws + WS_U) + (size_t)it * 16384, wid, fr, fq);
            {
                f32x4 acc = (f32x4){0.f, 0.f, 0.f, 0.f};
#pragma unroll
                for (int ls = 0; ls < 2; ++ls) {
                    const bf16x8 bn = frag_tr(Vt, 136, ls * 32, 128, fr, fq);
                    const bf16x8 ak = frag_tr(Kt, 136, ls * 32, wid * 16, fr, fq);
                    acc = __builtin_amdgcn_mfma_f32_16x16x32_bf16(ak, bn, acc, 0, 0, 0);
                }
                if (fr == 0) *(f32x4*)((float*)(ws + WS_NLOC) + (size_t)it * 128 + wid * 16 + fq * 4) = acc;
            }
            __syncthreads();
        } else {
            const int ci = it - 1024, t0 = ci * 64, cq = tid & 63, ts = tid >> 6, c0 = cq * 8, tb = t0 + ts * 8;
            const float* cw = p.in[I_AB_CONVW];
            float w0[8], w1[8], w2[8];
#pragma unroll
            for (int j = 0; j < 8; ++j) { w0[j] = cw[c0 + j]; w1[j] = cw[512 + c0 + j]; w2[j] = cw[1024 + c0 + j]; }
            const bool halo = ((tb & (SEQ - 1)) != 0);
            float zp2[8], zp1[8];
            {
                u32x4 g2 = (u32x4){0u, 0u, 0u, 0u}, x2 = g2, g1 = g2, x1 = g2;
                if (halo) { const bf16_t* r2 = PROJ + (size_t)(tb - 2) * PA; const bf16_t* r1 = PROJ + (size_t)(tb - 1) * PA;
                    g2 = __builtin_nontemporal_load((const u32x4*)(r2 + 2560 + c0)); x2 = __builtin_nontemporal_load((const u32x4*)(r2 + 3072 + c0));
                    g1 = __builtin_nontemporal_load((const u32x4*)(r1 + 2560 + c0)); x1 = __builtin_nontemporal_load((const u32x4*)(r1 + 3072 + c0)); }
                const unsigned a0[4] = {g2.x, g2.y, g2.z, g2.w}, b0[4] = {x2.x, x2.y, x2.z, x2.w}, a1[4] = {g1.x, g1.y, g1.z, g1.w}, b1[4] = {x1.x, x1.y, x1.z, x1.w};
#pragma unroll
                for (int q = 0; q < 4; ++q) {
                    zp2[2 * q] = bf2f(a0[q] & 0xffffu) * bf2f(b0[q] & 0xffffu); zp2[2 * q + 1] = bf2f(a0[q] >> 16) * bf2f(b0[q] >> 16);
                    zp1[2 * q] = bf2f(a1[q] & 0xffffu) * bf2f(b1[q] & 0xffffu); zp1[2 * q + 1] = bf2f(a1[q] >> 16) * bf2f(b1[q] >> 16);
                }
            }
            bf16_t* mix = (bf16_t*)(ws + WS_MIX);
#pragma unroll 1
            for (int ps = 0; ps < 2; ++ps) {
                u32x4 gbv[4], gcv[4], xiv[4];
#pragma unroll
                for (int t = 0; t < 4; ++t) { const bf16_t* r = PROJ + (size_t)(tb + ps * 4 + t) * PA;
                    gbv[t] = __builtin_nontemporal_load((const u32x4*)(r + 2048 + c0)); gcv[t] = __builtin_nontemporal_load((const u32x4*)(r + 2560 + c0)); xiv[t] = __builtin_nontemporal_load((const u32x4*)(r + 3072 + c0)); }
#pragma unroll
                for (int t = 0; t < 4; ++t) {
                    const unsigned ga[4] = {gcv[t].x, gcv[t].y, gcv[t].z, gcv[t].w}, xa[4] = {xiv[t].x, xiv[t].y, xiv[t].z, xiv[t].w}, ba[4] = {gbv[t].x, gbv[t].y, gbv[t].z, gbv[t].w};
                    float y[8];
#pragma unroll
                    for (int q = 0; q < 4; ++q) {
                        const float z0 = bf2f(ga[q] & 0xffffu) * bf2f(xa[q] & 0xffffu), z1 = bf2f(ga[q] >> 16) * bf2f(xa[q] >> 16);
                        y[2 * q] = bf2f(ba[q] & 0xffffu) * (w0[2 * q] * zp2[2 * q] + w1[2 * q] * zp1[2 * q] + w2[2 * q] * z0);
                        y[2 * q + 1] = bf2f(ba[q] >> 16) * (w0[2 * q + 1] * zp2[2 * q + 1] + w1[2 * q + 1] * zp1[2 * q + 1] + w2[2 * q + 1] * z1);
                        zp2[2 * q] = zp1[2 * q]; zp1[2 * q] = z0; zp2[2 * q + 1] = zp1[2 * q + 1]; zp1[2 * q + 1] = z1;
                    }
                    *(u32x4*)(mix + (size_t)(tb + ps * 4 + t) * 1024 + 512 + c0) = (u32x4){pk2(y[0], y[1]), pk2(y[2], y[3]), pk2(y[4], y[5]), pk2(y[6], y[7])};
                }
            }
        }
    }
}

template <bool HG>
__device__ __forceinline__ void phase_scan(const Params& p, unsigned char* lds) {
    unsigned char* ws = p.ws;
    const int tid = opaque_tid(), lane = tid & 63, wv = tid >> 6;
    const int NGT = gridDim.x * NTHR;
    const bf16_t* U = (const bf16_t*)(ws + WS_U);
    bf16_t* CP = (bf16_t*)(ws + WS_CPREV);
    const float* MLOC = (const float*)(ws + WS_MLOC); const float* BEND = (const float*)(ws + WS_BEND); const float* BENDV = (const float*)(ws + WS_BENDV);
    float* sd = (float*)lds;
    float* ssu = sd + 64;
    float* sbv = (float*)(lds + 1024);
    const float* XEND = (const float*)(ws + WS_XEND);
    int sb = ((int)blockIdx.x * 8 + wv) * 4;
    float er[16], ei[16];
    if (HG && sb < 8192) {
        const int seq = sb + (lane & 3), seg = lane >> 2;
        const float* xe = XEND + ((size_t)((seq >> 11) * 256 + seg * 16) * 32 + ((seq >> 6) & 31)) * 128 + (seq & 63);
#pragma unroll
        for (int j = 0; j < 16; ++j) { er[j] = xe[j * 4096]; ei[j] = xe[j * 4096 + 64]; }
    }
    for (int base = blockIdx.x * NTHR; base < 131072; base += NGT) {
        const int idx = base + tid;
        const int bh = idx >> 13, rem = idx & 8191, e = rem >> 6, k = (rem & 63) * 2;
        if (base != (int)blockIdx.x * NTHR) __syncthreads();
        unsigned uu[64];
        {
            const bf16_t* up = U + (size_t)(bh * 64) * 16384 + e * 128 + k;
#pragma unroll
            for (int c = 0; c < 64; ++c) uu[c] = __builtin_nontemporal_load((const unsigned*)(up + (size_t)c * 16384));
        }
        const int kn0 = ((base & 8191) >> 9) * 8;
        if (!HG) {
            sbv[tid] = ((const float*)(ws + WS_NLOC))[(unsigned)((bh * 64 + (tid >> 3)) * 128 + kn0 + (tid & 7))];
            if (wv == 0) {
                const float ml = MLOC[bh * 64 + lane], be = BEND[bh * 64 + lane];
                float a = be, b = ml;
#pragma unroll
                for (int d = 1; d < 64; d <<= 1) {
                    const float pa = __shfl_up(a, d), pb = __shfl_up(b, d);
                    if (lane >= d) { b = fmaxf(pb + a, b); a = pa + a; }
                }
                const float m = b;
                float mp = __shfl_up(m, 1); if (lane == 0) mp = -1e30f;
                sd[lane] = expf(be + mp - m); ssu[lane] = expf(ml - m);
                if (rem < 64) ((float*)(ws + WS_MPREV))[bh * 64 + lane] = mp;
            }
        } else {
#pragma unroll
            for (int i = 0; i < 4; ++i) { const int q = tid + NTHR * i; *(f32x4*)(sbv + q * 4) = *(const f32x4*)(BENDV + (size_t)(bh * 64) * 128 + q * 4); }
        }
        __syncthreads();
        if (!HG && tid >= 504) {
            float* np_ = (float*)(ws + WS_NPREV) + (unsigned)((bh * 64) * 128 + kn0 + (tid - 504));
            float n = 0.f;
#pragma unroll
            for (int c = 0; c < 64; ++c) { np_[c * 128] = n; n = sd[c] * n + ssu[c] * sbv[c * 8 + (tid - 504)]; }
        }
        float c0 = 0.f, c1 = 0.f;
        bf16_t* cp = CP + (size_t)(bh * 64) * 16384 + e * 128 + k;
#pragma unroll
        for (int c = 0; c < 64; ++c) {
            *(unsigned*)(cp + (size_t)c * 16384) = pk2(c0, c1);
            const float u0 = bf2f(uu[c] & 0xffffu), u1 = bf2f(uu[c] >> 16);
            if (!HG) { const float d = sd[c], su = ssu[c]; c0 = d * c0 + su * u0; c1 = d * c1 + su * u1; }
            else { const f32x2 bv = *(const f32x2*)(sbv + c * 128 + k); c0 = bv.x * c0 + u0; c1 = bv.y * c1 + u1; }
        }
    }
    if (HG) {
        const f32x2* POW = (const f32x2*)(ws + WS_S5POW); bf16_t* XPB = (bf16_t*)(ws + WS_XPREVB);
        while (sb < 8192) {
            const int seq = sb + (lane & 3), seg = lane >> 2;
            const int b = seq >> 11, g = (seq >> 6) & 31, pp = seq & 63;
            const f32x2 l16 = POW[(g * 64 + pp) * 17 + 16];
            float ar = l16.x, ai = l16.y;
#pragma unroll
            for (int q = 0; q < 4; ++q) { const float nr = ar * ar - ai * ai, ni = 2.f * ar * ai; ar = nr; ai = ni; }
            bf16_t* xo = XPB + ((size_t)(b * 256 + seg * 16) * 32 + g) * 128 + pp;
            float xr = 0.f, xi = 0.f;
#pragma unroll
            for (int j = 0; j < 16; ++j) { const float nr = l16.x * xr - l16.y * xi + er[j], ni = l16.x * xi + l16.y * xr + ei[j]; xr = nr; xi = ni; }
            float cr = 0.f, ci = 0.f;
#pragma unroll
            for (int r = 0; r < 15; ++r) {
                const float pr = __shfl(xr, (lane & 3) + 4 * r), pi = __shfl(xi, (lane & 3) + 4 * r);
                if (r < seg) { const float nr = ar * cr - ai * ci + pr, ni = ar * ci + ai * cr + pi; cr = nr; ci = ni; }
            }
            xr = cr; xi = ci;
#pragma unroll
            for (int j = 0; j < 16; ++j) {
                xo[j * 4096] = (bf16_t)f2bf(xr); xo[j * 4096 + 64] = (bf16_t)f2bf(xi);
                const float nr = l16.x * xr - l16.y * xi + er[j], ni = l16.x * xi + l16.y * xr + ei[j]; xr = nr; xi = ni;
            }
            sb += gridDim.x * 32;
            if (sb < 8192) {
                const int seq2 = sb + (lane & 3);
                const float* xe = XEND + ((size_t)((seq2 >> 11) * 256 + seg * 16) * 32 + ((seq2 >> 6) & 31)) * 128 + (seq2 & 63);
#pragma unroll
                for (int j = 0; j < 16; ++j) { er[j] = xe[j * 4096]; ei[j] = xe[j * 4096 + 64]; }
            }
        }
    }
}

__device__ __forceinline__ void phase_mlstm_out(const Params& p, unsigned char* lds) {
    const int tid = opaque_tid(), lane = tid & 63, wid = tid >> 6, fr = lane & 15, fq = lane >> 4;
    unsigned char* ws = p.ws;
    const bf16_t* PROJ = (const bf16_t*)(ws + WS_PROJ);
    const float* GATES = (const float*)(ws + WS_GATES);
    bf16_t* Qs = (bf16_t*)lds;
    bf16_t* Ks = (bf16_t*)(lds + 17408);
    float* Hs = (float*)lds;
    bf16_t* Vt = (bf16_t*)(lds + 34816);
    bf16_t* Cs = (bf16_t*)(lds + 53248);
    bf16_t* Ps = (bf16_t*)(lds + 88064);
    float* sa = (float*)(lds + 97280);
    float* sg = sa + 64;
    float* sisc = sg + 64;
    float* semr = sisc + 64;
    float* sdinv = semr + 64;
    float* snp = sdinv + 64;
    Tile2 rq, rk, rv; Tile4 rc; u32x4 rog[2]; float g0 = 0.f, g1 = 0.f, g2 = 0.f, g3 = 0.f, g4 = 0.f;
    auto load_item = [&](int it) {
        const int b = it >> 8, h = (it >> 6) & 3, c = it & 63, t0 = b * SEQ + c * 64;
        tile_load<true>(rq, PROJ + (size_t)t0 * PA + h * 128, PA, tid);
        tile_load<true>(rk, PROJ + (size_t)t0 * PA + 512 + h * 128, PA, tid);
        tile_load<true>(rv, PROJ + (size_t)t0 * PA + 1024 + h * 128, PA, tid);
        tile4_load<true>(rc, (const bf16_t*)(ws + WS_CPREV) + (size_t)it * 16384, tid);
        { const bf16_t* og = PROJ + (size_t)(t0 + (tid >> 3)) * PA + 1536 + h * 128 + (tid & 7) * 16; rog[0] = __builtin_nontemporal_load((const u32x4*)og); rog[1] = __builtin_nontemporal_load((const u32x4*)(og + 8)); }
        g0 = GATES[(size_t)(t0 + lane) * 8 + h]; g1 = GATES[(size_t)(t0 + lane) * 8 + 4 + h]; g2 = ((const float*)(ws + WS_MPREV))[it];
        g3 = ((const float*)(ws + WS_NPREV))[(size_t)it * 128 + lane]; g4 = ((const float*)(ws + WS_NPREV))[(size_t)it * 128 + 64 + lane];
    };
    if ((int)blockIdx.x < 1024) load_item(blockIdx.x);
    for (int it = blockIdx.x; it < 1024; it += gridDim.x) {
        const int b = it >> 8, h = (it >> 6) & 3, c = it & 63, t0 = b * SEQ + c * 64;
        if (wid == 0) {
            const float ip = g0, fp = g1, mprev = g2;
            const float bc = wave_incl_sum(logsigmoid_(fp), lane);
            const float a = ip - bc;
            const float g = fmaxf(wave_incl_max(a, lane), mprev);
            sa[lane] = a; sg[lane] = g; sisc[lane] = expf(mprev - g); semr[lane] = expf(-(bc + g));
        } else if (wid == 1) { snp[lane] = g3; snp[64 + lane] = g4; }
        tile_put_rows(rq, Qs, tid); tile_put_rows(rk, Ks, tid); tile_put_rows(rv, Vt, tid); tile4_put(rc, Cs, tid);
        const u32x4 ogc[2] = {rog[0], rog[1]};
        __syncthreads();
        if (it + (int)gridDim.x < 1024) load_item(it + gridDim.x);
#pragma unroll
        for (int i = 0; i < 2; ++i) {
            const int tix = wid * 2 + i, lt = tix >> 2, st = tix & 3;
            f32x4 acc = (f32x4){0.f, 0.f, 0.f, 0.f};
            if (st <= lt) {
#pragma unroll
                for (int ks = 0; ks < 4; ++ks) {
                    const bf16x8 ak = *(const bf16x8*)(Ks + (st * 16 + fr) * 136 + ks * 32 + fq * 8);
                    const bf16x8 bq = *(const bf16x8*)(Qs + (lt * 16 + fr) * 136 + ks * 32 + fq * 8);
                    acc = __builtin_amdgcn_mfma_f32_16x16x32_bf16(ak, bq, acc, 0, 0, 0);
                }
            }
            const int l = lt * 16 + fr; const float gl = sg[l];
            float pv[4];
#pragma unroll
            for (int r = 0; r < 4; ++r) { const int s = st * 16 + fq * 4 + r; pv[r] = (s <= l) ? acc[r] * fexp_(sa[s] - gl) : 0.f; }
            u32x2 o; o.x = pk2(pv[0], pv[1]); o.y = pk2(pv[2], pv[3]);
            *(u32x2*)(Ps + l * 72 + st * 16 + fq * 4) = o;
        }
        __syncthreads();
        {
            const int l = tid >> 3, part = tid & 7;
            float rs = 0.f, qn = 0.f;
            const u32x4 pw = *(const u32x4*)(Ps + l * 72 + part * 8);
            rs = (bf2f(pw.x & 0xffffu) + bf2f(pw.x >> 16)) + (bf2f(pw.y & 0xffffu) + bf2f(pw.y >> 16)) + (bf2f(pw.z & 0xffffu) + bf2f(pw.z >> 16)) + (bf2f(pw.w & 0xffffu) + bf2f(pw.w >> 16));
            const u32x4 q0 = *(const u32x4*)(Qs + l * 136 + part * 16), q1 = *(const u32x4*)(Qs + l * 136 + part * 16 + 8);
            const unsigned qw[8] = {q0.x, q0.y, q0.z, q0.w, q1.x, q1.y, q1.z, q1.w};
#pragma unroll
            for (int j = 0; j < 8; ++j) qn += bf2f(qw[j] & 0xffffu) * snp[part * 16 + 2 * j] + bf2f(qw[j] >> 16) * snp[part * 16 + 2 * j + 1];
            rs += __shfl_xor(rs, 1); rs += __shfl_xor(rs, 2); rs += __shfl_xor(rs, 4);
            qn += __shfl_xor(qn, 1); qn += __shfl_xor(qn, 2); qn += __shfl_xor(qn, 4);
            if (part == 0) { const float den = rs + sisc[l] * qn; sdinv[l] = 1.f / fmaxf(fabsf(den), semr[l]); }
        }
        f32x4 a1[4], a2[4];
#pragma unroll
        for (int lt = 0; lt < 4; ++lt) { a1[lt] = (f32x4){0.f, 0.f, 0.f, 0.f}; a2[lt] = (f32x4){0.f, 0.f, 0.f, 0.f}; }
        {
            const int e0 = wid * 16;
#pragma unroll
            for (int ss = 0; ss < 2; ++ss) {
                const bf16x8 av = frag_tr(Vt, 136, ss * 32, e0, fr, fq);
#pragma unroll
                for (int lt = 0; lt < 4; ++lt) { const bf16x8 bp = *(const bf16x8*)(Ps + (lt * 16 + fr) * 72 + ss * 32 + fq * 8); a1[lt] = __builtin_amdgcn_mfma_f32_16x16x32_bf16(av, bp, a1[lt], 0, 0, 0); }
            }
#pragma unroll
            for (int ks = 0; ks < 4; ++ks) {
                const bf16x8 ac = *(const bf16x8*)(Cs + (e0 + fr) * 136 + ks * 32 + fq * 8);
#pragma unroll
                for (int lt = 0; lt < 4; ++lt) { const bf16x8 bq = *(const bf16x8*)(Qs + (lt * 16 + fr) * 136 + ks * 32 + fq * 8); a2[lt] = __builtin_amdgcn_mfma_f32_16x16x32_bf16(ac, bq, a2[lt], 0, 0, 0); }
            }
        }
        __syncthreads();
        {
            const int e0 = wid * 16;
#pragma unroll
            for (int lt = 0; lt < 4; ++lt) {
                const int l = lt * 16 + fr; const float is = sisc[l], di = sdinv[l];
                const f32x4 hv = (a1[lt] + a2[lt] * is) * di;
                *(f32x4*)(Hs + l * 132 + e0 + fq * 4) = hv;
            }
        }
        __syncthreads();
        head_norm_out_r<0>(Hs, p.in[I_AB_HNORM] + h * 128, ogc, (bf16_t*)(ws + WS_MIX) + (size_t)t0 * 1024 + h * 128, 1024, tid);
        __syncthreads();
    }
}

__device__ __forceinline__ void load_h_row(const Params& p, int row, int lane, bool combine, f32x4 (&v)[4], int ylayer = 0) {
    const bf16_t* hrow = (const bf16_t*)(p.ws + WS_H16) + (size_t)row * 1024;
#pragma unroll
    for (int j = 0; j < 4; ++j) { const u32x2 a = *(const u32x2*)(hrow + 4 * lane + 256 * j); v[j] = (f32x4){bf2f(a.x & 0xffffu), bf2f(a.x >> 16), bf2f(a.y & 0xffffu), bf2f(a.y >> 16)}; }
    if (combine) {
        const bf16_t* y0 = (const bf16_t*)(p.ws + ws_y(ylayer)) + (size_t)row * 1024;
        const bf16_t* y1 = y0 + (size_t)T * 1024;
#pragma unroll
        for (int j = 0; j < 4; ++j) {
            const u32x2 a = __builtin_nontemporal_load((const u32x2*)(y0 + 4 * lane + 256 * j)), bq = __builtin_nontemporal_load((const u32x2*)(y1 + 4 * lane + 256 * j));
            v[j].x += bf2f(a.x & 0xffffu) + bf2f(bq.x & 0xffffu); v[j].y += bf2f(a.x >> 16) + bf2f(bq.x >> 16);
            v[j].z += bf2f(a.y & 0xffffu) + bf2f(bq.y & 0xffffu); v[j].w += bf2f(a.y >> 16) + bf2f(bq.y >> 16);
        }
    }
}

__device__ __forceinline__ void phase_combine_norm(const Params& p, bool final_) {
    const int tid = opaque_tid(), lane = tid & 63, wid = tid >> 6;
    const int gw = blockIdx.x * 8 + wid, NGW = gridDim.x * 8;
    for (int row = gw; row < T; row += NGW) {
        f32x4 v[4];
        load_h_row(p, row, lane, true, v, final_ ? 1 : 0);
        float* hrow = p.out + (size_t)row * 1024;
        if (!final_) {
            bf16_t* h16 = (bf16_t*)(p.ws + WS_H16) + (size_t)row * 1024;
#pragma unroll
            for (int j = 0; j < 4; ++j) { u32x2 o; o.x = pk2(v[j].x, v[j].y); o.y = pk2(v[j].z, v[j].w); *(u32x2*)(h16 + 4 * lane + 256 * j) = o; }
            float ss = 0.f;
#pragma unroll
            for (int j = 0; j < 4; ++j) ss += v[j].x * v[j].x + v[j].y * v[j].y + v[j].z * v[j].z + v[j].w * v[j].w;
            ss = wave_sum(ss);
            if (lane == 0) ((float*)(p.ws + WS_RSTD))[T + row] = rsqrtf(ss * (1.f / 1024.f) + EPS);
        } else {
            float ss = 0.f;
#pragma unroll
            for (int j = 0; j < 4; ++j) ss += v[j].x * v[j].x + v[j].y * v[j].y + v[j].z * v[j].z + v[j].w * v[j].w;
            ss = wave_sum(ss);
            const float r = rsqrtf(ss * (1.f / 1024.f) + EPS);
#pragma unroll
            for (int j = 0; j < 4; ++j) { const f32x4 w4 = *(const f32x4*)(p.in[I_NORM_FINAL] + 4 * lane + 256 * j); __builtin_nontemporal_store(v[j] * r * w4, (f32x4*)(hrow + 4 * lane + 256 * j)); }
        }
    }
}

template <bool DYN, int MODE = 0>
__device__ __forceinline__ void moe_convert(const Params& p, unsigned char* lds, int layer, int it_lo, int it_hi, int gw, int NGW, int wid, int lane, int* ctr = nullptr) {
    unsigned char* ws = p.ws;
    float* scr = (float*)(lds + wid * 8704);
    const float* wg = p.in[I_MOE_WGATE] + (size_t)layer * 32 * 1024 * 256;
    const float* wu = p.in[I_MOE_WUP] + (size_t)layer * 32 * 1024 * 256;
    const float* wd = p.in[I_MOE_WDOWN] + (size_t)layer * 32 * 256 * 1024;
    bf16_t* WGU = (bf16_t*)(ws + ws_wgu(layer)); bf16_t* WD = (bf16_t*)(ws + ws_wd(layer));
    constexpr int IT_GU = 16 * 16, IT_D = 32 * 4, IT_E = IT_GU + IT_D;
    for (int it0 = it_lo + gw;; it0 += NGW) {
        if (DYN) { int k = 0; if (lane == 0) k = __hip_atomic_fetch_add((__attribute__((address_space(3))) int*)ctr, 1, __ATOMIC_RELAXED, __HIP_MEMORY_SCOPE_WORKGROUP); it0 = it_lo + gw + __builtin_amdgcn_readfirstlane(k) * NGW; }
        if (it0 >= it_hi) break;
        const int e = MODE == 0 ? it0 / IT_E : (MODE == 1 ? it0 >> 7 : it0 >> 8); int it = MODE == 0 ? it0 - e * IT_E : (MODE == 1 ? IT_GU + (it0 & 127) : (it0 & 255));
        const float* src; bf16_t* dst; int ldn, ldk; const float* gam = nullptr;
        if (it < IT_GU) {
            const int nb = it >> 4, kb = it & 15, n0 = nb * 32, k0 = kb * 64;
            const int pn = n0 >> 8, isup = (n0 >> 7) & 1, f0 = pn * 128 + (n0 & 127);
            src = (isup ? wu : wg) + (size_t)e * 1024 * 256 + (size_t)k0 * 256 + f0; ldn = 256;
            dst = WGU + (size_t)e * 512 * 1024 + (size_t)n0 * 1024 + k0; ldk = 1024; gam = p.in[I_NORM_FFN] + layer * 1024 + k0;
        } else {
            it -= IT_GU;
            const int nb = it >> 2, kb = it & 3, n0 = nb * 32, k0 = kb * 64;
            src = wd + (size_t)e * 256 * 1024 + (size_t)k0 * 1024 + n0; ldn = 1024;
            dst = WD + (size_t)e * 1024 * 256 + (size_t)n0 * 256 + k0; ldk = 256;
        }
        transpose_tile(src, ldn, dst, ldk, 1.f, gam, scr, lane);
    }
}
template <int RSEL>
__device__ __forceinline__ void phase_route(const Params& p, unsigned char* lds, int layer) {
    const int tid = opaque_tid(), lane = tid & 63, wid = tid >> 6, fr = lane & 15, fq = lane >> 4;
    unsigned char* ws = p.ws;
    float* part = (float*)lds;
    float* lg = (float*)(lds + 98304 + 2048);
    int* ctr = (int*)(lds + 98304 + 2048 + 12288 + 256);
    if (tid == 0) *ctr = 0;
    if (RSEL == 1) __syncthreads();
    const bf16_t* H16 = (const bf16_t*)(ws + WS_H16);
    const bf16_t* wf = (const bf16_t*)(ws + WS_WCAT) + (size_t)layer * 2 * 6144 * 8;
    int* cnt = (int*)(ws + WS_CNT) + layer * 1024;
    int* list = (int*)(ws + WS_LIST); float* wlist = (float*)(ws + WS_WLIST);
    if (RSEL != 1)
    for (int grp = blockIdx.x; grp < T / 64; grp += gridDim.x) {
        const int row0 = grp * 64;
        if (grp != (int)blockIdx.x) __syncthreads();
        bf16x8 a[4][4];
#pragma unroll
        for (int rt = 0; rt < 3; ++rt)
#pragma unroll
            for (int s_ = 0; s_ < 4; ++s_) a[rt][s_] = *(const bf16x8*)(H16 + (size_t)(row0 + rt * 16 + fr) * 1024 + wid * 128 + s_ * 32 + fq * 8);
        {
#pragma unroll
            for (int hb = 0; hb < 2; ++hb) {
                bf16x8 x[4][2];
#pragma unroll
                for (int i = 0; i < 4; ++i) {
                    const bf16_t* hrow = H16 + (size_t)(row0 + wid * 8 + hb * 4 + i) * 1024 + lane * 8;
                    x[i][0] = *(const bf16x8*)hrow; x[i][1] = *(const bf16x8*)(hrow + 512);
                }
#pragma unroll
                for (int i = 0; i < 4; ++i) {
                    float f[16];
#pragma unroll
                    for (int j = 0; j < 8; ++j) { f[j] = bf2f((unsigned short)x[i][0][j]); f[8 + j] = bf2f((unsigned short)x[i][1][j]); }
                    float ss = 0.f;
#pragma unroll
                    for (int j = 0; j < 16; ++j) ss += f[j] * f[j];
                    ss = wave_sum(ss);
                    const float rs = rsqrtf(ss * (1.f / 1024.f) + EPS);
                    if (lane == 0) { lg[64 * 48 + wid * 8 + hb * 4 + i] = rs; ((float*)(ws + WS_RSTD))[2 * T + row0 + wid * 8 + hb * 4 + i] = rs; }
                }
            }
        }
        bf16x8 bh[4][3], bl[4][3];
#pragma unroll
        for (int s_ = 0; s_ < 4; ++s_) a[3][s_] = *(const bf16x8*)(H16 + (size_t)(row0 + 48 + fr) * 1024 + wid * 128 + s_ * 32 + fq * 8);
#pragma unroll
        for (int s_ = 0; s_ < 4; ++s_)
#pragma unroll
            for (int n = 0; n < 3; ++n) {
                bh[s_][n] = *(const bf16x8*)(wf + ((size_t)((wid * 4 + s_) * 3 + n) * 64 + lane) * 8);
                bl[s_][n] = *(const bf16x8*)(wf + ((size_t)6144 + (size_t)((wid * 4 + s_) * 3 + n) * 64 + lane) * 8);
            }
#pragma unroll
        for (int rt = 0; rt < 4; ++rt) {
            f32x4 acc[3] = {(f32x4){0.f, 0.f, 0.f, 0.f}, (f32x4){0.f, 0.f, 0.f, 0.f}, (f32x4){0.f, 0.f, 0.f, 0.f}};
#pragma unroll
            for (int s_ = 0; s_ < 4; ++s_)
#pragma unroll
                for (int n = 0; n < 3; ++n) {
                    acc[n] = __builtin_amdgcn_mfma_f32_16x16x32_bf16(a[rt][s_], bl[s_][n], acc[n], 0, 0, 0);
                    acc[n] = __builtin_amdgcn_mfma_f32_16x16x32_bf16(a[rt][s_], bh[s_][n], acc[n], 0, 0, 0);
                }
#pragma unroll
            for (int n = 0; n < 3; ++n)
#pragma unroll
                for (int r = 0; r < 4; ++r) part[(wid * 64 + rt * 16 + fq * 4 + r) * 48 + n * 16 + fr] = acc[n][r];
        }
        __syncthreads();
        for (int i = tid; i < 64 * 48; i += NTHR) {
            float t = 0.f;
#pragma unroll
            for (int w = 0; w < 8; ++w) t += part[w * 3072 + i];
            lg[i] = t;
        }
        __syncthreads();
        if (wid == 0) {
            const int row = row0 + lane;
            const float rs = lg[64 * 48 + lane];
            const float* l = lg + lane * 48;
            const float* bg = p.in[I_MOE_BG] + layer * 4; const float* br = p.in[I_MOE_BR] + layer * 32;
            float gm = l[32] * rs + bg[0]; int gi = 0; float gl[4]; gl[0] = gm;
#pragma unroll
            for (int i = 1; i < 4; ++i) { gl[i] = l[32 + i] * rs + bg[i]; if (gl[i] > gm) { gm = gl[i]; gi = i; } }
            float gs = 0.f;
#pragma unroll
            for (int i = 0; i < 4; ++i) gs += expf(gl[i] - gm);
            const float gval = 1.f / gs;
            float m1 = -3.0e38f, m2 = -3.0e38f; int i1 = 0, i2 = 0;
#pragma unroll
            for (int i = 0; i < 8; ++i) {
                const float v = l[gi * 8 + i] * rs + br[gi * 8 + i];
                if (v > m1) { m2 = m1; i2 = i1; m1 = v; i1 = i; } else if (v > m2) { m2 = v; i2 = i; }
            }
            const float e2 = expf(m2 - m1), inv = gval / (1.f + e2);
            const int x1 = gi * 8 + i1, x2 = gi * 8 + i2;
            const unsigned long long ltm = (1ull << lane) - 1ull;
            int myc = 0, r1 = 0, r2 = 0;
#pragma unroll 1
            for (int e = 0; e < 32; ++e) {
                const unsigned long long b1 = __ballot(x1 == e), b2 = __ballot(x2 == e);
                const int c1 = __popcll(b1), c = c1 + __popcll(b2);
                if (lane == e) myc = c;
                if (x1 == e) r1 = __popcll(b1 & ltm);
                if (x2 == e) r2 = c1 + __popcll(b2 & ltm);
            }
            int base = 0;
            if (lane < 32 && myc > 0) base = atomicAdd(&cnt[lane * 32], myc);
            const int p1 = x1 * ECAP + __shfl(base, x1) + r1, p2 = x2 * ECAP + __shfl(base, x2) + r2;
            list[p1] = row * 2; wlist[p1] = inv;
            list[p2] = row * 2 + 1; wlist[p2] = inv * e2;
        }
    }
    if (RSEL < 2) moe_convert<true, 2>(p, lds, layer, moe_first_late_expert(layer) * 256, 32 * 256, blockIdx.x, gridDim.x, wid, lane, ctr);
}

struct AGather {
    const bf16_t* XN; const int* lst; int n;
    __device__ __forceinline__ const bf16_t* operator()(int r, int kc) const { const int tok = (r < n) ? (lst[r] >> 1) : 0; return XN + (size_t)tok * 1024 + kc * 8; }
};
struct EpiGateUp {
    bf16_t* H; float rs0, rs1;
    __device__ __forceinline__ void operator()(const f32x4 (&acc)[2][4], int wr, int wc, int fr, int fq) const {
#pragma unroll
        for (int m = 0; m < 2; ++m) {
            const float r_ = m ? rs1 : rs0;
#pragma unroll
            for (int n = 0; n < 2; ++n) {
                const f32x4 g = acc[m][n] * r_, u = acc[m][n + 2] * r_;
                u32x2 o; o.x = pk2(fsilu_(g.x) * u.x, fsilu_(g.y) * u.y); o.y = pk2(fsilu_(g.z) * u.z, fsilu_(g.w) * u.w);
                *(u32x2*)(H + (size_t)(wr * 32 + m * 16 + fr) * 256 + wc * 32 + n * 16 + fq * 4) = o;
            }
        }
    }
};
struct EpiDown {
    bf16_t* Y; int en0, en1; float w0, w1; int n; int col0;
    __device__ __forceinline__ void operator()(const f32x4 (&acc)[2][4], int wr, int wc, int fr, int fq) const {
#pragma unroll
        for (int m = 0; m < 2; ++m) {
            const int r = wr * 32 + m * 16 + fr;
            if (r < n) {
                const int en = m ? en1 : en0; const float w = m ? w1 : w0;
                bf16_t* yr = Y + ((size_t)(en & 1) * T + (en >> 1)) * 1024 + col0 + wc * 64 + fq * 4;
#pragma unroll
                for (int nn = 0; nn < 4; ++nn) { const f32x4 v = acc[m][nn] * w; u32x2 o; o.x = pk2(v.x, v.y); o.y = pk2(v.z, v.w); *(u32x2*)(yr + nn * 16) = o; }
            }
        }
    }
};
__device__ __forceinline__ void moe_prefix(const Params& p, int layer, int* tp, int* cn) {
    const int* cnt = (const int*)(p.ws + WS_CNT) + layer * 1024;
    int* sp = cn + 32;
    const int tid = opaque_tid();
    __syncthreads();
    if (tid < 32) cn[tid] = cnt[tid * 32];
    __syncthreads();
    if (tid < 64) {
        const int c = tid < 32 ? cn[tid & 31] : 0, rem = c & 255;
        const int a = tid < 32 ? (c >> 8) + (rem > 128 ? 1 : 0) : 0, b = (tid < 32 && rem > 0 && rem <= 128) ? 1 : 0;
        int sa = a, sb = b;
#pragma unroll
        for (int d = 1; d < 32; d <<= 1) { const int ua = __shfl_up(sa, d), ub = __shfl_up(sb, d); if (tid >= d) { sa += ua; sb += ub; } }
        if (tid < 32) { tp[tid] = sa - a; sp[tid] = sb - b; }
        if (tid == 31) { tp[32] = sa; sp[32] = sb; }
    }
    __syncthreads();
}
struct BGateUp {
    const bf16_t* W; int f0;
    __device__ __forceinline__ const bf16_t* operator()(int r, int kc) const {
        const int f = f0 + (r >> 6) * 32 + ((r >> 4) & 1) * 16 + (r & 15), isup = (r >> 5) & 1;
        return W + (size_t)((f >> 7) * 256 + isup * 128 + (f & 127)) * 1024 + kc * 8;
    }
};
constexpr int LDS_MOE_TAB = 131072, LDS_MOE_TP = 131072 + 4096;
__device__ __forceinline__ void phase_moe_up(const Params& p, unsigned char* lds, int layer) {
    unsigned* tab = (unsigned*)(lds + LDS_MOE_TAB); float* rtab = (float*)(lds + LDS_MOE_TAB + 4096); int* tp = (int*)(lds + LDS_MOE_TP + 4096); int* cn = tp + 64;
    const float* rstd = (const float*)(p.ws + WS_RSTD) + 2 * T;
    moe_prefix(p, layer, tp, cn);
    pg8::SchedMoe S{tp, cn, tab, 2, tp[32] * 2, (int)gridDim.x, (int)blockIdx.x};
    const int* list = (const int*)(p.ws + WS_LIST);
    const int tid = opaque_tid();
    for (int i = 0; i < pg8::MOE_MAXU; ++i) {
        pg8::Unit u; if (!S.next(i, u)) break;
        const int e = u.pn >> 1, pos = (u.pm - tp[e]) * 256 + tid;
        if (tid < 256) { const bool ok = pos < cn[e]; const int tok = ok ? (list[(size_t)e * ECAP + pos] >> 1) : 0; tab[i * 256 + tid] = (unsigned)tok * 2048u; rtab[i * 256 + tid] = ok ? rstd[tok] : 0.f; }
    }
    const int* sp = cn + 32; const int nsm = sp[32], np8 = tp[32];
    const int G_ = (int)gridDim.x, uoff = (np8 * 2) % G_;
    const int u0 = ((int)blockIdx.x - uoff + G_) % G_;
    int* stok = (int*)(lds + 140288); float* srs = (float*)(lds + 140800);
    if (u0 < nsm * 4 && tid >= 256 && tid < 384) {
        const int si = u0 >> 2, r = tid - 256;
        int e = 0; while (sp[e + 1] <= si) ++e;
        const int pos0 = (tp[e + 1] - tp[e]) * 256, n = cn[e] - pos0;
        const int en = list[(size_t)e * ECAP + pos0 + min(r, n - 1)];
        stok[r] = en; srs[r] = (r < n) ? rstd[en >> 1] : 0.f;
    }
    {
        const int heavy = uoff + nsm * 4;
        int rank = (int)blockIdx.x - heavy, L = G_ - heavy;
        if (L < G_ / 2) { rank = (int)blockIdx.x; L = G_; }
        if (rank >= 0) moe_convert<false, 1>(p, lds, layer, moe_first_late_expert(layer) * 128, 32 * 128, rank * 8 + (tid >> 6), L * 8, tid >> 6, tid & 63);
    }
    __syncthreads();
    pg8::Gemm g{(const bf16_t*)(p.ws + WS_H16), (const bf16_t*)(p.ws + ws_wgu(layer)), 0, 0, 1024};
    pg8::EpiMoeUp E{(bf16_t*)(p.ws + WS_HID), rtab};
    pg8::gemm_phase_g<pg8::EpiMoeUp, pg8::SchedMoe>((PG8_LAS unsigned char*)lds, g, S, E);
    __syncthreads();
    for (int u = u0; u < nsm * 4; u += G_) {
        const int si = u >> 2, pn4 = u & 3;
        int e = 0; while (sp[e + 1] <= si) ++e;
        const int pos0 = (tp[e + 1] - tp[e]) * 256, n = cn[e] - pos0;
        const int* l_ = (u == u0) ? (const int*)stok : list + (size_t)e * ECAP + pos0;
        AGather ag{(const bf16_t*)(p.ws + WS_H16), l_, n};
        BGateUp bg{(const bf16_t*)(p.ws + ws_wgu(layer)) + (size_t)e * 512 * 1024, pn4 * 64};
        const int er_ = (tid >> 7) * 32 + (tid & 15);
        float rsa, rsb;
        if (u == u0) { rsa = srs[min(er_, n - 1)]; rsb = srs[min(er_ + 16, n - 1)]; }
        else { const int ia = l_[min(er_, n - 1)], ib = l_[min(er_ + 16, n - 1)]; rsa = rstd[ia >> 1]; rsb = rstd[ib >> 1]; }
        EpiGateUp ep{(bf16_t*)(p.ws + WS_HID) + ((size_t)np8 * 256 + (size_t)si * 128) * 256 + pn4 * 64, er_ < n ? rsa : 0.f, er_ + 16 < n ? rsb : 0.f};
        gemm128b(lds, ag, bg, 1024, ep);
    }
}
__device__ __forceinline__ void phase_moe_down(const Params& p, unsigned char* lds, int layer) {
    unsigned* tab = (unsigned*)(lds + LDS_MOE_TAB); float* wtab = (float*)(lds + LDS_MOE_TAB + 4096); int* tp = (int*)(lds + LDS_MOE_TP + 4096); int* cn = tp + 64;
    __syncthreads();
    pg8::SchedMoe S{tp, cn, tab, 4, tp[32] * 4, (int)gridDim.x, (int)blockIdx.x};
    const int* list = (const int*)(p.ws + WS_LIST); const float* wlist = (const float*)(p.ws + WS_WLIST);
    const int tid = opaque_tid();
    for (int i = 0; i < pg8::MOE_MAXU; ++i) {
        pg8::Unit u; if (!S.next(i, u)) break;
        const int e = u.pn >> 2, pos = (u.pm - tp[e]) * 256 + tid;
        if (tid < 256) {
            const bool ok = pos < cn[e];
            const int en = ok ? list[(size_t)e * ECAP + pos] : 0;
            tab[i * 256 + tid] = ok ? (unsigned)((en & 1) * T + (en >> 1)) : 0xffffffffu;
            wtab[i * 256 + tid] = ok ? wlist[(size_t)e * ECAP + pos] : 0.f;
        }
    }
    __syncthreads();
    pg8::Gemm g{(const bf16_t*)(p.ws + WS_HID), (const bf16_t*)(p.ws + ws_wd(layer)), 0, 0, 256};
    pg8::EpiMoeDown E{(bf16_t*)(p.ws + ws_y(layer)), tab, wtab};
    pg8::gemm_phase<pg8::EpiMoeDown, pg8::SchedMoe, true, true>((PG8_LAS unsigned char*)lds, g, S, E);
    __syncthreads();
    const int* sp = cn + 32; const int nsm = sp[32], np8 = tp[32];
    const int G_ = (int)gridDim.x, uoff = (np8 * 4) % G_;
    for (int u = ((int)blockIdx.x - uoff + G_) % G_; u < nsm * 8; u += G_) {
        const int si = u >> 3, pn8 = u & 7;
        int e = 0; while (sp[e + 1] <= si) ++e;
        const int pos0 = (tp[e + 1] - tp[e]) * 256, n = cn[e] - pos0;
        APlain ap{(const bf16_t*)(p.ws + WS_HID) + ((size_t)np8 * 256 + (size_t)si * 128) * 256, 256};
        const int* l_ = list + (size_t)e * ECAP + pos0; const float* w_ = wlist + (size_t)e * ECAP + pos0;
        const int er_ = (tid >> 7) * 32 + (tid & 15), ja = min(er_, n - 1), jb = min(er_ + 16, n - 1);
        EpiDown ep{(bf16_t*)(p.ws + ws_y(layer)), l_[ja], l_[jb], w_[ja], w_[jb], n, pn8 * 128};
        gemm128(lds, ap, (const bf16_t*)(p.ws + ws_wd(layer)) + (size_t)e * 1024 * 256 + (size_t)pn8 * 128 * 256, 256, ep);
    }
}

constexpr int LDS_HG_SEG = 98304, LDS_HG_LBT = 106496;
struct HgBlk { float bc[4][4]; float kk[4][4]; };
__device__ __forceinline__ void hgrn_lb_table(const Params& p, float* lbt, int tid) {
    const float* lbp = p.in[I_HGRN_LB];
    lbt[tid] = sigmoid_(lbp[512 + tid] - lbp[tid]);
    __syncthreads();
}
__device__ __forceinline__ void hg_block(const bf16_t* __restrict__ fg, const float* lbt, float* seg, int tid, HgBlk& B) {
    const int k0 = (tid & 31) * 4, l0 = (tid >> 5) * 4;
    const f32x4 lb4 = *(const f32x4*)(lbt + k0);
    u32x2 w[4];
#pragma unroll
    for (int i = 0; i < 4; ++i) w[i] = *(const u32x2*)(fg + (size_t)(l0 + i) * PC + k0);
    float run[4] = {1.f, 1.f, 1.f, 1.f};
#pragma unroll
    for (int i = 0; i < 4; ++i) {
        const float x[4] = {bf2f(w[i].x & 0xffffu), bf2f(w[i].x >> 16), bf2f(w[i].y & 0xffffu), bf2f(w[i].y >> 16)};
#pragma unroll
        for (int j = 0; j < 4; ++j) {
            const float lb = lb4[j], sg = fsigmoid_(x[j]), f = lb + (1.f - lb) * sg;
            run[j] *= f; B.bc[i][j] = run[j]; B.kk[i][j] = (1.f - lb) * (1.f - sg);
        }
    }
    *(f32x4*)(seg + (tid >> 5) * 128 + k0) = (f32x4){run[0], run[1], run[2], run[3]};
}
__device__ __forceinline__ void hg_offsets(const float* seg, int tid, HgBlk& B, f32x4& bend) {
    const int k0 = (tid & 31) * 4, ls = tid >> 5;
    f32x4 off = (f32x4){1.f, 1.f, 1.f, 1.f}, tot = off;
#pragma unroll
    for (int r = 0; r < 16; ++r) { const f32x4 v = *(const f32x4*)(seg + r * 128 + k0); if (r < ls) off *= v; tot *= v; }
#pragma unroll
    for (int i = 0; i < 4; ++i)
#pragma unroll
        for (int j = 0; j < 4; ++j) B.bc[i][j] *= off[j];
    bend = tot;
}

__device__ __forceinline__ void phase_cd_local(const Params& p, unsigned char* lds) {
    const int tid = opaque_tid(), lane = tid & 63, wid = tid >> 6, fr = lane & 15, fq = lane >> 4;
    unsigned char* ws = p.ws;
    const bf16_t* PROJ = (const bf16_t*)(ws + WS_PROJ);
    bf16_t* KhT = (bf16_t*)lds;
    bf16_t* Vt = (bf16_t*)(lds + 18432);
    float* seg = (float*)(lds + LDS_HG_SEG); float* lbt = (float*)(lds + LDS_HG_LBT);
    hgrn_lb_table(p, lbt, tid);
    const int k0 = (tid & 31) * 4, l0 = (tid >> 5) * 4;
    const bool s5first = (int)gridDim.x == 256 && (((int)blockIdx.x >> 3) & 1);
    for (int j = 0;; ++j) {
        const int it = s5first ? (j == 0 ? 1024 + (int)blockIdx.x : (int)blockIdx.x + (j - 1) * 256) : (int)blockIdx.x + j * (int)gridDim.x;
        if (s5first ? (j > 0 && it >= 1024) : it >= 1024 + 256) break;
        if (it < 1024) {
            const int b = it >> 8, h = (it >> 6) & 3, c = it & 63, t0 = b * SEQ + c * 64;
            HgBlk B;
            hg_block(PROJ + (size_t)t0 * PC + 1024 + h * 128, lbt + h * 128, seg, tid, B);
            Tile2 rv; tile_load(rv, PROJ + (size_t)t0 * PC + 1536 + h * 128, PC, tid);
            __syncthreads();
            f32x4 bend; hg_offsets(seg, tid, B, bend);
#pragma unroll
            for (int j = 0; j < 4; ++j) {
                u32x2 o; o.x = pk2(B.kk[0][j] * bend[j] * __builtin_amdgcn_rcpf(B.bc[0][j]), B.kk[1][j] * bend[j] * __builtin_amdgcn_rcpf(B.bc[1][j]));
                o.y = pk2(B.kk[2][j] * bend[j] * __builtin_amdgcn_rcpf(B.bc[2][j]), B.kk[3][j] * bend[j] * __builtin_amdgcn_rcpf(B.bc[3][j]));
                *(u32x2*)(KhT + tsw(k0 + j, l0)) = o;
            }
            if (tid < 32) *(f32x4*)((float*)(ws + WS_BENDV) + (size_t)it * 128 + k0) = bend;
            tile_put_rows(rv, Vt, tid);
            __syncthreads();
            state_outer_tr<false>(KhT, Vt, (bf16_t*)(ws + WS_U) + (size_t)it * 16384, wid, fr, fq);
            __syncthreads();
        } else {
            s5_unit_E(p, lds, it - 1024);
        }
    }
}

template <int SEL>
__device__ __forceinline__ void phase_cd_out(const Params& p, unsigned char* lds) {
    const int tid = opaque_tid(), lane = tid & 63, wid = tid >> 6, fr = lane & 15, fq = lane >> 4;
    unsigned char* ws = p.ws;
    const bf16_t* PROJ = (const bf16_t*)(ws + WS_PROJ);
    bf16_t* Qs = (bf16_t*)lds;
    bf16_t* Ks = (bf16_t*)(lds + 17408);
    float* Hs = (float*)lds;
    bf16_t* Vt = (bf16_t*)(lds + 34816);
    bf16_t* Ss = (bf16_t*)(lds + 53248);
    bf16_t* Ps = (bf16_t*)(lds + 88064);
    float* seg = (float*)(lds + LDS_HG_SEG); float* lbt = (float*)(lds + LDS_HG_LBT);
    __syncthreads();
    const int k0 = (tid & 31) * 4, l0 = (tid >> 5) * 4;
    const bool s5first = SEL == 0 && (int)gridDim.x == 256 && (((int)blockIdx.x >> 3) & 1);
    for (int j = 0;; ++j) {
        const int it = s5first ? (j == 0 ? 1024 + (int)blockIdx.x : (int)blockIdx.x + (j - 1) * 256) : (int)blockIdx.x + (SEL == 2 ? 1024 : 0) + j * (int)gridDim.x;
        if (s5first ? (j > 0 && it >= 1024) : it >= (SEL == 1 ? 1024 : 1024 + 256)) break;
        if (it < 1024) {
            const int b = it >> 8, h = (it >> 6) & 3, c = it & 63, t0 = b * SEQ + c * 64;
            HgBlk B;
            hg_block(PROJ + (size_t)t0 * PC + 1024 + h * 128, lbt + h * 128, seg, tid, B);
            u32x2 qw[4];
#pragma unroll
            for (int i = 0; i < 4; ++i) qw[i] = __builtin_nontemporal_load((const u32x2*)(PROJ + (size_t)(t0 + l0 + i) * PC + 512 + h * 128 + k0));
            Tile2 rv; Tile4 rs;
            tile_load<true>(rv, PROJ + (size_t)t0 * PC + 1536 + h * 128, PC, tid);
            tile4_load<true>(rs, (const bf16_t*)(ws + WS_CPREV) + (size_t)it * 16384, tid);
            tile_put_rows(rv, Vt, tid); tile4_put(rs, Ss, tid);
            __syncthreads();
            f32x4 bend; hg_offsets(seg, tid, B, bend);
#pragma unroll
            for (int i = 0; i < 4; ++i) {
                const float q0 = bf2f(qw[i].x & 0xffffu), q1 = bf2f(qw[i].x >> 16), q2 = bf2f(qw[i].y & 0xffffu), q3 = bf2f(qw[i].y >> 16);
                const float e0 = B.bc[i][0], e1 = B.bc[i][1], e2 = B.bc[i][2], e3 = B.bc[i][3];
                u32x2 oq; oq.x = pk2(q0 * e0, q1 * e1); oq.y = pk2(q2 * e2, q3 * e3);
                u32x2 ok; ok.x = pk2(B.kk[i][0] * __builtin_amdgcn_rcpf(e0), B.kk[i][1] * __builtin_amdgcn_rcpf(e1)); ok.y = pk2(B.kk[i][2] * __builtin_amdgcn_rcpf(e2), B.kk[i][3] * __builtin_amdgcn_rcpf(e3));
                *(u32x2*)(Qs + (l0 + i) * 136 + k0) = oq; *(u32x2*)(Ks + (l0 + i) * 136 + k0) = ok;
            }
            __syncthreads();
#pragma unroll
            for (int i = 0; i < 2; ++i) {
                const int tix = wid * 2 + i, lt = tix >> 2, st = tix & 3;
                f32x4 acc = (f32x4){0.f, 0.f, 0.f, 0.f};
                if (st <= lt) {
#pragma unroll
                    for (int ks = 0; ks < 4; ++ks) {
                        const bf16x8 ak = *(const bf16x8*)(Ks + (st * 16 + fr) * 136 + ks * 32 + fq * 8);
                        const bf16x8 bq = *(const bf16x8*)(Qs + (lt * 16 + fr) * 136 + ks * 32 + fq * 8);
                        acc = __builtin_amdgcn_mfma_f32_16x16x32_bf16(ak, bq, acc, 0, 0, 0);
                    }
                }
                const int l = lt * 16 + fr;
                float pv[4];
#pragma unroll
                for (int r = 0; r < 4; ++r) { const int s_ = st * 16 + fq * 4 + r; pv[r] = (s_ <= l) ? acc[r] : 0.f; }
                u32x2 o; o.x = pk2(pv[0], pv[1]); o.y = pk2(pv[2], pv[3]);
                *(u32x2*)(Ps + l * 72 + st * 16 + fq * 4) = o;
            }
            __syncthreads();
            f32x4 a1[4];
#pragma unroll
            for (int lt = 0; lt < 4; ++lt) a1[lt] = (f32x4){0.f, 0.f, 0.f, 0.f};
            {
                const int e0 = wid * 16;
#pragma unroll
                for (int ss = 0; ss < 2; ++ss) {
                    const bf16x8 av = frag_tr(Vt, 136, ss * 32, e0, fr, fq);
#pragma unroll
                    for (int lt = 0; lt < 4; ++lt) { const bf16x8 bp = *(const bf16x8*)(Ps + (lt * 16 + fr) * 72 + ss * 32 + fq * 8); a1[lt] = __builtin_amdgcn_mfma_f32_16x16x32_bf16(av, bp, a1[lt], 0, 0, 0); }
                }
#pragma unroll
                for (int ks = 0; ks < 4; ++ks) {
                    const bf16x8 ac = *(const bf16x8*)(Ss + (e0 + fr) * 136 + ks * 32 + fq * 8);
#pragma unroll
                    for (int lt = 0; lt < 4; ++lt) { const bf16x8 bq = *(const bf16x8*)(Qs + (lt * 16 + fr) * 136 + ks * 32 + fq * 8); a1[lt] = __builtin_amdgcn_mfma_f32_16x16x32_bf16(ac, bq, a1[lt], 0, 0, 0); }
                }
            }
            __syncthreads();
            {
                const int e0 = wid * 16;
#pragma unroll
                for (int lt = 0; lt < 4; ++lt) *(f32x4*)(Hs + (lt * 16 + fr) * 132 + e0 + fq * 4) = a1[lt];
            }
            __syncthreads();
            head_norm_out<1>(Hs, p.in[I_HGRN_ONORM] + h * 128, PROJ + (size_t)t0 * PC + 2048 + h * 128, PC, (bf16_t*)(ws + WS_MIX) + (size_t)t0 * 1024 + 512 + h * 128, 1024, tid);
            __syncthreads();
        } else {
            s5_unit_Y(p, lds, it - 1024);
        }
    }
}

#define XB_TMO      128
#define XB_XCNT(j)  (256  + 64 * (j))
#define XB_XSUB(j)  (1280 + 64 * (j))
#define XB_XGEN(j)  (2304 + 64 * (j))
#define XB_TOP      3328
#define XB_TOPGEN   3392
#define XCD_BAR_WORDS 3456
#define XB_SPIN_CAP (1u << 22)
#define LAS __attribute__((address_space(3)))
constexpr size_t WS_BAR = 4096;
constexpr size_t CTL_ZERO_BYTES = 32768;
static_assert(WS_BAR + XCD_BAR_WORDS * 4 <= CTL_ZERO_BYTES, "barrier words outside the zeroed region");
constexpr int LDS_BAR_OFF = LDS_BYTES - 16;
__device__ __forceinline__ unsigned xb_ld(unsigned* p)              { return __hip_atomic_load(p, __ATOMIC_RELAXED, __HIP_MEMORY_SCOPE_AGENT); }
__device__ __forceinline__ unsigned xb_add(unsigned* p, unsigned v) { return __hip_atomic_fetch_add(p, v, __ATOMIC_RELAXED, __HIP_MEMORY_SCOPE_AGENT); }
__device__ __forceinline__ unsigned xb_xcc_id() { return (unsigned)__builtin_amdgcn_s_getreg((3 << 11) | 20) & 0xFu; }
#define XB_SPIN(cond, bar) do { unsigned _sp = 0; while (cond) { __builtin_amdgcn_s_sleep(1); \
    if ((++_sp & 255u) == 0u) { if (xb_ld(&(bar)[XB_TMO])) break; if (_sp > XB_SPIN_CAP) { atomicAdd(&(bar)[XB_TMO], 1u); break; } } } } while (0)
struct XcdBarrier { unsigned* bar; unsigned x; volatile LAS unsigned* st; };
__device__ __forceinline__ XcdBarrier xcd_barrier_post(unsigned* bar, volatile LAS unsigned* st) {
    XcdBarrier b; b.bar = bar; b.x = xb_xcc_id(); b.st = st;
    if (opaque_tid() == 0) (void)xb_add(&bar[XB_XCNT(b.x)], 1u);
    return b;
}
__device__ __forceinline__ void xcd_barrier_complete(unsigned* bar, unsigned x, unsigned& nloc, unsigned& nx) {
    const unsigned G = gridDim.x * gridDim.y * gridDim.z;
    unsigned sum, cnt, mine, sp = 0u;
    for (;;) {
        sum = 0u; cnt = 0u; mine = 0u;
#pragma unroll
        for (unsigned j = 0; j < 16; ++j) { const unsigned c = xb_ld(&bar[XB_XCNT(j)]); sum += c; cnt += (c > 0u) ? 1u : 0u; mine = (j == x) ? c : mine; }
        if (sum == G) break;
        __builtin_amdgcn_s_sleep(1);
        if ((++sp & 255u) == 0u) { if (xb_ld(&bar[XB_TMO])) break; if (sp > XB_SPIN_CAP) { atomicAdd(&bar[XB_TMO], 1u); break; } }
    }
    nloc = mine > 0u ? mine : 1u; nx = cnt > 0u ? cnt : 1u;
}
__device__ __forceinline__ void xcd_barrier(const XcdBarrier& b) {
    asm volatile("s_waitcnt vmcnt(0)" ::: "memory");
    __syncthreads();
    if (opaque_tid() == 0) {
        unsigned* bar = b.bar;
        __builtin_amdgcn_s_waitcnt(0);
        unsigned nloc = b.st[0], nx = b.st[1];
        if (nloc == 0u) { xcd_barrier_complete(bar, b.x, nloc, nx); b.st[0] = nloc; b.st[1] = nx; }
        const unsigned old = xb_add(&bar[XB_XSUB(b.x)], 1u);
        const unsigned gen = old / nloc;
        if (old + 1u == (gen + 1u) * nloc) {
            __builtin_amdgcn_fence(__ATOMIC_RELEASE, "agent");
            asm volatile("s_waitcnt vmcnt(0)" ::: "memory");
            const unsigned og = xb_add(&bar[XB_TOP], 1u);
            asm volatile("buffer_inv sc1" ::: "memory");
            const unsigned tg = og / nx;
            if (og + 1u == (tg + 1u) * nx) xb_add(&bar[XB_TOPGEN], 1u);
            else XB_SPIN(xb_ld(&bar[XB_TOPGEN]) == tg, bar);
            asm volatile("s_waitcnt vmcnt(0)" ::: "memory");
            xb_add(&bar[XB_XGEN(b.x)], 1u);
            asm volatile("s_waitcnt vmcnt(0)" ::: "memory");
        } else {
            asm volatile("buffer_inv sc1" ::: "memory");
            XB_SPIN(xb_ld(&bar[XB_XGEN(b.x)]) == gen, bar);
            asm volatile("s_waitcnt vmcnt(0)" ::: "memory");
        }
    }
    __syncthreads();
}

constexpr int NPHASE = 20;
constexpr unsigned REP_MASK = 0u;
constexpr int PROBE_SEL = 0;
template <int PH>
__device__ __forceinline__ void run_phase(const Params& p, unsigned char* lds) {
    unsigned char* ws = p.ws;
    if constexpr (PH == 0) phase_prep(p, lds);
    else if constexpr (PH == 1) {
        s5_gen_ktab(p); phase_gemm256_inproj0(lds, p);
        const int G_ = (int)gridDim.x, first = 960 % G_;
        if (first != 0 && (int)blockIdx.x >= first) { __syncthreads(); const int t_ = opaque_tid(); dense_transposes(p, lds, DENSE_IT_WINA, DENSE_IT_TOTAL, ((int)blockIdx.x - first) * 8 + (t_ >> 6), (G_ - first) * 8, t_ >> 6, t_ & 63); }
    }
    else if constexpr (PH == 2) { s5_gen_ops(p); phase_mlstm_local(p, lds); }
    else if constexpr (PH == 3) phase_scan<false>(p, lds);
    else if constexpr (PH == 4) phase_mlstm_out(p, lds);
    else if constexpr (PH == 5) phase_gemm256_resid(lds, (const bf16_t*)(ws + WS_MIX), (const bf16_t*)(ws + WS_WOUTA), nullptr, (const bf16_t*)(ws + WS_H16), (bf16_t*)(ws + WS_H16));
    else if constexpr (PH == 6) phase_route<0>(p, lds, 0);
    else if constexpr (PH == 7) phase_moe_up(p, lds, 0);
    else if constexpr (PH == 8) phase_moe_down(p, lds, 0);
    else if constexpr (PH == 9) phase_combine_norm(p, false);
    else if constexpr (PH == 10) phase_gemm256_inproj1(lds, p);
    else if constexpr (PH == 11) phase_cd_local(p, lds);
    else if constexpr (PH == 12) phase_scan<true>(p, lds);
    else if constexpr (PH == 13) phase_cd_out<0>(p, lds);
    else if constexpr (PH == 14) {
        phase_gemm_glu(lds, p);
        if ((int)blockIdx.x >= 128) { const int t_ = opaque_tid(); moe_convert<false>(p, lds, 1, 0, MOE_CONV_EARLY, ((int)blockIdx.x - 128) * 8 + (t_ >> 6), ((int)gridDim.x - 128) * 8, t_ >> 6, t_ & 63); }
    }
    else if constexpr (PH == 15) phase_gemm256_resid(lds, (const bf16_t*)(ws + WS_MIX), (const bf16_t*)(ws + WS_WOUTC), nullptr, (const bf16_t*)(ws + WS_H16), (bf16_t*)(ws + WS_H16));
    else if constexpr (PH == 16) phase_route<0>(p, lds, 1);
    else if constexpr (PH == 17) phase_moe_up(p, lds, 1);
    else if constexpr (PH == 18) phase_moe_down(p, lds, 1);
    else if constexpr (PH == 19) phase_combine_norm(p, true);
}
template <int PH>
__device__ __forceinline__ void run_from(const Params& p, unsigned char* lds, const XcdBarrier& bar) {
    run_phase<PH>(p, lds);
    if constexpr ((REP_MASK >> PH) & 1u) {
        xcd_barrier(bar);
        if constexpr ((PH == 6 || PH == 16) && PROBE_SEL != 4) { { const int t_ = opaque_tid(); if (blockIdx.x == 0 && t_ < 32) ((int*)(p.ws + WS_CNT))[(PH == 16 ? 1024 : 0) + t_ * 32] = 0; } xcd_barrier(bar); }
        if constexpr (PH == 13 && PROBE_SEL != 0) phase_cd_out<PROBE_SEL>(p, lds); else
        if constexpr (PH == 6 && PROBE_SEL != 0) phase_route<PROBE_SEL>(p, lds, 0); else
        run_phase<PH>(p, lds);
    }
    if constexpr (PH + 1 < NPHASE) {
        xcd_barrier(bar);
        run_from<PH + 1>(p, lds, bar);
    }
}
__global__ void __launch_bounds__(NTHR, 2) mega(Params p) {
    extern __shared__ __attribute__((aligned(16))) unsigned char lds[];
    if (p.use_cg) cg::this_grid().sync();
    { const int t_ = opaque_tid(); if (t_ < 4) ((unsigned*)(lds + LDS_BAR_OFF))[t_] = 0u; }
    __syncthreads();
    const XcdBarrier bar = xcd_barrier_post((unsigned*)(p.ws + WS_BAR), (volatile LAS unsigned*)(lds + LDS_BAR_OFF));
    run_from<0>(p, lds, bar);
}

extern "C" void kernel_launch(void* const* d_in, const int* in_sizes, int n_in, void* d_out, int out_size, void* d_ws, size_t ws_size, hipStream_t stream) {
    static int grid = 0;
    if (grid == 0) {
        if (n_in != 30 || out_size != T * DM || ws_size < WS_END) { fprintf(stderr, "kernel_launch: unexpected shapes (n_in %d out %d ws %zu)\n", n_in, out_size, ws_size); grid = -1; return; }
        int dev = 0, cus = 0, per_cu = 0;
        (void)hipGetDevice(&dev);
        (void)hipDeviceGetAttribute(&cus, hipDeviceAttributeMultiprocessorCount, dev);
        (void)hipFuncSetAttribute((const void*)mega, hipFuncAttributeMaxDynamicSharedMemorySize, LDS_BYTES);
        (void)hipOccupancyMaxActiveBlocksPerMultiprocessor(&per_cu, (const void*)mega, NTHR, LDS_BYTES);
        if (per_cu < 1) { fprintf(stderr, "kernel_launch: occupancy query says %d blocks per CU\n", per_cu); per_cu = 1; }
        grid = cus * 1;
        (void)hipGetLastError();
    }
    if (grid < 0) return;
    Params p{};
    for (int i = 0; i < 30; ++i) p.in[i] = (const float*)d_in[i];
    p.out = (float*)d_out; p.ws = (unsigned char*)d_ws;
    p.use_cg = 0; p.pad = 0;
    (void)hipMemsetAsync((unsigned char*)d_ws + WS_CTL, 0, CTL_ZERO_BYTES, stream);
    void* args[] = {&p};
    hipError_t e = hipLaunchCooperativeKernel((const void*)mega, dim3(grid), dim3(NTHR), args, LDS_BYTES, stream);
    if (e != hipSuccess) fprintf(stderr, "cooperative launch failed: %s (grid %d)\n", hipGetErrorString(e), grid);
}
```
